# Optimizing an MI355X kernel written in HIP

```python
import math
import jax, jax.numpy as jnp
from jax import lax
import numpy as np

D_MODEL = 1024
BATCH = 16
SEQ = 2048
DEPTH = 2

N_META = 16
N_EVEN = (DEPTH + 1) // 2
N_ODD = DEPTH // 2

S5_WIDTH = D_MODEL // 2
S5_GROUP = 16
S5_GROUPS = S5_WIDTH // S5_GROUP
S5_STATE = 64
S5_DT_MIN = 0.001
S5_DT_MAX = 0.1

SB_HEAD_DIM = 64
SB_WIDTH = D_MODEL // 2
SB_HEADS = SB_WIDTH // SB_HEAD_DIM
SB_BLOCK = 128

HG_WIDTH = D_MODEL
HG_DK = 128
HG_HEADS = HG_WIDTH // HG_DK
HG_DV = HG_WIDTH // HG_HEADS
HG_CHUNK = 64

D_FF = 4 * D_MODEL
IN_AB = S5_WIDTH + 3 * SB_WIDTH
IN_C = 4 * HG_WIDTH

ALPHA = (2.0 * DEPTH) ** 0.25
BETA = (8.0 * DEPTH) ** -0.25
LN_EPS = 1e-5
RMS_EPS = 1e-6

kernel_name = 'hybrid_s5_stickbreak_hgrn2_deepnorm_meta'


def layer_norm(x, g, b):
    xf = x.astype(jnp.float32)
    mu = jnp.mean(xf, axis=-1, keepdims=True)
    var = jnp.mean(jnp.square(xf - mu), axis=-1, keepdims=True)
    return (xf - mu) * lax.rsqrt(var + LN_EPS) * g + b


def s5_mixer(u, lam_re, lam_im, log_dt, b_re, b_im, c_re, c_im, d, w_glu, b_glu):
    bn, seq_len, _ = u.shape
    f32 = jnp.float32
    uf = u.astype(f32).reshape(bn, seq_len, S5_GROUPS, S5_GROUP)
    lam = lax.complex(lam_re.astype(f32), lam_im.astype(f32))
    dt = jnp.exp(log_dt.astype(f32))[:, None]
    lam_bar = jnp.exp(lam * dt)
    b_mat = lax.complex(b_re.astype(f32), b_im.astype(f32))
    b_bar = ((lam_bar - 1.0) / lam)[:, :, None] * b_mat
    bu = jnp.einsum('blgh,gph->blgp', uf.astype(jnp.complex64), b_bar)
    a = jnp.broadcast_to(lam_bar, (1, seq_len) + lam_bar.shape)

    def combine(left, right):
        a_l, s_l = left
        a_r, s_r = right
        return a_r * a_l, a_r * s_l + s_r

    _, states = lax.associative_scan(combine, (a, bu), axis=1)
    c_mat = lax.complex(c_re.astype(f32), c_im.astype(f32))
    y = jnp.real(jnp.einsum('blgp,ghp->blgh', states, c_mat)) + d.astype(f32) * uf
    y = jax.nn.gelu(y.reshape(bn, seq_len, S5_WIDTH))
    return y * jax.nn.sigmoid(y @ w_glu + b_glu)


def _stick_breaking_block(qb, kb, vb, start):
    z = jnp.einsum('bhqd,bhkd->bhqk', qb, kb)
    nq = qb.shape[2]
    nk = kb.shape[2]
    visible = jnp.arange(nk)[None, :] < (start + jnp.arange(nq))[:, None]
    log_keep = jnp.where(visible, jax.nn.log_sigmoid(-z), 0.0)
    later = lax.cumsum(log_keep, axis=3, reverse=True) - log_keep
    w = jnp.where(visible, jnp.exp(jax.nn.log_sigmoid(z) + later), 0.0)
    return jnp.einsum('bhqk,bhkd->bhqd', w, vb)


def stick_breaking_attention(q, k, v):
    bn, seq_len = q.shape[0], q.shape[1]
    f32 = jnp.float32
    q = q.astype(f32).transpose(0, 2, 1, 3) * (SB_HEAD_DIM ** -0.5)
    k = k.astype(f32).transpose(0, 2, 1, 3)
    v = v.astype(f32).transpose(0, 2, 1, 3)
    blocks = [(0, N_META)] + [(N_META + i * SB_BLOCK, SB_BLOCK)
                              for i in range((seq_len - N_META) // SB_BLOCK)]
    outs = [_stick_breaking_block(q[:, :, s:s + n], k[:, :, :s + n], v[:, :, :s + n], s)
            for s, n in blocks]
    o = jnp.concatenate(outs, axis=2)
    return o.transpose(0, 2, 1, 3).reshape(bn, seq_len, SB_HEADS * SB_HEAD_DIM)


def hgrn_lower_bound(gamma, layer):
    p = jax.nn.softmax(gamma.astype(jnp.float32), axis=0)
    return (jnp.cumsum(p, axis=0) - p[0])[layer]


def _to_chunks(t, n_chunks):
    bn, _, nh, dd = t.shape
    return t.reshape(bn, n_chunks, HG_CHUNK, nh, dd).transpose(1, 0, 3, 2, 4)


def hgrn2_mixer(q, f_pre, i_in, g, lb, norm_g):
    bn, seq_len, _ = q.shape
    f32 = jnp.float32
    f = lb + (1.0 - lb) * jax.nn.sigmoid(f_pre.astype(f32))
    log_f = jnp.log(f)
    k = 1.0 - f
    pad = HG_CHUNK - N_META
    n_chunks = (seq_len + pad) // HG_CHUNK

    def heads(t, dd):
        t = t.astype(f32).reshape(bn, seq_len, HG_HEADS, dd)
        return _to_chunks(jnp.pad(t, ((0, 0), (pad, 0), (0, 0), (0, 0))), n_chunks)

    qh, kh, vh, lh = heads(q, HG_DK), heads(k, HG_DK), heads(i_in, HG_DV), heads(log_f, HG_DK)
    causal = jnp.tril(jnp.ones((HG_CHUNK, HG_CHUNK), dtype=bool))

    def step(state, xs):
        qc, kc, vc, lc = xs
        b = jnp.cumsum(lc, axis=2)
        b_last = b[:, :, -1:, :]
        q_dec = qc * jnp.exp(b)
        scores = jnp.einsum('bhtd,bhsd->bhts', q_dec, kc * jnp.exp(-b))
        scores = jnp.where(causal, scores, 0.0)
        o = (jnp.einsum('bhts,bhse->bhte', scores, vc)
             + jnp.einsum('bhtd,bhde->bhte', q_dec, state))
        state = (jnp.exp(b_last[:, :, 0, :])[..., None] * state
                 + jnp.einsum('bhsd,bhse->bhde', kc * jnp.exp(b_last - b), vc))
        return state, o

    s0 = jnp.zeros((bn, HG_HEADS, HG_DK, HG_DV), f32)
    _, o = lax.scan(step, s0, (qh, kh, vh, lh))
    o = o.transpose(1, 0, 3, 2, 4).reshape(bn, seq_len + pad, HG_HEADS, HG_DV)[:, pad:]
    o = o * lax.rsqrt(jnp.mean(jnp.square(o), axis=-1, keepdims=True) + RMS_EPS)
    o = o * norm_g.astype(f32).reshape(HG_HEADS, HG_DV)
    return o.reshape(bn, seq_len, HG_WIDTH) * jax.nn.silu(g.astype(f32))


def setup_inputs(seed: int = 0) -> dict:
    key = jax.random.key(seed)
    ks = jax.random.split(key, 32)
    f32 = jnp.float32
    nrm = lambda k, shape, scale: jax.random.normal(k, shape, f32) * scale
    n_arange = jnp.pi * jnp.arange(S5_STATE, dtype=f32)
    return {
        'x': nrm(ks[0], (BATCH, SEQ, D_MODEL), 1.0),
        'meta': nrm(ks[1], (N_META, D_MODEL), 1.0),
        'w_in_ab': nrm(ks[2], (N_EVEN, D_MODEL, IN_AB), D_MODEL ** -0.5),
        's5_lam_re': -0.5 * jnp.exp(nrm(ks[3], (N_EVEN, S5_GROUPS, S5_STATE), 0.05)),
        's5_lam_im': n_arange + nrm(ks[4], (N_EVEN, S5_GROUPS, S5_STATE), 0.01),
        's5_log_dt': jax.random.uniform(ks[5], (N_EVEN, S5_GROUPS), f32,
                                        minval=math.log(S5_DT_MIN), maxval=math.log(S5_DT_MAX)),
        's5_b_re': nrm(ks[6], (N_EVEN, S5_GROUPS, S5_STATE, S5_GROUP), (2.0 * S5_GROUP) ** -0.5),
        's5_b_im': nrm(ks[7], (N_EVEN, S5_GROUPS, S5_STATE, S5_GROUP), (2.0 * S5_GROUP) ** -0.5),
        's5_c_re': nrm(ks[8], (N_EVEN, S5_GROUPS, S5_GROUP, S5_STATE), S5_STATE ** -0.5),
        's5_c_im': nrm(ks[9], (N_EVEN, S5_GROUPS, S5_GROUP, S5_STATE), S5_STATE ** -0.5),
        's5_d': nrm(ks[10], (N_EVEN, S5_GROUPS, S5_GROUP), 1.0),
        's5_w_glu': nrm(ks[11], (N_EVEN, S5_WIDTH, S5_WIDTH), S5_WIDTH ** -0.5),
        's5_b_glu': nrm(ks[12], (N_EVEN, S5_WIDTH), 0.01),
        'w_out_ab': nrm(ks[13], (N_EVEN, S5_WIDTH + SB_WIDTH, D_MODEL), BETA * (S5_WIDTH + SB_WIDTH) ** -0.5),
        'w_in_c': nrm(ks[14], (N_ODD, D_MODEL, IN_C), D_MODEL ** -0.5),
        'hgrn_gamma': nrm(ks[15], (DEPTH, HG_WIDTH), 0.1),
        'hgrn_norm_g': 1.0 + nrm(ks[16], (N_ODD, HG_WIDTH), 0.01),
        'w_out_c': nrm(ks[17], (N_ODD, HG_WIDTH, D_MODEL), BETA * HG_WIDTH ** -0.5),
        'ln_mix_g': 1.0 + nrm(ks[18], (DEPTH, D_MODEL), 0.01),
        'ln_mix_b': nrm(ks[19], (DEPTH, D_MODEL), 0.01),
        'mlp_w_up': nrm(ks[20], (DEPTH, D_MODEL, D_FF), D_MODEL ** -0.5),
        'mlp_b_up': nrm(ks[21], (DEPTH, D_FF), 0.01),
        'mlp_w_down': nrm(ks[22], (DEPTH, D_FF, D_MODEL), BETA * D_FF ** -0.5),
        'mlp_b_down': nrm(ks[23], (DEPTH, D_MODEL), 0.01),
        'ln_mlp_g': 1.0 + nrm(ks[24], (DEPTH, D_MODEL), 0.01),
        'ln_mlp_b': nrm(ks[25], (DEPTH, D_MODEL), 0.01),
    }


def reference(x, meta, w_in_ab, s5_lam_re, s5_lam_im, s5_log_dt, s5_b_re, s5_b_im, s5_c_re, s5_c_im,
              s5_d, s5_w_glu, s5_b_glu, w_out_ab, w_in_c, hgrn_gamma, hgrn_norm_g, w_out_c,
              ln_mix_g, ln_mix_b, mlp_w_up, mlp_b_up, mlp_w_down, mlp_b_down, ln_mlp_g, ln_mlp_b):
    bn = x.shape[0]
    h = jnp.concatenate([jnp.broadcast_to(meta.astype(x.dtype)[None], (bn, N_META, D_MODEL)), x], axis=1)
    seq_len = h.shape[1]
    for layer in range(DEPTH):
        if layer % 2 == 0:
            e = layer // 2
            proj = h @ w_in_ab[e]
            u = proj[..., :S5_WIDTH]
            qkv = proj[..., S5_WIDTH:].reshape(bn, seq_len, 3, SB_HEADS, SB_HEAD_DIM)
            a_out = s5_mixer(u, s5_lam_re[e], s5_lam_im[e], s5_log_dt[e], s5_b_re[e], s5_b_im[e],
                             s5_c_re[e], s5_c_im[e], s5_d[e], s5_w_glu[e], s5_b_glu[e])
            b_out = stick_breaking_attention(qkv[:, :, 0], qkv[:, :, 1], qkv[:, :, 2])
            mix = jnp.concatenate([a_out, b_out], axis=-1) @ w_out_ab[e]
        else:
            o_idx = layer // 2
            proj = h @ w_in_c[o_idx]
            q, f_pre, i_in, g = jnp.split(proj, 4, axis=-1)
            lb = hgrn_lower_bound(hgrn_gamma, layer)
            mix = hgrn2_mixer(q, f_pre, i_in, g, lb, hgrn_norm_g[o_idx]) @ w_out_c[o_idx]
        h = layer_norm(ALPHA * h + mix, ln_mix_g[layer], ln_mix_b[layer])
        hid = jnp.square(jax.nn.relu(h @ mlp_w_up[layer] + mlp_b_up[layer]))
        h = layer_norm(ALPHA * h + hid @ mlp_w_down[layer] + mlp_b_down[layer],
                       ln_mlp_g[layer], ln_mlp_b[layer])
    return h[:, N_META:, :]
```

```cpp
#include <hip/hip_runtime.h>
#include <hip/hip_cooperative_groups.h>
#include <cstdio>
#include <cstdint>
namespace cg = cooperative_groups;
namespace pg8 {
#define PG8_LAS __attribute__((address_space(3)))
typedef unsigned short bf16_t;
typedef short bf16x8 __attribute__((ext_vector_type(8)));
typedef float f32x4 __attribute__((ext_vector_type(4)));
typedef unsigned u32x4 __attribute__((ext_vector_type(4)));
constexpr int BM = 256, BK = 64, HALF = 128, HTB = HALF * BK * 2  , STAGE_BYTES = 8 * HTB, NXCD = 8, WGM = 8;

__host__ __device__ __forceinline__ int lds_byte(int r, int c) { const int st = (r >> 4) * 2 + (c >> 5), rr = r & 15, cc = c & 31, ob = rr * 64 + cc * 2; return st * 1024 + (ob ^ (((ob >> 9) & 1) << 5)); }
__host__ __device__ __forceinline__ void stage_rc(int b, int& R, int& C) { const int st = b / 1024, sb = b % 1024, swz = sb ^ (((sb >> 9) & 1) << 5); R = (st >> 1) * 16 + swz / 64; C = (st & 1) * 32 + (swz % 64) / 2; }
__host__ __device__ __forceinline__ int perm32(int rho) { const int n = rho >> 4, i = rho & 15; return 8 * (i >> 2) + 4 * n + (i & 3); }

struct Unit { int pm, pn; };
struct Gemm { const bf16_t* A; const bf16_t* Bt; int M, N, K; };

struct StaticOrder {
    int nM, nN, nwg, G, c;
    __host__ __device__ void init(int M, int N, int G_, int c_) { nM = M / BM; nN = N / BM; nwg = nM * nN; G = G_; c = c_; }
    __host__ __device__ bool next(int i, Unit& u) const {
        const long L = (long)i * G + c; if (L >= nwg) return false;
        int wgid = (int)L; { const int q = nwg / NXCD, r = nwg % NXCD, xcd = wgid % NXCD, off = wgid / NXCD; wgid = (xcd < r ? xcd * (q + 1) : r * (q + 1) + (xcd - r) * q) + off; }
        const int nig = WGM * nN, gid = wgid / nig, fm = gid * WGM, gsz = (nM - fm) < WGM ? (nM - fm) : WGM;
        u.pm = fm + ((wgid % nig) % gsz); u.pn = (wgid % nig) / gsz; return true;
    }
    __device__ __forceinline__ void a_ready(const Unit&) const {}
    __device__ __forceinline__ void done(const Unit&) const {}
};

__device__ __forceinline__ unsigned cvt_pk_bf16(float lo, float hi) { unsigned r; asm volatile("v_cvt_pk_bf16_f32 %0, %1, %2" : "=v"(r) : "v"(lo), "v"(hi)); return r; }
template <class Epi, class Sched, bool ALIGN_EPI = false, bool SP2 = false>
__device__ __forceinline__ void gemm_phase(PG8_LAS unsigned char* lds, const Gemm g, const Sched& S, const Epi& E) {
    const int tid = threadIdx.x, wid = __builtin_amdgcn_readfirstlane(tid >> 6), lane = tid & 63, wr = wid >> 2, wc = wid & 3, fr = lane & 15, fq = lane >> 4;
    const int K = g.K, nt = K / BK;
    unsigned voffA[2], voffB[2];
#pragma unroll
    for (int i = 0; i < 2; ++i) { int R, C; stage_rc(tid * 16 + i * 8192, R, C); const int Rb = Epi::PERM ? ((R & ~31) + perm32(R & 31)) : R;
        voffA[i] = (unsigned)(R * K + C) * 2u; voffB[i] = (unsigned)(Rb * K + C) * 2u; }
    const size_t kstep = (size_t)(BK * 2);
    const size_t hstep = (size_t)HALF * K * 2;
    const size_t tstep = 2 * hstep;
    const unsigned ldsw = (unsigned)wid * 1024u;
    const int aoff = lds_byte(wr * 64 + fr, fq * 8), boff = lds_byte(wc * 32 + fr, fq * 8);
#define PG8_SA(b, h) (((b) * 2 + (h)) * HTB)
#define PG8_SB(b, h) ((4 + (b) * 2 + (h)) * HTB)
#define PG8_STAGE(bufoff, gbase, voff) do { _Pragma("unroll") for (int _i = 0; _i < 2; ++_i) \
        __builtin_amdgcn_global_load_lds((const unsigned*)((const char*)(gbase) + (voff)[_i]), (PG8_LAS unsigned*)(lds + (bufoff) + ldsw + _i * 8192), 16, 0, 0); } while (0)
#define PG8_LDA(dst, b, h) do { _Pragma("unroll") for (int m = 0; m < 4; ++m) _Pragma("unroll") for (int k = 0; k < 2; ++k) dst[m][k] = *(const PG8_LAS bf16x8*)(lds + PG8_SA(b, h) + aoff + m * 2048 + k * 1024); } while (0)
#define PG8_LDB(dst, b, h) do { _Pragma("unroll") for (int n = 0; n < 2; ++n) _Pragma("unroll") for (int k = 0; k < 2; ++k) dst[n][k] = *(const PG8_LAS bf16x8*)(lds + PG8_SB(b, h) + boff + n * 2048 + k * 1024); } while (0)
#define PG8_MMA(ai, bj, At, Bt) do { __builtin_amdgcn_s_setprio(1); _Pragma("unroll") for (int m = 0; m < 4; ++m) _Pragma("unroll") for (int n = 0; n < 2; ++n) _Pragma("unroll") for (int k = 0; k < 2; ++k) \
        acc[ai][bj][m][n] = __builtin_amdgcn_mfma_f32_16x16x32_bf16(Bt[n][k], At[m][k], acc[ai][bj][m][n], 0, 0, 0); __builtin_amdgcn_s_setprio(0); } while (0)
#define PG8_WAIT_V(n) asm volatile("s_waitcnt vmcnt(" #n ")" ::: "memory")
#define PG8_WAIT_L(n) asm volatile("s_waitcnt lgkmcnt(" #n ")" ::: "memory")
#define PG8_BAR __builtin_amdgcn_s_barrier()
#define PG8_SCHED __builtin_amdgcn_sched_barrier(0)
    Unit cur, nxt; int ui = 0;
    if (!S.next(0, cur)) return;
    f32x4 acc[2][2][4][2];
#pragma unroll
    for (int a = 0; a < 2; ++a)
#pragma unroll
        for (int b = 0; b < 2; ++b)
#pragma unroll
            for (int m = 0; m < 4; ++m)
#pragma unroll
                for (int n = 0; n < 2; ++n) acc[a][b][m][n] = (f32x4){0.f, 0.f, 0.f, 0.f};
    bf16x8 At[4][2], B0[2][2], B1[2][2];
    const char* cA = (const char*)g.A + (size_t)cur.pm * tstep; const char* cB = (const char*)g.Bt + (size_t)cur.pn * tstep;
    S.a_ready(cur);
    if constexpr (SP2) {
        PG8_STAGE(PG8_SB(0, 0), cB, voffB); PG8_STAGE(PG8_SB(0, 1), cB + hstep, voffB); PG8_STAGE(PG8_SA(0, 0), cA, voffA); PG8_STAGE(PG8_SA(0, 1), cA + hstep, voffA);
        if (wr == 1) PG8_BAR;
        PG8_WAIT_V(2); PG8_BAR;
        PG8_STAGE(PG8_SB(1, 0), cB + kstep, voffB); PG8_STAGE(PG8_SA(1, 0), cA + kstep, voffA); PG8_STAGE(PG8_SB(1, 1), cB + hstep + kstep, voffB);
        PG8_WAIT_V(6); PG8_BAR;
    } else {
        PG8_STAGE(PG8_SB(0, 0), cB, voffB); PG8_STAGE(PG8_SA(0, 0), cA, voffA); PG8_STAGE(PG8_SB(0, 1), cB + hstep, voffB); PG8_STAGE(PG8_SA(0, 1), cA + hstep, voffA);
        if (wr == 1) PG8_BAR;
        PG8_WAIT_V(4); PG8_BAR;
        PG8_STAGE(PG8_SB(1, 0), cB + kstep, voffB); PG8_STAGE(PG8_SA(1, 0), cA + kstep, voffA); PG8_STAGE(PG8_SB(1, 1), cB + hstep + kstep, voffB);
        PG8_WAIT_V(6); PG8_BAR;
    }
    for (;;) {
        const bool has_next = S.next(ui + 1, nxt);
        const char* nA = has_next ? (const char*)g.A + (size_t)nxt.pm * tstep : cA; const char* nB = has_next ? (const char*)g.Bt + (size_t)nxt.pn * tstep : cB;
        for (int t = 0; t < nt; t += 2) {
            const bool last = (t == nt - 2);
            const char* a1 = cA + (size_t)(t + 1) * kstep;
            const char* a2 = last ? nA : cA + (size_t)(t + 2) * kstep; const char* b2 = last ? nB : cB + (size_t)(t + 2) * kstep;
            const char* a3 = a2 + kstep; const char* b3 = b2 + kstep;
            if (last && has_next) S.a_ready(nxt);
            if constexpr (SP2) {
            PG8_LDB(B0, 0, 0); PG8_LDB(B1, 0, 1); PG8_SCHED; PG8_LDA(At, 0, 0); PG8_STAGE(PG8_SA(1, 1), a1 + hstep, voffA);
            PG8_WAIT_V(8); PG8_WAIT_L(0); PG8_BAR; PG8_MMA(0, 0, At, B0); PG8_MMA(0, 1, At, B1); PG8_BAR; PG8_SCHED;
            PG8_LDA(At, 0, 1); PG8_STAGE(PG8_SB(0, 0), b2, voffB); PG8_STAGE(PG8_SB(0, 1), b2 + hstep, voffB); PG8_STAGE(PG8_SA(0, 0), a2, voffA);
            PG8_WAIT_V(8); PG8_WAIT_L(0); PG8_BAR; PG8_MMA(1, 0, At, B0); PG8_MMA(1, 1, At, B1); PG8_BAR; PG8_SCHED;
            PG8_LDB(B0, 1, 0); PG8_LDB(B1, 1, 1); PG8_SCHED; PG8_LDA(At, 1, 0); PG8_STAGE(PG8_SA(0, 1), a2 + hstep, voffA);
            PG8_WAIT_V(8); PG8_WAIT_L(0); PG8_BAR; PG8_MMA(0, 0, At, B0); PG8_MMA(0, 1, At, B1); PG8_BAR; PG8_SCHED;
            PG8_LDA(At, 1, 1); PG8_STAGE(PG8_SB(1, 0), b3, voffB); PG8_STAGE(PG8_SB(1, 1), b3 + hstep, voffB); PG8_STAGE(PG8_SA(1, 0), a3, voffA);
            PG8_WAIT_V(8); PG8_WAIT_L(0); PG8_BAR; PG8_MMA(1, 0, At, B0); PG8_MMA(1, 1, At, B1); PG8_BAR; PG8_SCHED;
            } else {
            PG8_LDB(B0, 0, 0); PG8_SCHED; PG8_LDA(At, 0, 0); PG8_STAGE(PG8_SA(1, 1), a1 + hstep, voffA);
            PG8_WAIT_L(8); PG8_BAR; PG8_WAIT_L(0); PG8_MMA(0, 0, At, B0); PG8_BAR; PG8_SCHED;
            PG8_LDB(B1, 0, 1); PG8_STAGE(PG8_SB(0, 0), b2, voffB);
            PG8_BAR; PG8_WAIT_L(0); PG8_MMA(0, 1, At, B1); PG8_BAR;
            PG8_LDA(At, 0, 1); PG8_STAGE(PG8_SA(0, 0), a2, voffA);
            PG8_BAR; PG8_WAIT_L(0); PG8_MMA(1, 0, At, B0); PG8_BAR; PG8_SCHED;
            PG8_STAGE(PG8_SB(0, 1), b2 + hstep, voffB);
            PG8_WAIT_V(6); PG8_BAR; PG8_MMA(1, 1, At, B1); PG8_BAR;
            PG8_LDB(B0, 1, 0); PG8_SCHED; PG8_LDA(At, 1, 0); PG8_STAGE(PG8_SA(0, 1), a2 + hstep, voffA);
            PG8_WAIT_L(8); PG8_BAR; PG8_WAIT_L(0); PG8_MMA(0, 0, At, B0); PG8_BAR; PG8_SCHED;
            PG8_LDB(B1, 1, 1); PG8_STAGE(PG8_SB(1, 0), b3, voffB);
            PG8_BAR; PG8_WAIT_L(0); PG8_MMA(0, 1, At, B1); PG8_BAR;
            PG8_LDA(At, 1, 1); PG8_STAGE(PG8_SA(1, 0), a3, voffA);
            PG8_BAR; PG8_WAIT_L(0); PG8_MMA(1, 0, At, B0); PG8_BAR; PG8_SCHED;
            PG8_STAGE(PG8_SB(1, 1), b3 + hstep, voffB);
            PG8_WAIT_V(6); PG8_BAR; PG8_MMA(1, 1, At, B1); PG8_BAR;
            }
        }
        if constexpr (ALIGN_EPI) { if (wr == 0) PG8_BAR; }
        if constexpr (!Epi::AFTER_DRAIN) { E(acc, cur, wr, wc, fr, fq); S.done(cur); }
        if (!has_next) break;
#pragma unroll
        for (int a = 0; a < 2; ++a)
#pragma unroll
            for (int b = 0; b < 2; ++b)
#pragma unroll
                for (int m = 0; m < 4; ++m)
#pragma unroll
                    for (int n = 0; n < 2; ++n) acc[a][b][m][n] = (f32x4){0.f, 0.f, 0.f, 0.f};
        cur = nxt; cA = nA; cB = nB; ++ui;
        if constexpr (ALIGN_EPI) { if (wr == 1) PG8_BAR; }
    }
    PG8_WAIT_V(0);
    if constexpr (!ALIGN_EPI) { if (wr == 0) PG8_BAR; }
    PG8_BAR;
    if constexpr (Epi::AFTER_DRAIN) { E.fused(acc, cur, wr, wc, fr, fq, lds, wid, lane); S.done(cur); }
#undef PG8_SA
#undef PG8_SB
#undef PG8_STAGE
#undef PG8_LDA
#undef PG8_LDB
#undef PG8_MMA
#undef PG8_WAIT_V
#undef PG8_WAIT_L
#undef PG8_BAR
#undef PG8_SCHED
}
}

#define LAS __attribute__((address_space(3)))
typedef unsigned short bf16_t;
typedef short bf16x8 __attribute__((ext_vector_type(8)));
typedef short s16x4 __attribute__((ext_vector_type(4)));
typedef float f32x4 __attribute__((ext_vector_type(4)));
typedef float f32x16 __attribute__((ext_vector_type(16)));
typedef unsigned u32x4 __attribute__((ext_vector_type(4)));
typedef unsigned u32x2 __attribute__((ext_vector_type(2)));

constexpr int T = 16 * 2048;
constexpr int NMETA = 16;
constexpr int R = T + NMETA;
constexpr int DM = 1024, DFF = 4096;
constexpr float ALPHA = 1.4142135623730951f;
constexpr float QSCALE = 0.125f * 1.4426950408889634f;

constexpr size_t SZ_WAB = (size_t)2048 * 1024 * 2, SZ_WGLU = (size_t)512 * 512 * 2, SZ_W1M = (size_t)1024 * 1024 * 2, SZ_W4M = (size_t)4096 * 1024 * 2;
constexpr size_t OFF_WAB = 0, OFF_WGLU = OFF_WAB + SZ_WAB, OFF_WOAB = OFF_WGLU + SZ_WGLU, OFF_WC = OFF_WOAB + SZ_W1M, OFF_WOC = OFF_WC + SZ_W4M,
                 OFF_WUP0 = OFF_WOC + SZ_W1M, OFF_WUP1 = OFF_WUP0 + SZ_W4M, OFF_WDN0 = OFF_WUP1 + SZ_W4M, OFF_WDN1 = OFF_WDN0 + SZ_W4M,
                 OFF_HB = OFF_WDN1 + SZ_W4M, OFF_Z = OFF_HB + (size_t)R * 1024 * 2, OFF_BIG = OFF_Z + (size_t)R * 1024 * 4, WS_END = OFF_BIG + (size_t)R * 4096 * 2;
constexpr size_t BIG_PROJ = 0, BIG_APRE = (size_t)R * 2048 * 2, BIG_CAT = BIG_APRE + (size_t)R * 512 * 2;

struct Params { const float* in[26]; float* out; unsigned char* ws; };

__device__ __forceinline__ unsigned pk2(float lo, float hi) {
    typedef __bf16 bf2 __attribute__((ext_vector_type(2)));
    typedef float fl2 __attribute__((ext_vector_type(2)));
    fl2 v = {lo, hi}; bf2 r = __builtin_convertvector(v, bf2); return __builtin_bit_cast(unsigned, r);
}
__device__ __forceinline__ bf16_t f2bf(float x) { return (bf16_t)(pk2(x, 0.f) & 0xffffu); }
__device__ __forceinline__ float bf2f(bf16_t v) { return __uint_as_float((unsigned)v << 16); }
__device__ __forceinline__ float bflo(unsigned w) { return __uint_as_float(w << 16); }
__device__ __forceinline__ float bfhi(unsigned w) { return __uint_as_float(w & 0xffff0000u); }
__device__ __forceinline__ float sigmoidf_(float x) { return 1.0f / (1.0f + __expf(-x)); }
#define LDS_WAIT() asm volatile("s_waitcnt lgkmcnt(0)" ::: "memory")
#define MFMA16(a, b, c) __builtin_amdgcn_mfma_f32_16x16x32_bf16((a), (b), (c), 0, 0, 0)
#define MFMA32(a, b, c) __builtin_amdgcn_mfma_f32_32x32x16_bf16((a), (b), (c), 0, 0, 0)

struct EpInAB {
    bf16_t* O;
    __device__ __forceinline__ void apply8(int row, int col, f32x4 a, f32x4 b) const {
        const float s = (col >= 512 && col < 1024) ? QSCALE : 1.0f;
        u32x4 w; w.x = pk2(a[0] * s, a[1] * s); w.y = pk2(a[2] * s, a[3] * s); w.z = pk2(b[0] * s, b[1] * s); w.w = pk2(b[2] * s, b[3] * s);
        *(u32x4*)(O + (size_t)row * 2048 + col) = w;
    }
};
struct EpGlu {
    const bf16_t* APRE; const float* bias; bf16_t* CAT;
    __device__ __forceinline__ void apply8(int row, int col, f32x4 a, f32x4 b) const {
        const u32x4 ap = *(const u32x4*)(APRE + (size_t)row * 512 + col);
        const f32x4 b0 = *(const f32x4*)(bias + col), b1 = *(const f32x4*)(bias + col + 4);
        float v[8] = {a[0] + b0[0], a[1] + b0[1], a[2] + b0[2], a[3] + b0[3], b[0] + b1[0], b[1] + b1[1], b[2] + b1[2], b[3] + b1[3]};
        float y[8] = {bflo(ap.x), bfhi(ap.x), bflo(ap.y), bfhi(ap.y), bflo(ap.z), bfhi(ap.z), bflo(ap.w), bfhi(ap.w)};
#pragma unroll
        for (int i = 0; i < 8; ++i) y[i] = y[i] * sigmoidf_(v[i]);
        u32x4 w; w.x = pk2(y[0], y[1]); w.y = pk2(y[2], y[3]); w.z = pk2(y[4], y[5]); w.w = pk2(y[6], y[7]);
        *(u32x4*)(CAT + (size_t)row * 1024 + col) = w;
    }
};
struct EpRes {
    const float* base; const float* base_meta; float* Z; const float* bias;
    __device__ __forceinline__ void apply8(int row, int col, f32x4 a, f32x4 b) const {
        const float* bp = (base_meta && row >= T) ? base_meta + (size_t)(row - T) * 1024 + col : base + (size_t)row * 1024 + col;
        const f32x4 h0 = *(const f32x4*)bp, h1 = *(const f32x4*)(bp + 4);
        f32x4 o0 = h0 * ALPHA + a, o1 = h1 * ALPHA + b;
        if (bias) { o0 += *(const f32x4*)(bias + col); o1 += *(const f32x4*)(bias + col + 4); }
        float* zp = Z + (size_t)row * 1024 + col;
        *(f32x4*)zp = o0; *(f32x4*)(zp + 4) = o1;
    }
};
struct EpUp {
    bf16_t* H; const float* bias;
    __device__ __forceinline__ void apply8(int row, int col, f32x4 a, f32x4 b) const {
        f32x4 v0 = a + *(const f32x4*)(bias + col), v1 = b + *(const f32x4*)(bias + col + 4);
#pragma unroll
        for (int i = 0; i < 4; ++i) { v0[i] = fmaxf(v0[i], 0.f); v0[i] *= v0[i]; v1[i] = fmaxf(v1[i], 0.f); v1[i] *= v1[i]; }
        u32x4 w; w.x = pk2(v0[0], v0[1]); w.y = pk2(v0[2], v0[3]); w.z = pk2(v1[0], v1[1]); w.w = pk2(v1[2], v1[3]);
        *(u32x4*)(H + (size_t)row * 4096 + col) = w;
    }
};
struct EpInC {
    unsigned short* PC; const float* gamma;
    __device__ __forceinline__ void apply8(int row, int col, f32x4 a, f32x4 b) const {
        u32x4 w;
        if (col >= 1024 && col < 2048) {
            const int c = col - 1024;
            float v[8] = {a[0], a[1], a[2], a[3], b[0], b[1], b[2], b[3]};
            unsigned short h[8];
#pragma unroll
            for (int i = 0; i < 8; ++i) {
                const float lb = 1.0f / (1.0f + __expf(gamma[c + i] - gamma[1024 + c + i]));
                const float f = lb + (1.0f - lb) * sigmoidf_(v[i]);
                const _Float16 hf = (_Float16)__logf(f);
                h[i] = __builtin_bit_cast(unsigned short, hf);
            }
            w.x = h[0] | ((unsigned)h[1] << 16); w.y = h[2] | ((unsigned)h[3] << 16); w.z = h[4] | ((unsigned)h[5] << 16); w.w = h[6] | ((unsigned)h[7] << 16);
        } else { w.x = pk2(a[0], a[1]); w.y = pk2(a[2], a[3]); w.z = pk2(b[0], b[1]); w.w = pk2(b[2], b[3]); }
        *(u32x4*)(PC + (size_t)row * 4096 + col) = w;
    }
};
template <class F> struct EpiAdapt {
    static constexpr bool PERM = true, AFTER_DRAIN = false; F f;
    __device__ __forceinline__ void operator()(const f32x4 (&acc)[2][2][4][2], const pg8::Unit& u, int wr, int wc, int fr, int fq) const {
#pragma unroll
        for (int ai = 0; ai < 2; ++ai)
#pragma unroll
            for (int m = 0; m < 4; ++m) {
                const int row = u.pm * 256 + ai * 128 + wr * 64 + m * 16 + fr;
#pragma unroll
                for (int bj = 0; bj < 2; ++bj) f.apply8(row, u.pn * 256 + bj * 128 + wc * 32 + 8 * fq, acc[ai][bj][m][0], acc[ai][bj][m][1]);
                asm volatile("" ::: "memory");
            }
    }
};
template <class F> __device__ __forceinline__ void meta_gemm(const bf16_t* A16  , const bf16_t* Bt, int N, int K, const F& f, int blk, int G, int wave, int lane) {
    const int l15 = lane & 15, quad = lane >> 4;
    for (int item = blk + G * wave; item < N / 32; item += G * 8) {
        const int c0 = item * 32;
        const bf16_t* ap = A16 + (size_t)l15 * K + 8 * quad;
        const bf16_t* w0 = Bt + (size_t)(c0 + 8 * (l15 >> 2) + (l15 & 3)) * K + 8 * quad;
        const bf16_t* w1 = w0 + (size_t)4 * K;
        f32x4 acc0 = {0.f, 0.f, 0.f, 0.f}, acc1 = {0.f, 0.f, 0.f, 0.f};
#pragma unroll 4
        for (int k = 0; k < K; k += 32) {
            const bf16x8 xa = *(const bf16x8*)(ap + k), b0 = *(const bf16x8*)(w0 + k), b1 = *(const bf16x8*)(w1 + k);
            acc0 = MFMA16(b0, xa, acc0); acc1 = MFMA16(b1, xa, acc1);
        }
        f.apply8(T + l15, c0 + 8 * quad, acc0, acc1);
    }
}
template <class F> __device__ __forceinline__ void run_gemm(LAS unsigned char* lds, const bf16_t* A, const bf16_t* Bt, int N, int K, const F& f, bool with_meta, int blk, int G, int wave, int lane) {
    pg8::Gemm g{A, Bt, T, N, K}; pg8::StaticOrder S; S.init(T, N, G, blk);
    EpiAdapt<F> E{f};
    pg8::gemm_phase<EpiAdapt<F>, pg8::StaticOrder, true, true>((PG8_LAS unsigned char*)lds, g, S, E);
    if (with_meta) meta_gemm<F>(A + (size_t)T * K, Bt, N, K, f, blk, G, wave, lane);
}

__device__ __forceinline__ void transpose_item(const float* W, int K, int N, bf16_t* WT, LAS float* scr, int item, int lane) {
    const int nblk = N / 32, kb = item / nblk, nb = item % nblk, k0 = 64 * kb, n0 = 32 * nb;
#pragma unroll 8
    for (int i = 0; i < 32; ++i) { const int kk = 2 * i + (lane >> 5); scr[kk * 33 + (lane & 31)] = W[(size_t)(k0 + kk) * N + n0 + (lane & 31)]; }
    LDS_WAIT();
    const int c = lane & 7;
#pragma unroll
    for (int j = 0; j < 4; ++j) { const int n = (lane >> 3) + 8 * j; const LAS float* s = scr + (8 * c) * 33 + n;
        u32x4 o; o.x = pk2(s[0 * 33], s[1 * 33]); o.y = pk2(s[2 * 33], s[3 * 33]); o.z = pk2(s[4 * 33], s[5 * 33]); o.w = pk2(s[6 * 33], s[7 * 33]);
        *(u32x4*)(WT + (size_t)(n0 + n) * K + k0 + 8 * c) = o; }
    LDS_WAIT();
}
__device__ __forceinline__ void prologue_phase(const Params& P, LAS unsigned char* lds, int blk, int G, int tid) {
    const int wave = tid >> 6, lane = tid & 63;
    LAS float* scr = (LAS float*)(lds + wave * 8448);
    const int gw = blk * 8 + wave, NGW = G * 8;
    unsigned char* ws = P.ws;
    constexpr int I_AB = 16 * 64, I_GLU = 8 * 16, I_1M = 16 * 32, I_C = 16 * 128, I_UP = 16 * 128, I_DN = 64 * 32;
    constexpr int NITEMS = I_AB + I_GLU + I_1M + I_C + I_1M + 2 * I_UP + 2 * I_DN;
    for (int it = gw; it < NITEMS; it += NGW) {
        int r = it;
        if (r < I_AB) { transpose_item(P.in[2], 1024, 2048, (bf16_t*)(ws + OFF_WAB), scr, r, lane); continue; } r -= I_AB;
        if (r < I_GLU) { transpose_item(P.in[11], 512, 512, (bf16_t*)(ws + OFF_WGLU), scr, r, lane); continue; } r -= I_GLU;
        if (r < I_1M) { transpose_item(P.in[13], 1024, 1024, (bf16_t*)(ws + OFF_WOAB), scr, r, lane); continue; } r -= I_1M;
        if (r < I_C) { transpose_item(P.in[14], 1024, 4096, (bf16_t*)(ws + OFF_WC), scr, r, lane); continue; } r -= I_C;
        if (r < I_1M) { transpose_item(P.in[17], 1024, 1024, (bf16_t*)(ws + OFF_WOC), scr, r, lane); continue; } r -= I_1M;
        if (r < I_UP) { transpose_item(P.in[20], 1024, 4096, (bf16_t*)(ws + OFF_WUP0), scr, r, lane); continue; } r -= I_UP;
        if (r < I_UP) { transpose_item(P.in[20] + (size_t)1024 * 4096, 1024, 4096, (bf16_t*)(ws + OFF_WUP1), scr, r, lane); continue; } r -= I_UP;
        if (r < I_DN) { transpose_item(P.in[22], 4096, 1024, (bf16_t*)(ws + OFF_WDN0), scr, r, lane); continue; } r -= I_DN;
        transpose_item(P.in[22] + (size_t)4096 * 1024, 4096, 1024, (bf16_t*)(ws + OFF_WDN1), scr, r, lane);
    }
    bf16_t* HB = (bf16_t*)(ws + OFF_HB);
    const size_t n8 = (size_t)R * 1024 / 8;
    for (size_t i = (size_t)blk * 512 + tid; i < n8; i += (size_t)G * 512) {
        const size_t e = i * 8;
        const float* src = e < (size_t)T * 1024 ? P.in[0] + e : P.in[1] + (e - (size_t)T * 1024);
        const f32x4 a = *(const f32x4*)src, b = *(const f32x4*)(src + 4);
        u32x4 w; w.x = pk2(a[0], a[1]); w.y = pk2(a[2], a[3]); w.z = pk2(b[0], b[1]); w.w = pk2(b[2], b[3]);
        *(u32x4*)(HB + e) = w;
    }
}

__device__ __forceinline__ void ln_phase(const float* Zin, float* Fout, bf16_t* Bout, const float* g, const float* bta, int nrows, int blk, int G, int tid) {
    const int wave = tid >> 6, lane = tid & 63;
    for (int row = blk * 8 + wave; row < nrows; row += G * 8) {
        const f32x4* xr = (const f32x4*)(Zin + (size_t)row * 1024) + lane;
        f32x4 v[4]; float s = 0.f;
#pragma unroll
        for (int j = 0; j < 4; ++j) { v[j] = xr[64 * j]; s += (v[j][0] + v[j][1]) + (v[j][2] + v[j][3]); }
#pragma unroll
        for (int o = 1; o < 64; o <<= 1) s += __shfl_xor(s, o);
        const float mean = s * (1.f / 1024.f); float s2 = 0.f;
#pragma unroll
        for (int j = 0; j < 4; ++j) { v[j] = v[j] - mean; s2 += (v[j][0] * v[j][0] + v[j][1] * v[j][1]) + (v[j][2] * v[j][2] + v[j][3] * v[j][3]); }
#pragma unroll
        for (int o = 1; o < 64; o <<= 1) s2 += __shfl_xor(s2, o);
        const float rstd = 1.0f / sqrtf(s2 * (1.f / 1024.f) + 1e-5f);
#pragma unroll
        for (int j = 0; j < 4; ++j) {
            const int col = 4 * (lane + 64 * j);
            const f32x4 gg = *(const f32x4*)(g + col), bb = *(const f32x4*)(bta + col);
            const f32x4 o = v[j] * rstd * gg + bb;
            *(f32x4*)(Fout + (size_t)row * 1024 + col) = o;
            if (Bout) { u32x2 w; w.x = pk2(o[0], o[1]); w.y = pk2(o[2], o[3]); *(u32x2*)(Bout + (size_t)row * 1024 + col) = w; }
        }
    }
}

__device__ __forceinline__ void lam_coef(const float* lam_re, const float* lam_im, float dt, int idx, float& lbr, float& lbi, float& cr, float& ci) {
    const float lr = lam_re[idx], li = lam_im[idx];
    const float er = __expf(lr * dt);
    float ang = li * dt;
    const float kk = rintf(ang * 0.15915494309189535f);
    ang = fmaf(-kk, 6.2831854820251465f, ang); ang = fmaf(-kk, -1.7484555e-7f, ang);
    lbr = er * __cosf(ang); lbi = er * __sinf(ang);
    const float nr = lbr - 1.0f, ni = lbi, den = 1.0f / (lr * lr + li * li);
    cr = (nr * lr + ni * li) * den; ci = (ni * lr - nr * li) * den;
}
__device__ __forceinline__ void s5_phase(const Params& P, LAS unsigned char* lds, int blk, int G, int tid) {
    const int wave = tid >> 6, lane = tid & 63, l15 = lane & 15, quad = lane >> 4;
    LAS float* bu = (LAS float*)(lds + wave * 12800);
    LAS unsigned* sl = (LAS unsigned*)(lds + wave * 12800 + 8448);
    const bf16_t* PROJ = (const bf16_t*)(P.ws + OFF_BIG + BIG_PROJ);
    bf16_t* APRE = (bf16_t*)(P.ws + OFF_BIG + BIG_APRE);
    for (int item = blk + G * wave; item < 512; item += G * 8) {
        const int b = item >> 5, g = item & 31;
        const float dt = __expf(P.in[5][g]);
        float lbr, lbi, cr_, ci_;
        lam_coef(P.in[3], P.in[4], dt, g * 64 + lane, lbr, lbi, cr_, ci_);
        bf16x8 bfrag[8];
#pragma unroll
        for (int tile = 0; tile < 8; ++tile) {
            const int comp = 16 * tile + l15, st = comp & 63, isim = comp >> 6;
            float a0, a1, cr, ci; lam_coef(P.in[3], P.in[4], dt, g * 64 + st, a0, a1, cr, ci);
            bf16x8 fr = {0, 0, 0, 0, 0, 0, 0, 0};
            if (quad < 2) {
                const float* bre = P.in[6] + (size_t)(g * 64 + st) * 16 + 8 * quad;
                const float* bim = P.in[7] + (size_t)(g * 64 + st) * 16 + 8 * quad;
#pragma unroll
                for (int j = 0; j < 8; ++j) { const float v = isim ? (cr * bim[j] + ci * bre[j]) : (cr * bre[j] - ci * bim[j]); fr[j] = (short)f2bf(v); }
            }
            bfrag[tile] = fr;
        }
        bf16x8 cfrag[4];
#pragma unroll
        for (int ks = 0; ks < 4; ++ks) {
#pragma unroll
            for (int j = 0; j < 8; ++j) {
                const int k = 32 * ks + 8 * quad + j, p = k >> 1;
                const float v = (k & 1) ? -P.in[9][(size_t)(g * 16 + l15) * 64 + p] : P.in[8][(size_t)(g * 16 + l15) * 64 + p];
                cfrag[ks][j] = (short)f2bf(v);
            }
        }
        const float dh = P.in[10][g * 16 + l15];
        float sr = 0.f, si = 0.f;
        for (int chunk = 0; chunk < 129; ++chunk) {
            const int rowbase = chunk == 0 ? T : b * 2048 + (chunk - 1) * 16;
            bf16x8 ua = {0, 0, 0, 0, 0, 0, 0, 0};
            if (quad < 2) ua = *(const bf16x8*)(PROJ + (size_t)(rowbase + l15) * 2048 + g * 16 + 8 * quad);
#pragma unroll
            for (int tile = 0; tile < 8; ++tile) {
                f32x4 acc = {0.f, 0.f, 0.f, 0.f};
                acc = MFMA16(ua, bfrag[tile], acc);
#pragma unroll
                for (int r = 0; r < 4; ++r) bu[(4 * quad + r) * 132 + 16 * tile + l15] = acc[r];
            }
            LDS_WAIT();
#pragma unroll
            for (int t = 0; t < 16; ++t) {
                const float br = bu[t * 132 + lane], bi = bu[t * 132 + 64 + lane];
                const float nsr = fmaf(lbr, sr, fmaf(-lbi, si, br)), nsi = fmaf(lbr, si, fmaf(lbi, sr, bi));
                sr = nsr; si = nsi;
                sl[t * 68 + lane] = pk2(sr, si);
            }
            LDS_WAIT();
            f32x4 y = {0.f, 0.f, 0.f, 0.f};
#pragma unroll
            for (int ks = 0; ks < 4; ++ks) {
                const bf16x8 sa = *(const LAS bf16x8*)((const LAS bf16_t*)sl + l15 * 136 + 32 * ks + 8 * quad);
                y = MFMA16(sa, cfrag[ks], y);
            }
            if (chunk > 0 || b == 0) {
#pragma unroll
                for (int r = 0; r < 4; ++r) {
                    const size_t row = (size_t)(rowbase + 4 * quad + r);
                    const float u = bf2f(PROJ[row * 2048 + g * 16 + l15]);
                    const float v = y[r] + dh * u;
                    const float a2 = 1.5957691216057308f * (v + 0.044715f * v * v * v);
                    APRE[row * 512 + g * 16 + l15] = f2bf(v * sigmoidf_(a2));
                }
            }
            LDS_WAIT();
        }
    }
}

__device__ __forceinline__ void attn_tile_sub(const LAS bf16_t* Kl, const LAS bf16_t* Vl, const bf16x8 (&qf)[4], int sub, int keybase  ,
                                              int iq, int l31, int h, f32x16& o0, f32x16& o1, float& Rrun) {
    f32x16 st;
#pragma unroll
    for (int i = 0; i < 16; ++i) st[i] = 0.f;
#pragma unroll
    for (int s = 0; s < 4; ++s) {
        const bf16x8 ka = *(const LAS bf16x8*)(Kl + (32 * sub + l31) * 72 + 16 * s + 8 * h);
        st = MFMA32(ka, qf[s], st);
    }
    float lk[16]; bool vis[16];
#pragma unroll
    for (int i = 0; i < 16; ++i) {
        const int kl = 32 * sub + (i & 3) + 8 * (i >> 2) + 4 * h;
        vis[i] = keybase >= 0 ? (keybase + kl < iq) : (kl < 16);
        const float e = __builtin_amdgcn_exp2f(fminf(st[i], 100.f));
        const float sp = __builtin_amdgcn_logf(1.0f + e);
        lk[i] = vis[i] ? -sp : 0.f;
    }
    float ga[4], pa[4];
#pragma unroll
    for (int a = 0; a < 4; ++a) { ga[a] = (lk[4 * a] + lk[4 * a + 1]) + (lk[4 * a + 2] + lk[4 * a + 3]); pa[a] = __shfl_xor(ga[a], 32); }
    float run = Rrun; float w[16];
#pragma unroll
    for (int a = 3; a >= 0; --a) {
        const float off = h ? run : run + pa[a];
        const float I3 = off + lk[4 * a + 3], I2 = I3 + lk[4 * a + 2], I1 = I2 + lk[4 * a + 1], I0 = I1 + lk[4 * a];
        w[4 * a + 3] = vis[4 * a + 3] ? __builtin_amdgcn_exp2f(st[4 * a + 3] + I3) : 0.f;
        w[4 * a + 2] = vis[4 * a + 2] ? __builtin_amdgcn_exp2f(st[4 * a + 2] + I2) : 0.f;
        w[4 * a + 1] = vis[4 * a + 1] ? __builtin_amdgcn_exp2f(st[4 * a + 1] + I1) : 0.f;
        w[4 * a + 0] = vis[4 * a + 0] ? __builtin_amdgcn_exp2f(st[4 * a + 0] + I0) : 0.f;
        run += ga[a] + pa[a];
    }
    Rrun = run;
#pragma unroll
    for (int s2 = 0; s2 < 2; ++s2) {
        u32x4 pw; pw.x = pk2(w[8 * s2], w[8 * s2 + 1]); pw.y = pk2(w[8 * s2 + 2], w[8 * s2 + 3]); pw.z = pk2(w[8 * s2 + 4], w[8 * s2 + 5]); pw.w = pk2(w[8 * s2 + 6], w[8 * s2 + 7]);
        const bf16x8 pb = __builtin_bit_cast(bf16x8, pw);
#pragma unroll
        for (int mt = 0; mt < 2; ++mt) {
            const LAS bf16_t* vp = Vl + (32 * mt + l31) * 68 + 32 * sub + 16 * s2 + 4 * h;
            const s16x4 lo = *(const LAS s16x4*)vp, hi = *(const LAS s16x4*)(vp + 8);
            const bf16x8 va = __builtin_shufflevector(lo, hi, 0, 1, 2, 3, 4, 5, 6, 7);
            if (mt == 0) o0 = MFMA32(va, pb, o0); else o1 = MFMA32(va, pb, o1);
        }
    }
}
__device__ __forceinline__ void attn_phase(const Params& P, LAS unsigned char* lds, int blk, int G, int tid) {
    const int wave = tid >> 6, lane = tid & 63, l31 = lane & 31, h = lane >> 5;
    const bf16_t* PROJ = (const bf16_t*)(P.ws + OFF_BIG + BIG_PROJ);
    bf16_t* CAT = (bf16_t*)(P.ws + OFF_BIG + BIG_CAT);
    if (blk == G - 1) {
        LAS float* wm = (LAS float*)(lds + 40960);
        if (tid < 128) {
            const int t = tid & 15, hd = tid >> 4;
            const bf16_t* qp = PROJ + (size_t)(T + t) * 2048 + 512 + hd * 64;
            float run = 0.f;
            for (int j = 15; j >= 0; --j) {
                float wv = 0.f;
                if (j < t) {
                    const bf16_t* kp = PROJ + (size_t)(T + j) * 2048 + 1024 + hd * 64;
                    float z = 0.f;
                    for (int d = 0; d < 64; ++d) z = fmaf(bf2f(qp[d]), bf2f(kp[d]), z);
                    const float sp = __builtin_amdgcn_logf(1.0f + __builtin_amdgcn_exp2f(fminf(z, 100.f)));
                    run -= sp; wv = __builtin_amdgcn_exp2f(z + run);
                }
                wm[tid * 16 + j] = wv;
            }
        }
        __syncthreads();
        for (int idx = tid; idx < 16 * 512; idx += 512) {
            const int t = idx >> 9, c = idx & 511, hd = c >> 6;
            float o = 0.f;
            for (int j = 0; j < 16; ++j) o = fmaf(wm[(hd * 16 + t) * 16 + j], bf2f(PROJ[(size_t)(T + j) * 2048 + 1536 + c]), o);
            CAT[(size_t)(T + t) * 1024 + 512 + c] = f2bf(o);
        }
        __syncthreads();
    }
    LAS bf16_t* Kl0 = (LAS bf16_t*)lds;
    LAS bf16_t* Vl0 = (LAS bf16_t*)(lds + 2 * 9216);
    const int lkey = tid >> 3, lpart = tid & 7;
    for (int j4 = 0; j4 < 4; ++j4) {
        const int item = blk + G * j4;
        if (item >= 1024) break;
        const int c = item % 256, jj = item / 256, bh = c >> 1, par = c & 1;
        const int qb = par == 0 ? (jj == 0 ? 7 : jj == 1 ? 0 : jj == 2 ? 4 : 3) : (jj == 0 ? 6 : jj == 1 ? 1 : jj == 2 ? 5 : 2);
        const int b = bh >> 3, hd = bh & 7;
        const int iq = 256 * qb + 32 * wave + l31;
        const size_t qrow = (size_t)b * 2048 + iq;
        bf16x8 qf[4];
#pragma unroll
        for (int s = 0; s < 4; ++s) qf[s] = *(const bf16x8*)(PROJ + qrow * 2048 + 512 + hd * 64 + 16 * s + 8 * h);
        f32x16 o0, o1;
#pragma unroll
        for (int i = 0; i < 16; ++i) { o0[i] = 0.f; o1[i] = 0.f; }
        float Rrun = 0.f;
        const int nt = 4 * qb + 5;
        u32x4 kreg, vreg;
#define ATT_LOAD(it_) do { const int kt_ = 4 * qb + 3 - (it_); size_t row_; bool ok_ = true; \
            if (kt_ >= 0) row_ = (size_t)b * 2048 + 64 * kt_ + lkey; else { row_ = (size_t)T + lkey; ok_ = lkey < 16; } \
            if (ok_) { const bf16_t* p_ = PROJ + row_ * 2048 + 1024 + hd * 64 + lpart * 8; kreg = *(const u32x4*)p_; vreg = *(const u32x4*)(p_ + 512); } \
            else { kreg = (u32x4){0u, 0u, 0u, 0u}; vreg = kreg; } } while (0)
#define ATT_STORE(buf_) do { *(LAS u32x4*)(Kl0 + (buf_) * 4608 + lkey * 72 + lpart * 8) = kreg; \
            LAS bf16_t* vt_ = Vl0 + (buf_) * 4352 + (lpart * 8) * 68 + lkey; \
            vt_[0 * 68] = (bf16_t)(vreg.x & 0xffffu); vt_[1 * 68] = (bf16_t)(vreg.x >> 16); \
            vt_[2 * 68] = (bf16_t)(vreg.y & 0xffffu); vt_[3 * 68] = (bf16_t)(vreg.y >> 16); \
            vt_[4 * 68] = (bf16_t)(vreg.z & 0xffffu); vt_[5 * 68] = (bf16_t)(vreg.z >> 16); \
            vt_[6 * 68] = (bf16_t)(vreg.w & 0xffffu); vt_[7 * 68] = (bf16_t)(vreg.w >> 16); } while (0)
        ATT_LOAD(0); ATT_STORE(0);
        __syncthreads();
        int cur = 0;
        for (int it = 0; it < nt; ++it) {
            if (it + 1 < nt) ATT_LOAD(it + 1);
            const int kt = 4 * qb + 3 - it;
            const int keybase = kt >= 0 ? 64 * kt : -1;
            const int wq_end = 256 * qb + 32 * wave + 32;
            const LAS bf16_t* Kl = Kl0 + cur * 4608; const LAS bf16_t* Vl = Vl0 + cur * 4352;
            if (kt < 0) { attn_tile_sub(Kl, Vl, qf, 0, -1, iq, l31, h, o0, o1, Rrun); }
            else {
                if (keybase + 32 < wq_end) attn_tile_sub(Kl, Vl, qf, 1, keybase, iq, l31, h, o0, o1, Rrun);
                if (keybase < wq_end) attn_tile_sub(Kl, Vl, qf, 0, keybase, iq, l31, h, o0, o1, Rrun);
            }
            if (it + 1 < nt) ATT_STORE(cur ^ 1);
            __syncthreads();
            cur ^= 1;
        }
        bf16_t* op = CAT + qrow * 1024 + 512 + hd * 64;
#pragma unroll
        for (int a = 0; a < 4; ++a) {
            u32x2 w0; w0.x = pk2(o0[4 * a], o0[4 * a + 1]); w0.y = pk2(o0[4 * a + 2], o0[4 * a + 3]);
            u32x2 w1; w1.x = pk2(o1[4 * a], o1[4 * a + 1]); w1.y = pk2(o1[4 * a + 2], o1[4 * a + 3]);
            *(u32x2*)(op + 8 * a + 4 * h) = w0; *(u32x2*)(op + 32 + 8 * a + 4 * h) = w1;
        }
    }
}

__device__ __forceinline__ void hgrn_phase(const Params& P, LAS unsigned char* lds, int blk, int G, int tid) {
    const int wave = tid >> 6, lane = tid & 63, l15 = lane & 15, quad = lane >> 4;
    LAS bf16_t* qd = (LAS bf16_t*)lds;
    LAS bf16_t* kd = qd + 64 * 136;
    LAS bf16_t* klT = kd + 64 * 136;
    LAS bf16_t* vT = klT + 128 * 72;
    LAS bf16_t* sc = vT + 128 * 72;
    LAS float* ebl = (LAS float*)(sc + 64 * 72);
    LAS float* segtot = ebl + 128;
    LAS float* red = segtot + 512;
    const unsigned short* PC = (const unsigned short*)(P.ws + OFF_BIG);
    bf16_t* MIXC = (bf16_t*)(P.ws + OFF_HB);
    const float* ng = P.in[16];
    for (int item = blk; item < 128; item += G) {
        const int b = item >> 3, hd = item & 7;
        f32x4 Sacc[8];
#pragma unroll
        for (int i = 0; i < 8; ++i) Sacc[i] = (f32x4){0.f, 0.f, 0.f, 0.f};
        for (int c = 0; c < 33; ++c) {
            {
                const int d = tid & 127, sg = tid >> 7;
                float cs[16]; float run = 0.f;
#pragma unroll
                for (int tt = 0; tt < 16; ++tt) {
                    const int t = 16 * sg + tt;
                    float lf = 0.f;
                    if (c > 0 || t >= 48) {
                        const size_t row = c > 0 ? (size_t)b * 2048 + (c - 1) * 64 + t : (size_t)T + (t - 48);
                        lf = (float)__builtin_bit_cast(_Float16, PC[row * 4096 + 1024 + hd * 128 + d]);
                    }
                    run += lf; cs[tt] = run;
                }
                segtot[sg * 128 + d] = run;
                __syncthreads();
                const float s0 = segtot[d], s1 = segtot[128 + d], s2 = segtot[256 + d], s3 = segtot[384 + d];
                const float off = (sg > 0 ? s0 : 0.f) + (sg > 1 ? s1 : 0.f) + (sg > 2 ? s2 : 0.f);
                const float blast = (s0 + s1) + (s2 + s3);
                if (sg == 3) ebl[d] = __expf(blast);
#pragma unroll
                for (int tp = 0; tp < 8; ++tp) {
                    float klv[2]; unsigned short vraw[2];
#pragma unroll
                    for (int e = 0; e < 2; ++e) {
                        const int tt = 2 * tp + e, t = 16 * sg + tt;
                        const float lf = cs[tt] - (tt ? cs[tt - 1] : 0.f);
                        const float bt = off + cs[tt];
                        float q = 0.f; unsigned short vr = 0;
                        if (c > 0 || t >= 48) {
                            const size_t row = c > 0 ? (size_t)b * 2048 + (c - 1) * 64 + t : (size_t)T + (t - 48);
                            q = bf2f(PC[row * 4096 + hd * 128 + d]); vr = PC[row * 4096 + 2048 + hd * 128 + d];
                        }
                        const float k = 1.0f - __expf(lf);
                        qd[t * 136 + d] = f2bf(q * __expf(bt));
                        kd[t * 136 + d] = f2bf(k * __expf(-bt));
                        klv[e] = k * __expf(blast - bt); vraw[e] = vr;
                    }
                    const int t0 = 16 * sg + 2 * tp;
                    *(LAS unsigned*)(klT + d * 72 + t0) = pk2(klv[0], klv[1]);
                    *(LAS unsigned*)(vT + d * 72 + t0) = (unsigned)vraw[0] | ((unsigned)vraw[1] << 16);
                }
            }
            __syncthreads();
            f32x4 oacc[4];
#pragma unroll
            for (int i = 0; i < 4; ++i) oacc[i] = (f32x4){0.f, 0.f, 0.f, 0.f};
#pragma unroll
            for (int ks = 0; ks < 4; ++ks) {
                u32x4 sw; sw.x = pk2(Sacc[2 * ks][0], Sacc[2 * ks][1]); sw.y = pk2(Sacc[2 * ks][2], Sacc[2 * ks][3]);
                sw.z = pk2(Sacc[2 * ks + 1][0], Sacc[2 * ks + 1][1]); sw.w = pk2(Sacc[2 * ks + 1][2], Sacc[2 * ks + 1][3]);
                const bf16x8 sb = __builtin_bit_cast(bf16x8, sw);
#pragma unroll
                for (int tt = 0; tt < 4; ++tt) {
                    const LAS bf16_t* ap = qd + (16 * tt + l15) * 136 + 32 * ks + 4 * quad;
                    const s16x4 lo = *(const LAS s16x4*)ap, hi = *(const LAS s16x4*)(ap + 16);
                    oacc[tt] = MFMA16(__builtin_shufflevector(lo, hi, 0, 1, 2, 3, 4, 5, 6, 7), sb, oacc[tt]);
                }
            }
#pragma unroll
            for (int e = 0; e < 2; ++e) {
                const int tile = 2 * wave + e, tt = tile >> 2, ss = tile & 3;
                f32x4 sa = {0.f, 0.f, 0.f, 0.f};
#pragma unroll
                for (int ks = 0; ks < 4; ++ks) {
                    const bf16x8 a = *(const LAS bf16x8*)(qd + (16 * tt + l15) * 136 + 32 * ks + 8 * quad);
                    const bf16x8 bb = *(const LAS bf16x8*)(kd + (16 * ss + l15) * 136 + 32 * ks + 8 * quad);
                    sa = MFMA16(a, bb, sa);
                }
#pragma unroll
                for (int r = 0; r < 4; ++r) { const int tg = 16 * tt + 4 * quad + r, sg_ = 16 * ss + l15; sc[tg * 72 + sg_] = f2bf(sg_ <= tg ? sa[r] : 0.f); }
            }
            __syncthreads();
#pragma unroll
            for (int dt = 0; dt < 8; ++dt)
#pragma unroll
                for (int r = 0; r < 4; ++r) Sacc[dt][r] *= ebl[16 * dt + 4 * quad + r];
#pragma unroll
            for (int ks = 0; ks < 2; ++ks) {
                const bf16x8 vb = *(const LAS bf16x8*)(vT + (16 * wave + l15) * 72 + 32 * ks + 8 * quad);
#pragma unroll
                for (int tt = 0; tt < 4; ++tt) { const bf16x8 a = *(const LAS bf16x8*)(sc + (16 * tt + l15) * 72 + 32 * ks + 8 * quad); oacc[tt] = MFMA16(a, vb, oacc[tt]); }
#pragma unroll
                for (int dt = 0; dt < 8; ++dt) { const bf16x8 a = *(const LAS bf16x8*)(klT + (16 * dt + l15) * 72 + 32 * ks + 8 * quad); Sacc[dt] = MFMA16(a, vb, Sacc[dt]); }
            }
#pragma unroll
            for (int tt = 0; tt < 4; ++tt)
#pragma unroll
                for (int r = 0; r < 4; ++r) {
                    float s = oacc[tt][r] * oacc[tt][r];
                    s += __shfl_xor(s, 1); s += __shfl_xor(s, 2); s += __shfl_xor(s, 4); s += __shfl_xor(s, 8);
                    if (l15 == 0) red[(16 * tt + 4 * quad + r) * 8 + wave] = s;
                }
            __syncthreads();
            if (c > 0) {
                const int dvg = hd * 128 + 16 * wave + l15;
                const float gn = ng[dvg];
#pragma unroll
                for (int tt = 0; tt < 4; ++tt)
#pragma unroll
                    for (int r = 0; r < 4; ++r) {
                        const int t = 16 * tt + 4 * quad + r;
                        const f32x4 r0 = *(const LAS f32x4*)(red + t * 8), r1 = *(const LAS f32x4*)(red + t * 8 + 4);
                        const float ssum = ((r0[0] + r0[1]) + (r0[2] + r0[3])) + ((r1[0] + r1[1]) + (r1[2] + r1[3]));
                        const float rs = 1.0f / sqrtf(ssum * (1.0f / 128.0f) + 1e-6f);
                        const size_t row = (size_t)b * 2048 + (c - 1) * 64 + t;
                        const float gv = bf2f(PC[row * 4096 + 3072 + dvg]);
                        MIXC[row * 1024 + dvg] = f2bf(oacc[tt][r] * rs * gn * gv * sigmoidf_(gv));
                    }
            }
        }
        __syncthreads();
    }
}

__global__ void __launch_bounds__(512, 2) fwd_megakernel(Params P) {
    extern __shared__ __attribute__((aligned(16))) unsigned char lds_raw[];
    LAS unsigned char* lds = (LAS unsigned char*)lds_raw;
    cg::grid_group grid = cg::this_grid();
    const int tid = threadIdx.x, blk = blockIdx.x, G = gridDim.x, wave = tid >> 6, lane = tid & 63;
    unsigned char* ws = P.ws;
    bf16_t* HB = (bf16_t*)(ws + OFF_HB);
    float* Z = (float*)(ws + OFF_Z);
    bf16_t* PROJ = (bf16_t*)(ws + OFF_BIG + BIG_PROJ);
    bf16_t* APRE = (bf16_t*)(ws + OFF_BIG + BIG_APRE);
    bf16_t* CAT = (bf16_t*)(ws + OFF_BIG + BIG_CAT);
    bf16_t* HID = (bf16_t*)(ws + OFF_BIG);
    unsigned short* PC = (unsigned short*)(ws + OFF_BIG);

    prologue_phase(P, lds, blk, G, tid);
    grid.sync();
    run_gemm(lds, HB, (const bf16_t*)(ws + OFF_WAB), 2048, 1024, EpInAB{PROJ}, true, blk, G, wave, lane);
    grid.sync();
    s5_phase(P, lds, blk, G, tid);
    __syncthreads();
    attn_phase(P, lds, blk, G, tid);
    grid.sync();
    run_gemm(lds, APRE, (const bf16_t*)(ws + OFF_WGLU), 512, 512, EpGlu{APRE, P.in[12], CAT}, true, blk, G, wave, lane);
    grid.sync();
    run_gemm(lds, CAT, (const bf16_t*)(ws + OFF_WOAB), 1024, 1024, EpRes{P.in[0], P.in[1], Z, nullptr}, true, blk, G, wave, lane);
    grid.sync();
    ln_phase(Z, Z, HB, P.in[18], P.in[19], R, blk, G, tid);
    grid.sync();
    run_gemm(lds, HB, (const bf16_t*)(ws + OFF_WUP0), 4096, 1024, EpUp{HID, P.in[21]}, true, blk, G, wave, lane);
    grid.sync();
    run_gemm(lds, HID, (const bf16_t*)(ws + OFF_WDN0), 1024, 4096, EpRes{Z, nullptr, Z, P.in[23]}, true, blk, G, wave, lane);
    grid.sync();
    ln_phase(Z, Z, HB, P.in[24], P.in[25], R, blk, G, tid);
    grid.sync();
    run_gemm(lds, HB, (const bf16_t*)(ws + OFF_WC), 4096, 1024, EpInC{PC, P.in[15]}, true, blk, G, wave, lane);
    grid.sync();
    hgrn_phase(P, lds, blk, G, tid);
    grid.sync();
    run_gemm(lds, HB  , (const bf16_t*)(ws + OFF_WOC), 1024, 1024, EpRes{Z, nullptr, Z, nullptr}, false, blk, G, wave, lane);
    grid.sync();
    ln_phase(Z, Z, HB, P.in[18] + 1024, P.in[19] + 1024, T, blk, G, tid);
    grid.sync();
    run_gemm(lds, HB, (const bf16_t*)(ws + OFF_WUP1), 4096, 1024, EpUp{HID, P.in[21] + 4096}, false, blk, G, wave, lane);
    grid.sync();
    run_gemm(lds, HID, (const bf16_t*)(ws + OFF_WDN1), 1024, 4096, EpRes{Z, nullptr, Z, P.in[23] + 1024}, false, blk, G, wave, lane);
    grid.sync();
    ln_phase(Z, P.out, nullptr, P.in[24] + 1024, P.in[25] + 1024, T, blk, G, tid);
}

extern "C" void kernel_launch(void* const* d_in, const int* in_sizes, int n_in, void* d_out, int out_size, void* d_ws, size_t ws_size, hipStream_t stream) {
    constexpr size_t kDynLds = 131072;
    static int grid_blocks = 0;
    if (!grid_blocks) {
        if (n_in != 26 || ws_size < WS_END) { fprintf(stderr, "kernel_launch: expected 26 inputs and >= %zu bytes of workspace (got %d, %zu)\n", (size_t)WS_END, n_in, ws_size); grid_blocks = -1; return; }
        int dev = 0, cus = 0, per_cu = 0;
        hipGetDevice(&dev);
        hipDeviceGetAttribute(&cus, hipDeviceAttributeMultiprocessorCount, dev);
        hipFuncSetAttribute((const void*)fwd_megakernel, hipFuncAttributeMaxDynamicSharedMemorySize, (int)kDynLds);
        hipOccupancyMaxActiveBlocksPerMultiprocessor(&per_cu, (const void*)fwd_megakernel, 512, kDynLds);
        if (per_cu < 1) { fprintf(stderr, "kernel_launch: occupancy query says %d blocks per CU\n", per_cu); per_cu = 1; }
        grid_blocks = cus * (per_cu > 1 ? 1 : per_cu);
        if (grid_blocks != 256) fprintf(stderr, "kernel_launch: note: grid is %d workgroups (tuned for 256)\n", grid_blocks);
    }
    if (grid_blocks < 1) return;
    Params p{};
    for (int i = 0; i < 26; ++i) p.in[i] = (const float*)d_in[i];
    p.out = (float*)d_out; p.ws = (unsigned char*)d_ws;
    void* args[] = {&p};
    hipError_t e = hipLaunchCooperativeKernel((const void*)fwd_megakernel, dim3(grid_blocks), dim3(512), args, kDynLds, stream);
    if (e != hipSuccess) fprintf(stderr, "cooperative launch failed: %s (grid %d)\n", hipGetErrorString(e), grid_blocks);
}
```

```cpp
#include <hip/hip_runtime.h>
#include <hip/hip_cooperative_groups.h>
#include <cstdio>
#include <cstdint>
namespace cg = cooperative_groups;
#ifndef PROBE_DUP_S5
#define PROBE_DUP_S5 0
#endif
#ifndef PROBE_DUP_ATTN
#define PROBE_DUP_ATTN 0
#endif
#ifndef PROBE_DUP_HGRN
#define PROBE_DUP_HGRN 0
#endif
#ifndef PROBE_DUP_INC
#define PROBE_DUP_INC 0
#endif
__device__ __forceinline__ int lane_id_v() { int l; asm volatile("v_mbcnt_lo_u32_b32 %0, -1, 0\n\tv_mbcnt_hi_u32_b32 %0, -1, %0" : "=v"(l)); return l; }
namespace pg8 {
#define PG8_LAS __attribute__((address_space(3)))
typedef unsigned short bf16_t;
typedef short bf16x8 __attribute__((ext_vector_type(8)));
typedef float f32x4 __attribute__((ext_vector_type(4)));
typedef unsigned u32x4 __attribute__((ext_vector_type(4)));
constexpr int BM = 256, BK = 64, HALF = 128, HTB = HALF * BK * 2  , STAGE_BYTES = 8 * HTB, NXCD = 8, WGM = 8;

__host__ __device__ __forceinline__ int lds_byte(int r, int c) { const int st = (r >> 4) * 2 + (c >> 5), rr = r & 15, cc = c & 31, ob = rr * 64 + cc * 2; return st * 1024 + (ob ^ (((ob >> 9) & 1) << 5)); }
__host__ __device__ __forceinline__ void stage_rc(int b, int& R, int& C) { const int st = b / 1024, sb = b % 1024, swz = sb ^ (((sb >> 9) & 1) << 5); R = (st >> 1) * 16 + swz / 64; C = (st & 1) * 32 + (swz % 64) / 2; }
__host__ __device__ __forceinline__ int perm32(int rho) { const int n = rho >> 4, i = rho & 15; return 8 * (i >> 2) + 4 * n + (i & 3); }

struct Unit { int pm, pn; };
struct Gemm { const bf16_t* A; const bf16_t* Bt; int M, N, K; };

struct StaticOrder {
    int nM, nN, nwg, G, c;
    __host__ __device__ void init(int M, int N, int G_, int c_) { nM = M / BM; nN = N / BM; nwg = nM * nN; G = G_; c = c_; }
    __host__ __device__ bool next(int i, Unit& u) const {
        const long L = (long)i * G + c; if (L >= nwg) return false;
        int wgid = (int)L; { const int q = nwg / NXCD, r = nwg % NXCD, xcd = wgid % NXCD, off = wgid / NXCD; wgid = (xcd < r ? xcd * (q + 1) : r * (q + 1) + (xcd - r) * q) + off; }
        const int nig = WGM * nN, gid = wgid / nig, fm = gid * WGM, gsz = (nM - fm) < WGM ? (nM - fm) : WGM;
        u.pm = fm + ((wgid % nig) % gsz); u.pn = (wgid % nig) / gsz; return true;
    }
    __device__ __forceinline__ void a_ready(const Unit&) const {}
    __device__ __forceinline__ void done(const Unit&) const {}
};

__device__ __forceinline__ unsigned cvt_pk_bf16(float lo, float hi) { unsigned r; asm volatile("v_cvt_pk_bf16_f32 %0, %1, %2" : "=v"(r) : "v"(lo), "v"(hi)); return r; }
template <class Epi, class Sched, bool ALIGN_EPI = false, bool SP2 = false>
__device__ __forceinline__ void gemm_phase(PG8_LAS unsigned char* lds, const Gemm g, const Sched& S, const Epi& E, int wave_in) {
    const int lane = lane_id_v(), wid = __builtin_amdgcn_readfirstlane(wave_in), tid = wid * 64 + lane, wr = wid >> 2, wc = wid & 3, fr = lane & 15, fq = lane >> 4;
    const int K = g.K, nt = K / BK;
    unsigned voffA[2], voffB[2];
#pragma unroll
    for (int i = 0; i < 2; ++i) { int R, C; stage_rc(tid * 16 + i * 8192, R, C); const int Rb = Epi::PERM ? ((R & ~31) + perm32(R & 31)) : R;
        voffA[i] = (unsigned)(R * K + C) * 2u; voffB[i] = (unsigned)(Rb * K + C) * 2u; }
    const size_t kstep = (size_t)(BK * 2);
    const size_t hstep = (size_t)HALF * K * 2;
    const size_t tstep = 2 * hstep;
    const unsigned ldsw = (unsigned)wid * 1024u;
    const int aoff = lds_byte(wr * 64 + fr, fq * 8), boff = lds_byte(wc * 32 + fr, fq * 8);
#define PG8_SA(b, h) (((b) * 2 + (h)) * HTB)
#define PG8_SB(b, h) ((4 + (b) * 2 + (h)) * HTB)
#define PG8_STAGE(bufoff, gbase, voff) do { _Pragma("unroll") for (int _i = 0; _i < 2; ++_i) \
        __builtin_amdgcn_global_load_lds((const unsigned*)((const char*)(gbase) + (voff)[_i]), (PG8_LAS unsigned*)(lds + (bufoff) + ldsw + _i * 8192), 16, 0, 0); } while (0)
#define PG8_LDA(dst, b, h) do { _Pragma("unroll") for (int m = 0; m < 4; ++m) _Pragma("unroll") for (int k = 0; k < 2; ++k) dst[m][k] = *(const PG8_LAS bf16x8*)(lds + PG8_SA(b, h) + aoff + m * 2048 + k * 1024); } while (0)
#define PG8_LDB(dst, b, h) do { _Pragma("unroll") for (int n = 0; n < 2; ++n) _Pragma("unroll") for (int k = 0; k < 2; ++k) dst[n][k] = *(const PG8_LAS bf16x8*)(lds + PG8_SB(b, h) + boff + n * 2048 + k * 1024); } while (0)
#define PG8_MMA(ai, bj, At, Bt) do { __builtin_amdgcn_s_setprio(1); _Pragma("unroll") for (int m = 0; m < 4; ++m) _Pragma("unroll") for (int n = 0; n < 2; ++n) _Pragma("unroll") for (int k = 0; k < 2; ++k) \
        acc[ai][bj][m][n] = __builtin_amdgcn_mfma_f32_16x16x32_bf16(Bt[n][k], At[m][k], acc[ai][bj][m][n], 0, 0, 0); __builtin_amdgcn_s_setprio(0); } while (0)
#define PG8_WAIT_V(n) asm volatile("s_waitcnt vmcnt(" #n ")" ::: "memory")
#define PG8_WAIT_L(n) asm volatile("s_waitcnt lgkmcnt(" #n ")" ::: "memory")
#define PG8_BAR __builtin_amdgcn_s_barrier()
#define PG8_SCHED __builtin_amdgcn_sched_barrier(0)
    Unit cur, nxt; int ui = 0;
    if (!S.next(0, cur)) return;
    f32x4 acc[2][2][4][2];
#pragma unroll
    for (int a = 0; a < 2; ++a)
#pragma unroll
        for (int b = 0; b < 2; ++b)
#pragma unroll
            for (int m = 0; m < 4; ++m)
#pragma unroll
                for (int n = 0; n < 2; ++n) acc[a][b][m][n] = (f32x4){0.f, 0.f, 0.f, 0.f};
    bf16x8 At[4][2], B0[2][2], B1[2][2];
    const char* cA = (const char*)g.A + (size_t)cur.pm * tstep; const char* cB = (const char*)g.Bt + (size_t)cur.pn * tstep;
    S.a_ready(cur);
    if constexpr (SP2) {
        PG8_STAGE(PG8_SB(0, 0), cB, voffB); PG8_STAGE(PG8_SB(0, 1), cB + hstep, voffB); PG8_STAGE(PG8_SA(0, 0), cA, voffA); PG8_STAGE(PG8_SA(0, 1), cA + hstep, voffA);
        if (wr == 1) PG8_BAR;
        PG8_WAIT_V(2); PG8_BAR;
        PG8_STAGE(PG8_SB(1, 0), cB + kstep, voffB); PG8_STAGE(PG8_SA(1, 0), cA + kstep, voffA); PG8_STAGE(PG8_SB(1, 1), cB + hstep + kstep, voffB);
        PG8_WAIT_V(6); PG8_BAR;
    } else {
        PG8_STAGE(PG8_SB(0, 0), cB, voffB); PG8_STAGE(PG8_SA(0, 0), cA, voffA); PG8_STAGE(PG8_SB(0, 1), cB + hstep, voffB); PG8_STAGE(PG8_SA(0, 1), cA + hstep, voffA);
        if (wr == 1) PG8_BAR;
        PG8_WAIT_V(4); PG8_BAR;
        PG8_STAGE(PG8_SB(1, 0), cB + kstep, voffB); PG8_STAGE(PG8_SA(1, 0), cA + kstep, voffA); PG8_STAGE(PG8_SB(1, 1), cB + hstep + kstep, voffB);
        PG8_WAIT_V(6); PG8_BAR;
    }
    for (;;) {
        const bool has_next = S.next(ui + 1, nxt);
        const char* nA = has_next ? (const char*)g.A + (size_t)nxt.pm * tstep : cA; const char* nB = has_next ? (const char*)g.Bt + (size_t)nxt.pn * tstep : cB;
        for (int t = 0; t < nt; t += 2) {
            const bool last = (t == nt - 2);
            const char* a1 = cA + (size_t)(t + 1) * kstep;
            const char* a2 = last ? nA : cA + (size_t)(t + 2) * kstep; const char* b2 = last ? nB : cB + (size_t)(t + 2) * kstep;
            const char* a3 = a2 + kstep; const char* b3 = b2 + kstep;
            if (last && has_next) S.a_ready(nxt);
            if constexpr (SP2) {
            PG8_LDB(B0, 0, 0); PG8_LDB(B1, 0, 1); PG8_SCHED; PG8_LDA(At, 0, 0); PG8_STAGE(PG8_SA(1, 1), a1 + hstep, voffA);
            PG8_WAIT_V(8); PG8_WAIT_L(0); PG8_BAR; PG8_MMA(0, 0, At, B0); PG8_MMA(0, 1, At, B1); PG8_BAR; PG8_SCHED;
            PG8_LDA(At, 0, 1); PG8_STAGE(PG8_SB(0, 0), b2, voffB); PG8_STAGE(PG8_SB(0, 1), b2 + hstep, voffB); PG8_STAGE(PG8_SA(0, 0), a2, voffA);
            PG8_WAIT_V(8); PG8_WAIT_L(0); PG8_BAR; PG8_MMA(1, 0, At, B0); PG8_MMA(1, 1, At, B1); PG8_BAR; PG8_SCHED;
            PG8_LDB(B0, 1, 0); PG8_LDB(B1, 1, 1); PG8_SCHED; PG8_LDA(At, 1, 0); PG8_STAGE(PG8_SA(0, 1), a2 + hstep, voffA);
            PG8_WAIT_V(8); PG8_WAIT_L(0); PG8_BAR; PG8_MMA(0, 0, At, B0); PG8_MMA(0, 1, At, B1); PG8_BAR; PG8_SCHED;
            PG8_LDA(At, 1, 1); PG8_STAGE(PG8_SB(1, 0), b3, voffB); PG8_STAGE(PG8_SB(1, 1), b3 + hstep, voffB); PG8_STAGE(PG8_SA(1, 0), a3, voffA);
            PG8_WAIT_V(8); PG8_WAIT_L(0); PG8_BAR; PG8_MMA(1, 0, At, B0); PG8_MMA(1, 1, At, B1); PG8_BAR; PG8_SCHED;
            } else {
            PG8_LDB(B0, 0, 0); PG8_SCHED; PG8_LDA(At, 0, 0); PG8_STAGE(PG8_SA(1, 1), a1 + hstep, voffA);
            PG8_WAIT_L(8); PG8_BAR; PG8_WAIT_L(0); PG8_MMA(0, 0, At, B0); PG8_BAR; PG8_SCHED;
            PG8_LDB(B1, 0, 1); PG8_STAGE(PG8_SB(0, 0), b2, voffB);
            PG8_BAR; PG8_WAIT_L(0); PG8_MMA(0, 1, At, B1); PG8_BAR;
            PG8_LDA(At, 0, 1); PG8_STAGE(PG8_SA(0, 0), a2, voffA);
            PG8_BAR; PG8_WAIT_L(0); PG8_MMA(1, 0, At, B0); PG8_BAR; PG8_SCHED;
            PG8_STAGE(PG8_SB(0, 1), b2 + hstep, voffB);
            PG8_WAIT_V(6); PG8_BAR; PG8_MMA(1, 1, At, B1); PG8_BAR;
            PG8_LDB(B0, 1, 0); PG8_SCHED; PG8_LDA(At, 1, 0); PG8_STAGE(PG8_SA(0, 1), a2 + hstep, voffA);
            PG8_WAIT_L(8); PG8_BAR; PG8_WAIT_L(0); PG8_MMA(0, 0, At, B0); PG8_BAR; PG8_SCHED;
            PG8_LDB(B1, 1, 1); PG8_STAGE(PG8_SB(1, 0), b3, voffB);
            PG8_BAR; PG8_WAIT_L(0); PG8_MMA(0, 1, At, B1); PG8_BAR;
            PG8_LDA(At, 1, 1); PG8_STAGE(PG8_SA(1, 0), a3, voffA);
            PG8_BAR; PG8_WAIT_L(0); PG8_MMA(1, 0, At, B0); PG8_BAR; PG8_SCHED;
            PG8_STAGE(PG8_SB(1, 1), b3 + hstep, voffB);
            PG8_WAIT_V(6); PG8_BAR; PG8_MMA(1, 1, At, B1); PG8_BAR;
            }
        }
        if constexpr (ALIGN_EPI) { if (wr == 0) PG8_BAR; }
        if constexpr (!Epi::AFTER_DRAIN) { E(acc, cur, wr, wc, fr, fq); S.done(cur); }
        if (!has_next) break;
#pragma unroll
        for (int a = 0; a < 2; ++a)
#pragma unroll
            for (int b = 0; b < 2; ++b)
#pragma unroll
                for (int m = 0; m < 4; ++m)
#pragma unroll
                    for (int n = 0; n < 2; ++n) acc[a][b][m][n] = (f32x4){0.f, 0.f, 0.f, 0.f};
        cur = nxt; cA = nA; cB = nB; ++ui;
        if constexpr (ALIGN_EPI) { if (wr == 1) PG8_BAR; }
    }
    PG8_WAIT_V(0);
    if constexpr (!ALIGN_EPI) { if (wr == 0) PG8_BAR; }
    PG8_BAR;
    if constexpr (Epi::AFTER_DRAIN) { E.fused(acc, cur, wr, wc, fr, fq, lds, wid, lane); S.done(cur); }
#undef PG8_SA
#undef PG8_SB
#undef PG8_STAGE
#undef PG8_LDA
#undef PG8_LDB
#undef PG8_MMA
#undef PG8_WAIT_V
#undef PG8_WAIT_L
#undef PG8_BAR
#undef PG8_SCHED
}
}

#define LAS __attribute__((address_space(3)))
typedef unsigned short bf16_t;
typedef short bf16x8 __attribute__((ext_vector_type(8)));
typedef short s16x4 __attribute__((ext_vector_type(4)));
typedef float f32x4 __attribute__((ext_vector_type(4)));
typedef float f32x16 __attribute__((ext_vector_type(16)));
typedef unsigned u32x4 __attribute__((ext_vector_type(4)));
typedef unsigned u32x2 __attribute__((ext_vector_type(2)));

constexpr int T = 16 * 2048;
constexpr int NMETA = 16;
constexpr int R = T + NMETA;
constexpr int DM = 1024, DFF = 4096;
constexpr float ALPHA = 1.4142135623730951f;
constexpr float QSCALE = 0.125f * 1.4426950408889634f;

constexpr size_t SZ_WAB = (size_t)2048 * 1024 * 2, SZ_WGLU = (size_t)512 * 512 * 2, SZ_W1M = (size_t)1024 * 1024 * 2, SZ_W4M = (size_t)4096 * 1024 * 2;
constexpr size_t OFF_WAB = 0, OFF_WGLU = OFF_WAB + SZ_WAB, OFF_WOAB = OFF_WGLU + SZ_WGLU, OFF_WC = OFF_WOAB + SZ_W1M, OFF_WOC = OFF_WC + SZ_W4M,
                 OFF_WUP0 = OFF_WOC + SZ_W1M, OFF_WUP1 = OFF_WUP0 + SZ_W4M, OFF_WDN0 = OFF_WUP1 + SZ_W4M, OFF_WDN1 = OFF_WDN0 + SZ_W4M,
                 OFF_HB = OFF_WDN1 + SZ_W4M, OFF_Z = OFF_HB + (size_t)R * 1024 * 2, OFF_BIG = OFF_Z + (size_t)R * 1024 * 4, WS_END = OFF_BIG + (size_t)R * 4096 * 2;
constexpr size_t BIG_PROJ = 0, BIG_APRE = (size_t)R * 2048 * 2, BIG_CAT = BIG_APRE + (size_t)R * 512 * 2;

struct Params { const float* in[26]; float* out; unsigned char* ws; };

__device__ __forceinline__ unsigned pk2(float lo, float hi) {
    typedef __bf16 bf2 __attribute__((ext_vector_type(2)));
    typedef float fl2 __attribute__((ext_vector_type(2)));
    fl2 v = {lo, hi}; bf2 r = __builtin_convertvector(v, bf2); return __builtin_bit_cast(unsigned, r);
}
__device__ __forceinline__ bf16_t f2bf(float x) { return (bf16_t)(pk2(x, 0.f) & 0xffffu); }
__device__ __forceinline__ float bf2f(bf16_t v) { return __uint_as_float((unsigned)v << 16); }
__device__ __forceinline__ float bflo(unsigned w) { return __uint_as_float(w << 16); }
__device__ __forceinline__ float bfhi(unsigned w) { return __uint_as_float(w & 0xffff0000u); }
__device__ __forceinline__ float sigmoidf_(float x) { return 1.0f / (1.0f + __expf(-x)); }
#define LDS_WAIT() asm volatile("s_waitcnt lgkmcnt(0)" ::: "memory")
#define MFMA16(a, b, c) __builtin_amdgcn_mfma_f32_16x16x32_bf16((a), (b), (c), 0, 0, 0)
#define MFMA32(a, b, c) __builtin_amdgcn_mfma_f32_32x32x16_bf16((a), (b), (c), 0, 0, 0)

struct EpInAB {
    bf16_t* O;
    __device__ __forceinline__ void apply8(int row, int col, f32x4 a, f32x4 b) const {
        const float s = (col >= 512 && col < 1024) ? QSCALE : 1.0f;
        u32x4 w; w.x = pk2(a[0] * s, a[1] * s); w.y = pk2(a[2] * s, a[3] * s); w.z = pk2(b[0] * s, b[1] * s); w.w = pk2(b[2] * s, b[3] * s);
        *(u32x4*)(O + (size_t)row * 2048 + col) = w;
    }
};
struct EpGlu {
    const bf16_t* APRE; const float* bias; bf16_t* CAT;
    __device__ __forceinline__ void apply8(int row, int col, f32x4 a, f32x4 b) const {
        const u32x4 ap = *(const u32x4*)(APRE + (size_t)row * 512 + col);
        const f32x4 b0 = *(const f32x4*)(bias + col), b1 = *(const f32x4*)(bias + col + 4);
        float v[8] = {a[0] + b0[0], a[1] + b0[1], a[2] + b0[2], a[3] + b0[3], b[0] + b1[0], b[1] + b1[1], b[2] + b1[2], b[3] + b1[3]};
        float y[8] = {bflo(ap.x), bfhi(ap.x), bflo(ap.y), bfhi(ap.y), bflo(ap.z), bfhi(ap.z), bflo(ap.w), bfhi(ap.w)};
#pragma unroll
        for (int i = 0; i < 8; ++i) y[i] = y[i] * sigmoidf_(v[i]);
        u32x4 w; w.x = pk2(y[0], y[1]); w.y = pk2(y[2], y[3]); w.z = pk2(y[4], y[5]); w.w = pk2(y[6], y[7]);
        *(u32x4*)(CAT + (size_t)row * 1024 + col) = w;
    }
};
struct EpRes {
    const float* base; const float* base_meta; float* Z; const float* bias;
    __device__ __forceinline__ void apply8(int row, int col, f32x4 a, f32x4 b) const {
        const float* bp = (base_meta && row >= T) ? base_meta + (size_t)(row - T) * 1024 + col : base + (size_t)row * 1024 + col;
        const f32x4 h0 = *(const f32x4*)bp, h1 = *(const f32x4*)(bp + 4);
        f32x4 o0 = h0 * ALPHA + a, o1 = h1 * ALPHA + b;
        if (bias) { o0 += *(const f32x4*)(bias + col); o1 += *(const f32x4*)(bias + col + 4); }
        float* zp = Z + (size_t)row * 1024 + col;
        *(f32x4*)zp = o0; *(f32x4*)(zp + 4) = o1;
    }
};
struct EpUp {
    bf16_t* H; const float* bias;
    __device__ __forceinline__ void apply8(int row, int col, f32x4 a, f32x4 b) const {
        f32x4 v0 = a + *(const f32x4*)(bias + col), v1 = b + *(const f32x4*)(bias + col + 4);
#pragma unroll
        for (int i = 0; i < 4; ++i) { v0[i] = fmaxf(v0[i], 0.f); v0[i] *= v0[i]; v1[i] = fmaxf(v1[i], 0.f); v1[i] *= v1[i]; }
        u32x4 w; w.x = pk2(v0[0], v0[1]); w.y = pk2(v0[2], v0[3]); w.z = pk2(v1[0], v1[1]); w.w = pk2(v1[2], v1[3]);
        *(u32x4*)(H + (size_t)row * 4096 + col) = w;
    }
};
struct EpInC {
    unsigned short* PC; const float* gamma;
    __device__ __forceinline__ void apply8(int row, int col, f32x4 a, f32x4 b) const {
        u32x4 w;
        if (col >= 1024 && col < 2048) {
            const int c = col - 1024;
            float v[8] = {a[0], a[1], a[2], a[3], b[0], b[1], b[2], b[3]};
            unsigned short h[8];
#pragma unroll
            for (int i = 0; i < 8; ++i) {
                const float lb = 1.0f / (1.0f + __expf(gamma[c + i] - gamma[1024 + c + i]));
                const float f = lb + (1.0f - lb) * sigmoidf_(v[i]);
                const _Float16 hf = (_Float16)__logf(f);
                h[i] = __builtin_bit_cast(unsigned short, hf);
            }
            w.x = h[0] | ((unsigned)h[1] << 16); w.y = h[2] | ((unsigned)h[3] << 16); w.z = h[4] | ((unsigned)h[5] << 16); w.w = h[6] | ((unsigned)h[7] << 16);
        } else { w.x = pk2(a[0], a[1]); w.y = pk2(a[2], a[3]); w.z = pk2(b[0], b[1]); w.w = pk2(b[2], b[3]); }
        *(u32x4*)(PC + (size_t)row * 4096 + col) = w;
    }
};
template <class F> struct EpiAdapt {
    static constexpr bool PERM = true, AFTER_DRAIN = false; F f;
    __device__ __forceinline__ void operator()(const f32x4 (&acc)[2][2][4][2], const pg8::Unit& u, int wr, int wc, int fr, int fq) const {
#pragma unroll
        for (int ai = 0; ai < 2; ++ai)
#pragma unroll
            for (int m = 0; m < 4; ++m) {
                const int row = u.pm * 256 + ai * 128 + wr * 64 + m * 16 + fr;
#pragma unroll
                for (int bj = 0; bj < 2; ++bj) f.apply8(row, u.pn * 256 + bj * 128 + wc * 32 + 8 * fq, acc[ai][bj][m][0], acc[ai][bj][m][1]);
                asm volatile("" ::: "memory");
            }
    }
};
template <class F> __device__ __forceinline__ void meta_gemm(const bf16_t* A16  , const bf16_t* Bt, int N, int K, const F& f, int blk, int G, int wave, int lane) {
    const int l15 = lane & 15, quad = lane >> 4;
    for (int item = blk + G * wave; item < N / 32; item += G * 8) {
        const int c0 = item * 32;
        const bf16_t* ap = A16 + (size_t)l15 * K + 8 * quad;
        const bf16_t* w0 = Bt + (size_t)(c0 + 8 * (l15 >> 2) + (l15 & 3)) * K + 8 * quad;
        const bf16_t* w1 = w0 + (size_t)4 * K;
        f32x4 acc0 = {0.f, 0.f, 0.f, 0.f}, acc1 = {0.f, 0.f, 0.f, 0.f};
#pragma unroll 8
        for (int k = 0; k < K; k += 32) {
            const bf16x8 xa = *(const bf16x8*)(ap + k), b0 = *(const bf16x8*)(w0 + k), b1 = *(const bf16x8*)(w1 + k);
            acc0 = MFMA16(b0, xa, acc0); acc1 = MFMA16(b1, xa, acc1);
        }
        f.apply8(T + l15, c0 + 8 * quad, acc0, acc1);
    }
}
template <class F> __device__ __forceinline__ void run_gemm(LAS unsigned char* lds, const bf16_t* A, const bf16_t* Bt, int N, int K, const F& f, bool with_meta, int blk, int G, int wave) {
    pg8::Gemm g{A, Bt, T, N, K}; pg8::StaticOrder S; S.init(T, N, G, blk);
    EpiAdapt<F> E{f};
    pg8::gemm_phase<EpiAdapt<F>, pg8::StaticOrder, true, true>((PG8_LAS unsigned char*)lds, g, S, E, wave);
    if (with_meta) meta_gemm<F>(A + (size_t)T * K, Bt, N, K, f, blk, G, wave, lane_id_v());
}

__device__ __forceinline__ void transpose_item(const float* W, int K, int N, bf16_t* WT, LAS float* scr, int item, int lane) {
    const int nblk = N / 32, kb = item / nblk, nb = item % nblk, k0 = 64 * kb, n0 = 32 * nb;
#pragma unroll 8
    for (int i = 0; i < 32; ++i) { const int kk = 2 * i + (lane >> 5); scr[kk * 33 + (lane & 31)] = W[(size_t)(k0 + kk) * N + n0 + (lane & 31)]; }
    LDS_WAIT();
    const int c = lane & 7;
#pragma unroll
    for (int j = 0; j < 4; ++j) { const int n = (lane >> 3) + 8 * j; const LAS float* s = scr + (8 * c) * 33 + n;
        u32x4 o; o.x = pk2(s[0 * 33], s[1 * 33]); o.y = pk2(s[2 * 33], s[3 * 33]); o.z = pk2(s[4 * 33], s[5 * 33]); o.w = pk2(s[6 * 33], s[7 * 33]);
        *(u32x4*)(WT + (size_t)(n0 + n) * K + k0 + 8 * c) = o; }
    LDS_WAIT();
}
__device__ __forceinline__ void prologue_phase(const Params& P, LAS unsigned char* lds, int blk, int G, int wave) {
    const int lane = lane_id_v(), tid = wave * 64 + lane;
    LAS float* scr = (LAS float*)(lds + wave * 8448);
    const int gw = blk * 8 + wave, NGW = G * 8;
    unsigned char* ws = P.ws;
    constexpr int I_AB = 16 * 64, I_GLU = 8 * 16, I_1M = 16 * 32, I_C = 16 * 128, I_UP = 16 * 128, I_DN = 64 * 32;
    constexpr int NITEMS = I_AB + I_GLU + I_1M + I_C + I_1M + 2 * I_UP + 2 * I_DN;
    for (int it = gw; it < NITEMS; it += NGW) {
        int r = it;
        if (r < I_AB) { transpose_item(P.in[2], 1024, 2048, (bf16_t*)(ws + OFF_WAB), scr, r, lane); continue; } r -= I_AB;
        if (r < I_GLU) { transpose_item(P.in[11], 512, 512, (bf16_t*)(ws + OFF_WGLU), scr, r, lane); continue; } r -= I_GLU;
        if (r < I_1M) { transpose_item(P.in[13], 1024, 1024, (bf16_t*)(ws + OFF_WOAB), scr, r, lane); continue; } r -= I_1M;
        if (r < I_C) { transpose_item(P.in[14], 1024, 4096, (bf16_t*)(ws + OFF_WC), scr, r, lane); continue; } r -= I_C;
        if (r < I_1M) { transpose_item(P.in[17], 1024, 1024, (bf16_t*)(ws + OFF_WOC), scr, r, lane); continue; } r -= I_1M;
        if (r < I_UP) { transpose_item(P.in[20], 1024, 4096, (bf16_t*)(ws + OFF_WUP0), scr, r, lane); continue; } r -= I_UP;
        if (r < I_UP) { transpose_item(P.in[20] + (size_t)1024 * 4096, 1024, 4096, (bf16_t*)(ws + OFF_WUP1), scr, r, lane); continue; } r -= I_UP;
        if (r < I_DN) { transpose_item(P.in[22], 4096, 1024, (bf16_t*)(ws + OFF_WDN0), scr, r, lane); continue; } r -= I_DN;
        transpose_item(P.in[22] + (size_t)4096 * 1024, 4096, 1024, (bf16_t*)(ws + OFF_WDN1), scr, r, lane);
    }
    bf16_t* HB = (bf16_t*)(ws + OFF_HB);
    const size_t n8 = (size_t)R * 1024 / 8;
    for (size_t i = (size_t)blk * 512 + tid; i < n8; i += (size_t)G * 512) {
        const size_t e = i * 8;
        const float* src = e < (size_t)T * 1024 ? P.in[0] + e : P.in[1] + (e - (size_t)T * 1024);
        const f32x4 a = *(const f32x4*)src, b = *(const f32x4*)(src + 4);
        u32x4 w; w.x = pk2(a[0], a[1]); w.y = pk2(a[2], a[3]); w.z = pk2(b[0], b[1]); w.w = pk2(b[2], b[3]);
        *(u32x4*)(HB + e) = w;
    }
}

__device__ __forceinline__ void ln_phase(const float* Zin, float* Fout, bf16_t* Bout, const float* g, const float* bta, int nrows, int blk, int G, int wave) {
    const int lane = lane_id_v();
    for (int row = blk * 8 + wave; row < nrows; row += G * 8) {
        const f32x4* xr = (const f32x4*)(Zin + (size_t)row * 1024) + lane;
        f32x4 v[4]; float s = 0.f;
#pragma unroll
        for (int j = 0; j < 4; ++j) { v[j] = xr[64 * j]; s += (v[j][0] + v[j][1]) + (v[j][2] + v[j][3]); }
#pragma unroll
        for (int o = 1; o < 64; o <<= 1) s += __shfl_xor(s, o);
        const float mean = s * (1.f / 1024.f); float s2 = 0.f;
#pragma unroll
        for (int j = 0; j < 4; ++j) { v[j] = v[j] - mean; s2 += (v[j][0] * v[j][0] + v[j][1] * v[j][1]) + (v[j][2] * v[j][2] + v[j][3] * v[j][3]); }
#pragma unroll
        for (int o = 1; o < 64; o <<= 1) s2 += __shfl_xor(s2, o);
        const float rstd = 1.0f / sqrtf(s2 * (1.f / 1024.f) + 1e-5f);
#pragma unroll
        for (int j = 0; j < 4; ++j) {
            const int col = 4 * (lane + 64 * j);
            const f32x4 gg = *(const f32x4*)(g + col), bb = *(const f32x4*)(bta + col);
            const f32x4 o = v[j] * rstd * gg + bb;
            *(f32x4*)(Fout + (size_t)row * 1024 + col) = o;
            if (Bout) { u32x2 w; w.x = pk2(o[0], o[1]); w.y = pk2(o[2], o[3]); *(u32x2*)(Bout + (size_t)row * 1024 + col) = w; }
        }
    }
}

__device__ __forceinline__ void lam_coef(const float* lam_re, const float* lam_im, float dt, int idx, float& lbr, float& lbi, float& cr, float& ci) {
    const float lr = lam_re[idx], li = lam_im[idx];
    const float er = __expf(lr * dt);
    float ang = li * dt;
    const float kk = rintf(ang * 0.15915494309189535f);
    ang = fmaf(-kk, 6.2831854820251465f, ang); ang = fmaf(-kk, -1.7484555e-7f, ang);
    lbr = er * __cosf(ang); lbi = er * __sinf(ang);
    const float nr = lbr - 1.0f, ni = lbi, den = 1.0f / (lr * lr + li * li);
    cr = (nr * lr + ni * li) * den; ci = (ni * lr - nr * li) * den;
}
__device__ __forceinline__ void s5_phase(const Params& P, LAS unsigned char* lds, int blk, int G, int wave) {
    const int lane = lane_id_v(), l15 = lane & 15, quad = lane >> 4;
    LAS float* bu = (LAS float*)(lds + wave * 12800);
    LAS unsigned* sl = (LAS unsigned*)(lds + wave * 12800 + 8448);
    const bf16_t* PROJ = (const bf16_t*)(P.ws + OFF_BIG + BIG_PROJ);
    bf16_t* APRE = (bf16_t*)(P.ws + OFF_BIG + BIG_APRE);
    for (int item = blk + G * wave; item < 512; item += G * 8) {
        const int b = item >> 5, g = item & 31;
        const float dt = __expf(P.in[5][g]);
        float lbr, lbi, cr_, ci_;
        lam_coef(P.in[3], P.in[4], dt, g * 64 + lane, lbr, lbi, cr_, ci_);
        bf16x8 bfrag[8];
#pragma unroll
        for (int tile = 0; tile < 8; ++tile) {
            const int comp = 16 * tile + l15, st = comp & 63, isim = comp >> 6;
            float a0, a1, cr, ci; lam_coef(P.in[3], P.in[4], dt, g * 64 + st, a0, a1, cr, ci);
            bf16x8 fr = {0, 0, 0, 0, 0, 0, 0, 0};
            if (quad < 2) {
                const float* bre = P.in[6] + (size_t)(g * 64 + st) * 16 + 8 * quad;
                const float* bim = P.in[7] + (size_t)(g * 64 + st) * 16 + 8 * quad;
#pragma unroll
                for (int j = 0; j < 8; ++j) { const float v = isim ? (cr * bim[j] + ci * bre[j]) : (cr * bre[j] - ci * bim[j]); fr[j] = (short)f2bf(v); }
            }
            bfrag[tile] = fr;
        }
        bf16x8 cfrag[4];
#pragma unroll
        for (int ks = 0; ks < 4; ++ks) {
#pragma unroll
            for (int j = 0; j < 8; ++j) {
                const int k = 32 * ks + 8 * quad + j, p = k >> 1;
                const float v = (k & 1) ? -P.in[9][(size_t)(g * 16 + l15) * 64 + p] : P.in[8][(size_t)(g * 16 + l15) * 64 + p];
                cfrag[ks][j] = (short)f2bf(v);
            }
        }
        const float dh = P.in[10][g * 16 + l15];
        float sr = 0.f, si = 0.f;
        const bf16x8 zero8 = {0, 0, 0, 0, 0, 0, 0, 0};
        bf16x8 ua_n = *(const bf16x8*)(PROJ + (size_t)(T + l15) * 2048 + g * 16 + 8 * (quad & 1));
        unsigned short ue_n[4];
#pragma unroll
        for (int r = 0; r < 4; ++r) ue_n[r] = PROJ[(size_t)(T + 4 * quad + r) * 2048 + g * 16 + l15];
        for (int chunk = 0; chunk < 129; ++chunk) {
            const int rowbase = chunk == 0 ? T : b * 2048 + (chunk - 1) * 16;
            const bf16x8 ua = quad < 2 ? ua_n : zero8;
            unsigned short ue[4];
#pragma unroll
            for (int r = 0; r < 4; ++r) ue[r] = ue_n[r];
            {
                const int cn = chunk + 1 < 129 ? chunk + 1 : 128;
                const int rbn = b * 2048 + (cn - 1) * 16;
                ua_n = *(const bf16x8*)(PROJ + (size_t)(rbn + l15) * 2048 + g * 16 + 8 * (quad & 1));
#pragma unroll
                for (int r = 0; r < 4; ++r) ue_n[r] = PROJ[(size_t)(rbn + 4 * quad + r) * 2048 + g * 16 + l15];
            }
#pragma unroll
            for (int tile = 0; tile < 8; ++tile) {
                f32x4 acc = {0.f, 0.f, 0.f, 0.f};
                acc = MFMA16(ua, bfrag[tile], acc);
#pragma unroll
                for (int r = 0; r < 4; ++r) bu[(4 * quad + r) * 132 + 16 * tile + l15] = acc[r];
            }
            LDS_WAIT();
#pragma unroll
            for (int t = 0; t < 16; ++t) {
                const float br = bu[t * 132 + lane], bi = bu[t * 132 + 64 + lane];
                const float nsr = fmaf(lbr, sr, fmaf(-lbi, si, br)), nsi = fmaf(lbr, si, fmaf(lbi, sr, bi));
                sr = nsr; si = nsi;
                sl[t * 68 + lane] = pk2(sr, si);
            }
            LDS_WAIT();
            f32x4 y = {0.f, 0.f, 0.f, 0.f};
#pragma unroll
            for (int ks = 0; ks < 4; ++ks) {
                const bf16x8 sa = *(const LAS bf16x8*)((const LAS bf16_t*)sl + l15 * 136 + 32 * ks + 8 * quad);
                y = MFMA16(sa, cfrag[ks], y);
            }
            if (chunk > 0 || b == 0) {
#pragma unroll
                for (int r = 0; r < 4; ++r) {
                    const size_t row = (size_t)(rowbase + 4 * quad + r);
                    const float u = bf2f(ue[r]);
                    const float v = y[r] + dh * u;
                    const float a2 = 1.5957691216057308f * (v + 0.044715f * v * v * v);
                    APRE[row * 512 + g * 16 + l15] = f2bf(v * sigmoidf_(a2));
                }
            }
            LDS_WAIT();
        }
    }
}

__device__ __forceinline__ void attn_tile_sub(const LAS bf16_t* Kl, const LAS bf16_t* Vl, const bf16x8 (&qf)[4], int sub, int keybase  ,
                                              int iq, int l31, int h, f32x16& o0, f32x16& o1, float& Rrun) {
    f32x16 st;
#pragma unroll
    for (int i = 0; i < 16; ++i) st[i] = 0.f;
#pragma unroll
    for (int s = 0; s < 4; ++s) {
        const bf16x8 ka = *(const LAS bf16x8*)(Kl + (32 * sub + l31) * 72 + 16 * s + 8 * h);
        st = MFMA32(ka, qf[s], st);
    }
    float lk[16]; bool vis[16];
#pragma unroll
    for (int i = 0; i < 16; ++i) {
        const int kl = 32 * sub + (i & 3) + 8 * (i >> 2) + 4 * h;
        vis[i] = keybase >= 0 ? (keybase + kl < iq) : (kl < 16);
        const float e = __builtin_amdgcn_exp2f(fminf(st[i], 100.f));
        const float sp = __builtin_amdgcn_logf(1.0f + e);
        lk[i] = vis[i] ? -sp : 0.f;
    }
    float ga[4], pa[4];
#pragma unroll
    for (int a = 0; a < 4; ++a) { ga[a] = (lk[4 * a] + lk[4 * a + 1]) + (lk[4 * a + 2] + lk[4 * a + 3]); pa[a] = __shfl_xor(ga[a], 32); }
    float run = Rrun; float w[16];
#pragma unroll
    for (int a = 3; a >= 0; --a) {
        const float off = h ? run : run + pa[a];
        const float I3 = off + lk[4 * a + 3], I2 = I3 + lk[4 * a + 2], I1 = I2 + lk[4 * a + 1], I0 = I1 + lk[4 * a];
        w[4 * a + 3] = vis[4 * a + 3] ? __builtin_amdgcn_exp2f(st[4 * a + 3] + I3) : 0.f;
        w[4 * a + 2] = vis[4 * a + 2] ? __builtin_amdgcn_exp2f(st[4 * a + 2] + I2) : 0.f;
        w[4 * a + 1] = vis[4 * a + 1] ? __builtin_amdgcn_exp2f(st[4 * a + 1] + I1) : 0.f;
        w[4 * a + 0] = vis[4 * a + 0] ? __builtin_amdgcn_exp2f(st[4 * a + 0] + I0) : 0.f;
        run += ga[a] + pa[a];
    }
    Rrun = run;
#pragma unroll
    for (int s2 = 0; s2 < 2; ++s2) {
        u32x4 pw; pw.x = pk2(w[8 * s2], w[8 * s2 + 1]); pw.y = pk2(w[8 * s2 + 2], w[8 * s2 + 3]); pw.z = pk2(w[8 * s2 + 4], w[8 * s2 + 5]); pw.w = pk2(w[8 * s2 + 6], w[8 * s2 + 7]);
        const bf16x8 pb = __builtin_bit_cast(bf16x8, pw);
#pragma unroll
        for (int mt = 0; mt < 2; ++mt) {
            const LAS bf16_t* vp = Vl + (32 * mt + l31) * 68 + 32 * sub + 16 * s2 + 4 * h;
            const s16x4 lo = *(const LAS s16x4*)vp, hi = *(const LAS s16x4*)(vp + 8);
            const bf16x8 va = __builtin_shufflevector(lo, hi, 0, 1, 2, 3, 4, 5, 6, 7);
            if (mt == 0) o0 = MFMA32(va, pb, o0); else o1 = MFMA32(va, pb, o1);
        }
    }
}
__device__ __forceinline__ void attn_phase(const Params& P, LAS unsigned char* lds, int blk, int G, int wave) {
    const int lane = lane_id_v(), tid = wave * 64 + lane, l31 = lane & 31, h = lane >> 5;
    const bf16_t* PROJ = (const bf16_t*)(P.ws + OFF_BIG + BIG_PROJ);
    bf16_t* CAT = (bf16_t*)(P.ws + OFF_BIG + BIG_CAT);
    if (blk == G - 1) {
        LAS float* wm = (LAS float*)(lds + 40960);
        if (tid < 128) {
            const int t = tid & 15, hd = tid >> 4;
            const bf16_t* qp = PROJ + (size_t)(T + t) * 2048 + 512 + hd * 64;
            float run = 0.f;
            for (int j = 15; j >= 0; --j) {
                float wv = 0.f;
                if (j < t) {
                    const bf16_t* kp = PROJ + (size_t)(T + j) * 2048 + 1024 + hd * 64;
                    float z = 0.f;
                    for (int d = 0; d < 64; ++d) z = fmaf(bf2f(qp[d]), bf2f(kp[d]), z);
                    const float sp = __builtin_amdgcn_logf(1.0f + __builtin_amdgcn_exp2f(fminf(z, 100.f)));
                    run -= sp; wv = __builtin_amdgcn_exp2f(z + run);
                }
                wm[tid * 16 + j] = wv;
            }
        }
        __syncthreads();
        for (int idx = tid; idx < 16 * 512; idx += 512) {
            const int t = idx >> 9, c = idx & 511, hd = c >> 6;
            float o = 0.f;
            for (int j = 0; j < 16; ++j) o = fmaf(wm[(hd * 16 + t) * 16 + j], bf2f(PROJ[(size_t)(T + j) * 2048 + 1536 + c]), o);
            CAT[(size_t)(T + t) * 1024 + 512 + c] = f2bf(o);
        }
        __syncthreads();
    }
    LAS bf16_t* Kl0 = (LAS bf16_t*)lds;
    LAS bf16_t* Vl0 = (LAS bf16_t*)(lds + 2 * 9216);
    const int lkey = tid >> 3, lpart = tid & 7;
    for (int j4 = 0; j4 < 4; ++j4) {
        const int item = blk + G * j4;
        if (item >= 1024) break;
        const int c = item % 256, jj = item / 256, bh = c >> 1, par = c & 1;
        const int qb = par == 0 ? (jj == 0 ? 7 : jj == 1 ? 0 : jj == 2 ? 4 : 3) : (jj == 0 ? 6 : jj == 1 ? 1 : jj == 2 ? 5 : 2);
        const int b = bh >> 3, hd = bh & 7;
        const int iq = 256 * qb + 32 * wave + l31;
        const size_t qrow = (size_t)b * 2048 + iq;
        bf16x8 qf[4];
#pragma unroll
        for (int s = 0; s < 4; ++s) qf[s] = *(const bf16x8*)(PROJ + qrow * 2048 + 512 + hd * 64 + 16 * s + 8 * h);
        f32x16 o0, o1;
#pragma unroll
        for (int i = 0; i < 16; ++i) { o0[i] = 0.f; o1[i] = 0.f; }
        float Rrun = 0.f;
        const int nt = 4 * qb + 5;
        u32x4 kreg, vreg;
#define ATT_LOAD(it_) do { const int kt_ = 4 * qb + 3 - (it_); size_t row_; bool ok_ = true; \
            if (kt_ >= 0) row_ = (size_t)b * 2048 + 64 * kt_ + lkey; else { row_ = (size_t)T + lkey; ok_ = lkey < 16; } \
            if (ok_) { const bf16_t* p_ = PROJ + row_ * 2048 + 1024 + hd * 64 + lpart * 8; kreg = *(const u32x4*)p_; vreg = *(const u32x4*)(p_ + 512); } \
            else { kreg = (u32x4){0u, 0u, 0u, 0u}; vreg = kreg; } } while (0)
#define ATT_STORE(buf_) do { *(LAS u32x4*)(Kl0 + (buf_) * 4608 + lkey * 72 + lpart * 8) = kreg; \
            LAS bf16_t* vt_ = Vl0 + (buf_) * 4352 + (lpart * 8) * 68 + lkey; \
            vt_[0 * 68] = (bf16_t)(vreg.x & 0xffffu); vt_[1 * 68] = (bf16_t)(vreg.x >> 16); \
            vt_[2 * 68] = (bf16_t)(vreg.y & 0xffffu); vt_[3 * 68] = (bf16_t)(vreg.y >> 16); \
            vt_[4 * 68] = (bf16_t)(vreg.z & 0xffffu); vt_[5 * 68] = (bf16_t)(vreg.z >> 16); \
            vt_[6 * 68] = (bf16_t)(vreg.w & 0xffffu); vt_[7 * 68] = (bf16_t)(vreg.w >> 16); } while (0)
        ATT_LOAD(0); ATT_STORE(0);
        __syncthreads();
        int cur = 0;
        for (int it = 0; it < nt; ++it) {
            if (it + 1 < nt) ATT_LOAD(it + 1);
            const int kt = 4 * qb + 3 - it;
            const int keybase = kt >= 0 ? 64 * kt : -1;
            const int wq_end = 256 * qb + 32 * wave + 32;
            const LAS bf16_t* Kl = Kl0 + cur * 4608; const LAS bf16_t* Vl = Vl0 + cur * 4352;
            if (kt < 0) { attn_tile_sub(Kl, Vl, qf, 0, -1, iq, l31, h, o0, o1, Rrun); }
            else {
                if (keybase + 32 < wq_end) attn_tile_sub(Kl, Vl, qf, 1, keybase, iq, l31, h, o0, o1, Rrun);
                if (keybase < wq_end) attn_tile_sub(Kl, Vl, qf, 0, keybase, iq, l31, h, o0, o1, Rrun);
            }
            if (it + 1 < nt) ATT_STORE(cur ^ 1);
            __syncthreads();
            cur ^= 1;
        }
        bf16_t* op = CAT + qrow * 1024 + 512 + hd * 64;
#pragma unroll
        for (int a = 0; a < 4; ++a) {
            u32x2 w0; w0.x = pk2(o0[4 * a], o0[4 * a + 1]); w0.y = pk2(o0[4 * a + 2], o0[4 * a + 3]);
            u32x2 w1; w1.x = pk2(o1[4 * a], o1[4 * a + 1]); w1.y = pk2(o1[4 * a + 2], o1[4 * a + 3]);
            *(u32x2*)(op + 8 * a + 4 * h) = w0; *(u32x2*)(op + 32 + 8 * a + 4 * h) = w1;
        }
    }
}

__device__ __forceinline__ void hgrn_phase(const Params& P, LAS unsigned char* lds, int blk, int G, int wave) {
    const int lane = lane_id_v(), tid = wave * 64 + lane, l15 = lane & 15, quad = lane >> 4;
    LAS bf16_t* qd = (LAS bf16_t*)lds;
    LAS bf16_t* kd = qd + 64 * 136;
    LAS bf16_t* klT = kd + 64 * 136;
    LAS bf16_t* vT = klT + 128 * 72;
    LAS bf16_t* sc = vT + 128 * 72;
    LAS float* ebl = (LAS float*)(sc + 64 * 72);
    LAS float* segtot = ebl + 128;
    LAS float* red = segtot + 1024;
    const unsigned short* PC = (const unsigned short*)(P.ws + OFF_BIG);
    bf16_t* MIXC = (bf16_t*)(P.ws + OFF_HB);
    const float* ng = P.in[16];
    for (int item = blk; item < 128; item += G) {
        const int b = item >> 3, hd = item & 7;
        f32x4 Sacc[8];
#pragma unroll
        for (int i = 0; i < 8; ++i) Sacc[i] = (f32x4){0.f, 0.f, 0.f, 0.f};
        const int dp = tid & 63, sg = tid >> 6;
        unsigned lfc[8], qc[8], vc[8];
#define HG_ROW(cc_, t_) ((cc_) > 0 ? (size_t)b * 2048 + ((cc_) - 1) * 64 + (t_) : (size_t)T + ((t_) >= 48 ? (t_) - 48 : 0))
#define HG_LOAD(cc_, LF_, Q_, V_) do { _Pragma("unroll") for (int tt_ = 0; tt_ < 8; ++tt_) { const unsigned short* rp_ = PC + HG_ROW(cc_, 8 * sg + tt_) * 4096 + hd * 128 + 2 * dp; \
            Q_[tt_] = *(const unsigned*)rp_; LF_[tt_] = *(const unsigned*)(rp_ + 1024); V_[tt_] = *(const unsigned*)(rp_ + 2048); } } while (0)
        HG_LOAD(0, lfc, qc, vc);
        for (int c = 0; c < 33; ++c) {
            unsigned lfn[8], qn[8], vn[8];
            { const int cn = c + 1 < 33 ? c + 1 : 32; HG_LOAD(cn, lfn, qn, vn); }
            unsigned short gr[16];
            {
                const int cg_ = c > 0 ? c : 1;
#pragma unroll
                for (int tt = 0; tt < 4; ++tt)
#pragma unroll
                    for (int r = 0; r < 4; ++r) gr[4 * tt + r] = PC[((size_t)b * 2048 + (cg_ - 1) * 64 + 16 * tt + 4 * quad + r) * 4096 + 3072 + hd * 128 + 16 * wave + l15];
            }
            {
                float cs0[8], cs1[8]; float run0 = 0.f, run1 = 0.f;
#pragma unroll
                for (int tt = 0; tt < 8; ++tt) {
                    const bool ok = c > 0 || (8 * sg + tt) >= 48;
                    const float l0 = ok ? (float)__builtin_bit_cast(_Float16, (unsigned short)(lfc[tt] & 0xffffu)) : 0.f;
                    const float l1 = ok ? (float)__builtin_bit_cast(_Float16, (unsigned short)(lfc[tt] >> 16)) : 0.f;
                    run0 += l0; run1 += l1; cs0[tt] = run0; cs1[tt] = run1;
                }
                segtot[sg * 128 + 2 * dp] = run0; segtot[sg * 128 + 2 * dp + 1] = run1;
                __syncthreads();
                float off0 = 0.f, off1 = 0.f, bl0 = 0.f, bl1 = 0.f;
#pragma unroll
                for (int s2 = 0; s2 < 8; ++s2) {
                    const float a0 = segtot[s2 * 128 + 2 * dp], a1 = segtot[s2 * 128 + 2 * dp + 1];
                    bl0 += a0; bl1 += a1; if (s2 < sg) { off0 += a0; off1 += a1; }
                }
                if (sg == 7) { ebl[2 * dp] = __expf(bl0); ebl[2 * dp + 1] = __expf(bl1); }
                unsigned kl0[4], kl1[4], v0[4], v1[4];
#pragma unroll
                for (int tp = 0; tp < 4; ++tp) {
                    float klv0[2], klv1[2];
#pragma unroll
                    for (int e = 0; e < 2; ++e) {
                        const int tt = 2 * tp + e, t = 8 * sg + tt;
                        const bool ok = c > 0 || t >= 48;
                        const float lf0 = cs0[tt] - (tt ? cs0[tt - 1] : 0.f), lf1 = cs1[tt] - (tt ? cs1[tt - 1] : 0.f);
                        const float bt0 = off0 + cs0[tt], bt1 = off1 + cs1[tt];
                        const float q0 = ok ? bflo(qc[tt]) : 0.f, q1 = ok ? bfhi(qc[tt]) : 0.f;
                        const float k0 = 1.0f - __expf(lf0), k1 = 1.0f - __expf(lf1);
                        *(LAS unsigned*)(qd + t * 136 + 2 * dp) = pk2(q0 * __expf(bt0), q1 * __expf(bt1));
                        *(LAS unsigned*)(kd + t * 136 + 2 * dp) = pk2(k0 * __expf(-bt0), k1 * __expf(-bt1));
                        klv0[e] = k0 * __expf(bl0 - bt0); klv1[e] = k1 * __expf(bl1 - bt1);
                    }
                    kl0[tp] = pk2(klv0[0], klv0[1]); kl1[tp] = pk2(klv1[0], klv1[1]);
                    const bool okA = c > 0 || (8 * sg + 2 * tp) >= 48, okB = c > 0 || (8 * sg + 2 * tp + 1) >= 48;
                    const unsigned va = okA ? vc[2 * tp] : 0u, vb = okB ? vc[2 * tp + 1] : 0u;
                    v0[tp] = (va & 0xffffu) | (vb << 16); v1[tp] = (va >> 16) | (vb & 0xffff0000u);
                }
                *(LAS u32x4*)(klT + (2 * dp) * 72 + 8 * sg) = (u32x4){kl0[0], kl0[1], kl0[2], kl0[3]};
                *(LAS u32x4*)(klT + (2 * dp + 1) * 72 + 8 * sg) = (u32x4){kl1[0], kl1[1], kl1[2], kl1[3]};
                *(LAS u32x4*)(vT + (2 * dp) * 72 + 8 * sg) = (u32x4){v0[0], v0[1], v0[2], v0[3]};
                *(LAS u32x4*)(vT + (2 * dp + 1) * 72 + 8 * sg) = (u32x4){v1[0], v1[1], v1[2], v1[3]};
            }
            __syncthreads();
            f32x4 oacc[4];
#pragma unroll
            for (int i = 0; i < 4; ++i) oacc[i] = (f32x4){0.f, 0.f, 0.f, 0.f};
#pragma unroll
            for (int ks = 0; ks < 4; ++ks) {
                u32x4 sw; sw.x = pk2(Sacc[2 * ks][0], Sacc[2 * ks][1]); sw.y = pk2(Sacc[2 * ks][2], Sacc[2 * ks][3]);
                sw.z = pk2(Sacc[2 * ks + 1][0], Sacc[2 * ks + 1][1]); sw.w = pk2(Sacc[2 * ks + 1][2], Sacc[2 * ks + 1][3]);
                const bf16x8 sb = __builtin_bit_cast(bf16x8, sw);
#pragma unroll
                for (int tt = 0; tt < 4; ++tt) {
                    const LAS bf16_t* ap = qd + (16 * tt + l15) * 136 + 32 * ks + 4 * quad;
                    const s16x4 lo = *(const LAS s16x4*)ap, hi = *(const LAS s16x4*)(ap + 16);
                    oacc[tt] = MFMA16(__builtin_shufflevector(lo, hi, 0, 1, 2, 3, 4, 5, 6, 7), sb, oacc[tt]);
                }
            }
#pragma unroll
            for (int e = 0; e < 2; ++e) {
                const int tile = 2 * wave + e, tt = tile >> 2, ss = tile & 3;
                f32x4 sa = {0.f, 0.f, 0.f, 0.f};
#pragma unroll
                for (int ks = 0; ks < 4; ++ks) {
                    const bf16x8 a = *(const LAS bf16x8*)(qd + (16 * tt + l15) * 136 + 32 * ks + 8 * quad);
                    const bf16x8 bb = *(const LAS bf16x8*)(kd + (16 * ss + l15) * 136 + 32 * ks + 8 * quad);
                    sa = MFMA16(a, bb, sa);
                }
#pragma unroll
                for (int r = 0; r < 4; ++r) { const int tg = 16 * tt + 4 * quad + r, sg_ = 16 * ss + l15; sc[tg * 72 + sg_] = f2bf(sg_ <= tg ? sa[r] : 0.f); }
            }
            __syncthreads();
#pragma unroll
            for (int dt = 0; dt < 8; ++dt)
#pragma unroll
                for (int r = 0; r < 4; ++r) Sacc[dt][r] *= ebl[16 * dt + 4 * quad + r];
#pragma unroll
            for (int ks = 0; ks < 2; ++ks) {
                const bf16x8 vb = *(const LAS bf16x8*)(vT + (16 * wave + l15) * 72 + 32 * ks + 8 * quad);
#pragma unroll
                for (int tt = 0; tt < 4; ++tt) { const bf16x8 a = *(const LAS bf16x8*)(sc + (16 * tt + l15) * 72 + 32 * ks + 8 * quad); oacc[tt] = MFMA16(a, vb, oacc[tt]); }
#pragma unroll
                for (int dt = 0; dt < 8; ++dt) { const bf16x8 a = *(const LAS bf16x8*)(klT + (16 * dt + l15) * 72 + 32 * ks + 8 * quad); Sacc[dt] = MFMA16(a, vb, Sacc[dt]); }
            }
#pragma unroll
            for (int tt = 0; tt < 4; ++tt)
#pragma unroll
                for (int r = 0; r < 4; ++r) {
                    float s = oacc[tt][r] * oacc[tt][r];
                    s += __shfl_xor(s, 1); s += __shfl_xor(s, 2); s += __shfl_xor(s, 4); s += __shfl_xor(s, 8);
                    if (l15 == 0) red[(16 * tt + 4 * quad + r) * 8 + wave] = s;
                }
            __syncthreads();
            if (c > 0) {
                const int dvg = hd * 128 + 16 * wave + l15;
                const float gn = ng[dvg];
#pragma unroll
                for (int tt = 0; tt < 4; ++tt)
#pragma unroll
                    for (int r = 0; r < 4; ++r) {
                        const int t = 16 * tt + 4 * quad + r;
                        const f32x4 r0 = *(const LAS f32x4*)(red + t * 8), r1 = *(const LAS f32x4*)(red + t * 8 + 4);
                        const float ssum = ((r0[0] + r0[1]) + (r0[2] + r0[3])) + ((r1[0] + r1[1]) + (r1[2] + r1[3]));
                        const float rs = 1.0f / sqrtf(ssum * (1.0f / 128.0f) + 1e-6f);
                        const size_t row = (size_t)b * 2048 + (c - 1) * 64 + t;
                        const float gv = bf2f(gr[4 * tt + r]);
                        MIXC[row * 1024 + dvg] = f2bf(oacc[tt][r] * rs * gn * gv * sigmoidf_(gv));
                    }
            }
#pragma unroll
            for (int i = 0; i < 8; ++i) { lfc[i] = lfn[i]; qc[i] = qn[i]; vc[i] = vn[i]; }
        }
        __syncthreads();
    }
}

__global__ void __launch_bounds__(512, 2) fwd_megakernel(Params P) {
    extern __shared__ __attribute__((aligned(16))) unsigned char lds_raw[];
    LAS unsigned char* lds = (LAS unsigned char*)lds_raw;
    cg::grid_group grid = cg::this_grid();
    const int blk = blockIdx.x, G = gridDim.x, wave = __builtin_amdgcn_readfirstlane((int)(threadIdx.x >> 6));
    unsigned char* ws = P.ws;
    bf16_t* HB = (bf16_t*)(ws + OFF_HB);
    float* Z = (float*)(ws + OFF_Z);
    bf16_t* PROJ = (bf16_t*)(ws + OFF_BIG + BIG_PROJ);
    bf16_t* APRE = (bf16_t*)(ws + OFF_BIG + BIG_APRE);
    bf16_t* CAT = (bf16_t*)(ws + OFF_BIG + BIG_CAT);
    bf16_t* HID = (bf16_t*)(ws + OFF_BIG);
    unsigned short* PC = (unsigned short*)(ws + OFF_BIG);

    prologue_phase(P, lds, blk, G, wave);
    grid.sync();
    run_gemm(lds, HB, (const bf16_t*)(ws + OFF_WAB), 2048, 1024, EpInAB{PROJ}, true, blk, G, wave);
    grid.sync();
    s5_phase(P, lds, blk, G, wave);
    __syncthreads();
#if PROBE_DUP_S5
    s5_phase(P, lds, blk, G, wave);
    __syncthreads();
#endif
    attn_phase(P, lds, blk, G, wave);
#if PROBE_DUP_ATTN
    __syncthreads();
    attn_phase(P, lds, blk, G, wave);
#endif
    grid.sync();
    run_gemm(lds, APRE, (const bf16_t*)(ws + OFF_WGLU), 512, 512, EpGlu{APRE, P.in[12], CAT}, true, blk, G, wave);
    grid.sync();
    run_gemm(lds, CAT, (const bf16_t*)(ws + OFF_WOAB), 1024, 1024, EpRes{P.in[0], P.in[1], Z, nullptr}, true, blk, G, wave);
    grid.sync();
    ln_phase(Z, Z, HB, P.in[18], P.in[19], R, blk, G, wave);
    grid.sync();
    run_gemm(lds, HB, (const bf16_t*)(ws + OFF_WUP0), 4096, 1024, EpUp{HID, P.in[21]}, true, blk, G, wave);
    grid.sync();
    run_gemm(lds, HID, (const bf16_t*)(ws + OFF_WDN0), 1024, 4096, EpRes{Z, nullptr, Z, P.in[23]}, true, blk, G, wave);
    grid.sync();
    ln_phase(Z, Z, HB, P.in[24], P.in[25], R, blk, G, wave);
    grid.sync();
    run_gemm(lds, HB, (const bf16_t*)(ws + OFF_WC), 4096, 1024, EpInC{PC, P.in[15]}, true, blk, G, wave);
#if PROBE_DUP_INC
    __syncthreads();
    run_gemm(lds, HB, (const bf16_t*)(ws + OFF_WC), 4096, 1024, EpInC{PC, P.in[15]}, true, blk, G, wave);
#endif
    grid.sync();
    hgrn_phase(P, lds, blk, G, wave);
#if PROBE_DUP_HGRN
    __syncthreads();
    hgrn_phase(P, lds, blk, G, wave);
#endif
    grid.sync();
    run_gemm(lds, HB  , (const bf16_t*)(ws + OFF_WOC), 1024, 1024, EpRes{Z, nullptr, Z, nullptr}, false, blk, G, wave);
    grid.sync();
    ln_phase(Z, Z, HB, P.in[18] + 1024, P.in[19] + 1024, T, blk, G, wave);
    grid.sync();
    run_gemm(lds, HB, (const bf16_t*)(ws + OFF_WUP1), 4096, 1024, EpUp{HID, P.in[21] + 4096}, false, blk, G, wave);
    grid.sync();
    run_gemm(lds, HID, (const bf16_t*)(ws + OFF_WDN1), 1024, 4096, EpRes{Z, nullptr, Z, P.in[23] + 1024}, false, blk, G, wave);
    grid.sync();
    ln_phase(Z, P.out, nullptr, P.in[24] + 1024, P.in[25] + 1024, T, blk, G, wave);
}

extern "C" void kernel_launch(void* const* d_in, const int* in_sizes, int n_in, void* d_out, int out_size, void* d_ws, size_t ws_size, hipStream_t stream) {
    constexpr size_t kDynLds = 131072;
    static int grid_blocks = 0;
    if (!grid_blocks) {
        if (n_in != 26 || ws_size < WS_END) { fprintf(stderr, "kernel_launch: expected 26 inputs and >= %zu bytes of workspace (got %d, %zu)\n", (size_t)WS_END, n_in, ws_size); grid_blocks = -1; return; }
        int dev = 0, cus = 0, per_cu = 0;
        hipGetDevice(&dev);
        hipDeviceGetAttribute(&cus, hipDeviceAttributeMultiprocessorCount, dev);
        hipFuncSetAttribute((const void*)fwd_megakernel, hipFuncAttributeMaxDynamicSharedMemorySize, (int)kDynLds);
        hipOccupancyMaxActiveBlocksPerMultiprocessor(&per_cu, (const void*)fwd_megakernel, 512, kDynLds);
        if (per_cu < 1) { fprintf(stderr, "kernel_launch: occupancy query says %d blocks per CU\n", per_cu); per_cu = 1; }
        grid_blocks = cus * (per_cu > 1 ? 1 : per_cu);
        if (grid_blocks != 256) fprintf(stderr, "kernel_launch: note: grid is %d workgroups (tuned for 256)\n", grid_blocks);
    }
    if (grid_blocks < 1) return;
    Params p{};
    for (int i = 0; i < 26; ++i) p.in[i] = (const float*)d_in[i];
    p.out = (float*)d_out; p.ws = (unsigned char*)d_ws;
    void* args[] = {&p};
    hipError_t e = hipLaunchCooperativeKernel((const void*)fwd_megakernel, dim3(grid_blocks), dim3(512), args, kDynLds, stream);
    if (e != hipSuccess) fprintf(stderr, "cooperative launch failed: %s (grid %d)\n", hipGetErrorString(e), grid_blocks);
}
```

```cpp
#include <hip/hip_runtime.h>
#include <hip/hip_cooperative_groups.h>
#include <cstdio>
#include <cstdint>
namespace cg = cooperative_groups;
#ifndef PROBE_DUP_S5
#define PROBE_DUP_S5 0
#endif
#ifndef PROBE_DUP_ATTN
#define PROBE_DUP_ATTN 0
#endif
#ifndef PROBE_DUP_HGRN
#define PROBE_DUP_HGRN 0
#endif
#ifndef PROBE_DUP_INC
#define PROBE_DUP_INC 0
#endif
__device__ __forceinline__ int lane_id_v() { int l; asm volatile("v_mbcnt_lo_u32_b32 %0, -1, 0\n\tv_mbcnt_hi_u32_b32 %0, -1, %0" : "=v"(l)); return l; }
namespace pg8 {
#define PG8_LAS __attribute__((address_space(3)))
typedef unsigned short bf16_t;
typedef short bf16x8 __attribute__((ext_vector_type(8)));
typedef float f32x4 __attribute__((ext_vector_type(4)));
typedef unsigned u32x4 __attribute__((ext_vector_type(4)));
constexpr int BM = 256, BK = 64, HALF = 128, HTB = HALF * BK * 2  , STAGE_BYTES = 8 * HTB, NXCD = 8, WGM = 8;

__host__ __device__ __forceinline__ int lds_byte(int r, int c) { const int st = (r >> 4) * 2 + (c >> 5), rr = r & 15, cc = c & 31, ob = rr * 64 + cc * 2; return st * 1024 + (ob ^ (((ob >> 9) & 1) << 5)); }
__host__ __device__ __forceinline__ void stage_rc(int b, int& R, int& C) { const int st = b / 1024, sb = b % 1024, swz = sb ^ (((sb >> 9) & 1) << 5); R = (st >> 1) * 16 + swz / 64; C = (st & 1) * 32 + (swz % 64) / 2; }
__host__ __device__ __forceinline__ int perm32(int rho) { const int n = rho >> 4, i = rho & 15; return 8 * (i >> 2) + 4 * n + (i & 3); }

struct Unit { int pm, pn; };
struct Gemm { const bf16_t* A; const bf16_t* Bt; int M, N, K; };

struct StaticOrder {
    int nM, nN, nwg, G, c;
    __host__ __device__ void init(int M, int N, int G_, int c_) { nM = M / BM; nN = N / BM; nwg = nM * nN; G = G_; c = c_; }
    __host__ __device__ bool next(int i, Unit& u) const {
        const long L = (long)i * G + c; if (L >= nwg) return false;
        int wgid = (int)L; { const int q = nwg / NXCD, r = nwg % NXCD, xcd = wgid % NXCD, off = wgid / NXCD; wgid = (xcd < r ? xcd * (q + 1) : r * (q + 1) + (xcd - r) * q) + off; }
        const int nig = WGM * nN, gid = wgid / nig, fm = gid * WGM, gsz = (nM - fm) < WGM ? (nM - fm) : WGM;
        u.pm = fm + ((wgid % nig) % gsz); u.pn = (wgid % nig) / gsz; return true;
    }
    __device__ __forceinline__ void a_ready(const Unit&) const {}
    __device__ __forceinline__ void done(const Unit&) const {}
};

__device__ __forceinline__ unsigned cvt_pk_bf16(float lo, float hi) { unsigned r; asm volatile("v_cvt_pk_bf16_f32 %0, %1, %2" : "=v"(r) : "v"(lo), "v"(hi)); return r; }
template <class Epi, class Sched, bool ALIGN_EPI = false, bool SP2 = false>
__device__ __forceinline__ void gemm_phase(PG8_LAS unsigned char* lds, const Gemm g, const Sched& S, const Epi& E, int wave_in) {
    const int lane = lane_id_v(), wid = __builtin_amdgcn_readfirstlane(wave_in), tid = wid * 64 + lane, wr = wid >> 2, wc = wid & 3, fr = lane & 15, fq = lane >> 4;
    const int K = g.K, nt = K / BK;
    unsigned voffA[2], voffB[2];
#pragma unroll
    for (int i = 0; i < 2; ++i) { int R, C; stage_rc(tid * 16 + i * 8192, R, C); const int Rb = Epi::PERM ? ((R & ~31) + perm32(R & 31)) : R;
        voffA[i] = (unsigned)(R * K + C) * 2u; voffB[i] = (unsigned)(Rb * K + C) * 2u; }
    const size_t kstep = (size_t)(BK * 2);
    const size_t hstep = (size_t)HALF * K * 2;
    const size_t tstep = 2 * hstep;
    const unsigned ldsw = (unsigned)wid * 1024u;
    const int aoff = lds_byte(wr * 64 + fr, fq * 8), boff = lds_byte(wc * 32 + fr, fq * 8);
#define PG8_SA(b, h) (((b) * 2 + (h)) * HTB)
#define PG8_SB(b, h) ((4 + (b) * 2 + (h)) * HTB)
#define PG8_STAGE(bufoff, gbase, voff) do { _Pragma("unroll") for (int _i = 0; _i < 2; ++_i) \
        __builtin_amdgcn_global_load_lds((const unsigned*)((const char*)(gbase) + (voff)[_i]), (PG8_LAS unsigned*)(lds + (bufoff) + ldsw + _i * 8192), 16, 0, 0); } while (0)
#define PG8_LDA(dst, b, h) do { _Pragma("unroll") for (int m = 0; m < 4; ++m) _Pragma("unroll") for (int k = 0; k < 2; ++k) dst[m][k] = *(const PG8_LAS bf16x8*)(lds + PG8_SA(b, h) + aoff + m * 2048 + k * 1024); } while (0)
#define PG8_LDB(dst, b, h) do { _Pragma("unroll") for (int n = 0; n < 2; ++n) _Pragma("unroll") for (int k = 0; k < 2; ++k) dst[n][k] = *(const PG8_LAS bf16x8*)(lds + PG8_SB(b, h) + boff + n * 2048 + k * 1024); } while (0)
#define PG8_MMA(ai, bj, At, Bt) do { __builtin_amdgcn_s_setprio(1); _Pragma("unroll") for (int m = 0; m < 4; ++m) _Pragma("unroll") for (int n = 0; n < 2; ++n) _Pragma("unroll") for (int k = 0; k < 2; ++k) \
        acc[ai][bj][m][n] = __builtin_amdgcn_mfma_f32_16x16x32_bf16(Bt[n][k], At[m][k], acc[ai][bj][m][n], 0, 0, 0); __builtin_amdgcn_s_setprio(0); } while (0)
#define PG8_WAIT_V(n) asm volatile("s_waitcnt vmcnt(" #n ")" ::: "memory")
#define PG8_WAIT_L(n) asm volatile("s_waitcnt lgkmcnt(" #n ")" ::: "memory")
#define PG8_BAR __builtin_amdgcn_s_barrier()
#define PG8_SCHED __builtin_amdgcn_sched_barrier(0)
    Unit cur, nxt; int ui = 0;
    if (!S.next(0, cur)) return;
    f32x4 acc[2][2][4][2];
#pragma unroll
    for (int a = 0; a < 2; ++a)
#pragma unroll
        for (int b = 0; b < 2; ++b)
#pragma unroll
            for (int m = 0; m < 4; ++m)
#pragma unroll
                for (int n = 0; n < 2; ++n) acc[a][b][m][n] = (f32x4){0.f, 0.f, 0.f, 0.f};
    bf16x8 At[4][2], B0[2][2], B1[2][2];
    const char* cA = (const char*)g.A + (size_t)cur.pm * tstep; const char* cB = (const char*)g.Bt + (size_t)cur.pn * tstep;
    S.a_ready(cur);
    if constexpr (SP2) {
        PG8_STAGE(PG8_SB(0, 0), cB, voffB); PG8_STAGE(PG8_SB(0, 1), cB + hstep, voffB); PG8_STAGE(PG8_SA(0, 0), cA, voffA); PG8_STAGE(PG8_SA(0, 1), cA + hstep, voffA);
        if (wr == 1) PG8_BAR;
        PG8_WAIT_V(2); PG8_BAR;
        PG8_STAGE(PG8_SB(1, 0), cB + kstep, voffB); PG8_STAGE(PG8_SA(1, 0), cA + kstep, voffA); PG8_STAGE(PG8_SB(1, 1), cB + hstep + kstep, voffB);
        PG8_WAIT_V(6); PG8_BAR;
    } else {
        PG8_STAGE(PG8_SB(0, 0), cB, voffB); PG8_STAGE(PG8_SA(0, 0), cA, voffA); PG8_STAGE(PG8_SB(0, 1), cB + hstep, voffB); PG8_STAGE(PG8_SA(0, 1), cA + hstep, voffA);
        if (wr == 1) PG8_BAR;
        PG8_WAIT_V(4); PG8_BAR;
        PG8_STAGE(PG8_SB(1, 0), cB + kstep, voffB); PG8_STAGE(PG8_SA(1, 0), cA + kstep, voffA); PG8_STAGE(PG8_SB(1, 1), cB + hstep + kstep, voffB);
        PG8_WAIT_V(6); PG8_BAR;
    }
    for (;;) {
        const bool has_next = S.next(ui + 1, nxt);
        const char* nA = has_next ? (const char*)g.A + (size_t)nxt.pm * tstep : cA; const char* nB = has_next ? (const char*)g.Bt + (size_t)nxt.pn * tstep : cB;
        for (int t = 0; t < nt; t += 2) {
            const bool last = (t == nt - 2);
            const char* a1 = cA + (size_t)(t + 1) * kstep;
            const char* a2 = last ? nA : cA + (size_t)(t + 2) * kstep; const char* b2 = last ? nB : cB + (size_t)(t + 2) * kstep;
            const char* a3 = a2 + kstep; const char* b3 = b2 + kstep;
            if (last && has_next) S.a_ready(nxt);
            if constexpr (SP2) {
            PG8_LDB(B0, 0, 0); PG8_LDB(B1, 0, 1); PG8_SCHED; PG8_LDA(At, 0, 0); PG8_STAGE(PG8_SA(1, 1), a1 + hstep, voffA);
            PG8_WAIT_V(8); PG8_WAIT_L(0); PG8_BAR; PG8_MMA(0, 0, At, B0); PG8_MMA(0, 1, At, B1); PG8_BAR; PG8_SCHED;
            PG8_LDA(At, 0, 1); PG8_STAGE(PG8_SB(0, 0), b2, voffB); PG8_STAGE(PG8_SB(0, 1), b2 + hstep, voffB); PG8_STAGE(PG8_SA(0, 0), a2, voffA);
            PG8_WAIT_V(8); PG8_WAIT_L(0); PG8_BAR; PG8_MMA(1, 0, At, B0); PG8_MMA(1, 1, At, B1); PG8_BAR; PG8_SCHED;
            PG8_LDB(B0, 1, 0); PG8_LDB(B1, 1, 1); PG8_SCHED; PG8_LDA(At, 1, 0); PG8_STAGE(PG8_SA(0, 1), a2 + hstep, voffA);
            PG8_WAIT_V(8); PG8_WAIT_L(0); PG8_BAR; PG8_MMA(0, 0, At, B0); PG8_MMA(0, 1, At, B1); PG8_BAR; PG8_SCHED;
            PG8_LDA(At, 1, 1); PG8_STAGE(PG8_SB(1, 0), b3, voffB); PG8_STAGE(PG8_SB(1, 1), b3 + hstep, voffB); PG8_STAGE(PG8_SA(1, 0), a3, voffA);
            PG8_WAIT_V(8); PG8_WAIT_L(0); PG8_BAR; PG8_MMA(1, 0, At, B0); PG8_MMA(1, 1, At, B1); PG8_BAR; PG8_SCHED;
            } else {
            PG8_LDB(B0, 0, 0); PG8_SCHED; PG8_LDA(At, 0, 0); PG8_STAGE(PG8_SA(1, 1), a1 + hstep, voffA);
            PG8_WAIT_L(8); PG8_BAR; PG8_WAIT_L(0); PG8_MMA(0, 0, At, B0); PG8_BAR; PG8_SCHED;
            PG8_LDB(B1, 0, 1); PG8_STAGE(PG8_SB(0, 0), b2, voffB);
            PG8_BAR; PG8_WAIT_L(0); PG8_MMA(0, 1, At, B1); PG8_BAR;
            PG8_LDA(At, 0, 1); PG8_STAGE(PG8_SA(0, 0), a2, voffA);
            PG8_BAR; PG8_WAIT_L(0); PG8_MMA(1, 0, At, B0); PG8_BAR; PG8_SCHED;
            PG8_STAGE(PG8_SB(0, 1), b2 + hstep, voffB);
            PG8_WAIT_V(6); PG8_BAR; PG8_MMA(1, 1, At, B1); PG8_BAR;
            PG8_LDB(B0, 1, 0); PG8_SCHED; PG8_LDA(At, 1, 0); PG8_STAGE(PG8_SA(0, 1), a2 + hstep, voffA);
            PG8_WAIT_L(8); PG8_BAR; PG8_WAIT_L(0); PG8_MMA(0, 0, At, B0); PG8_BAR; PG8_SCHED;
            PG8_LDB(B1, 1, 1); PG8_STAGE(PG8_SB(1, 0), b3, voffB);
            PG8_BAR; PG8_WAIT_L(0); PG8_MMA(0, 1, At, B1); PG8_BAR;
            PG8_LDA(At, 1, 1); PG8_STAGE(PG8_SA(1, 0), a3, voffA);
            PG8_BAR; PG8_WAIT_L(0); PG8_MMA(1, 0, At, B0); PG8_BAR; PG8_SCHED;
            PG8_STAGE(PG8_SB(1, 1), b3 + hstep, voffB);
            PG8_WAIT_V(6); PG8_BAR; PG8_MMA(1, 1, At, B1); PG8_BAR;
            }
        }
        if constexpr (ALIGN_EPI) { if (wr == 0) PG8_BAR; }
        if constexpr (!Epi::AFTER_DRAIN) { E(acc, cur, wr, wc, fr, fq); S.done(cur); }
        if (!has_next) break;
#pragma unroll
        for (int a = 0; a < 2; ++a)
#pragma unroll
            for (int b = 0; b < 2; ++b)
#pragma unroll
                for (int m = 0; m < 4; ++m)
#pragma unroll
                    for (int n = 0; n < 2; ++n) acc[a][b][m][n] = (f32x4){0.f, 0.f, 0.f, 0.f};
        cur = nxt; cA = nA; cB = nB; ++ui;
        if constexpr (ALIGN_EPI) { if (wr == 1) PG8_BAR; }
    }
    PG8_WAIT_V(0);
    if constexpr (!ALIGN_EPI) { if (wr == 0) PG8_BAR; }
    PG8_BAR;
    if constexpr (Epi::AFTER_DRAIN) { E.fused(acc, cur, wr, wc, fr, fq, lds, wid, lane); S.done(cur); }
#undef PG8_SA
#undef PG8_SB
#undef PG8_STAGE
#undef PG8_LDA
#undef PG8_LDB
#undef PG8_MMA
#undef PG8_WAIT_V
#undef PG8_WAIT_L
#undef PG8_BAR
#undef PG8_SCHED
}
}

#define LAS __attribute__((address_space(3)))
typedef unsigned short bf16_t;
typedef short bf16x8 __attribute__((ext_vector_type(8)));
typedef short s16x4 __attribute__((ext_vector_type(4)));
typedef float f32x4 __attribute__((ext_vector_type(4)));
typedef float f32x16 __attribute__((ext_vector_type(16)));
typedef unsigned u32x4 __attribute__((ext_vector_type(4)));
typedef unsigned u32x2 __attribute__((ext_vector_type(2)));

constexpr int T = 16 * 2048;
constexpr int NMETA = 16;
constexpr int R = T + NMETA;
constexpr int DM = 1024, DFF = 4096;
constexpr float ALPHA = 1.4142135623730951f;
constexpr float QSCALE = 0.125f * 1.4426950408889634f;

constexpr size_t SZ_WAB = (size_t)2048 * 1024 * 2, SZ_WGLU = (size_t)512 * 512 * 2, SZ_W1M = (size_t)1024 * 1024 * 2, SZ_W4M = (size_t)4096 * 1024 * 2;
constexpr size_t OFF_WAB = 0, OFF_WGLU = OFF_WAB + SZ_WAB, OFF_WOAB = OFF_WGLU + SZ_WGLU, OFF_WC = OFF_WOAB + SZ_W1M, OFF_WOC = OFF_WC + SZ_W4M,
                 OFF_WUP0 = OFF_WOC + SZ_W1M, OFF_WUP1 = OFF_WUP0 + SZ_W4M, OFF_WDN0 = OFF_WUP1 + SZ_W4M, OFF_WDN1 = OFF_WDN0 + SZ_W4M,
                 OFF_HB = OFF_WDN1 + SZ_W4M, OFF_Z = OFF_HB + (size_t)R * 1024 * 2, OFF_BIG = OFF_Z + (size_t)R * 1024 * 4, WS_END = OFF_BIG + (size_t)R * 4096 * 2;
constexpr size_t OFF_ST = (WS_END + 255) & ~(size_t)255;
constexpr size_t SZ_ST = (size_t)4 * R * 2 * 4;
constexpr size_t OFF_SV = OFF_ST + SZ_ST, OFF_TV = OFF_SV + (size_t)3 * 4096 * 4, ZERO_END = OFF_TV + (size_t)3 * 4096 * 4;
constexpr size_t BIG_PROJ = 0, BIG_APRE = (size_t)R * 2048 * 2, BIG_CAT = BIG_APRE + (size_t)R * 512 * 2;

struct Params { const float* in[26]; float* out; unsigned char* ws; };

__device__ __forceinline__ unsigned pk2(float lo, float hi) {
    typedef __bf16 bf2 __attribute__((ext_vector_type(2)));
    typedef float fl2 __attribute__((ext_vector_type(2)));
    fl2 v = {lo, hi}; bf2 r = __builtin_convertvector(v, bf2); return __builtin_bit_cast(unsigned, r);
}
__device__ __forceinline__ bf16_t f2bf(float x) { return (bf16_t)(pk2(x, 0.f) & 0xffffu); }
__device__ __forceinline__ float bf2f(bf16_t v) { return __uint_as_float((unsigned)v << 16); }
__device__ __forceinline__ float bflo(unsigned w) { return __uint_as_float(w << 16); }
__device__ __forceinline__ float bfhi(unsigned w) { return __uint_as_float(w & 0xffff0000u); }
__device__ __forceinline__ float sigmoidf_(float x) { return 1.0f / (1.0f + __expf(-x)); }
#define LDS_WAIT() asm volatile("s_waitcnt lgkmcnt(0)" ::: "memory")
#define MFMA16(a, b, c) __builtin_amdgcn_mfma_f32_16x16x32_bf16((a), (b), (c), 0, 0, 0)
#define MFMA32(a, b, c) __builtin_amdgcn_mfma_f32_32x32x16_bf16((a), (b), (c), 0, 0, 0)

struct RowCtx { float mu, rstd; };
__device__ __forceinline__ RowCtx ln_ctx(const float* st, int row) {
    const float sum = st[2 * (size_t)row], sq = st[2 * (size_t)row + 1];
    RowCtx rc; rc.mu = sum * (1.0f / 1024.0f); const float var = fmaxf(sq * (1.0f / 1024.0f) - rc.mu * rc.mu, 0.f); rc.rstd = 1.0f / sqrtf(var + 1e-5f); return rc;
}
struct NoCtx {};
struct EpInAB {
    static constexpr bool MAKES_STATS = false; static constexpr int BATCH = 8;
    typedef NoCtx ColCtx; typedef NoCtx Pre;
    bf16_t* O;
    __device__ __forceinline__ ColCtx col_ctx(int) const { return NoCtx{}; }
    __device__ __forceinline__ Pre pre(int, int) const { return NoCtx{}; }
    __device__ __forceinline__ RowCtx row_ctx(int) const { return RowCtx{0.f, 1.f}; }
    __device__ __forceinline__ float* st_ptr() const { return nullptr; }
    __device__ __forceinline__ void apply8(int row, int col, f32x4 a, f32x4 b, const RowCtx&, const ColCtx&, const Pre&, float&, float&) const {
        const float s = (col >= 512 && col < 1024) ? QSCALE : 1.0f;
        u32x4 w; w.x = pk2(a[0] * s, a[1] * s); w.y = pk2(a[2] * s, a[3] * s); w.z = pk2(b[0] * s, b[1] * s); w.w = pk2(b[2] * s, b[3] * s);
        *(u32x4*)(O + (size_t)row * 2048 + col) = w;
    }
};
struct EpGlu {
    static constexpr bool MAKES_STATS = false; static constexpr int BATCH = 4;
    struct ColCtx { f32x4 b0, b1; }; struct Pre { u32x4 ap; };
    const bf16_t* APRE; const float* bias; bf16_t* CAT;
    __device__ __forceinline__ ColCtx col_ctx(int col) const { return ColCtx{*(const f32x4*)(bias + col), *(const f32x4*)(bias + col + 4)}; }
    __device__ __forceinline__ Pre pre(int row, int col) const { return Pre{*(const u32x4*)(APRE + (size_t)row * 512 + col)}; }
    __device__ __forceinline__ RowCtx row_ctx(int) const { return RowCtx{0.f, 1.f}; }
    __device__ __forceinline__ float* st_ptr() const { return nullptr; }
    __device__ __forceinline__ void apply8(int row, int col, f32x4 a, f32x4 b, const RowCtx&, const ColCtx& cc, const Pre& pr, float&, float&) const {
        const u32x4 ap = pr.ap;
        float v[8] = {a[0] + cc.b0[0], a[1] + cc.b0[1], a[2] + cc.b0[2], a[3] + cc.b0[3], b[0] + cc.b1[0], b[1] + cc.b1[1], b[2] + cc.b1[2], b[3] + cc.b1[3]};
        float y[8] = {bflo(ap.x), bfhi(ap.x), bflo(ap.y), bfhi(ap.y), bflo(ap.z), bfhi(ap.z), bflo(ap.w), bfhi(ap.w)};
#pragma unroll
        for (int i = 0; i < 8; ++i) y[i] = y[i] * sigmoidf_(v[i]);
        u32x4 w; w.x = pk2(y[0], y[1]); w.y = pk2(y[2], y[3]); w.z = pk2(y[4], y[5]); w.w = pk2(y[6], y[7]);
        *(u32x4*)(CAT + (size_t)row * 1024 + col) = w;
    }
};
struct EpRes {
    static constexpr bool MAKES_STATS = true; static constexpr int BATCH = 1;
    struct ColCtx { f32x4 ag0, ag1, ab0, ab1; }; struct Pre { f32x4 h0, h1; };
    const float* base; const float* base_meta; float* Z; const float* bias;
    const float* st_prev; const float* g; const float* bta; float* st_out; bf16_t* ZB;
    __device__ __forceinline__ ColCtx col_ctx(int col) const {
        ColCtx c; const f32x4 one = {1.f, 1.f, 1.f, 1.f}, zero = {0.f, 0.f, 0.f, 0.f};
        const f32x4 g0 = st_prev ? *(const f32x4*)(g + col) : one, g1 = st_prev ? *(const f32x4*)(g + col + 4) : one;
        const f32x4 t0 = st_prev ? *(const f32x4*)(bta + col) : zero, t1 = st_prev ? *(const f32x4*)(bta + col + 4) : zero;
        const f32x4 b0 = bias ? *(const f32x4*)(bias + col) : zero, b1 = bias ? *(const f32x4*)(bias + col + 4) : zero;
        c.ag0 = g0 * ALPHA; c.ag1 = g1 * ALPHA; c.ab0 = t0 * ALPHA + b0; c.ab1 = t1 * ALPHA + b1; return c;
    }
    __device__ __forceinline__ Pre pre(int row, int col) const {
        const float* bp = (base_meta && row >= T) ? base_meta + (size_t)(row - T) * 1024 + col : base + (size_t)row * 1024 + col;
        return Pre{*(const f32x4*)bp, *(const f32x4*)(bp + 4)};
    }
    __device__ __forceinline__ RowCtx row_ctx(int row) const { return st_prev ? ln_ctx(st_prev, row) : RowCtx{0.f, 1.f}; }
    __device__ __forceinline__ float* st_ptr() const { return st_out; }
    __device__ __forceinline__ void apply8(int row, int col, f32x4 a, f32x4 b, const RowCtx& rc, const ColCtx& cc, const Pre& pr, float& s, float& q) const {
        const f32x4 o0 = (pr.h0 - rc.mu) * rc.rstd * cc.ag0 + cc.ab0 + a, o1 = (pr.h1 - rc.mu) * rc.rstd * cc.ag1 + cc.ab1 + b;
        float* zp = Z + (size_t)row * 1024 + col;
        *(f32x4*)zp = o0; *(f32x4*)(zp + 4) = o1;
        if (ZB) { u32x4 w; w.x = pk2(o0[0], o0[1]); w.y = pk2(o0[2], o0[3]); w.z = pk2(o1[0], o1[1]); w.w = pk2(o1[2], o1[3]); *(u32x4*)(ZB + (size_t)row * 1024 + col) = w; }
        s += ((o0[0] + o0[1]) + (o0[2] + o0[3])) + ((o1[0] + o1[1]) + (o1[2] + o1[3]));
        q += ((o0[0] * o0[0] + o0[1] * o0[1]) + (o0[2] * o0[2] + o0[3] * o0[3])) + ((o1[0] * o1[0] + o1[1] * o1[1]) + (o1[2] * o1[2] + o1[3] * o1[3]));
    }
};
struct EpUp {
    static constexpr bool MAKES_STATS = false; static constexpr int BATCH = 8;
    struct ColCtx { f32x4 s0, s1, t0, t1; }; typedef NoCtx Pre;
    bf16_t* H; const float* bias; const float* st_prev; const float* sv; const float* tv;
    __device__ __forceinline__ ColCtx col_ctx(int col) const {
        return ColCtx{*(const f32x4*)(sv + col), *(const f32x4*)(sv + col + 4), *(const f32x4*)(tv + col) + *(const f32x4*)(bias + col), *(const f32x4*)(tv + col + 4) + *(const f32x4*)(bias + col + 4)};
    }
    __device__ __forceinline__ Pre pre(int, int) const { return NoCtx{}; }
    __device__ __forceinline__ RowCtx row_ctx(int row) const { return ln_ctx(st_prev, row); }
    __device__ __forceinline__ float* st_ptr() const { return nullptr; }
    __device__ __forceinline__ void apply8(int row, int col, f32x4 a, f32x4 b, const RowCtx& rc, const ColCtx& cc, const Pre&, float&, float&) const {
        f32x4 v0 = (a - rc.mu * cc.s0) * rc.rstd + cc.t0, v1 = (b - rc.mu * cc.s1) * rc.rstd + cc.t1;
#pragma unroll
        for (int i = 0; i < 4; ++i) { v0[i] = fmaxf(v0[i], 0.f); v0[i] *= v0[i]; v1[i] = fmaxf(v1[i], 0.f); v1[i] *= v1[i]; }
        u32x4 w; w.x = pk2(v0[0], v0[1]); w.y = pk2(v0[2], v0[3]); w.z = pk2(v1[0], v1[1]); w.w = pk2(v1[2], v1[3]);
        *(u32x4*)(H + (size_t)row * 4096 + col) = w;
    }
};
struct EpInC {
    static constexpr bool MAKES_STATS = false; static constexpr int BATCH = 8;
    struct ColCtx { f32x4 s0, s1, t0, t1, lb0, lb1; }; typedef NoCtx Pre;
    unsigned short* PC; const float* gamma; const float* st_prev; const float* sv; const float* tv;
    __device__ __forceinline__ ColCtx col_ctx(int col) const {
        ColCtx c{*(const f32x4*)(sv + col), *(const f32x4*)(sv + col + 4), *(const f32x4*)(tv + col), *(const f32x4*)(tv + col + 4), {0.f, 0.f, 0.f, 0.f}, {0.f, 0.f, 0.f, 0.f}};
        if (col >= 1024 && col < 2048) {
            const f32x4 ga = *(const f32x4*)(gamma + col - 1024), gb = *(const f32x4*)(gamma + col - 1020), gc = *(const f32x4*)(gamma + col), gd = *(const f32x4*)(gamma + col + 4);
#pragma unroll
            for (int i = 0; i < 4; ++i) { c.lb0[i] = 1.0f / (1.0f + __expf(ga[i] - gc[i])); c.lb1[i] = 1.0f / (1.0f + __expf(gb[i] - gd[i])); }
        }
        return c;
    }
    __device__ __forceinline__ Pre pre(int, int) const { return NoCtx{}; }
    __device__ __forceinline__ RowCtx row_ctx(int row) const { return ln_ctx(st_prev, row); }
    __device__ __forceinline__ float* st_ptr() const { return nullptr; }
    __device__ __forceinline__ void apply8(int row, int col, f32x4 a, f32x4 b, const RowCtx& rc, const ColCtx& cc, const Pre&, float&, float&) const {
        a = (a - rc.mu * cc.s0) * rc.rstd + cc.t0;
        b = (b - rc.mu * cc.s1) * rc.rstd + cc.t1;
        u32x4 w;
        if (col >= 1024 && col < 2048) {
            float v[8] = {a[0], a[1], a[2], a[3], b[0], b[1], b[2], b[3]};
            float lb[8] = {cc.lb0[0], cc.lb0[1], cc.lb0[2], cc.lb0[3], cc.lb1[0], cc.lb1[1], cc.lb1[2], cc.lb1[3]};
            unsigned short h[8];
#pragma unroll
            for (int i = 0; i < 8; ++i) {
                const float f = lb[i] + (1.0f - lb[i]) * sigmoidf_(v[i]);
                const _Float16 hf = (_Float16)__logf(f);
                h[i] = __builtin_bit_cast(unsigned short, hf);
            }
            w.x = h[0] | ((unsigned)h[1] << 16); w.y = h[2] | ((unsigned)h[3] << 16); w.z = h[4] | ((unsigned)h[5] << 16); w.w = h[6] | ((unsigned)h[7] << 16);
        } else { w.x = pk2(a[0], a[1]); w.y = pk2(a[2], a[3]); w.z = pk2(b[0], b[1]); w.w = pk2(b[2], b[3]); }
        *(u32x4*)(PC + (size_t)row * 4096 + col) = w;
    }
};
template <class F> struct EpiAdapt {
    static constexpr bool PERM = true, AFTER_DRAIN = false; F f;
    __device__ __forceinline__ void operator()(const f32x4 (&acc)[2][2][4][2], const pg8::Unit& u, int wr, int wc, int fr, int fq) const {
        const int col0 = u.pn * 256 + wc * 32 + 8 * fq, row0 = u.pm * 256 + wr * 64 + fr;
        const typename F::ColCtx cc[2] = {f.col_ctx(col0), f.col_ctx(col0 + 128)};
        RowCtx rc[8];
#pragma unroll
        for (int r8 = 0; r8 < 8; ++r8) rc[r8] = f.row_ctx(row0 + (r8 >> 2) * 128 + (r8 & 3) * 16);
        constexpr int NB = F::BATCH;
#pragma unroll
        for (int bt = 0; bt < 8 / NB; ++bt) {
            typename F::Pre pr[NB][2];
#pragma unroll
            for (int i = 0; i < NB; ++i) { const int r8 = bt * NB + i, row = row0 + (r8 >> 2) * 128 + (r8 & 3) * 16;
                pr[i][0] = f.pre(row, col0); pr[i][1] = f.pre(row, col0 + 128); }
#pragma unroll
            for (int i = 0; i < NB; ++i) { const int r8 = bt * NB + i, ai = r8 >> 2, m = r8 & 3, row = row0 + ai * 128 + m * 16;
                float s = 0.f, q = 0.f;
                f.apply8(row, col0, acc[ai][0][m][0], acc[ai][0][m][1], rc[r8], cc[0], pr[i][0], s, q);
                f.apply8(row, col0 + 128, acc[ai][1][m][0], acc[ai][1][m][1], rc[r8], cc[1], pr[i][1], s, q);
                if (F::MAKES_STATS) {
                    s += __shfl_xor(s, 16); s += __shfl_xor(s, 32); q += __shfl_xor(q, 16); q += __shfl_xor(q, 32);
                    if (fq == 0) { float* st = f.st_ptr() + 2 * (size_t)row; unsafeAtomicAdd(st, s); unsafeAtomicAdd(st + 1, q); }
                }
            }
            asm volatile("" ::: "memory");
        }
    }
};
template <class F> __device__ __forceinline__ void meta_gemm(const bf16_t* A16  , const bf16_t* Bt, int N, int K, const F& f, int blk, int G, int wave, int lane) {
    const int l15 = lane & 15, quad = lane >> 4;
    for (int item = blk + G * wave; item < N / 32; item += G * 8) {
        const int c0 = item * 32;
        const bf16_t* ap = A16 + (size_t)l15 * K + 8 * quad;
        const bf16_t* w0 = Bt + (size_t)(c0 + 8 * (l15 >> 2) + (l15 & 3)) * K + 8 * quad;
        const bf16_t* w1 = w0 + (size_t)4 * K;
        f32x4 acc0 = {0.f, 0.f, 0.f, 0.f}, acc1 = {0.f, 0.f, 0.f, 0.f};
#pragma unroll 8
        for (int k = 0; k < K; k += 32) {
            const bf16x8 xa = *(const bf16x8*)(ap + k), b0 = *(const bf16x8*)(w0 + k), b1 = *(const bf16x8*)(w1 + k);
            acc0 = MFMA16(b0, xa, acc0); acc1 = MFMA16(b1, xa, acc1);
        }
        const RowCtx rc = f.row_ctx(T + l15);
        const typename F::ColCtx cc = f.col_ctx(c0 + 8 * quad);
        const typename F::Pre pr = f.pre(T + l15, c0 + 8 * quad);
        float s = 0.f, q = 0.f;
        f.apply8(T + l15, c0 + 8 * quad, acc0, acc1, rc, cc, pr, s, q);
        if (F::MAKES_STATS) {
            s += __shfl_xor(s, 16); s += __shfl_xor(s, 32); q += __shfl_xor(q, 16); q += __shfl_xor(q, 32);
            if (quad == 0) { float* st = f.st_ptr() + 2 * (size_t)(T + l15); unsafeAtomicAdd(st, s); unsafeAtomicAdd(st + 1, q); }
        }
    }
}
template <class F> __device__ __forceinline__ void run_gemm(LAS unsigned char* lds, const bf16_t* A, const bf16_t* Bt, int N, int K, const F& f, bool with_meta, int blk, int G, int wave) {
    pg8::Gemm g{A, Bt, T, N, K}; pg8::StaticOrder S; S.init(T, N, G, blk);
    EpiAdapt<F> E{f};
    pg8::gemm_phase<EpiAdapt<F>, pg8::StaticOrder, true, true>((PG8_LAS unsigned char*)lds, g, S, E, wave);
    if (with_meta) meta_gemm<F>(A + (size_t)T * K, Bt, N, K, f, blk, G, wave, lane_id_v());
}

__device__ __forceinline__ void transpose_item(const float* W, int K, int N, bf16_t* WT, LAS float* scr, int item, int lane) {
    const int nblk = N / 32, kb = item / nblk, nb = item % nblk, k0 = 64 * kb, n0 = 32 * nb;
#pragma unroll 8
    for (int i = 0; i < 32; ++i) { const int kk = 2 * i + (lane >> 5); scr[kk * 33 + (lane & 31)] = W[(size_t)(k0 + kk) * N + n0 + (lane & 31)]; }
    LDS_WAIT();
    const int c = lane & 7;
#pragma unroll
    for (int j = 0; j < 4; ++j) { const int n = (lane >> 3) + 8 * j; const LAS float* s = scr + (8 * c) * 33 + n;
        u32x4 o; o.x = pk2(s[0 * 33], s[1 * 33]); o.y = pk2(s[2 * 33], s[3 * 33]); o.z = pk2(s[4 * 33], s[5 * 33]); o.w = pk2(s[6 * 33], s[7 * 33]);
        *(u32x4*)(WT + (size_t)(n0 + n) * K + k0 + 8 * c) = o; }
    LDS_WAIT();
}
__device__ __forceinline__ void transpose_item_fold(const float* W, int K, int N, bf16_t* WT, LAS float* scr, int item, int lane, const float* g, const float* bta, float* sv, float* tv) {
    const int nblk = N / 32, kb = item / nblk, nb = item % nblk, k0 = 64 * kb, n0 = 32 * nb;
#pragma unroll 8
    for (int i = 0; i < 32; ++i) { const int kk = 2 * i + (lane >> 5); scr[kk * 33 + (lane & 31)] = W[(size_t)(k0 + kk) * N + n0 + (lane & 31)]; }
    LDS_WAIT();
    const int c = lane & 7;
    const f32x4 g0 = *(const f32x4*)(g + k0 + 8 * c), g1 = *(const f32x4*)(g + k0 + 8 * c + 4), b0 = *(const f32x4*)(bta + k0 + 8 * c), b1 = *(const f32x4*)(bta + k0 + 8 * c + 4);
#pragma unroll
    for (int j = 0; j < 4; ++j) { const int n = (lane >> 3) + 8 * j; const LAS float* s = scr + (8 * c) * 33 + n;
        const float w0 = s[0 * 33], w1 = s[1 * 33], w2 = s[2 * 33], w3 = s[3 * 33], w4 = s[4 * 33], w5 = s[5 * 33], w6 = s[6 * 33], w7 = s[7 * 33];
        u32x4 o; o.x = pk2(g0[0] * w0, g0[1] * w1); o.y = pk2(g0[2] * w2, g0[3] * w3); o.z = pk2(g1[0] * w4, g1[1] * w5); o.w = pk2(g1[2] * w6, g1[3] * w7);
        *(u32x4*)(WT + (size_t)(n0 + n) * K + k0 + 8 * c) = o;
        float ss = ((bflo(o.x) + bfhi(o.x)) + (bflo(o.y) + bfhi(o.y))) + ((bflo(o.z) + bfhi(o.z)) + (bflo(o.w) + bfhi(o.w)));
        float tt = ((b0[0] * w0 + b0[1] * w1) + (b0[2] * w2 + b0[3] * w3)) + ((b1[0] * w4 + b1[1] * w5) + (b1[2] * w6 + b1[3] * w7));
        ss += __shfl_xor(ss, 1); ss += __shfl_xor(ss, 2); ss += __shfl_xor(ss, 4);
        tt += __shfl_xor(tt, 1); tt += __shfl_xor(tt, 2); tt += __shfl_xor(tt, 4);
        if (c == 0) { unsafeAtomicAdd(sv + n0 + n, ss); unsafeAtomicAdd(tv + n0 + n, tt); } }
    LDS_WAIT();
}
__device__ __forceinline__ void prologue_phase(const Params& P, LAS unsigned char* lds, int blk, int G, int wave) {
    const int lane = lane_id_v(), tid = wave * 64 + lane;
    LAS float* scr = (LAS float*)(lds + wave * 8448);
    const int gw = blk * 8 + wave, NGW = G * 8;
    unsigned char* ws = P.ws;
    constexpr int I_AB = 16 * 64, I_GLU = 8 * 16, I_1M = 16 * 32, I_C = 16 * 128, I_UP = 16 * 128, I_DN = 64 * 32;
    constexpr int NITEMS = I_AB + I_GLU + I_1M + I_C + I_1M + 2 * I_UP + 2 * I_DN;
    for (int it = gw; it < NITEMS; it += NGW) {
        int r = it;
        if (r < I_AB) { transpose_item(P.in[2], 1024, 2048, (bf16_t*)(ws + OFF_WAB), scr, r, lane); continue; } r -= I_AB;
        if (r < I_GLU) { transpose_item(P.in[11], 512, 512, (bf16_t*)(ws + OFF_WGLU), scr, r, lane); continue; } r -= I_GLU;
        if (r < I_1M) { transpose_item(P.in[13], 1024, 1024, (bf16_t*)(ws + OFF_WOAB), scr, r, lane); continue; } r -= I_1M;
        if (r < I_C) { transpose_item_fold(P.in[14], 1024, 4096, (bf16_t*)(ws + OFF_WC), scr, r, lane, P.in[24], P.in[25], (float*)(ws + OFF_SV) + 4096, (float*)(ws + OFF_TV) + 4096); continue; } r -= I_C;
        if (r < I_1M) { transpose_item(P.in[17], 1024, 1024, (bf16_t*)(ws + OFF_WOC), scr, r, lane); continue; } r -= I_1M;
        if (r < I_UP) { transpose_item_fold(P.in[20], 1024, 4096, (bf16_t*)(ws + OFF_WUP0), scr, r, lane, P.in[18], P.in[19], (float*)(ws + OFF_SV), (float*)(ws + OFF_TV)); continue; } r -= I_UP;
        if (r < I_UP) { transpose_item_fold(P.in[20] + (size_t)1024 * 4096, 1024, 4096, (bf16_t*)(ws + OFF_WUP1), scr, r, lane, P.in[18] + 1024, P.in[19] + 1024, (float*)(ws + OFF_SV) + 8192, (float*)(ws + OFF_TV) + 8192); continue; } r -= I_UP;
        if (r < I_DN) { transpose_item(P.in[22], 4096, 1024, (bf16_t*)(ws + OFF_WDN0), scr, r, lane); continue; } r -= I_DN;
        transpose_item(P.in[22] + (size_t)4096 * 1024, 4096, 1024, (bf16_t*)(ws + OFF_WDN1), scr, r, lane);
    }
    bf16_t* HB = (bf16_t*)(ws + OFF_HB);
    const size_t n8 = (size_t)R * 1024 / 8;
#pragma unroll 4
    for (size_t i = (size_t)blk * 512 + tid; i < n8; i += (size_t)G * 512) {
        const size_t e = i * 8;
        const float* src = e < (size_t)T * 1024 ? P.in[0] + e : P.in[1] + (e - (size_t)T * 1024);
        const f32x4 a = *(const f32x4*)src, b = *(const f32x4*)(src + 4);
        u32x4 w; w.x = pk2(a[0], a[1]); w.y = pk2(a[2], a[3]); w.z = pk2(b[0], b[1]); w.w = pk2(b[2], b[3]);
        *(u32x4*)(HB + e) = w;
    }
}

__device__ __forceinline__ void ln_phase(const float* Zin, float* Fout, bf16_t* Bout, const float* g, const float* bta, int nrows, int blk, int G, int wave) {
    const int lane = lane_id_v();
    for (int row = blk * 8 + wave; row < nrows; row += G * 8) {
        const f32x4* xr = (const f32x4*)(Zin + (size_t)row * 1024) + lane;
        f32x4 v[4]; float s = 0.f;
#pragma unroll
        for (int j = 0; j < 4; ++j) { v[j] = xr[64 * j]; s += (v[j][0] + v[j][1]) + (v[j][2] + v[j][3]); }
#pragma unroll
        for (int o = 1; o < 64; o <<= 1) s += __shfl_xor(s, o);
        const float mean = s * (1.f / 1024.f); float s2 = 0.f;
#pragma unroll
        for (int j = 0; j < 4; ++j) { v[j] = v[j] - mean; s2 += (v[j][0] * v[j][0] + v[j][1] * v[j][1]) + (v[j][2] * v[j][2] + v[j][3] * v[j][3]); }
#pragma unroll
        for (int o = 1; o < 64; o <<= 1) s2 += __shfl_xor(s2, o);
        const float rstd = 1.0f / sqrtf(s2 * (1.f / 1024.f) + 1e-5f);
#pragma unroll
        for (int j = 0; j < 4; ++j) {
            const int col = 4 * (lane + 64 * j);
            const f32x4 gg = *(const f32x4*)(g + col), bb = *(const f32x4*)(bta + col);
            const f32x4 o = v[j] * rstd * gg + bb;
            *(f32x4*)(Fout + (size_t)row * 1024 + col) = o;
            if (Bout) { u32x2 w; w.x = pk2(o[0], o[1]); w.y = pk2(o[2], o[3]); *(u32x2*)(Bout + (size_t)row * 1024 + col) = w; }
        }
    }
}

__device__ __forceinline__ void final_ln_phase(const float* Zin, const float* st, float* out, const float* g, const float* bta, int blk, int G, int wave) {
    const int lane = lane_id_v();
    for (int row0 = (blk * 8 + wave) * 4; row0 < T; row0 += G * 8 * 4) {
#pragma unroll
        for (int rr = 0; rr < 4; ++rr) {
            const int row = row0 + rr;
            const RowCtx rc = ln_ctx(st, row);
#pragma unroll
            for (int j = 0; j < 4; ++j) {
                const int col = 4 * (lane + 64 * j);
                const f32x4 v = *(const f32x4*)(Zin + (size_t)row * 1024 + col);
                *(f32x4*)(out + (size_t)row * 1024 + col) = (v - rc.mu) * rc.rstd * *(const f32x4*)(g + col) + *(const f32x4*)(bta + col);
            }
        }
    }
}

__device__ __forceinline__ void lam_coef(const float* lam_re, const float* lam_im, float dt, int idx, float& lbr, float& lbi, float& cr, float& ci) {
    const float lr = lam_re[idx], li = lam_im[idx];
    const float er = __expf(lr * dt);
    float ang = li * dt;
    const float kk = rintf(ang * 0.15915494309189535f);
    ang = fmaf(-kk, 6.2831854820251465f, ang); ang = fmaf(-kk, -1.7484555e-7f, ang);
    lbr = er * __cosf(ang); lbi = er * __sinf(ang);
    const float nr = lbr - 1.0f, ni = lbi, den = 1.0f / (lr * lr + li * li);
    cr = (nr * lr + ni * li) * den; ci = (ni * lr - nr * li) * den;
}
__device__ __forceinline__ void s5_phase(const Params& P, LAS unsigned char* lds, int blk, int G, int wave) {
    const int lane = lane_id_v(), l15 = lane & 15, quad = lane >> 4;
    LAS float* bu = (LAS float*)(lds + wave * 12800);
    LAS unsigned* sl = (LAS unsigned*)(lds + wave * 12800 + 8448);
    const bf16_t* PROJ = (const bf16_t*)(P.ws + OFF_BIG + BIG_PROJ);
    bf16_t* APRE = (bf16_t*)(P.ws + OFF_BIG + BIG_APRE);
    for (int item = blk + G * wave; item < 512; item += G * 8) {
        const int b = item >> 5, g = item & 31;
        const float dt = __expf(P.in[5][g]);
        float lbr, lbi, cr_, ci_;
        lam_coef(P.in[3], P.in[4], dt, g * 64 + lane, lbr, lbi, cr_, ci_);
        bf16x8 bfrag[8];
#pragma unroll
        for (int tile = 0; tile < 8; ++tile) {
            const int comp = 16 * tile + l15, st = comp & 63, isim = comp >> 6;
            float a0, a1, cr, ci; lam_coef(P.in[3], P.in[4], dt, g * 64 + st, a0, a1, cr, ci);
            bf16x8 fr = {0, 0, 0, 0, 0, 0, 0, 0};
            if (quad < 2) {
                const float* bre = P.in[6] + (size_t)(g * 64 + st) * 16 + 8 * quad;
                const float* bim = P.in[7] + (size_t)(g * 64 + st) * 16 + 8 * quad;
#pragma unroll
                for (int j = 0; j < 8; ++j) { const float v = isim ? (cr * bim[j] + ci * bre[j]) : (cr * bre[j] - ci * bim[j]); fr[j] = (short)f2bf(v); }
            }
            bfrag[tile] = fr;
        }
        bf16x8 cfrag[4];
#pragma unroll
        for (int ks = 0; ks < 4; ++ks) {
#pragma unroll
            for (int j = 0; j < 8; ++j) {
                const int k = 32 * ks + 8 * quad + j, p = k >> 1;
                const float v = (k & 1) ? -P.in[9][(size_t)(g * 16 + l15) * 64 + p] : P.in[8][(size_t)(g * 16 + l15) * 64 + p];
                cfrag[ks][j] = (short)f2bf(v);
            }
        }
        const float dh = P.in[10][g * 16 + l15];
        float sr = 0.f, si = 0.f;
        const bf16x8 zero8 = {0, 0, 0, 0, 0, 0, 0, 0};
        bf16x8 ua_n = *(const bf16x8*)(PROJ + (size_t)(T + l15) * 2048 + g * 16 + 8 * (quad & 1));
        unsigned short ue_n[4];
#pragma unroll
        for (int r = 0; r < 4; ++r) ue_n[r] = PROJ[(size_t)(T + 4 * quad + r) * 2048 + g * 16 + l15];
        for (int chunk = 0; chunk < 129; ++chunk) {
            const int rowbase = chunk == 0 ? T : b * 2048 + (chunk - 1) * 16;
            const bf16x8 ua = quad < 2 ? ua_n : zero8;
            unsigned short ue[4];
#pragma unroll
            for (int r = 0; r < 4; ++r) ue[r] = ue_n[r];
            {
                const int cn = chunk + 1 < 129 ? chunk + 1 : 128;
                const int rbn = b * 2048 + (cn - 1) * 16;
                ua_n = *(const bf16x8*)(PROJ + (size_t)(rbn + l15) * 2048 + g * 16 + 8 * (quad & 1));
#pragma unroll
                for (int r = 0; r < 4; ++r) ue_n[r] = PROJ[(size_t)(rbn + 4 * quad + r) * 2048 + g * 16 + l15];
            }
#pragma unroll
            for (int tile = 0; tile < 8; ++tile) {
                f32x4 acc = {0.f, 0.f, 0.f, 0.f};
                acc = MFMA16(ua, bfrag[tile], acc);
#pragma unroll
                for (int r = 0; r < 4; ++r) bu[(4 * quad + r) * 132 + 16 * tile + l15] = acc[r];
            }
            LDS_WAIT();
#pragma unroll
            for (int t = 0; t < 16; ++t) {
                const float br = bu[t * 132 + lane], bi = bu[t * 132 + 64 + lane];
                const float nsr = fmaf(lbr, sr, fmaf(-lbi, si, br)), nsi = fmaf(lbr, si, fmaf(lbi, sr, bi));
                sr = nsr; si = nsi;
                sl[t * 68 + lane] = pk2(sr, si);
            }
            LDS_WAIT();
            f32x4 y = {0.f, 0.f, 0.f, 0.f};
#pragma unroll
            for (int ks = 0; ks < 4; ++ks) {
                const bf16x8 sa = *(const LAS bf16x8*)((const LAS bf16_t*)sl + l15 * 136 + 32 * ks + 8 * quad);
                y = MFMA16(sa, cfrag[ks], y);
            }
            if (chunk > 0 || b == 0) {
#pragma unroll
                for (int r = 0; r < 4; ++r) {
                    const size_t row = (size_t)(rowbase + 4 * quad + r);
                    const float u = bf2f(ue[r]);
                    const float v = y[r] + dh * u;
                    const float a2 = 1.5957691216057308f * (v + 0.044715f * v * v * v);
                    APRE[row * 512 + g * 16 + l15] = f2bf(v * sigmoidf_(a2));
                }
            }
            LDS_WAIT();
        }
    }
}

__device__ __forceinline__ void attn_tile_sub(const LAS bf16_t* Kl, const LAS bf16_t* Vl, const bf16x8 (&qf)[4], int sub, int keybase  ,
                                              int iq, int l31, int h, f32x16& o0, f32x16& o1, float& Rrun) {
    f32x16 st;
#pragma unroll
    for (int i = 0; i < 16; ++i) st[i] = 0.f;
#pragma unroll
    for (int s = 0; s < 4; ++s) {
        const bf16x8 ka = *(const LAS bf16x8*)(Kl + (32 * sub + l31) * 72 + 16 * s + 8 * h);
        st = MFMA32(ka, qf[s], st);
    }
    float lk[16]; bool vis[16];
#pragma unroll
    for (int i = 0; i < 16; ++i) {
        const int kl = 32 * sub + (i & 3) + 8 * (i >> 2) + 4 * h;
        vis[i] = keybase >= 0 ? (keybase + kl < iq) : (kl < 16);
        const float e = __builtin_amdgcn_exp2f(fminf(st[i], 100.f));
        const float sp = __builtin_amdgcn_logf(1.0f + e);
        lk[i] = vis[i] ? -sp : 0.f;
    }
    float ga[4], pa[4];
#pragma unroll
    for (int a = 0; a < 4; ++a) { ga[a] = (lk[4 * a] + lk[4 * a + 1]) + (lk[4 * a + 2] + lk[4 * a + 3]); pa[a] = __shfl_xor(ga[a], 32); }
    float run = Rrun; float w[16];
#pragma unroll
    for (int a = 3; a >= 0; --a) {
        const float off = h ? run : run + pa[a];
        const float I3 = off + lk[4 * a + 3], I2 = I3 + lk[4 * a + 2], I1 = I2 + lk[4 * a + 1], I0 = I1 + lk[4 * a];
        w[4 * a + 3] = vis[4 * a + 3] ? __builtin_amdgcn_exp2f(st[4 * a + 3] + I3) : 0.f;
        w[4 * a + 2] = vis[4 * a + 2] ? __builtin_amdgcn_exp2f(st[4 * a + 2] + I2) : 0.f;
        w[4 * a + 1] = vis[4 * a + 1] ? __builtin_amdgcn_exp2f(st[4 * a + 1] + I1) : 0.f;
        w[4 * a + 0] = vis[4 * a + 0] ? __builtin_amdgcn_exp2f(st[4 * a + 0] + I0) : 0.f;
        run += ga[a] + pa[a];
    }
    Rrun = run;
#pragma unroll
    for (int s2 = 0; s2 < 2; ++s2) {
        u32x4 pw; pw.x = pk2(w[8 * s2], w[8 * s2 + 1]); pw.y = pk2(w[8 * s2 + 2], w[8 * s2 + 3]); pw.z = pk2(w[8 * s2 + 4], w[8 * s2 + 5]); pw.w = pk2(w[8 * s2 + 6], w[8 * s2 + 7]);
        const bf16x8 pb = __builtin_bit_cast(bf16x8, pw);
#pragma unroll
        for (int mt = 0; mt < 2; ++mt) {
            const LAS bf16_t* vp = Vl + (32 * mt + l31) * 68 + 32 * sub + 16 * s2 + 4 * h;
            const s16x4 lo = *(const LAS s16x4*)vp, hi = *(const LAS s16x4*)(vp + 8);
            const bf16x8 va = __builtin_shufflevector(lo, hi, 0, 1, 2, 3, 4, 5, 6, 7);
            if (mt == 0) o0 = MFMA32(va, pb, o0); else o1 = MFMA32(va, pb, o1);
        }
    }
}
__device__ __forceinline__ void attn_phase(const Params& P, LAS unsigned char* lds, int blk, int G, int wave) {
    const int lane = lane_id_v(), tid = wave * 64 + lane, l31 = lane & 31, h = lane >> 5;
    const bf16_t* PROJ = (const bf16_t*)(P.ws + OFF_BIG + BIG_PROJ);
    bf16_t* CAT = (bf16_t*)(P.ws + OFF_BIG + BIG_CAT);
    if (blk == G - 1) {
        LAS float* wm = (LAS float*)(lds + 40960);
        if (tid < 128) {
            const int t = tid & 15, hd = tid >> 4;
            const bf16_t* qp = PROJ + (size_t)(T + t) * 2048 + 512 + hd * 64;
            float run = 0.f;
            for (int j = 15; j >= 0; --j) {
                float wv = 0.f;
                if (j < t) {
                    const bf16_t* kp = PROJ + (size_t)(T + j) * 2048 + 1024 + hd * 64;
                    float z = 0.f;
                    for (int d = 0; d < 64; ++d) z = fmaf(bf2f(qp[d]), bf2f(kp[d]), z);
                    const float sp = __builtin_amdgcn_logf(1.0f + __builtin_amdgcn_exp2f(fminf(z, 100.f)));
                    run -= sp; wv = __builtin_amdgcn_exp2f(z + run);
                }
                wm[tid * 16 + j] = wv;
            }
        }
        __syncthreads();
        for (int idx = tid; idx < 16 * 512; idx += 512) {
            const int t = idx >> 9, c = idx & 511, hd = c >> 6;
            float o = 0.f;
            for (int j = 0; j < 16; ++j) o = fmaf(wm[(hd * 16 + t) * 16 + j], bf2f(PROJ[(size_t)(T + j) * 2048 + 1536 + c]), o);
            CAT[(size_t)(T + t) * 1024 + 512 + c] = f2bf(o);
        }
        __syncthreads();
    }
    LAS bf16_t* Kl0 = (LAS bf16_t*)lds;
    LAS bf16_t* Vl0 = (LAS bf16_t*)(lds + 2 * 9216);
    const int lkey = tid >> 3, lpart = tid & 7;
    for (int j4 = 0; j4 < 4; ++j4) {
        const int item = blk + G * j4;
        if (item >= 1024) break;
        const int c = item % 256, jj = item / 256, bh = c >> 1, par = c & 1;
        const int qb = par == 0 ? (jj == 0 ? 7 : jj == 1 ? 0 : jj == 2 ? 4 : 3) : (jj == 0 ? 6 : jj == 1 ? 1 : jj == 2 ? 5 : 2);
        const int b = bh >> 3, hd = bh & 7;
        const int iq = 256 * qb + 32 * wave + l31;
        const size_t qrow = (size_t)b * 2048 + iq;
        bf16x8 qf[4];
#pragma unroll
        for (int s = 0; s < 4; ++s) qf[s] = *(const bf16x8*)(PROJ + qrow * 2048 + 512 + hd * 64 + 16 * s + 8 * h);
        f32x16 o0, o1;
#pragma unroll
        for (int i = 0; i < 16; ++i) { o0[i] = 0.f; o1[i] = 0.f; }
        float Rrun = 0.f;
        const int nt = 4 * qb + 5;
        u32x4 kreg, vreg;
#define ATT_LOAD(it_) do { const int kt_ = 4 * qb + 3 - (it_); size_t row_; bool ok_ = true; \
            if (kt_ >= 0) row_ = (size_t)b * 2048 + 64 * kt_ + lkey; else { row_ = (size_t)T + lkey; ok_ = lkey < 16; } \
            if (ok_) { const bf16_t* p_ = PROJ + row_ * 2048 + 1024 + hd * 64 + lpart * 8; kreg = *(const u32x4*)p_; vreg = *(const u32x4*)(p_ + 512); } \
            else { kreg = (u32x4){0u, 0u, 0u, 0u}; vreg = kreg; } } while (0)
#define ATT_STORE(buf_) do { *(LAS u32x4*)(Kl0 + (buf_) * 4608 + lkey * 72 + lpart * 8) = kreg; \
            LAS bf16_t* vt_ = Vl0 + (buf_) * 4352 + (lpart * 8) * 68 + lkey; \
            vt_[0 * 68] = (bf16_t)(vreg.x & 0xffffu); vt_[1 * 68] = (bf16_t)(vreg.x >> 16); \
            vt_[2 * 68] = (bf16_t)(vreg.y & 0xffffu); vt_[3 * 68] = (bf16_t)(vreg.y >> 16); \
            vt_[4 * 68] = (bf16_t)(vreg.z & 0xffffu); vt_[5 * 68] = (bf16_t)(vreg.z >> 16); \
            vt_[6 * 68] = (bf16_t)(vreg.w & 0xffffu); vt_[7 * 68] = (bf16_t)(vreg.w >> 16); } while (0)
        ATT_LOAD(0); ATT_STORE(0);
        __syncthreads();
        int cur = 0;
        for (int it = 0; it < nt; ++it) {
            if (it + 1 < nt) ATT_LOAD(it + 1);
            const int kt = 4 * qb + 3 - it;
            const int keybase = kt >= 0 ? 64 * kt : -1;
            const int wq_end = 256 * qb + 32 * wave + 32;
            const LAS bf16_t* Kl = Kl0 + cur * 4608; const LAS bf16_t* Vl = Vl0 + cur * 4352;
            if (kt < 0) { attn_tile_sub(Kl, Vl, qf, 0, -1, iq, l31, h, o0, o1, Rrun); }
            else {
                if (keybase + 32 < wq_end) attn_tile_sub(Kl, Vl, qf, 1, keybase, iq, l31, h, o0, o1, Rrun);
                if (keybase < wq_end) attn_tile_sub(Kl, Vl, qf, 0, keybase, iq, l31, h, o0, o1, Rrun);
            }
            if (it + 1 < nt) ATT_STORE(cur ^ 1);
            __syncthreads();
            cur ^= 1;
        }
        bf16_t* op = CAT + qrow * 1024 + 512 + hd * 64;
#pragma unroll
        for (int a = 0; a < 4; ++a) {
            u32x2 w0; w0.x = pk2(o0[4 * a], o0[4 * a + 1]); w0.y = pk2(o0[4 * a + 2], o0[4 * a + 3]);
            u32x2 w1; w1.x = pk2(o1[4 * a], o1[4 * a + 1]); w1.y = pk2(o1[4 * a + 2], o1[4 * a + 3]);
            *(u32x2*)(op + 8 * a + 4 * h) = w0; *(u32x2*)(op + 32 + 8 * a + 4 * h) = w1;
        }
    }
}

__device__ __forceinline__ void hgrn_phase(const Params& P, LAS unsigned char* lds, int blk, int G, int wave) {
    const int lane = lane_id_v(), tid = wave * 64 + lane, l15 = lane & 15, quad = lane >> 4;
    LAS bf16_t* qd = (LAS bf16_t*)lds;
    LAS bf16_t* kd = qd + 64 * 136;
    LAS bf16_t* klT = kd + 64 * 136;
    LAS bf16_t* vT = klT + 128 * 72;
    LAS bf16_t* sc = vT + 128 * 72;
    LAS float* ebl = (LAS float*)(sc + 64 * 72);
    LAS float* segtot = ebl + 128;
    LAS float* red = segtot + 1024;
    const unsigned short* PC = (const unsigned short*)(P.ws + OFF_BIG);
    bf16_t* MIXC = (bf16_t*)P.out;
    const float* ng = P.in[16];
    for (int item = blk; item < 128; item += G) {
        const int b = item >> 3, hd = item & 7;
        f32x4 Sacc[8];
#pragma unroll
        for (int i = 0; i < 8; ++i) Sacc[i] = (f32x4){0.f, 0.f, 0.f, 0.f};
        const int dp = tid & 63, sg = tid >> 6;
        unsigned lfc[8], qc[8], vc[8];
#define HG_ROW(cc_, t_) ((cc_) > 0 ? (size_t)b * 2048 + ((cc_) - 1) * 64 + (t_) : (size_t)T + ((t_) >= 48 ? (t_) - 48 : 0))
#define HG_LOAD(cc_, LF_, Q_, V_) do { _Pragma("unroll") for (int tt_ = 0; tt_ < 8; ++tt_) { const unsigned short* rp_ = PC + HG_ROW(cc_, 8 * sg + tt_) * 4096 + hd * 128 + 2 * dp; \
            Q_[tt_] = *(const unsigned*)rp_; LF_[tt_] = *(const unsigned*)(rp_ + 1024); V_[tt_] = *(const unsigned*)(rp_ + 2048); } } while (0)
        HG_LOAD(0, lfc, qc, vc);
        for (int c = 0; c < 33; ++c) {
            unsigned lfn[8], qn[8], vn[8];
            { const int cn = c + 1 < 33 ? c + 1 : 32; HG_LOAD(cn, lfn, qn, vn); }
            unsigned short gr[16];
            {
                const int cg_ = c > 0 ? c : 1;
#pragma unroll
                for (int tt = 0; tt < 4; ++tt)
#pragma unroll
                    for (int r = 0; r < 4; ++r) gr[4 * tt + r] = PC[((size_t)b * 2048 + (cg_ - 1) * 64 + 16 * tt + 4 * quad + r) * 4096 + 3072 + hd * 128 + 16 * wave + l15];
            }
            {
                float cs0[8], cs1[8]; float run0 = 0.f, run1 = 0.f;
#pragma unroll
                for (int tt = 0; tt < 8; ++tt) {
                    const bool ok = c > 0 || (8 * sg + tt) >= 48;
                    const float l0 = ok ? (float)__builtin_bit_cast(_Float16, (unsigned short)(lfc[tt] & 0xffffu)) : 0.f;
                    const float l1 = ok ? (float)__builtin_bit_cast(_Float16, (unsigned short)(lfc[tt] >> 16)) : 0.f;
                    run0 += l0; run1 += l1; cs0[tt] = run0; cs1[tt] = run1;
                }
                segtot[sg * 128 + 2 * dp] = run0; segtot[sg * 128 + 2 * dp + 1] = run1;
                __syncthreads();
                float off0 = 0.f, off1 = 0.f, bl0 = 0.f, bl1 = 0.f;
#pragma unroll
                for (int s2 = 0; s2 < 8; ++s2) {
                    const float a0 = segtot[s2 * 128 + 2 * dp], a1 = segtot[s2 * 128 + 2 * dp + 1];
                    bl0 += a0; bl1 += a1; if (s2 < sg) { off0 += a0; off1 += a1; }
                }
                if (sg == 7) { ebl[2 * dp] = __expf(bl0); ebl[2 * dp + 1] = __expf(bl1); }
                unsigned kl0[4], kl1[4], v0[4], v1[4];
#pragma unroll
                for (int tp = 0; tp < 4; ++tp) {
                    float klv0[2], klv1[2];
#pragma unroll
                    for (int e = 0; e < 2; ++e) {
                        const int tt = 2 * tp + e, t = 8 * sg + tt;
                        const bool ok = c > 0 || t >= 48;
                        const float lf0 = cs0[tt] - (tt ? cs0[tt - 1] : 0.f), lf1 = cs1[tt] - (tt ? cs1[tt - 1] : 0.f);
                        const float bt0 = off0 + cs0[tt], bt1 = off1 + cs1[tt];
                        const float q0 = ok ? bflo(qc[tt]) : 0.f, q1 = ok ? bfhi(qc[tt]) : 0.f;
                        const float k0 = 1.0f - __expf(lf0), k1 = 1.0f - __expf(lf1);
                        *(LAS unsigned*)(qd + t * 136 + 2 * dp) = pk2(q0 * __expf(bt0), q1 * __expf(bt1));
                        *(LAS unsigned*)(kd + t * 136 + 2 * dp) = pk2(k0 * __expf(-bt0), k1 * __expf(-bt1));
                        klv0[e] = k0 * __expf(bl0 - bt0); klv1[e] = k1 * __expf(bl1 - bt1);
                    }
                    kl0[tp] = pk2(klv0[0], klv0[1]); kl1[tp] = pk2(klv1[0], klv1[1]);
                    const bool okA = c > 0 || (8 * sg + 2 * tp) >= 48, okB = c > 0 || (8 * sg + 2 * tp + 1) >= 48;
                    const unsigned va = okA ? vc[2 * tp] : 0u, vb = okB ? vc[2 * tp + 1] : 0u;
                    v0[tp] = (va & 0xffffu) | (vb << 16); v1[tp] = (va >> 16) | (vb & 0xffff0000u);
                }
                *(LAS u32x4*)(klT + (2 * dp) * 72 + 8 * sg) = (u32x4){kl0[0], kl0[1], kl0[2], kl0[3]};
                *(LAS u32x4*)(klT + (2 * dp + 1) * 72 + 8 * sg) = (u32x4){kl1[0], kl1[1], kl1[2], kl1[3]};
                *(LAS u32x4*)(vT + (2 * dp) * 72 + 8 * sg) = (u32x4){v0[0], v0[1], v0[2], v0[3]};
                *(LAS u32x4*)(vT + (2 * dp + 1) * 72 + 8 * sg) = (u32x4){v1[0], v1[1], v1[2], v1[3]};
            }
            __syncthreads();
            f32x4 oacc[4];
#pragma unroll
            for (int i = 0; i < 4; ++i) oacc[i] = (f32x4){0.f, 0.f, 0.f, 0.f};
#pragma unroll
            for (int ks = 0; ks < 4; ++ks) {
                u32x4 sw; sw.x = pk2(Sacc[2 * ks][0], Sacc[2 * ks][1]); sw.y = pk2(Sacc[2 * ks][2], Sacc[2 * ks][3]);
                sw.z = pk2(Sacc[2 * ks + 1][0], Sacc[2 * ks + 1][1]); sw.w = pk2(Sacc[2 * ks + 1][2], Sacc[2 * ks + 1][3]);
                const bf16x8 sb = __builtin_bit_cast(bf16x8, sw);
#pragma unroll
                for (int tt = 0; tt < 4; ++tt) {
                    const LAS bf16_t* ap = qd + (16 * tt + l15) * 136 + 32 * ks + 4 * quad;
                    const s16x4 lo = *(const LAS s16x4*)ap, hi = *(const LAS s16x4*)(ap + 16);
                    oacc[tt] = MFMA16(__builtin_shufflevector(lo, hi, 0, 1, 2, 3, 4, 5, 6, 7), sb, oacc[tt]);
                }
            }
#pragma unroll
            for (int e = 0; e < 2; ++e) {
                const int tile = 2 * wave + e, tt = tile >> 2, ss = tile & 3;
                f32x4 sa = {0.f, 0.f, 0.f, 0.f};
#pragma unroll
                for (int ks = 0; ks < 4; ++ks) {
                    const bf16x8 a = *(const LAS bf16x8*)(qd + (16 * tt + l15) * 136 + 32 * ks + 8 * quad);
                    const bf16x8 bb = *(const LAS bf16x8*)(kd + (16 * ss + l15) * 136 + 32 * ks + 8 * quad);
                    sa = MFMA16(a, bb, sa);
                }
#pragma unroll
                for (int r = 0; r < 4; ++r) { const int tg = 16 * tt + 4 * quad + r, sg_ = 16 * ss + l15; sc[tg * 72 + sg_] = f2bf(sg_ <= tg ? sa[r] : 0.f); }
            }
            __syncthreads();
#pragma unroll
            for (int dt = 0; dt < 8; ++dt)
#pragma unroll
                for (int r = 0; r < 4; ++r) Sacc[dt][r] *= ebl[16 * dt + 4 * quad + r];
#pragma unroll
            for (int ks = 0; ks < 2; ++ks) {
                const bf16x8 vb = *(const LAS bf16x8*)(vT + (16 * wave + l15) * 72 + 32 * ks + 8 * quad);
#pragma unroll
                for (int tt = 0; tt < 4; ++tt) { const bf16x8 a = *(const LAS bf16x8*)(sc + (16 * tt + l15) * 72 + 32 * ks + 8 * quad); oacc[tt] = MFMA16(a, vb, oacc[tt]); }
#pragma unroll
                for (int dt = 0; dt < 8; ++dt) { const bf16x8 a = *(const LAS bf16x8*)(klT + (16 * dt + l15) * 72 + 32 * ks + 8 * quad); Sacc[dt] = MFMA16(a, vb, Sacc[dt]); }
            }
#pragma unroll
            for (int tt = 0; tt < 4; ++tt)
#pragma unroll
                for (int r = 0; r < 4; ++r) {
                    float s = oacc[tt][r] * oacc[tt][r];
                    s += __shfl_xor(s, 1); s += __shfl_xor(s, 2); s += __shfl_xor(s, 4); s += __shfl_xor(s, 8);
                    if (l15 == 0) red[(16 * tt + 4 * quad + r) * 8 + wave] = s;
                }
            __syncthreads();
            if (c > 0) {
                const int dvg = hd * 128 + 16 * wave + l15;
                const float gn = ng[dvg];
#pragma unroll
                for (int tt = 0; tt < 4; ++tt)
#pragma unroll
                    for (int r = 0; r < 4; ++r) {
                        const int t = 16 * tt + 4 * quad + r;
                        const f32x4 r0 = *(const LAS f32x4*)(red + t * 8), r1 = *(const LAS f32x4*)(red + t * 8 + 4);
                        const float ssum = ((r0[0] + r0[1]) + (r0[2] + r0[3])) + ((r1[0] + r1[1]) + (r1[2] + r1[3]));
                        const float rs = 1.0f / sqrtf(ssum * (1.0f / 128.0f) + 1e-6f);
                        const size_t row = (size_t)b * 2048 + (c - 1) * 64 + t;
                        const float gv = bf2f(gr[4 * tt + r]);
                        MIXC[row * 1024 + dvg] = f2bf(oacc[tt][r] * rs * gn * gv * sigmoidf_(gv));
                    }
            }
#pragma unroll
            for (int i = 0; i < 8; ++i) { lfc[i] = lfn[i]; qc[i] = qn[i]; vc[i] = vn[i]; }
        }
        __syncthreads();
    }
}

__global__ void __launch_bounds__(512, 2) fwd_megakernel(Params P) {
    extern __shared__ __attribute__((aligned(16))) unsigned char lds_raw[];
    LAS unsigned char* lds = (LAS unsigned char*)lds_raw;
    cg::grid_group grid = cg::this_grid();
    const int blk = blockIdx.x, G = gridDim.x, wave = __builtin_amdgcn_readfirstlane((int)(threadIdx.x >> 6));
    unsigned char* ws = P.ws;
    bf16_t* HB = (bf16_t*)(ws + OFF_HB);
    float* Z = (float*)(ws + OFF_Z);
    bf16_t* PROJ = (bf16_t*)(ws + OFF_BIG + BIG_PROJ);
    bf16_t* APRE = (bf16_t*)(ws + OFF_BIG + BIG_APRE);
    bf16_t* CAT = (bf16_t*)(ws + OFF_BIG + BIG_CAT);
    bf16_t* HID = (bf16_t*)(ws + OFF_BIG);
    unsigned short* PC = (unsigned short*)(ws + OFF_BIG);

    prologue_phase(P, lds, blk, G, wave);
    grid.sync();
    run_gemm(lds, HB, (const bf16_t*)(ws + OFF_WAB), 2048, 1024, EpInAB{PROJ}, true, blk, G, wave);
    grid.sync();
    s5_phase(P, lds, blk, G, wave);
    __syncthreads();
#if PROBE_DUP_S5
    s5_phase(P, lds, blk, G, wave);
    __syncthreads();
#endif
    attn_phase(P, lds, blk, G, wave);
#if PROBE_DUP_ATTN
    __syncthreads();
    attn_phase(P, lds, blk, G, wave);
#endif
    grid.sync();
    run_gemm(lds, APRE, (const bf16_t*)(ws + OFF_WGLU), 512, 512, EpGlu{APRE, P.in[12], CAT}, true, blk, G, wave);
    grid.sync();
    float* ST = (float*)(ws + OFF_ST); const float* SV = (const float*)(ws + OFF_SV); const float* TV = (const float*)(ws + OFF_TV);
    float *ST1 = ST, *ST2 = ST + 2 * (size_t)R, *ST3 = ST + 4 * (size_t)R, *ST4 = ST + 6 * (size_t)R;
    run_gemm(lds, CAT, (const bf16_t*)(ws + OFF_WOAB), 1024, 1024, EpRes{P.in[0], P.in[1], Z, nullptr, nullptr, nullptr, nullptr, ST1, HB}, true, blk, G, wave);
    grid.sync();
    run_gemm(lds, HB, (const bf16_t*)(ws + OFF_WUP0), 4096, 1024, EpUp{HID, P.in[21], ST1, SV, TV}, true, blk, G, wave);
    grid.sync();
    run_gemm(lds, HID, (const bf16_t*)(ws + OFF_WDN0), 1024, 4096, EpRes{Z, nullptr, Z, P.in[23], ST1, P.in[18], P.in[19], ST2, HB}, true, blk, G, wave);
    grid.sync();
    run_gemm(lds, HB, (const bf16_t*)(ws + OFF_WC), 4096, 1024, EpInC{PC, P.in[15], ST2, SV + 4096, TV + 4096}, true, blk, G, wave);
#if PROBE_DUP_INC
    __syncthreads();
    run_gemm(lds, HB, (const bf16_t*)(ws + OFF_WC), 4096, 1024, EpInC{PC, P.in[15], ST2, SV + 4096, TV + 4096}, true, blk, G, wave);
#endif
    grid.sync();
    hgrn_phase(P, lds, blk, G, wave);
#if PROBE_DUP_HGRN
    __syncthreads();
    hgrn_phase(P, lds, blk, G, wave);
#endif
    grid.sync();
    run_gemm(lds, (const bf16_t*)P.out  , (const bf16_t*)(ws + OFF_WOC), 1024, 1024, EpRes{Z, nullptr, Z, nullptr, ST2, P.in[24], P.in[25], ST3, HB}, false, blk, G, wave);
    grid.sync();
    run_gemm(lds, HB, (const bf16_t*)(ws + OFF_WUP1), 4096, 1024, EpUp{HID, P.in[21] + 4096, ST3, SV + 8192, TV + 8192}, false, blk, G, wave);
    grid.sync();
    run_gemm(lds, HID, (const bf16_t*)(ws + OFF_WDN1), 1024, 4096, EpRes{Z, nullptr, Z, P.in[23] + 1024, ST3, P.in[18] + 1024, P.in[19] + 1024, ST4, nullptr}, false, blk, G, wave);
    grid.sync();
    final_ln_phase(Z, ST4, P.out, P.in[24] + 1024, P.in[25] + 1024, blk, G, wave);
}

extern "C" void kernel_launch(void* const* d_in, const int* in_sizes, int n_in, void* d_out, int out_size, void* d_ws, size_t ws_size, hipStream_t stream) {
    constexpr size_t kDynLds = 131072;
    static int grid_blocks = 0;
    if (!grid_blocks) {
        if (n_in != 26 || ws_size < ZERO_END) { fprintf(stderr, "kernel_launch: expected 26 inputs and >= %zu bytes of workspace (got %d, %zu)\n", (size_t)ZERO_END, n_in, ws_size); grid_blocks = -1; return; }
        int dev = 0, cus = 0, per_cu = 0;
        hipGetDevice(&dev);
        hipDeviceGetAttribute(&cus, hipDeviceAttributeMultiprocessorCount, dev);
        hipFuncSetAttribute((const void*)fwd_megakernel, hipFuncAttributeMaxDynamicSharedMemorySize, (int)kDynLds);
        hipOccupancyMaxActiveBlocksPerMultiprocessor(&per_cu, (const void*)fwd_megakernel, 512, kDynLds);
        if (per_cu < 1) { fprintf(stderr, "kernel_launch: occupancy query says %d blocks per CU\n", per_cu); per_cu = 1; }
        grid_blocks = cus * (per_cu > 1 ? 1 : per_cu);
        if (grid_blocks != 256) fprintf(stderr, "kernel_launch: note: grid is %d workgroups (tuned for 256)\n", grid_blocks);
    }
    if (grid_blocks < 1) return;
    Params p{};
    for (int i = 0; i < 26; ++i) p.in[i] = (const float*)d_in[i];
    p.out = (float*)d_out; p.ws = (unsigned char*)d_ws;
    hipMemsetAsync((char*)d_ws + OFF_ST, 0, ZERO_END - OFF_ST, stream);
    void* args[] = {&p};
    hipError_t e = hipLaunchCooperativeKernel((const void*)fwd_megakernel, dim3(grid_blocks), dim3(512), args, kDynLds, stream);
    if (e != hipSuccess) fprintf(stderr, "cooperative launch failed: %s (grid %d)\n", hipGetErrorString(e), grid_blocks);
}
```

```cpp
#include <hip/hip_runtime.h>
#include <hip/hip_cooperative_groups.h>
#include <cstdio>
#include <cstdint>
namespace cg = cooperative_groups;
#ifndef PROBE_DUP_S5
#define PROBE_DUP_S5 0
#endif
#ifndef PROBE_DUP_ATTN
#define PROBE_DUP_ATTN 0
#endif
#ifndef PROBE_DUP_HGRN
#define PROBE_DUP_HGRN 0
#endif
#ifndef PROBE_DUP_INC
#define PROBE_DUP_INC 0
#endif
__device__ __forceinline__ int lane_id_v() { int l; asm volatile("v_mbcnt_lo_u32_b32 %0, -1, 0\n\tv_mbcnt_hi_u32_b32 %0, -1, %0" : "=v"(l)); return l; }
#ifndef PROBE_DUP_UP0
#define PROBE_DUP_UP0 0
#endif
#ifndef PROBE_SYNCS
#define PROBE_SYNCS 0
#endif
#define XB_TMO      128
#define XB_XCNT(j)  (256  + 64 * (j))
#define XB_XSUB(j)  (1280 + 64 * (j))
#define XB_XGEN(j)  (2304 + 64 * (j))
#define XB_TOP      3328
#define XB_TOPGEN   3392
#define XCD_BAR_WORDS 3456
#define XB_SPIN_CAP (1u << 18)

__device__ __forceinline__ unsigned xb_ld(unsigned* p)              { return __hip_atomic_load(p, __ATOMIC_RELAXED, __HIP_MEMORY_SCOPE_AGENT); }
__device__ __forceinline__ unsigned xb_add(unsigned* p, unsigned v) { return __hip_atomic_fetch_add(p, v, __ATOMIC_RELAXED, __HIP_MEMORY_SCOPE_AGENT); }
__device__ __forceinline__ unsigned xb_xcc_id() { return (unsigned)__builtin_amdgcn_s_getreg((3 << 11) | 20) & 0xFu; }
#define XB_SPIN(cond, bar) do { unsigned _sp = 0; while (cond) { __builtin_amdgcn_s_sleep(1); \
    if ((++_sp & 255u) == 0u) { if (xb_ld(&(bar)[XB_TMO])) break; if (_sp > XB_SPIN_CAP) { atomicAdd(&(bar)[XB_TMO], 1u); break; } } } } while (0)

struct XcdBarrier {
    unsigned* bar; unsigned x;
    volatile __attribute__((address_space(3))) unsigned* st;
};

__device__ __forceinline__ XcdBarrier xcd_barrier_post(unsigned* bar, volatile __attribute__((address_space(3))) unsigned* st, int wave_in) {
    XcdBarrier b; b.bar = bar; b.x = xb_xcc_id(); b.st = st;
    if (wave_in == 0 && lane_id_v() == 0) (void)xb_add(&bar[XB_XCNT(b.x)], 1u);
    return b;
}
__device__ __forceinline__ void xcd_barrier_complete(unsigned* bar, unsigned x, unsigned& nloc, unsigned& nx) {
    const unsigned G = gridDim.x * gridDim.y * gridDim.z;
    unsigned sum, cnt, mine, sp = 0u;
    for (;;) {
        sum = 0u; cnt = 0u; mine = 0u;
#pragma unroll
        for (unsigned j = 0; j < 16; ++j) { const unsigned c = xb_ld(&bar[XB_XCNT(j)]); sum += c; cnt += (c > 0u) ? 1u : 0u; mine = (j == x) ? c : mine; }
        if (sum == G) break;
        __builtin_amdgcn_s_sleep(1);
        if ((++sp & 255u) == 0u) { if (xb_ld(&bar[XB_TMO])) break; if (sp > XB_SPIN_CAP) { atomicAdd(&bar[XB_TMO], 1u); break; } }
    }
    nloc = mine > 0u ? mine : 1u; nx = cnt > 0u ? cnt : 1u;
}

__device__ __forceinline__ void xcd_barrier(const XcdBarrier& b, int wave_in) {
    asm volatile("s_waitcnt vmcnt(0)" ::: "memory");
    __syncthreads();
    if (wave_in == 0 && lane_id_v() == 0) {
        unsigned* bar = b.bar;
        __builtin_amdgcn_s_waitcnt(0);
        unsigned nloc = b.st[0], nx = b.st[1];
        if (nloc == 0u) { xcd_barrier_complete(bar, b.x, nloc, nx); b.st[0] = nloc; b.st[1] = nx; }
        const unsigned old = xb_add(&bar[XB_XSUB(b.x)], 1u);
        const unsigned gen = old / nloc;
        if (old + 1u == (gen + 1u) * nloc) {
            __builtin_amdgcn_fence(__ATOMIC_RELEASE, "agent");
            asm volatile("s_waitcnt vmcnt(0)" ::: "memory");
            const unsigned og = xb_add(&bar[XB_TOP], 1u);
            const unsigned tg = og / nx;
            if (og + 1u == (tg + 1u) * nx) xb_add(&bar[XB_TOPGEN], 1u);
            else XB_SPIN(xb_ld(&bar[XB_TOPGEN]) == tg, bar);
            __builtin_amdgcn_fence(__ATOMIC_ACQUIRE, "agent");
            xb_add(&bar[XB_XGEN(b.x)], 1u);
            asm volatile("s_waitcnt vmcnt(0)" ::: "memory");
        } else {
            XB_SPIN(xb_ld(&bar[XB_XGEN(b.x)]) == gen, bar);
            __builtin_amdgcn_fence(__ATOMIC_ACQUIRE, "agent");
            asm volatile("s_waitcnt vmcnt(0)" ::: "memory");
        }
    }
    __syncthreads();
}

namespace pg8 {
#define PG8_LAS __attribute__((address_space(3)))
typedef unsigned short bf16_t;
typedef short bf16x8 __attribute__((ext_vector_type(8)));
typedef float f32x4 __attribute__((ext_vector_type(4)));
typedef unsigned u32x4 __attribute__((ext_vector_type(4)));
constexpr int BM = 256, BK = 64, HALF = 128, HTB = HALF * BK * 2  , STAGE_BYTES = 8 * HTB, NXCD = 8, WGM = 8;

__host__ __device__ __forceinline__ int lds_byte(int r, int c) { const int st = (r >> 4) * 2 + (c >> 5), rr = r & 15, cc = c & 31, ob = rr * 64 + cc * 2; return st * 1024 + (ob ^ (((ob >> 9) & 1) << 5)); }
__host__ __device__ __forceinline__ void stage_rc(int b, int& R, int& C) { const int st = b / 1024, sb = b % 1024, swz = sb ^ (((sb >> 9) & 1) << 5); R = (st >> 1) * 16 + swz / 64; C = (st & 1) * 32 + (swz % 64) / 2; }
__host__ __device__ __forceinline__ int perm32(int rho) { const int n = rho >> 4, i = rho & 15; return 8 * (i >> 2) + 4 * n + (i & 3); }

struct Unit { int pm, pn; };
struct Gemm { const bf16_t* A; const bf16_t* Bt; int M, N, K; };

struct StaticOrder {
    int nM, nN, nwg, G, c;
    __host__ __device__ void init(int M, int N, int G_, int c_) { nM = M / BM; nN = N / BM; nwg = nM * nN; G = G_; c = c_; }
    __host__ __device__ bool next(int i, Unit& u) const {
        const long L = (long)i * G + c; if (L >= nwg) return false;
        int wgid = (int)L; { const int q = nwg / NXCD, r = nwg % NXCD, xcd = wgid % NXCD, off = wgid / NXCD; wgid = (xcd < r ? xcd * (q + 1) : r * (q + 1) + (xcd - r) * q) + off; }
        const int nig = WGM * nN, gid = wgid / nig, fm = gid * WGM, gsz = (nM - fm) < WGM ? (nM - fm) : WGM;
        u.pm = fm + ((wgid % nig) % gsz); u.pn = (wgid % nig) / gsz; return true;
    }
    __device__ __forceinline__ void a_ready(const Unit&) const {}
    __device__ __forceinline__ void done(const Unit&) const {}
};

__device__ __forceinline__ unsigned cvt_pk_bf16(float lo, float hi) { unsigned r; asm volatile("v_cvt_pk_bf16_f32 %0, %1, %2" : "=v"(r) : "v"(lo), "v"(hi)); return r; }
template <class Epi, class Sched, bool ALIGN_EPI = false, bool SP2 = false>
__device__ __forceinline__ void gemm_phase(PG8_LAS unsigned char* lds, const Gemm g, const Sched& S, const Epi& E, int wave_in) {
    const int lane = lane_id_v(), wid = __builtin_amdgcn_readfirstlane(wave_in), tid = wid * 64 + lane, wr = wid >> 2, wc = wid & 3, fr = lane & 15, fq = lane >> 4;
    const int K = g.K, nt = K / BK;
    unsigned voffA[2], voffB[2];
#pragma unroll
    for (int i = 0; i < 2; ++i) { int R, C; stage_rc(tid * 16 + i * 8192, R, C); const int Rb = Epi::PERM ? ((R & ~31) + perm32(R & 31)) : R;
        voffA[i] = (unsigned)(R * K + C) * 2u; voffB[i] = (unsigned)(Rb * K + C) * 2u; }
    const size_t kstep = (size_t)(BK * 2);
    const size_t hstep = (size_t)HALF * K * 2;
    const size_t tstep = 2 * hstep;
    const unsigned ldsw = (unsigned)wid * 1024u;
    const int aoff = lds_byte(wr * 64 + fr, fq * 8), boff = lds_byte(wc * 32 + fr, fq * 8);
#define PG8_SA(b, h) (((b) * 2 + (h)) * HTB)
#define PG8_SB(b, h) ((4 + (b) * 2 + (h)) * HTB)
#define PG8_STAGE(bufoff, gbase, voff) do { _Pragma("unroll") for (int _i = 0; _i < 2; ++_i) \
        __builtin_amdgcn_global_load_lds((const unsigned*)((const char*)(gbase) + (voff)[_i]), (PG8_LAS unsigned*)(lds + (bufoff) + ldsw + _i * 8192), 16, 0, 0); } while (0)
#define PG8_LDA(dst, b, h) do { _Pragma("unroll") for (int m = 0; m < 4; ++m) _Pragma("unroll") for (int k = 0; k < 2; ++k) dst[m][k] = *(const PG8_LAS bf16x8*)(lds + PG8_SA(b, h) + aoff + m * 2048 + k * 1024); } while (0)
#define PG8_LDB(dst, b, h) do { _Pragma("unroll") for (int n = 0; n < 2; ++n) _Pragma("unroll") for (int k = 0; k < 2; ++k) dst[n][k] = *(const PG8_LAS bf16x8*)(lds + PG8_SB(b, h) + boff + n * 2048 + k * 1024); } while (0)
#define PG8_MMA(ai, bj, At, Bt) do { __builtin_amdgcn_s_setprio(1); _Pragma("unroll") for (int m = 0; m < 4; ++m) _Pragma("unroll") for (int n = 0; n < 2; ++n) _Pragma("unroll") for (int k = 0; k < 2; ++k) \
        acc[ai][bj][m][n] = __builtin_amdgcn_mfma_f32_16x16x32_bf16(Bt[n][k], At[m][k], acc[ai][bj][m][n], 0, 0, 0); __builtin_amdgcn_s_setprio(0); } while (0)
#define PG8_WAIT_V(n) asm volatile("s_waitcnt vmcnt(" #n ")" ::: "memory")
#define PG8_WAIT_L(n) asm volatile("s_waitcnt lgkmcnt(" #n ")" ::: "memory")
#define PG8_BAR __builtin_amdgcn_s_barrier()
#define PG8_SCHED __builtin_amdgcn_sched_barrier(0)
    Unit cur, nxt; int ui = 0;
    if (!S.next(0, cur)) return;
    f32x4 acc[2][2][4][2];
#pragma unroll
    for (int a = 0; a < 2; ++a)
#pragma unroll
        for (int b = 0; b < 2; ++b)
#pragma unroll
            for (int m = 0; m < 4; ++m)
#pragma unroll
                for (int n = 0; n < 2; ++n) acc[a][b][m][n] = (f32x4){0.f, 0.f, 0.f, 0.f};
    bf16x8 At[4][2], B0[2][2], B1[2][2];
    const char* cA = (const char*)g.A + (size_t)cur.pm * tstep; const char* cB = (const char*)g.Bt + (size_t)cur.pn * tstep;
    S.a_ready(cur);
    if constexpr (SP2) {
        PG8_STAGE(PG8_SB(0, 0), cB, voffB); PG8_STAGE(PG8_SB(0, 1), cB + hstep, voffB); PG8_STAGE(PG8_SA(0, 0), cA, voffA); PG8_STAGE(PG8_SA(0, 1), cA + hstep, voffA);
        if (wr == 1) PG8_BAR;
        PG8_WAIT_V(2); PG8_BAR;
        PG8_STAGE(PG8_SB(1, 0), cB + kstep, voffB); PG8_STAGE(PG8_SA(1, 0), cA + kstep, voffA); PG8_STAGE(PG8_SB(1, 1), cB + hstep + kstep, voffB);
        PG8_WAIT_V(6); PG8_BAR;
    } else {
        PG8_STAGE(PG8_SB(0, 0), cB, voffB); PG8_STAGE(PG8_SA(0, 0), cA, voffA); PG8_STAGE(PG8_SB(0, 1), cB + hstep, voffB); PG8_STAGE(PG8_SA(0, 1), cA + hstep, voffA);
        if (wr == 1) PG8_BAR;
        PG8_WAIT_V(4); PG8_BAR;
        PG8_STAGE(PG8_SB(1, 0), cB + kstep, voffB); PG8_STAGE(PG8_SA(1, 0), cA + kstep, voffA); PG8_STAGE(PG8_SB(1, 1), cB + hstep + kstep, voffB);
        PG8_WAIT_V(6); PG8_BAR;
    }
    for (;;) {
        const bool has_next = S.next(ui + 1, nxt);
        const char* nA = has_next ? (const char*)g.A + (size_t)nxt.pm * tstep : cA; const char* nB = has_next ? (const char*)g.Bt + (size_t)nxt.pn * tstep : cB;
        for (int t = 0; t < nt; t += 2) {
            const bool last = (t == nt - 2);
            const char* a1 = cA + (size_t)(t + 1) * kstep;
            const char* a2 = last ? nA : cA + (size_t)(t + 2) * kstep; const char* b2 = last ? nB : cB + (size_t)(t + 2) * kstep;
            const char* a3 = a2 + kstep; const char* b3 = b2 + kstep;
            if (last && has_next) S.a_ready(nxt);
            if constexpr (SP2) {
            PG8_LDB(B0, 0, 0); PG8_LDB(B1, 0, 1); PG8_SCHED; PG8_LDA(At, 0, 0); PG8_STAGE(PG8_SA(1, 1), a1 + hstep, voffA);
            PG8_WAIT_V(8); PG8_WAIT_L(0); PG8_BAR; PG8_MMA(0, 0, At, B0); PG8_MMA(0, 1, At, B1); PG8_BAR; PG8_SCHED;
            PG8_LDA(At, 0, 1); PG8_STAGE(PG8_SB(0, 0), b2, voffB); PG8_STAGE(PG8_SB(0, 1), b2 + hstep, voffB); PG8_STAGE(PG8_SA(0, 0), a2, voffA);
            PG8_WAIT_V(8); PG8_WAIT_L(0); PG8_BAR; PG8_MMA(1, 0, At, B0); PG8_MMA(1, 1, At, B1); PG8_BAR; PG8_SCHED;
            PG8_LDB(B0, 1, 0); PG8_LDB(B1, 1, 1); PG8_SCHED; PG8_LDA(At, 1, 0); PG8_STAGE(PG8_SA(0, 1), a2 + hstep, voffA);
            PG8_WAIT_V(8); PG8_WAIT_L(0); PG8_BAR; PG8_MMA(0, 0, At, B0); PG8_MMA(0, 1, At, B1); PG8_BAR; PG8_SCHED;
            PG8_LDA(At, 1, 1); PG8_STAGE(PG8_SB(1, 0), b3, voffB); PG8_STAGE(PG8_SB(1, 1), b3 + hstep, voffB); PG8_STAGE(PG8_SA(1, 0), a3, voffA);
            PG8_WAIT_V(8); PG8_WAIT_L(0); PG8_BAR; PG8_MMA(1, 0, At, B0); PG8_MMA(1, 1, At, B1); PG8_BAR; PG8_SCHED;
            } else {
            PG8_LDB(B0, 0, 0); PG8_SCHED; PG8_LDA(At, 0, 0); PG8_STAGE(PG8_SA(1, 1), a1 + hstep, voffA);
            PG8_WAIT_L(8); PG8_BAR; PG8_WAIT_L(0); PG8_MMA(0, 0, At, B0); PG8_BAR; PG8_SCHED;
            PG8_LDB(B1, 0, 1); PG8_STAGE(PG8_SB(0, 0), b2, voffB);
            PG8_BAR; PG8_WAIT_L(0); PG8_MMA(0, 1, At, B1); PG8_BAR;
            PG8_LDA(At, 0, 1); PG8_STAGE(PG8_SA(0, 0), a2, voffA);
            PG8_BAR; PG8_WAIT_L(0); PG8_MMA(1, 0, At, B0); PG8_BAR; PG8_SCHED;
            PG8_STAGE(PG8_SB(0, 1), b2 + hstep, voffB);
            PG8_WAIT_V(6); PG8_BAR; PG8_MMA(1, 1, At, B1); PG8_BAR;
            PG8_LDB(B0, 1, 0); PG8_SCHED; PG8_LDA(At, 1, 0); PG8_STAGE(PG8_SA(0, 1), a2 + hstep, voffA);
            PG8_WAIT_L(8); PG8_BAR; PG8_WAIT_L(0); PG8_MMA(0, 0, At, B0); PG8_BAR; PG8_SCHED;
            PG8_LDB(B1, 1, 1); PG8_STAGE(PG8_SB(1, 0), b3, voffB);
            PG8_BAR; PG8_WAIT_L(0); PG8_MMA(0, 1, At, B1); PG8_BAR;
            PG8_LDA(At, 1, 1); PG8_STAGE(PG8_SA(1, 0), a3, voffA);
            PG8_BAR; PG8_WAIT_L(0); PG8_MMA(1, 0, At, B0); PG8_BAR; PG8_SCHED;
            PG8_STAGE(PG8_SB(1, 1), b3 + hstep, voffB);
            PG8_WAIT_V(6); PG8_BAR; PG8_MMA(1, 1, At, B1); PG8_BAR;
            }
        }
        if constexpr (ALIGN_EPI) { if (wr == 0) PG8_BAR; }
        if constexpr (!Epi::AFTER_DRAIN) { E(acc, cur, wr, wc, fr, fq); S.done(cur); }
        if (!has_next) break;
#pragma unroll
        for (int a = 0; a < 2; ++a)
#pragma unroll
            for (int b = 0; b < 2; ++b)
#pragma unroll
                for (int m = 0; m < 4; ++m)
#pragma unroll
                    for (int n = 0; n < 2; ++n) acc[a][b][m][n] = (f32x4){0.f, 0.f, 0.f, 0.f};
        cur = nxt; cA = nA; cB = nB; ++ui;
        if constexpr (ALIGN_EPI) { if (wr == 1) PG8_BAR; }
    }
    PG8_WAIT_V(0);
    if constexpr (!ALIGN_EPI) { if (wr == 0) PG8_BAR; }
    PG8_BAR;
    if constexpr (Epi::AFTER_DRAIN) { E.fused(acc, cur, wr, wc, fr, fq, lds, wid, lane); S.done(cur); }
#undef PG8_SA
#undef PG8_SB
#undef PG8_STAGE
#undef PG8_LDA
#undef PG8_LDB
#undef PG8_MMA
#undef PG8_WAIT_V
#undef PG8_WAIT_L
#undef PG8_BAR
#undef PG8_SCHED
}
}

#define LAS __attribute__((address_space(3)))
typedef unsigned short bf16_t;
typedef short bf16x8 __attribute__((ext_vector_type(8)));
typedef short s16x4 __attribute__((ext_vector_type(4)));
typedef float f32x4 __attribute__((ext_vector_type(4)));
typedef float f32x16 __attribute__((ext_vector_type(16)));
typedef unsigned u32x4 __attribute__((ext_vector_type(4)));
typedef unsigned u32x2 __attribute__((ext_vector_type(2)));

constexpr int T = 16 * 2048;
constexpr int NMETA = 16;
constexpr int R = T + NMETA;
constexpr int DM = 1024, DFF = 4096;
constexpr float ALPHA = 1.4142135623730951f;
constexpr float QSCALE = 0.125f * 1.4426950408889634f;

constexpr size_t SZ_WAB = (size_t)2048 * 1024 * 2, SZ_WGLU = (size_t)512 * 512 * 2, SZ_W1M = (size_t)1024 * 1024 * 2, SZ_W4M = (size_t)4096 * 1024 * 2;
constexpr size_t OFF_WAB = 0, OFF_WGLU = OFF_WAB + SZ_WAB, OFF_WOAB = OFF_WGLU + SZ_WGLU, OFF_WC = OFF_WOAB + SZ_W1M, OFF_WOC = OFF_WC + SZ_W4M,
                 OFF_WUP0 = OFF_WOC + SZ_W1M, OFF_WUP1 = OFF_WUP0 + SZ_W4M, OFF_WDN0 = OFF_WUP1 + SZ_W4M, OFF_WDN1 = OFF_WDN0 + SZ_W4M,
                 OFF_HB = OFF_WDN1 + SZ_W4M, OFF_Z = OFF_HB + (size_t)R * 1024 * 2, OFF_BIG = OFF_Z + (size_t)R * 1024 * 4, WS_END = OFF_BIG + (size_t)R * 4096 * 2;
constexpr size_t OFF_ST = (WS_END + 255) & ~(size_t)255;
constexpr size_t SZ_ST = (size_t)4 * R * 2 * 4;
constexpr size_t OFF_SV = OFF_ST + SZ_ST, OFF_TV = OFF_SV + (size_t)3 * 4096 * 4, OFF_BAR = OFF_TV + (size_t)3 * 4096 * 4, ZERO_END = OFF_BAR + (size_t)XCD_BAR_WORDS * 4;
constexpr size_t BIG_PROJ = 0, BIG_APRE = (size_t)R * 2048 * 2, BIG_CAT = BIG_APRE + (size_t)R * 512 * 2;

struct Params { const float* in[26]; float* out; unsigned char* ws; };

__device__ __forceinline__ unsigned pk2(float lo, float hi) {
    typedef __bf16 bf2 __attribute__((ext_vector_type(2)));
    typedef float fl2 __attribute__((ext_vector_type(2)));
    fl2 v = {lo, hi}; bf2 r = __builtin_convertvector(v, bf2); return __builtin_bit_cast(unsigned, r);
}
__device__ __forceinline__ bf16_t f2bf(float x) { return (bf16_t)(pk2(x, 0.f) & 0xffffu); }
__device__ __forceinline__ float bf2f(bf16_t v) { return __uint_as_float((unsigned)v << 16); }
__device__ __forceinline__ float bflo(unsigned w) { return __uint_as_float(w << 16); }
__device__ __forceinline__ float bfhi(unsigned w) { return __uint_as_float(w & 0xffff0000u); }
__device__ __forceinline__ float sigmoidf_(float x) { return 1.0f / (1.0f + __expf(-x)); }
#define LDS_WAIT() asm volatile("s_waitcnt lgkmcnt(0)" ::: "memory")
#define MFMA16(a, b, c) __builtin_amdgcn_mfma_f32_16x16x32_bf16((a), (b), (c), 0, 0, 0)
#define MFMA32(a, b, c) __builtin_amdgcn_mfma_f32_32x32x16_bf16((a), (b), (c), 0, 0, 0)

struct RowCtx { float mu, rstd; };
__device__ __forceinline__ RowCtx ln_ctx(const float* st, int row) {
    const float sum = st[2 * (size_t)row], sq = st[2 * (size_t)row + 1];
    RowCtx rc; rc.mu = sum * (1.0f / 1024.0f); const float var = fmaxf(sq * (1.0f / 1024.0f) - rc.mu * rc.mu, 0.f); rc.rstd = 1.0f / sqrtf(var + 1e-5f); return rc;
}
struct NoCtx {};
struct EpInAB {
    static constexpr bool MAKES_STATS = false; static constexpr int BATCH = 8;
    typedef NoCtx ColCtx; typedef NoCtx Pre;
    bf16_t* O;
    __device__ __forceinline__ ColCtx col_ctx(int) const { return NoCtx{}; }
    __device__ __forceinline__ Pre pre(int, int) const { return NoCtx{}; }
    __device__ __forceinline__ RowCtx row_ctx(int) const { return RowCtx{0.f, 1.f}; }
    __device__ __forceinline__ float* st_ptr() const { return nullptr; }
    __device__ __forceinline__ void apply8(int row, int col, f32x4 a, f32x4 b, const RowCtx&, const ColCtx&, const Pre&, float&, float&) const {
        const float s = (col >= 512 && col < 1024) ? QSCALE : 1.0f;
        u32x4 w; w.x = pk2(a[0] * s, a[1] * s); w.y = pk2(a[2] * s, a[3] * s); w.z = pk2(b[0] * s, b[1] * s); w.w = pk2(b[2] * s, b[3] * s);
        *(u32x4*)(O + (size_t)row * 2048 + col) = w;
    }
};
struct EpGlu {
    static constexpr bool MAKES_STATS = false; static constexpr int BATCH = 4;
    struct ColCtx { f32x4 b0, b1; }; struct Pre { u32x4 ap; };
    const bf16_t* APRE; const float* bias; bf16_t* CAT;
    __device__ __forceinline__ ColCtx col_ctx(int col) const { return ColCtx{*(const f32x4*)(bias + col), *(const f32x4*)(bias + col + 4)}; }
    __device__ __forceinline__ Pre pre(int row, int col) const { return Pre{*(const u32x4*)(APRE + (size_t)row * 512 + col)}; }
    __device__ __forceinline__ RowCtx row_ctx(int) const { return RowCtx{0.f, 1.f}; }
    __device__ __forceinline__ float* st_ptr() const { return nullptr; }
    __device__ __forceinline__ void apply8(int row, int col, f32x4 a, f32x4 b, const RowCtx&, const ColCtx& cc, const Pre& pr, float&, float&) const {
        const u32x4 ap = pr.ap;
        float v[8] = {a[0] + cc.b0[0], a[1] + cc.b0[1], a[2] + cc.b0[2], a[3] + cc.b0[3], b[0] + cc.b1[0], b[1] + cc.b1[1], b[2] + cc.b1[2], b[3] + cc.b1[3]};
        float y[8] = {bflo(ap.x), bfhi(ap.x), bflo(ap.y), bfhi(ap.y), bflo(ap.z), bfhi(ap.z), bflo(ap.w), bfhi(ap.w)};
#pragma unroll
        for (int i = 0; i < 8; ++i) y[i] = y[i] * sigmoidf_(v[i]);
        u32x4 w; w.x = pk2(y[0], y[1]); w.y = pk2(y[2], y[3]); w.z = pk2(y[4], y[5]); w.w = pk2(y[6], y[7]);
        *(u32x4*)(CAT + (size_t)row * 1024 + col) = w;
    }
};
struct EpRes {
    static constexpr bool MAKES_STATS = true; static constexpr int BATCH = 1;
    struct ColCtx { f32x4 ag0, ag1, ab0, ab1; }; struct Pre { f32x4 h0, h1; };
    const float* base; const float* base_meta; float* Z; const float* bias;
    const float* st_prev; const float* g; const float* bta; float* st_out; bf16_t* ZB;
    __device__ __forceinline__ ColCtx col_ctx(int col) const {
        ColCtx c; const f32x4 one = {1.f, 1.f, 1.f, 1.f}, zero = {0.f, 0.f, 0.f, 0.f};
        const f32x4 g0 = st_prev ? *(const f32x4*)(g + col) : one, g1 = st_prev ? *(const f32x4*)(g + col + 4) : one;
        const f32x4 t0 = st_prev ? *(const f32x4*)(bta + col) : zero, t1 = st_prev ? *(const f32x4*)(bta + col + 4) : zero;
        const f32x4 b0 = bias ? *(const f32x4*)(bias + col) : zero, b1 = bias ? *(const f32x4*)(bias + col + 4) : zero;
        c.ag0 = g0 * ALPHA; c.ag1 = g1 * ALPHA; c.ab0 = t0 * ALPHA + b0; c.ab1 = t1 * ALPHA + b1; return c;
    }
    __device__ __forceinline__ Pre pre(int row, int col) const {
        const float* bp = (base_meta && row >= T) ? base_meta + (size_t)(row - T) * 1024 + col : base + (size_t)row * 1024 + col;
        return Pre{*(const f32x4*)bp, *(const f32x4*)(bp + 4)};
    }
    __device__ __forceinline__ RowCtx row_ctx(int row) const { return st_prev ? ln_ctx(st_prev, row) : RowCtx{0.f, 1.f}; }
    __device__ __forceinline__ float* st_ptr() const { return st_out; }
    __device__ __forceinline__ void apply8(int row, int col, f32x4 a, f32x4 b, const RowCtx& rc, const ColCtx& cc, const Pre& pr, float& s, float& q) const {
        const f32x4 o0 = (pr.h0 - rc.mu) * rc.rstd * cc.ag0 + cc.ab0 + a, o1 = (pr.h1 - rc.mu) * rc.rstd * cc.ag1 + cc.ab1 + b;
        float* zp = Z + (size_t)row * 1024 + col;
        *(f32x4*)zp = o0; *(f32x4*)(zp + 4) = o1;
        if (ZB) { u32x4 w; w.x = pk2(o0[0], o0[1]); w.y = pk2(o0[2], o0[3]); w.z = pk2(o1[0], o1[1]); w.w = pk2(o1[2], o1[3]); *(u32x4*)(ZB + (size_t)row * 1024 + col) = w; }
        s += ((o0[0] + o0[1]) + (o0[2] + o0[3])) + ((o1[0] + o1[1]) + (o1[2] + o1[3]));
        q += ((o0[0] * o0[0] + o0[1] * o0[1]) + (o0[2] * o0[2] + o0[3] * o0[3])) + ((o1[0] * o1[0] + o1[1] * o1[1]) + (o1[2] * o1[2] + o1[3] * o1[3]));
    }
};
struct EpUp {
    static constexpr bool MAKES_STATS = false; static constexpr int BATCH = 8;
    struct ColCtx { f32x4 s0, s1, t0, t1; }; typedef NoCtx Pre;
    bf16_t* H; const float* bias; const float* st_prev; const float* sv; const float* tv;
    __device__ __forceinline__ ColCtx col_ctx(int col) const {
        return ColCtx{*(const f32x4*)(sv + col), *(const f32x4*)(sv + col + 4), *(const f32x4*)(tv + col) + *(const f32x4*)(bias + col), *(const f32x4*)(tv + col + 4) + *(const f32x4*)(bias + col + 4)};
    }
    __device__ __forceinline__ Pre pre(int, int) const { return NoCtx{}; }
    __device__ __forceinline__ RowCtx row_ctx(int row) const { return ln_ctx(st_prev, row); }
    __device__ __forceinline__ float* st_ptr() const { return nullptr; }
    __device__ __forceinline__ void apply8(int row, int col, f32x4 a, f32x4 b, const RowCtx& rc, const ColCtx& cc, const Pre&, float&, float&) const {
        f32x4 v0 = (a - rc.mu * cc.s0) * rc.rstd + cc.t0, v1 = (b - rc.mu * cc.s1) * rc.rstd + cc.t1;
#pragma unroll
        for (int i = 0; i < 4; ++i) { v0[i] = fmaxf(v0[i], 0.f); v0[i] *= v0[i]; v1[i] = fmaxf(v1[i], 0.f); v1[i] *= v1[i]; }
        u32x4 w; w.x = pk2(v0[0], v0[1]); w.y = pk2(v0[2], v0[3]); w.z = pk2(v1[0], v1[1]); w.w = pk2(v1[2], v1[3]);
        *(u32x4*)(H + (size_t)row * 4096 + col) = w;
    }
};
struct EpInC {
    static constexpr bool MAKES_STATS = false; static constexpr int BATCH = 8;
    struct ColCtx { f32x4 s0, s1, t0, t1, lb0, lb1; }; typedef NoCtx Pre;
    unsigned short* PC; const float* gamma; const float* st_prev; const float* sv; const float* tv;
    __device__ __forceinline__ ColCtx col_ctx(int col) const {
        ColCtx c{*(const f32x4*)(sv + col), *(const f32x4*)(sv + col + 4), *(const f32x4*)(tv + col), *(const f32x4*)(tv + col + 4), {0.f, 0.f, 0.f, 0.f}, {0.f, 0.f, 0.f, 0.f}};
        if (col >= 1024 && col < 2048) {
            const f32x4 ga = *(const f32x4*)(gamma + col - 1024), gb = *(const f32x4*)(gamma + col - 1020), gc = *(const f32x4*)(gamma + col), gd = *(const f32x4*)(gamma + col + 4);
#pragma unroll
            for (int i = 0; i < 4; ++i) { c.lb0[i] = 1.0f / (1.0f + __expf(ga[i] - gc[i])); c.lb1[i] = 1.0f / (1.0f + __expf(gb[i] - gd[i])); }
        }
        return c;
    }
    __device__ __forceinline__ Pre pre(int, int) const { return NoCtx{}; }
    __device__ __forceinline__ RowCtx row_ctx(int row) const { return ln_ctx(st_prev, row); }
    __device__ __forceinline__ float* st_ptr() const { return nullptr; }
    __device__ __forceinline__ void apply8(int row, int col, f32x4 a, f32x4 b, const RowCtx& rc, const ColCtx& cc, const Pre&, float&, float&) const {
        a = (a - rc.mu * cc.s0) * rc.rstd + cc.t0;
        b = (b - rc.mu * cc.s1) * rc.rstd + cc.t1;
        u32x4 w;
        if (col >= 1024 && col < 2048) {
            float v[8] = {a[0], a[1], a[2], a[3], b[0], b[1], b[2], b[3]};
            float lb[8] = {cc.lb0[0], cc.lb0[1], cc.lb0[2], cc.lb0[3], cc.lb1[0], cc.lb1[1], cc.lb1[2], cc.lb1[3]};
            unsigned short h[8];
#pragma unroll
            for (int i = 0; i < 8; ++i) {
                const float f = lb[i] + (1.0f - lb[i]) * sigmoidf_(v[i]);
                const _Float16 hf = (_Float16)__logf(f);
                h[i] = __builtin_bit_cast(unsigned short, hf);
            }
            w.x = h[0] | ((unsigned)h[1] << 16); w.y = h[2] | ((unsigned)h[3] << 16); w.z = h[4] | ((unsigned)h[5] << 16); w.w = h[6] | ((unsigned)h[7] << 16);
        } else { w.x = pk2(a[0], a[1]); w.y = pk2(a[2], a[3]); w.z = pk2(b[0], b[1]); w.w = pk2(b[2], b[3]); }
        *(u32x4*)(PC + (size_t)row * 4096 + col) = w;
    }
};
template <class F> struct EpiAdapt {
    static constexpr bool PERM = true, AFTER_DRAIN = false; F f;
    __device__ __forceinline__ void operator()(const f32x4 (&acc)[2][2][4][2], const pg8::Unit& u, int wr, int wc, int fr, int fq) const {
        const int col0 = u.pn * 256 + wc * 32 + 8 * fq, row0 = u.pm * 256 + wr * 64 + fr;
        const typename F::ColCtx cc[2] = {f.col_ctx(col0), f.col_ctx(col0 + 128)};
        RowCtx rc[8];
#pragma unroll
        for (int r8 = 0; r8 < 8; ++r8) rc[r8] = f.row_ctx(row0 + (r8 >> 2) * 128 + (r8 & 3) * 16);
        constexpr int NB = F::BATCH;
#pragma unroll
        for (int bt = 0; bt < 8 / NB; ++bt) {
            typename F::Pre pr[NB][2];
#pragma unroll
            for (int i = 0; i < NB; ++i) { const int r8 = bt * NB + i, row = row0 + (r8 >> 2) * 128 + (r8 & 3) * 16;
                pr[i][0] = f.pre(row, col0); pr[i][1] = f.pre(row, col0 + 128); }
#pragma unroll
            for (int i = 0; i < NB; ++i) { const int r8 = bt * NB + i, ai = r8 >> 2, m = r8 & 3, row = row0 + ai * 128 + m * 16;
                float s = 0.f, q = 0.f;
                f.apply8(row, col0, acc[ai][0][m][0], acc[ai][0][m][1], rc[r8], cc[0], pr[i][0], s, q);
                f.apply8(row, col0 + 128, acc[ai][1][m][0], acc[ai][1][m][1], rc[r8], cc[1], pr[i][1], s, q);
                if (F::MAKES_STATS) {
                    s += __shfl_xor(s, 16); s += __shfl_xor(s, 32); q += __shfl_xor(q, 16); q += __shfl_xor(q, 32);
                    if (fq == 0) { float* st = f.st_ptr() + 2 * (size_t)row; unsafeAtomicAdd(st, s); unsafeAtomicAdd(st + 1, q); }
                }
            }
            asm volatile("" ::: "memory");
        }
    }
};
template <class F> __device__ __forceinline__ void meta_gemm(const bf16_t* A16  , const bf16_t* Bt, int N, int K, const F& f, int blk, int G, int wave, int lane) {
    const int l15 = lane & 15, quad = lane >> 4;
    for (int item = blk + G * wave; item < N / 32; item += G * 8) {
        const int c0 = item * 32;
        const bf16_t* ap = A16 + (size_t)l15 * K + 8 * quad;
        const bf16_t* w0 = Bt + (size_t)(c0 + 8 * (l15 >> 2) + (l15 & 3)) * K + 8 * quad;
        const bf16_t* w1 = w0 + (size_t)4 * K;
        f32x4 acc0 = {0.f, 0.f, 0.f, 0.f}, acc1 = {0.f, 0.f, 0.f, 0.f};
#pragma unroll 8
        for (int k = 0; k < K; k += 32) {
            const bf16x8 xa = *(const bf16x8*)(ap + k), b0 = *(const bf16x8*)(w0 + k), b1 = *(const bf16x8*)(w1 + k);
            acc0 = MFMA16(b0, xa, acc0); acc1 = MFMA16(b1, xa, acc1);
        }
        const RowCtx rc = f.row_ctx(T + l15);
        const typename F::ColCtx cc = f.col_ctx(c0 + 8 * quad);
        const typename F::Pre pr = f.pre(T + l15, c0 + 8 * quad);
        float s = 0.f, q = 0.f;
        f.apply8(T + l15, c0 + 8 * quad, acc0, acc1, rc, cc, pr, s, q);
        if (F::MAKES_STATS) {
            s += __shfl_xor(s, 16); s += __shfl_xor(s, 32); q += __shfl_xor(q, 16); q += __shfl_xor(q, 32);
            if (quad == 0) { float* st = f.st_ptr() + 2 * (size_t)(T + l15); unsafeAtomicAdd(st, s); unsafeAtomicAdd(st + 1, q); }
        }
    }
}
template <class F> __device__ __forceinline__ void run_gemm(LAS unsigned char* lds, const bf16_t* A, const bf16_t* Bt, int N, int K, const F& f, bool with_meta, int blk, int G, int wave) {
    pg8::Gemm g{A, Bt, T, N, K}; pg8::StaticOrder S; S.init(T, N, G, blk);
    EpiAdapt<F> E{f};
    pg8::gemm_phase<EpiAdapt<F>, pg8::StaticOrder, true, true>((PG8_LAS unsigned char*)lds, g, S, E, wave);
    if (with_meta) meta_gemm<F>(A + (size_t)T * K, Bt, N, K, f, blk, G, wave, lane_id_v());
}

__device__ __forceinline__ void transpose_item(const float* W, int K, int N, bf16_t* WT, LAS float* scr, int item, int lane) {
    const int nblk = N / 32, kb = item / nblk, nb = item % nblk, k0 = 64 * kb, n0 = 32 * nb;
#pragma unroll 8
    for (int i = 0; i < 32; ++i) { const int kk = 2 * i + (lane >> 5); scr[kk * 33 + (lane & 31)] = W[(size_t)(k0 + kk) * N + n0 + (lane & 31)]; }
    LDS_WAIT();
    const int c = lane & 7;
#pragma unroll
    for (int j = 0; j < 4; ++j) { const int n = (lane >> 3) + 8 * j; const LAS float* s = scr + (8 * c) * 33 + n;
        u32x4 o; o.x = pk2(s[0 * 33], s[1 * 33]); o.y = pk2(s[2 * 33], s[3 * 33]); o.z = pk2(s[4 * 33], s[5 * 33]); o.w = pk2(s[6 * 33], s[7 * 33]);
        *(u32x4*)(WT + (size_t)(n0 + n) * K + k0 + 8 * c) = o; }
    LDS_WAIT();
}
__device__ __forceinline__ void transpose_item_fold(const float* W, int K, int N, bf16_t* WT, LAS float* scr, int item, int lane, const float* g, const float* bta, float* sv, float* tv) {
    const int nblk = N / 32, kb = item / nblk, nb = item % nblk, k0 = 64 * kb, n0 = 32 * nb;
#pragma unroll 8
    for (int i = 0; i < 32; ++i) { const int kk = 2 * i + (lane >> 5); scr[kk * 33 + (lane & 31)] = W[(size_t)(k0 + kk) * N + n0 + (lane & 31)]; }
    LDS_WAIT();
    const int c = lane & 7;
    const f32x4 g0 = *(const f32x4*)(g + k0 + 8 * c), g1 = *(const f32x4*)(g + k0 + 8 * c + 4), b0 = *(const f32x4*)(bta + k0 + 8 * c), b1 = *(const f32x4*)(bta + k0 + 8 * c + 4);
#pragma unroll
    for (int j = 0; j < 4; ++j) { const int n = (lane >> 3) + 8 * j; const LAS float* s = scr + (8 * c) * 33 + n;
        const float w0 = s[0 * 33], w1 = s[1 * 33], w2 = s[2 * 33], w3 = s[3 * 33], w4 = s[4 * 33], w5 = s[5 * 33], w6 = s[6 * 33], w7 = s[7 * 33];
        u32x4 o; o.x = pk2(g0[0] * w0, g0[1] * w1); o.y = pk2(g0[2] * w2, g0[3] * w3); o.z = pk2(g1[0] * w4, g1[1] * w5); o.w = pk2(g1[2] * w6, g1[3] * w7);
        *(u32x4*)(WT + (size_t)(n0 + n) * K + k0 + 8 * c) = o;
        float ss = ((bflo(o.x) + bfhi(o.x)) + (bflo(o.y) + bfhi(o.y))) + ((bflo(o.z) + bfhi(o.z)) + (bflo(o.w) + bfhi(o.w)));
        float tt = ((b0[0] * w0 + b0[1] * w1) + (b0[2] * w2 + b0[3] * w3)) + ((b1[0] * w4 + b1[1] * w5) + (b1[2] * w6 + b1[3] * w7));
        ss += __shfl_xor(ss, 1); ss += __shfl_xor(ss, 2); ss += __shfl_xor(ss, 4);
        tt += __shfl_xor(tt, 1); tt += __shfl_xor(tt, 2); tt += __shfl_xor(tt, 4);
        if (c == 0) { unsafeAtomicAdd(sv + n0 + n, ss); unsafeAtomicAdd(tv + n0 + n, tt); } }
    LDS_WAIT();
}
__device__ __forceinline__ void prologue_phase(const Params& P, LAS unsigned char* lds, int blk, int G, int wave) {
    const int lane = lane_id_v(), tid = wave * 64 + lane;
    LAS float* scr = (LAS float*)(lds + wave * 8448);
    const int gw = blk * 8 + wave, NGW = G * 8;
    unsigned char* ws = P.ws;
    constexpr int I_AB = 16 * 64, I_GLU = 8 * 16, I_1M = 16 * 32, I_C = 16 * 128, I_UP = 16 * 128, I_DN = 64 * 32;
    constexpr int NITEMS = I_AB + I_GLU + I_1M + I_C + I_1M + 2 * I_UP + 2 * I_DN;
    for (int it = gw; it < NITEMS; it += NGW) {
        int r = it;
        if (r < I_AB) { transpose_item(P.in[2], 1024, 2048, (bf16_t*)(ws + OFF_WAB), scr, r, lane); continue; } r -= I_AB;
        if (r < I_GLU) { transpose_item(P.in[11], 512, 512, (bf16_t*)(ws + OFF_WGLU), scr, r, lane); continue; } r -= I_GLU;
        if (r < I_1M) { transpose_item(P.in[13], 1024, 1024, (bf16_t*)(ws + OFF_WOAB), scr, r, lane); continue; } r -= I_1M;
        if (r < I_C) { transpose_item_fold(P.in[14], 1024, 4096, (bf16_t*)(ws + OFF_WC), scr, r, lane, P.in[24], P.in[25], (float*)(ws + OFF_SV) + 4096, (float*)(ws + OFF_TV) + 4096); continue; } r -= I_C;
        if (r < I_1M) { transpose_item(P.in[17], 1024, 1024, (bf16_t*)(ws + OFF_WOC), scr, r, lane); continue; } r -= I_1M;
        if (r < I_UP) { transpose_item_fold(P.in[20], 1024, 4096, (bf16_t*)(ws + OFF_WUP0), scr, r, lane, P.in[18], P.in[19], (float*)(ws + OFF_SV), (float*)(ws + OFF_TV)); continue; } r -= I_UP;
        if (r < I_UP) { transpose_item_fold(P.in[20] + (size_t)1024 * 4096, 1024, 4096, (bf16_t*)(ws + OFF_WUP1), scr, r, lane, P.in[18] + 1024, P.in[19] + 1024, (float*)(ws + OFF_SV) + 8192, (float*)(ws + OFF_TV) + 8192); continue; } r -= I_UP;
        if (r < I_DN) { transpose_item(P.in[22], 4096, 1024, (bf16_t*)(ws + OFF_WDN0), scr, r, lane); continue; } r -= I_DN;
        transpose_item(P.in[22] + (size_t)4096 * 1024, 4096, 1024, (bf16_t*)(ws + OFF_WDN1), scr, r, lane);
    }
    bf16_t* HB = (bf16_t*)(ws + OFF_HB);
    const size_t n8 = (size_t)R * 1024 / 8;
#pragma unroll 4
    for (size_t i = (size_t)blk * 512 + tid; i < n8; i += (size_t)G * 512) {
        const size_t e = i * 8;
        const float* src = e < (size_t)T * 1024 ? P.in[0] + e : P.in[1] + (e - (size_t)T * 1024);
        const f32x4 a = *(const f32x4*)src, b = *(const f32x4*)(src + 4);
        u32x4 w; w.x = pk2(a[0], a[1]); w.y = pk2(a[2], a[3]); w.z = pk2(b[0], b[1]); w.w = pk2(b[2], b[3]);
        *(u32x4*)(HB + e) = w;
    }
}

__device__ __forceinline__ void ln_phase(const float* Zin, float* Fout, bf16_t* Bout, const float* g, const float* bta, int nrows, int blk, int G, int wave) {
    const int lane = lane_id_v();
    for (int row = blk * 8 + wave; row < nrows; row += G * 8) {
        const f32x4* xr = (const f32x4*)(Zin + (size_t)row * 1024) + lane;
        f32x4 v[4]; float s = 0.f;
#pragma unroll
        for (int j = 0; j < 4; ++j) { v[j] = xr[64 * j]; s += (v[j][0] + v[j][1]) + (v[j][2] + v[j][3]); }
#pragma unroll
        for (int o = 1; o < 64; o <<= 1) s += __shfl_xor(s, o);
        const float mean = s * (1.f / 1024.f); float s2 = 0.f;
#pragma unroll
        for (int j = 0; j < 4; ++j) { v[j] = v[j] - mean; s2 += (v[j][0] * v[j][0] + v[j][1] * v[j][1]) + (v[j][2] * v[j][2] + v[j][3] * v[j][3]); }
#pragma unroll
        for (int o = 1; o < 64; o <<= 1) s2 += __shfl_xor(s2, o);
        const float rstd = 1.0f / sqrtf(s2 * (1.f / 1024.f) + 1e-5f);
#pragma unroll
        for (int j = 0; j < 4; ++j) {
            const int col = 4 * (lane + 64 * j);
            const f32x4 gg = *(const f32x4*)(g + col), bb = *(const f32x4*)(bta + col);
            const f32x4 o = v[j] * rstd * gg + bb;
            *(f32x4*)(Fout + (size_t)row * 1024 + col) = o;
            if (Bout) { u32x2 w; w.x = pk2(o[0], o[1]); w.y = pk2(o[2], o[3]); *(u32x2*)(Bout + (size_t)row * 1024 + col) = w; }
        }
    }
}

__device__ __forceinline__ void final_ln_phase(const float* Zin, const float* st, float* out, const float* g, const float* bta, int blk, int G, int wave) {
    const int lane = lane_id_v();
    for (int row0 = (blk * 8 + wave) * 4; row0 < T; row0 += G * 8 * 4) {
#pragma unroll
        for (int rr = 0; rr < 4; ++rr) {
            const int row = row0 + rr;
            const RowCtx rc = ln_ctx(st, row);
#pragma unroll
            for (int j = 0; j < 4; ++j) {
                const int col = 4 * (lane + 64 * j);
                const f32x4 v = *(const f32x4*)(Zin + (size_t)row * 1024 + col);
                *(f32x4*)(out + (size_t)row * 1024 + col) = (v - rc.mu) * rc.rstd * *(const f32x4*)(g + col) + *(const f32x4*)(bta + col);
            }
        }
    }
}

__device__ __forceinline__ void lam_coef(const float* lam_re, const float* lam_im, float dt, int idx, float& lbr, float& lbi, float& cr, float& ci) {
    const float lr = lam_re[idx], li = lam_im[idx];
    const float er = __expf(lr * dt);
    float ang = li * dt;
    const float kk = rintf(ang * 0.15915494309189535f);
    ang = fmaf(-kk, 6.2831854820251465f, ang); ang = fmaf(-kk, -1.7484555e-7f, ang);
    lbr = er * __cosf(ang); lbi = er * __sinf(ang);
    const float nr = lbr - 1.0f, ni = lbi, den = 1.0f / (lr * lr + li * li);
    cr = (nr * lr + ni * li) * den; ci = (ni * lr - nr * li) * den;
}
__device__ __forceinline__ void s5_phase(const Params& P, LAS unsigned char* lds, int blk, int G, int wave) {
    const int lane = lane_id_v(), l15 = lane & 15, quad = lane >> 4;
    LAS float* bu = (LAS float*)(lds + wave * 12800);
    LAS unsigned* sl = (LAS unsigned*)(lds + wave * 12800 + 8448);
    const bf16_t* PROJ = (const bf16_t*)(P.ws + OFF_BIG + BIG_PROJ);
    bf16_t* APRE = (bf16_t*)(P.ws + OFF_BIG + BIG_APRE);
    for (int item = blk + G * wave; item < 512; item += G * 8) {
        const int b = item >> 5, g = item & 31;
        const float dt = __expf(P.in[5][g]);
        float lbr, lbi, cr_, ci_;
        lam_coef(P.in[3], P.in[4], dt, g * 64 + lane, lbr, lbi, cr_, ci_);
        bf16x8 bfrag[8];
#pragma unroll
        for (int tile = 0; tile < 8; ++tile) {
            const int comp = 16 * tile + l15, st = comp & 63, isim = comp >> 6;
            float a0, a1, cr, ci; lam_coef(P.in[3], P.in[4], dt, g * 64 + st, a0, a1, cr, ci);
            bf16x8 fr = {0, 0, 0, 0, 0, 0, 0, 0};
            if (quad < 2) {
                const float* bre = P.in[6] + (size_t)(g * 64 + st) * 16 + 8 * quad;
                const float* bim = P.in[7] + (size_t)(g * 64 + st) * 16 + 8 * quad;
#pragma unroll
                for (int j = 0; j < 8; ++j) { const float v = isim ? (cr * bim[j] + ci * bre[j]) : (cr * bre[j] - ci * bim[j]); fr[j] = (short)f2bf(v); }
            }
            bfrag[tile] = fr;
        }
        bf16x8 cfrag[4];
#pragma unroll
        for (int ks = 0; ks < 4; ++ks) {
#pragma unroll
            for (int j = 0; j < 8; ++j) {
                const int k = 32 * ks + 8 * quad + j, p = k >> 1;
                const float v = (k & 1) ? -P.in[9][(size_t)(g * 16 + l15) * 64 + p] : P.in[8][(size_t)(g * 16 + l15) * 64 + p];
                cfrag[ks][j] = (short)f2bf(v);
            }
        }
        const float dh = P.in[10][g * 16 + l15];
        float sr = 0.f, si = 0.f;
        const bf16x8 zero8 = {0, 0, 0, 0, 0, 0, 0, 0};
        bf16x8 ua_n = *(const bf16x8*)(PROJ + (size_t)(T + l15) * 2048 + g * 16 + 8 * (quad & 1));
        unsigned short ue_n[4];
#pragma unroll
        for (int r = 0; r < 4; ++r) ue_n[r] = PROJ[(size_t)(T + 4 * quad + r) * 2048 + g * 16 + l15];
        for (int chunk = 0; chunk < 129; ++chunk) {
            const int rowbase = chunk == 0 ? T : b * 2048 + (chunk - 1) * 16;
            const bf16x8 ua = quad < 2 ? ua_n : zero8;
            unsigned short ue[4];
#pragma unroll
            for (int r = 0; r < 4; ++r) ue[r] = ue_n[r];
            {
                const int cn = chunk + 1 < 129 ? chunk + 1 : 128;
                const int rbn = b * 2048 + (cn - 1) * 16;
                ua_n = *(const bf16x8*)(PROJ + (size_t)(rbn + l15) * 2048 + g * 16 + 8 * (quad & 1));
#pragma unroll
                for (int r = 0; r < 4; ++r) ue_n[r] = PROJ[(size_t)(rbn + 4 * quad + r) * 2048 + g * 16 + l15];
            }
#pragma unroll
            for (int tile = 0; tile < 8; ++tile) {
                f32x4 acc = {0.f, 0.f, 0.f, 0.f};
                acc = MFMA16(ua, bfrag[tile], acc);
#pragma unroll
                for (int r = 0; r < 4; ++r) bu[(4 * quad + r) * 132 + 16 * tile + l15] = acc[r];
            }
            LDS_WAIT();
#pragma unroll
            for (int t = 0; t < 16; ++t) {
                const float br = bu[t * 132 + lane], bi = bu[t * 132 + 64 + lane];
                const float nsr = fmaf(lbr, sr, fmaf(-lbi, si, br)), nsi = fmaf(lbr, si, fmaf(lbi, sr, bi));
                sr = nsr; si = nsi;
                sl[t * 68 + lane] = pk2(sr, si);
            }
            LDS_WAIT();
            f32x4 y = {0.f, 0.f, 0.f, 0.f};
#pragma unroll
            for (int ks = 0; ks < 4; ++ks) {
                const bf16x8 sa = *(const LAS bf16x8*)((const LAS bf16_t*)sl + l15 * 136 + 32 * ks + 8 * quad);
                y = MFMA16(sa, cfrag[ks], y);
            }
            if (chunk > 0 || b == 0) {
#pragma unroll
                for (int r = 0; r < 4; ++r) {
                    const size_t row = (size_t)(rowbase + 4 * quad + r);
                    const float u = bf2f(ue[r]);
                    const float v = y[r] + dh * u;
                    const float a2 = 1.5957691216057308f * (v + 0.044715f * v * v * v);
                    APRE[row * 512 + g * 16 + l15] = f2bf(v * sigmoidf_(a2));
                }
            }
            LDS_WAIT();
        }
    }
}

template <bool MASKED>
__device__ __forceinline__ void attn_tile_sub(const LAS bf16_t* Kl, const LAS bf16_t* Vl, const bf16x8 (&qf)[4], int sub, int keybase  ,
                                              int iq, int l31, int h, bool pick0, f32x16& o0, f32x16& o1, float& Rrun) {
    bf16x8 ka[4];
#pragma unroll
    for (int s = 0; s < 4; ++s) ka[s] = *(const LAS bf16x8*)(Kl + (32 * sub + l31) * 72 + 16 * s + 8 * h);
    bf16x8 va[2][2];
#pragma unroll
    for (int s2 = 0; s2 < 2; ++s2)
#pragma unroll
        for (int mt = 0; mt < 2; ++mt) {
            const LAS bf16_t* vp = Vl + (32 * mt + l31) * 68 + 32 * sub + 16 * s2 + 4 * h;
            const s16x4 lo = *(const LAS s16x4*)vp, hi = *(const LAS s16x4*)(vp + 8);
            va[s2][mt] = __builtin_shufflevector(lo, hi, 0, 1, 2, 3, 4, 5, 6, 7);
        }
    __builtin_amdgcn_sched_barrier(0);
    f32x16 st;
#pragma unroll
    for (int i = 0; i < 16; ++i) st[i] = 0.f;
#pragma unroll
    for (int s = 0; s < 4; ++s) st = MFMA32(ka[s], qf[s], st);
    float kp[16], be[16];
#pragma unroll
    for (int i = 0; i < 16; ++i) {
        const float e = __builtin_amdgcn_exp2f(st[i]);
        float r = __builtin_amdgcn_rcpf(1.0f + e);
        if (MASKED) {
            const int kl = 32 * sub + (i & 3) + 8 * (i >> 2) + 4 * h;
            const bool vis = keybase >= 0 ? (keybase + kl < iq) : (kl < 16);
            r = vis ? r : 1.0f;
        }
        kp[i] = r; be[i] = 1.0f - r;
    }
    float ga[4], pa[4];
#pragma unroll
    for (int a = 0; a < 4; ++a) {
        ga[a] = (kp[4 * a] * kp[4 * a + 1]) * (kp[4 * a + 2] * kp[4 * a + 3]);
        const auto sw = __builtin_amdgcn_permlane32_swap(__float_as_uint(ga[a]), __float_as_uint(ga[a]), false, false);
        pa[a] = __uint_as_float(pick0 ? sw[0] : sw[1]);
    }
    float run = Rrun; float w[16];
#pragma unroll
    for (int a = 3; a >= 0; --a) {
        const float P3 = h ? run : run * pa[a];
        const float P2 = P3 * kp[4 * a + 3], P1 = P2 * kp[4 * a + 2], P0 = P1 * kp[4 * a + 1];
        w[4 * a + 3] = be[4 * a + 3] * P3; w[4 * a + 2] = be[4 * a + 2] * P2; w[4 * a + 1] = be[4 * a + 1] * P1; w[4 * a + 0] = be[4 * a + 0] * P0;
        run *= ga[a] * pa[a];
    }
    Rrun = run;
#pragma unroll
    for (int s2 = 0; s2 < 2; ++s2) {
        u32x4 pw; pw.x = pk2(w[8 * s2], w[8 * s2 + 1]); pw.y = pk2(w[8 * s2 + 2], w[8 * s2 + 3]); pw.z = pk2(w[8 * s2 + 4], w[8 * s2 + 5]); pw.w = pk2(w[8 * s2 + 6], w[8 * s2 + 7]);
        const bf16x8 pb = __builtin_bit_cast(bf16x8, pw);
        o0 = MFMA32(va[s2][0], pb, o0); o1 = MFMA32(va[s2][1], pb, o1);
    }
}
__device__ __forceinline__ void attn_phase(const Params& P, LAS unsigned char* lds, int blk, int G, int wave) {
    const int lane = lane_id_v(), tid = wave * 64 + lane, l31 = lane & 31, h = lane >> 5;
    const bf16_t* PROJ = (const bf16_t*)(P.ws + OFF_BIG + BIG_PROJ);
    bf16_t* CAT = (bf16_t*)(P.ws + OFF_BIG + BIG_CAT);
    if (blk == G - 1) {
        LAS float* wm = (LAS float*)(lds + 40960);
        if (tid < 128) {
            const int t = tid & 15, hd = tid >> 4;
            const bf16_t* qp = PROJ + (size_t)(T + t) * 2048 + 512 + hd * 64;
            float run = 1.f;
            for (int j = 15; j >= 0; --j) {
                float wv = 0.f;
                if (j < t) {
                    const bf16_t* kp = PROJ + (size_t)(T + j) * 2048 + 1024 + hd * 64;
                    float z = 0.f;
                    for (int d = 0; d < 64; ++d) z = fmaf(bf2f(qp[d]), bf2f(kp[d]), z);
                    const float r = __builtin_amdgcn_rcpf(1.0f + __builtin_amdgcn_exp2f(z));
                    wv = (1.0f - r) * run; run *= r;
                }
                wm[tid * 16 + j] = wv;
            }
        }
        __syncthreads();
        for (int idx = tid; idx < 16 * 512; idx += 512) {
            const int t = idx >> 9, c = idx & 511, hd = c >> 6;
            float o = 0.f;
            for (int j = 0; j < 16; ++j) o = fmaf(wm[(hd * 16 + t) * 16 + j], bf2f(PROJ[(size_t)(T + j) * 2048 + 1536 + c]), o);
            CAT[(size_t)(T + t) * 1024 + 512 + c] = f2bf(o);
        }
        __syncthreads();
    }
    bool pick0;
    { const auto hs = __builtin_amdgcn_permlane32_swap((unsigned)h, (unsigned)h, false, false); pick0 = hs[0] != (unsigned)h; }
    LAS bf16_t* Kl0 = (LAS bf16_t*)lds;
    LAS bf16_t* Vl0 = (LAS bf16_t*)(lds + 2 * 9216);
    const int lkey = tid >> 3, lpart = tid & 7;
    for (int j4 = 0; j4 < 4; ++j4) {
        const int item = blk + G * j4;
        if (item >= 1024) break;
        const int c = item % 256, jj = item / 256, bh = c >> 1, par = c & 1;
        const int qb = par == 0 ? (jj == 0 ? 7 : jj == 1 ? 0 : jj == 2 ? 4 : 3) : (jj == 0 ? 6 : jj == 1 ? 1 : jj == 2 ? 5 : 2);
        const int b = bh >> 3, hd = bh & 7;
        const int iq = 256 * qb + 32 * wave + l31;
        const size_t qrow = (size_t)b * 2048 + iq;
        bf16x8 qf[4];
#pragma unroll
        for (int s = 0; s < 4; ++s) qf[s] = *(const bf16x8*)(PROJ + qrow * 2048 + 512 + hd * 64 + 16 * s + 8 * h);
        f32x16 o0, o1;
#pragma unroll
        for (int i = 0; i < 16; ++i) { o0[i] = 0.f; o1[i] = 0.f; }
        float Rrun = 1.0f;
        const int nt = 4 * qb + 5;
        u32x4 kreg, vreg;
#define ATT_LOAD(it_) do { const int kt_ = 4 * qb + 3 - (it_); size_t row_; bool ok_ = true; \
            if (kt_ >= 0) row_ = (size_t)b * 2048 + 64 * kt_ + lkey; else { row_ = (size_t)T + lkey; ok_ = lkey < 16; } \
            if (ok_) { const bf16_t* p_ = PROJ + row_ * 2048 + 1024 + hd * 64 + lpart * 8; kreg = *(const u32x4*)p_; vreg = *(const u32x4*)(p_ + 512); } \
            else { kreg = (u32x4){0u, 0u, 0u, 0u}; vreg = kreg; } } while (0)
#define ATT_STORE(buf_) do { *(LAS u32x4*)(Kl0 + (buf_) * 4608 + lkey * 72 + lpart * 8) = kreg; \
            LAS bf16_t* vt_ = Vl0 + (buf_) * 4352 + (lpart * 8) * 68 + lkey; \
            vt_[0 * 68] = (bf16_t)(vreg.x & 0xffffu); vt_[1 * 68] = (bf16_t)(vreg.x >> 16); \
            vt_[2 * 68] = (bf16_t)(vreg.y & 0xffffu); vt_[3 * 68] = (bf16_t)(vreg.y >> 16); \
            vt_[4 * 68] = (bf16_t)(vreg.z & 0xffffu); vt_[5 * 68] = (bf16_t)(vreg.z >> 16); \
            vt_[6 * 68] = (bf16_t)(vreg.w & 0xffffu); vt_[7 * 68] = (bf16_t)(vreg.w >> 16); } while (0)
        ATT_LOAD(0); ATT_STORE(0);
        __syncthreads();
        int cur = 0;
        for (int it = 0; it < nt; ++it) {
            if (it + 1 < nt) ATT_LOAD(it + 1);
            const int kt = 4 * qb + 3 - it;
            const int keybase = kt >= 0 ? 64 * kt : -1;
            const int wq_end = 256 * qb + 32 * wave + 32;
            const LAS bf16_t* Kl = Kl0 + cur * 4608; const LAS bf16_t* Vl = Vl0 + cur * 4352;
            if (kt < 0) { attn_tile_sub<true>(Kl, Vl, qf, 0, -1, iq, l31, h, pick0, o0, o1, Rrun); }
            else {
                const int wq_beg = wq_end - 32;
                if (keybase + 64 <= wq_beg) { attn_tile_sub<false>(Kl, Vl, qf, 1, keybase, iq, l31, h, pick0, o0, o1, Rrun); attn_tile_sub<false>(Kl, Vl, qf, 0, keybase, iq, l31, h, pick0, o0, o1, Rrun); }
                else {
                    if (keybase + 32 < wq_end) attn_tile_sub<true>(Kl, Vl, qf, 1, keybase, iq, l31, h, pick0, o0, o1, Rrun);
                    if (keybase < wq_end) attn_tile_sub<true>(Kl, Vl, qf, 0, keybase, iq, l31, h, pick0, o0, o1, Rrun);
                }
            }
            if (it + 1 < nt) ATT_STORE(cur ^ 1);
            __syncthreads();
            cur ^= 1;
        }
        bf16_t* op = CAT + qrow * 1024 + 512 + hd * 64;
#pragma unroll
        for (int a = 0; a < 4; ++a) {
            u32x2 w0; w0.x = pk2(o0[4 * a], o0[4 * a + 1]); w0.y = pk2(o0[4 * a + 2], o0[4 * a + 3]);
            u32x2 w1; w1.x = pk2(o1[4 * a], o1[4 * a + 1]); w1.y = pk2(o1[4 * a + 2], o1[4 * a + 3]);
            *(u32x2*)(op + 8 * a + 4 * h) = w0; *(u32x2*)(op + 32 + 8 * a + 4 * h) = w1;
        }
    }
}

__device__ __forceinline__ void hgrn_phase(const Params& P, LAS unsigned char* lds, int blk, int G, int wave) {
    const int lane = lane_id_v(), tid = wave * 64 + lane, l15 = lane & 15, quad = lane >> 4;
    LAS bf16_t* qd = (LAS bf16_t*)lds;
    LAS bf16_t* kd = qd + 64 * 136;
    LAS bf16_t* klT = kd + 64 * 136;
    LAS bf16_t* vT = klT + 128 * 72;
    LAS bf16_t* sc = vT + 128 * 72;
    LAS float* ebl = (LAS float*)(sc + 64 * 72);
    LAS float* segtot = ebl + 128;
    LAS float* red = segtot + 1024;
    const unsigned short* PC = (const unsigned short*)(P.ws + OFF_BIG);
    bf16_t* MIXC = (bf16_t*)P.out;
    const float* ng = P.in[16];
    for (int item = blk; item < 128; item += G) {
        const int b = item >> 3, hd = item & 7;
        f32x4 Sacc[8];
#pragma unroll
        for (int i = 0; i < 8; ++i) Sacc[i] = (f32x4){0.f, 0.f, 0.f, 0.f};
        const int dp = tid & 63, sg = tid >> 6;
        unsigned lfc[8], qc[8], vc[8];
#define HG_OFF0(cc_) ((unsigned)((cc_) > 0 ? b * 2048 + ((cc_) - 1) * 64 + 8 * sg : T + (sg >= 6 ? 8 * (sg - 6) : 0)) * 8192u + (unsigned)(hd * 128 + 2 * dp) * 2u)
#define HG_LOAD(cc_, LF_, Q_, V_) do { const unsigned o0_ = HG_OFF0(cc_); _Pragma("unroll") for (int tt_ = 0; tt_ < 8; ++tt_) { const unsigned o_ = o0_ + (unsigned)tt_ * 8192u; \
            Q_[tt_] = *(const unsigned*)((const char*)PC + o_); LF_[tt_] = *(const unsigned*)((const char*)PC + o_ + 2048u); V_[tt_] = *(const unsigned*)((const char*)PC + o_ + 4096u); } } while (0)
        HG_LOAD(0, lfc, qc, vc);
        for (int c = 0; c < 33; ++c) {
            unsigned lfn[8], qn[8], vn[8];
            { const int cn = c + 1 < 33 ? c + 1 : 32; HG_LOAD(cn, lfn, qn, vn); }
            {
                float cs0[8], cs1[8]; float run0 = 0.f, run1 = 0.f;
#pragma unroll
                for (int tt = 0; tt < 8; ++tt) {
                    const bool ok = c > 0 || (8 * sg + tt) >= 48;
                    const float l0 = ok ? 1.4426950408889634f * (float)__builtin_bit_cast(_Float16, (unsigned short)(lfc[tt] & 0xffffu)) : 0.f;
                    const float l1 = ok ? 1.4426950408889634f * (float)__builtin_bit_cast(_Float16, (unsigned short)(lfc[tt] >> 16)) : 0.f;
                    run0 += l0; run1 += l1; cs0[tt] = run0; cs1[tt] = run1;
                }
                segtot[sg * 128 + 2 * dp] = run0; segtot[sg * 128 + 2 * dp + 1] = run1;
                __syncthreads();
                float off0 = 0.f, off1 = 0.f, bl0 = 0.f, bl1 = 0.f;
#pragma unroll
                for (int s2 = 0; s2 < 8; ++s2) {
                    const float a0 = segtot[s2 * 128 + 2 * dp], a1 = segtot[s2 * 128 + 2 * dp + 1];
                    bl0 += a0; bl1 += a1; if (s2 < sg) { off0 += a0; off1 += a1; }
                }
                const float ebl0 = __builtin_amdgcn_exp2f(bl0), ebl1 = __builtin_amdgcn_exp2f(bl1);
                if (sg == 7) { ebl[2 * dp] = ebl0; ebl[2 * dp + 1] = ebl1; }
                float eip0 = __builtin_amdgcn_exp2f(-off0), eip1 = __builtin_amdgcn_exp2f(-off1);
                unsigned kl0[4], kl1[4], v0[4], v1[4];
#pragma unroll
                for (int tp = 0; tp < 4; ++tp) {
                    float klv0[2], klv1[2];
#pragma unroll
                    for (int e = 0; e < 2; ++e) {
                        const int tt = 2 * tp + e, t = 8 * sg + tt;
                        const bool ok = c > 0 || t >= 48;
                        const float bt0 = off0 + cs0[tt], bt1 = off1 + cs1[tt];
                        const float q0 = ok ? bflo(qc[tt]) : 0.f, q1 = ok ? bfhi(qc[tt]) : 0.f;
                        const float eb0 = __builtin_amdgcn_exp2f(bt0), eb1 = __builtin_amdgcn_exp2f(bt1);
                        const float ei0 = __builtin_amdgcn_rcpf(eb0), ei1 = __builtin_amdgcn_rcpf(eb1);
                        const float k0 = 1.0f - eb0 * eip0, k1 = 1.0f - eb1 * eip1;
                        eip0 = ei0; eip1 = ei1;
                        const float kd0 = k0 * ei0, kd1 = k1 * ei1;
                        *(LAS unsigned*)(qd + t * 136 + 2 * dp) = pk2(q0 * eb0, q1 * eb1);
                        *(LAS unsigned*)(kd + t * 136 + 2 * dp) = pk2(kd0, kd1);
                        klv0[e] = kd0 * ebl0; klv1[e] = kd1 * ebl1;
                    }
                    kl0[tp] = pk2(klv0[0], klv0[1]); kl1[tp] = pk2(klv1[0], klv1[1]);
                    const bool okA = c > 0 || (8 * sg + 2 * tp) >= 48, okB = c > 0 || (8 * sg + 2 * tp + 1) >= 48;
                    const unsigned va = okA ? vc[2 * tp] : 0u, vb = okB ? vc[2 * tp + 1] : 0u;
                    v0[tp] = (va & 0xffffu) | (vb << 16); v1[tp] = (va >> 16) | (vb & 0xffff0000u);
                }
                *(LAS u32x4*)(klT + (2 * dp) * 72 + 8 * sg) = (u32x4){kl0[0], kl0[1], kl0[2], kl0[3]};
                *(LAS u32x4*)(klT + (2 * dp + 1) * 72 + 8 * sg) = (u32x4){kl1[0], kl1[1], kl1[2], kl1[3]};
                *(LAS u32x4*)(vT + (2 * dp) * 72 + 8 * sg) = (u32x4){v0[0], v0[1], v0[2], v0[3]};
                *(LAS u32x4*)(vT + (2 * dp + 1) * 72 + 8 * sg) = (u32x4){v1[0], v1[1], v1[2], v1[3]};
            }
            __syncthreads();
            f32x4 oacc[4];
#pragma unroll
            for (int i = 0; i < 4; ++i) oacc[i] = (f32x4){0.f, 0.f, 0.f, 0.f};
#pragma unroll
            for (int kh = 0; kh < 2; ++kh) {
                s16x4 alo[2][4], ahi[2][4];
#pragma unroll
                for (int k2 = 0; k2 < 2; ++k2)
#pragma unroll
                    for (int tt = 0; tt < 4; ++tt) { const LAS bf16_t* ap = qd + (16 * tt + l15) * 136 + 32 * (2 * kh + k2) + 4 * quad; alo[k2][tt] = *(const LAS s16x4*)ap; ahi[k2][tt] = *(const LAS s16x4*)(ap + 16); }
                __builtin_amdgcn_sched_barrier(0);
#pragma unroll
                for (int k2 = 0; k2 < 2; ++k2) {
                    const int ks = 2 * kh + k2;
                    u32x4 sw; sw.x = pk2(Sacc[2 * ks][0], Sacc[2 * ks][1]); sw.y = pk2(Sacc[2 * ks][2], Sacc[2 * ks][3]);
                    sw.z = pk2(Sacc[2 * ks + 1][0], Sacc[2 * ks + 1][1]); sw.w = pk2(Sacc[2 * ks + 1][2], Sacc[2 * ks + 1][3]);
                    const bf16x8 sb = __builtin_bit_cast(bf16x8, sw);
#pragma unroll
                    for (int tt = 0; tt < 4; ++tt) oacc[tt] = MFMA16(__builtin_shufflevector(alo[k2][tt], ahi[k2][tt], 0, 1, 2, 3, 4, 5, 6, 7), sb, oacc[tt]);
                }
                __builtin_amdgcn_sched_barrier(0);
            }
#pragma unroll
            for (int e = 0; e < 2; ++e) {
                const int tile = 2 * wave + e, tt = tile >> 2, ss = tile & 3;
                bf16x8 fa[4], fb[4];
#pragma unroll
                for (int ks = 0; ks < 4; ++ks) { fa[ks] = *(const LAS bf16x8*)(qd + (16 * tt + l15) * 136 + 32 * ks + 8 * quad); fb[ks] = *(const LAS bf16x8*)(kd + (16 * ss + l15) * 136 + 32 * ks + 8 * quad); }
                __builtin_amdgcn_sched_barrier(0);
                f32x4 sa = {0.f, 0.f, 0.f, 0.f};
#pragma unroll
                for (int ks = 0; ks < 4; ++ks) sa = MFMA16(fa[ks], fb[ks], sa);
#pragma unroll
                for (int r = 0; r < 4; ++r) { const int tg = 16 * tt + 4 * quad + r, sg_ = 16 * ss + l15; sc[tg * 72 + sg_] = f2bf(sg_ <= tg ? sa[r] : 0.f); }
                __builtin_amdgcn_sched_barrier(0);
            }
            __syncthreads();
            unsigned short gr[16];
            {
                const int cg_ = c > 0 ? c : 1;
#pragma unroll
                for (int tt = 0; tt < 4; ++tt)
#pragma unroll
                    for (int r = 0; r < 4; ++r) gr[4 * tt + r] = *(const unsigned short*)((const char*)PC + ((unsigned)(b * 2048 + (cg_ - 1) * 64 + 16 * tt + 4 * quad + r) * 8192u + (unsigned)(3072 + hd * 128 + 16 * wave + l15) * 2u));
            }
            {
#pragma unroll
                for (int dt = 0; dt < 8; ++dt) Sacc[dt] *= *(const LAS f32x4*)(ebl + 16 * dt + 4 * quad);
                __builtin_amdgcn_sched_barrier(0);
#pragma unroll
                for (int ks = 0; ks < 2; ++ks) {
                    bf16x8 fsc[4], fkl[8];
                    const bf16x8 vb = *(const LAS bf16x8*)(vT + (16 * wave + l15) * 72 + 32 * ks + 8 * quad);
#pragma unroll
                    for (int tt = 0; tt < 4; ++tt) fsc[tt] = *(const LAS bf16x8*)(sc + (16 * tt + l15) * 72 + 32 * ks + 8 * quad);
#pragma unroll
                    for (int dt = 0; dt < 8; ++dt) fkl[dt] = *(const LAS bf16x8*)(klT + (16 * dt + l15) * 72 + 32 * ks + 8 * quad);
                    __builtin_amdgcn_sched_barrier(0);
#pragma unroll
                    for (int tt = 0; tt < 4; ++tt) oacc[tt] = MFMA16(fsc[tt], vb, oacc[tt]);
#pragma unroll
                    for (int dt = 0; dt < 8; ++dt) Sacc[dt] = MFMA16(fkl[dt], vb, Sacc[dt]);
                    __builtin_amdgcn_sched_barrier(0);
                }
            }
#pragma unroll
            for (int tt = 0; tt < 4; ++tt)
#pragma unroll
                for (int r = 0; r < 4; ++r) {
                    float sq = oacc[tt][r] * oacc[tt][r];
                    sq += __int_as_float(__builtin_amdgcn_update_dpp(0, __float_as_int(sq), 0xB1, 0xf, 0xf, false));
                    sq += __int_as_float(__builtin_amdgcn_update_dpp(0, __float_as_int(sq), 0x4E, 0xf, 0xf, false));
                    sq += __int_as_float(__builtin_amdgcn_update_dpp(0, __float_as_int(sq), 0x141, 0xf, 0xf, false));
                    sq += __int_as_float(__builtin_amdgcn_update_dpp(0, __float_as_int(sq), 0x140, 0xf, 0xf, false));
                    if (l15 == 0) red[(16 * tt + 4 * quad + r) * 8 + wave] = sq;
                }
            __syncthreads();
            if (c > 0) {
                const int dvg = hd * 128 + 16 * wave + l15;
                const float gn = ng[dvg];
#pragma unroll
                for (int tt = 0; tt < 4; ++tt)
#pragma unroll
                    for (int r = 0; r < 4; ++r) {
                        const int t = 16 * tt + 4 * quad + r;
                        const f32x4 r0 = *(const LAS f32x4*)(red + t * 8), r1 = *(const LAS f32x4*)(red + t * 8 + 4);
                        const float ssum = ((r0[0] + r0[1]) + (r0[2] + r0[3])) + ((r1[0] + r1[1]) + (r1[2] + r1[3]));
                        const float rs = __builtin_amdgcn_rsqf(ssum * (1.0f / 128.0f) + 1e-6f);
                        const unsigned moff = (unsigned)(b * 2048 + (c - 1) * 64 + t) * 2048u + (unsigned)dvg * 2u;
                        const float gv = bf2f(gr[4 * tt + r]);
                        *(bf16_t*)((char*)MIXC + moff) = f2bf(oacc[tt][r] * rs * gn * gv * __builtin_amdgcn_rcpf(1.0f + __builtin_amdgcn_exp2f(-1.4426950408889634f * gv)));
                    }
            }
#pragma unroll
            for (int i = 0; i < 8; ++i) { lfc[i] = lfn[i]; qc[i] = qn[i]; vc[i] = vn[i]; }
        }
        __syncthreads();
    }
}

__global__ void __launch_bounds__(512, 2) fwd_megakernel(Params P) {
    extern __shared__ __attribute__((aligned(16))) unsigned char lds_raw[];
    LAS unsigned char* lds = (LAS unsigned char*)lds_raw;
    cg::grid_group grid = cg::this_grid();
    const int blk = blockIdx.x, G = gridDim.x, wave = __builtin_amdgcn_readfirstlane((int)(threadIdx.x >> 6));
    unsigned char* ws = P.ws;
    bf16_t* HB = (bf16_t*)(ws + OFF_HB);
    float* Z = (float*)(ws + OFF_Z);
    bf16_t* PROJ = (bf16_t*)(ws + OFF_BIG + BIG_PROJ);
    bf16_t* APRE = (bf16_t*)(ws + OFF_BIG + BIG_APRE);
    bf16_t* CAT = (bf16_t*)(ws + OFF_BIG + BIG_CAT);
    bf16_t* HID = (bf16_t*)(ws + OFF_BIG);
    unsigned short* PC = (unsigned short*)(ws + OFF_BIG);

    volatile LAS unsigned* xst = (volatile LAS unsigned*)(lds + 131072);
    if (wave == 0 && lane_id_v() < 4) xst[lane_id_v()] = 0u;
    __syncthreads();
    const XcdBarrier xb = xcd_barrier_post((unsigned*)(ws + OFF_BAR), xst, wave);
    prologue_phase(P, lds, blk, G, wave);
    grid.sync();
    run_gemm(lds, HB, (const bf16_t*)(ws + OFF_WAB), 2048, 1024, EpInAB{PROJ}, true, blk, G, wave);
    xcd_barrier(xb, wave);
    s5_phase(P, lds, blk, G, wave);
    __syncthreads();
#if PROBE_DUP_S5
    s5_phase(P, lds, blk, G, wave);
    __syncthreads();
#endif
    attn_phase(P, lds, blk, G, wave);
#if PROBE_DUP_ATTN
    __syncthreads();
    attn_phase(P, lds, blk, G, wave);
#endif
    xcd_barrier(xb, wave);
    run_gemm(lds, APRE, (const bf16_t*)(ws + OFF_WGLU), 512, 512, EpGlu{APRE, P.in[12], CAT}, true, blk, G, wave);
    xcd_barrier(xb, wave);
    float* ST = (float*)(ws + OFF_ST); const float* SV = (const float*)(ws + OFF_SV); const float* TV = (const float*)(ws + OFF_TV);
    float *ST1 = ST, *ST2 = ST + 2 * (size_t)R, *ST3 = ST + 4 * (size_t)R, *ST4 = ST + 6 * (size_t)R;
    run_gemm(lds, CAT, (const bf16_t*)(ws + OFF_WOAB), 1024, 1024, EpRes{P.in[0], P.in[1], Z, nullptr, nullptr, nullptr, nullptr, ST1, HB}, true, blk, G, wave);
    xcd_barrier(xb, wave);
    run_gemm(lds, HB, (const bf16_t*)(ws + OFF_WUP0), 4096, 1024, EpUp{HID, P.in[21], ST1, SV, TV}, true, blk, G, wave);
#if PROBE_DUP_UP0
    __syncthreads();
    run_gemm(lds, HB, (const bf16_t*)(ws + OFF_WUP0), 4096, 1024, EpUp{HID, P.in[21], ST1, SV, TV}, true, blk, G, wave);
#endif
#if PROBE_SYNCS
    for (int i_ = 0; i_ < PROBE_SYNCS; ++i_) xcd_barrier(xb, wave);
#endif
    xcd_barrier(xb, wave);
    run_gemm(lds, HID, (const bf16_t*)(ws + OFF_WDN0), 1024, 4096, EpRes{Z, nullptr, Z, P.in[23], ST1, P.in[18], P.in[19], ST2, HB}, true, blk, G, wave);
    xcd_barrier(xb, wave);
    run_gemm(lds, HB, (const bf16_t*)(ws + OFF_WC), 4096, 1024, EpInC{PC, P.in[15], ST2, SV + 4096, TV + 4096}, true, blk, G, wave);
#if PROBE_DUP_INC
    __syncthreads();
    run_gemm(lds, HB, (const bf16_t*)(ws + OFF_WC), 4096, 1024, EpInC{PC, P.in[15], ST2, SV + 4096, TV + 4096}, true, blk, G, wave);
#endif
    xcd_barrier(xb, wave);
    hgrn_phase(P, lds, blk, G, wave);
#if PROBE_DUP_HGRN
    __syncthreads();
    hgrn_phase(P, lds, blk, G, wave);
#endif
    xcd_barrier(xb, wave);
    run_gemm(lds, (const bf16_t*)P.out  , (const bf16_t*)(ws + OFF_WOC), 1024, 1024, EpRes{Z, nullptr, Z, nullptr, ST2, P.in[24], P.in[25], ST3, HB}, false, blk, G, wave);
    xcd_barrier(xb, wave);
    run_gemm(lds, HB, (const bf16_t*)(ws + OFF_WUP1), 4096, 1024, EpUp{HID, P.in[21] + 4096, ST3, SV + 8192, TV + 8192}, false, blk, G, wave);
    xcd_barrier(xb, wave);
    run_gemm(lds, HID, (const bf16_t*)(ws + OFF_WDN1), 1024, 4096, EpRes{Z, nullptr, Z, P.in[23] + 1024, ST3, P.in[18] + 1024, P.in[19] + 1024, ST4, nullptr}, false, blk, G, wave);
    xcd_barrier(xb, wave);
    final_ln_phase(Z, ST4, P.out, P.in[24] + 1024, P.in[25] + 1024, blk, G, wave);
}

extern "C" void kernel_launch(void* const* d_in, const int* in_sizes, int n_in, void* d_out, int out_size, void* d_ws, size_t ws_size, hipStream_t stream) {
    constexpr size_t kDynLds = 131072 + 256;
    static int grid_blocks = 0;
    if (!grid_blocks) {
        if (n_in != 26 || ws_size < ZERO_END) { fprintf(stderr, "kernel_launch: expected 26 inputs and >= %zu bytes of workspace (got %d, %zu)\n", (size_t)ZERO_END, n_in, ws_size); grid_blocks = -1; return; }
        int dev = 0, cus = 0, per_cu = 0;
        hipGetDevice(&dev);
        hipDeviceGetAttribute(&cus, hipDeviceAttributeMultiprocessorCount, dev);
        hipFuncSetAttribute((const void*)fwd_megakernel, hipFuncAttributeMaxDynamicSharedMemorySize, (int)kDynLds);
        hipOccupancyMaxActiveBlocksPerMultiprocessor(&per_cu, (const void*)fwd_megakernel, 512, kDynLds);
        if (per_cu < 1) { fprintf(stderr, "kernel_launch: occupancy query says %d blocks per CU\n", per_cu); per_cu = 1; }
        grid_blocks = cus * (per_cu > 1 ? 1 : per_cu);
        if (grid_blocks != 256) fprintf(stderr, "kernel_launch: note: grid is %d workgroups (tuned for 256)\n", grid_blocks);
    }
    if (grid_blocks < 1) return;
    Params p{};
    for (int i = 0; i < 26; ++i) p.in[i] = (const float*)d_in[i];
    p.out = (float*)d_out; p.ws = (unsigned char*)d_ws;
    hipMemsetAsync((char*)d_ws + OFF_ST, 0, ZERO_END - OFF_ST, stream);
    void* args[] = {&p};
    hipError_t e = hipLaunchCooperativeKernel((const void*)fwd_megakernel, dim3(grid_blocks), dim3(512), args, kDynLds, stream);
    if (e != hipSuccess) fprintf(stderr, "cooperative launch failed: %s (grid %d)\n", hipGetErrorString(e), grid_blocks);
}
```

```cpp
#define NB_OUTAB 4
#define NB_DN0 2
#define NB_OUTC 4
#define NB_DN1 2
#include <hip/hip_runtime.h>
#include <hip/hip_cooperative_groups.h>
#include <cstdio>
#include <cstdint>
namespace cg = cooperative_groups;
#ifndef PROBE_DUP_S5
#define PROBE_DUP_S5 0
#endif
#ifndef PROBE_DUP_ATTN
#define PROBE_DUP_ATTN 0
#endif
#ifndef PROBE_DUP_HGRN
#define PROBE_DUP_HGRN 0
#endif
#ifndef PROBE_DUP_INC
#define PROBE_DUP_INC 0
#endif
__device__ __forceinline__ int lane_id_v() { int l; asm volatile("v_mbcnt_lo_u32_b32 %0, -1, 0\n\tv_mbcnt_hi_u32_b32 %0, -1, %0" : "=v"(l)); return l; }
#ifndef PROBE_DUP_UP0
#define PROBE_DUP_UP0 0
#endif
#ifndef PROBE_SYNCS
#define PROBE_SYNCS 0
#endif
#ifndef NB_OUTAB
#define NB_OUTAB 4
#endif
#ifndef NB_DN0
#define NB_DN0 4
#endif
#ifndef NB_OUTC
#define NB_OUTC 4
#endif
#ifndef NB_DN1
#define NB_DN1 4
#endif
#ifndef PROBE_GEMMS
#define PROBE_GEMMS 0
#endif
#ifndef PROBE_DUP_PRO
#define PROBE_DUP_PRO 0
#endif
#ifndef PROBE_DUP_OUTAB
#define PROBE_DUP_OUTAB 0
#endif
#define XB_TMO      128
#define XB_XCNT(j)  (256  + 64 * (j))
#define XB_XSUB(j)  (1280 + 64 * (j))
#define XB_XGEN(j)  (2304 + 64 * (j))
#define XB_TOP      3328
#define XB_TOPGEN   3392
#define XCD_BAR_WORDS 3456
#define XB_SPIN_CAP (1u << 18)

__device__ __forceinline__ unsigned xb_ld(unsigned* p)              { return __hip_atomic_load(p, __ATOMIC_RELAXED, __HIP_MEMORY_SCOPE_AGENT); }
__device__ __forceinline__ unsigned xb_add(unsigned* p, unsigned v) { return __hip_atomic_fetch_add(p, v, __ATOMIC_RELAXED, __HIP_MEMORY_SCOPE_AGENT); }
__device__ __forceinline__ unsigned xb_xcc_id() { return (unsigned)__builtin_amdgcn_s_getreg((3 << 11) | 20) & 0xFu; }
#define XB_SPIN(cond, bar) do { unsigned _sp = 0; while (cond) { __builtin_amdgcn_s_sleep(1); \
    if ((++_sp & 255u) == 0u) { if (xb_ld(&(bar)[XB_TMO])) break; if (_sp > XB_SPIN_CAP) { atomicAdd(&(bar)[XB_TMO], 1u); break; } } } } while (0)

struct XcdBarrier {
    unsigned* bar; unsigned x;
    volatile __attribute__((address_space(3))) unsigned* st;
};

__device__ __forceinline__ XcdBarrier xcd_barrier_post(unsigned* bar, volatile __attribute__((address_space(3))) unsigned* st, int wave_in) {
    XcdBarrier b; b.bar = bar; b.x = xb_xcc_id(); b.st = st;
    if (wave_in == 0 && lane_id_v() == 0) (void)xb_add(&bar[XB_XCNT(b.x)], 1u);
    return b;
}
__device__ __forceinline__ void xcd_barrier_complete(unsigned* bar, unsigned x, unsigned& nloc, unsigned& nx) {
    const unsigned G = gridDim.x * gridDim.y * gridDim.z;
    unsigned sum, cnt, mine, sp = 0u;
    for (;;) {
        sum = 0u; cnt = 0u; mine = 0u;
#pragma unroll
        for (unsigned j = 0; j < 16; ++j) { const unsigned c = xb_ld(&bar[XB_XCNT(j)]); sum += c; cnt += (c > 0u) ? 1u : 0u; mine = (j == x) ? c : mine; }
        if (sum == G) break;
        __builtin_amdgcn_s_sleep(1);
        if ((++sp & 255u) == 0u) { if (xb_ld(&bar[XB_TMO])) break; if (sp > XB_SPIN_CAP) { atomicAdd(&bar[XB_TMO], 1u); break; } }
    }
    nloc = mine > 0u ? mine : 1u; nx = cnt > 0u ? cnt : 1u;
}

__device__ __forceinline__ void xcd_barrier(const XcdBarrier& b, int wave_in) {
    asm volatile("s_waitcnt vmcnt(0)" ::: "memory");
    __syncthreads();
    if (wave_in == 0 && lane_id_v() == 0) {
        unsigned* bar = b.bar;
        __builtin_amdgcn_s_waitcnt(0);
        unsigned nloc = b.st[0], nx = b.st[1];
        if (nloc == 0u) { xcd_barrier_complete(bar, b.x, nloc, nx); b.st[0] = nloc; b.st[1] = nx; }
        const unsigned old = xb_add(&bar[XB_XSUB(b.x)], 1u);
        const unsigned gen = old / nloc;
        if (old + 1u == (gen + 1u) * nloc) {
            __builtin_amdgcn_fence(__ATOMIC_RELEASE, "agent");
            asm volatile("s_waitcnt vmcnt(0)" ::: "memory");
            const unsigned og = xb_add(&bar[XB_TOP], 1u);
            const unsigned tg = og / nx;
            if (og + 1u == (tg + 1u) * nx) xb_add(&bar[XB_TOPGEN], 1u);
            else XB_SPIN(xb_ld(&bar[XB_TOPGEN]) == tg, bar);
            __builtin_amdgcn_fence(__ATOMIC_ACQUIRE, "agent");
            xb_add(&bar[XB_XGEN(b.x)], 1u);
            asm volatile("s_waitcnt vmcnt(0)" ::: "memory");
        } else {
            XB_SPIN(xb_ld(&bar[XB_XGEN(b.x)]) == gen, bar);
            __builtin_amdgcn_fence(__ATOMIC_ACQUIRE, "agent");
            asm volatile("s_waitcnt vmcnt(0)" ::: "memory");
        }
    }
    __syncthreads();
}

namespace pg8 {
#define PG8_LAS __attribute__((address_space(3)))
typedef unsigned short bf16_t;
typedef short bf16x8 __attribute__((ext_vector_type(8)));
typedef float f32x4 __attribute__((ext_vector_type(4)));
typedef unsigned u32x4 __attribute__((ext_vector_type(4)));
constexpr int BM = 256, BK = 64, HALF = 128, HTB = HALF * BK * 2  , STAGE_BYTES = 8 * HTB, NXCD = 8, WGM = 8;

__host__ __device__ __forceinline__ int lds_byte(int r, int c) { const int st = (r >> 4) * 2 + (c >> 5), rr = r & 15, cc = c & 31, ob = rr * 64 + cc * 2; return st * 1024 + (ob ^ (((ob >> 9) & 1) << 5)); }
__host__ __device__ __forceinline__ void stage_rc(int b, int& R, int& C) { const int st = b / 1024, sb = b % 1024, swz = sb ^ (((sb >> 9) & 1) << 5); R = (st >> 1) * 16 + swz / 64; C = (st & 1) * 32 + (swz % 64) / 2; }
__host__ __device__ __forceinline__ int perm32(int rho) { const int n = rho >> 4, i = rho & 15; return 8 * (i >> 2) + 4 * n + (i & 3); }

struct Unit { int pm, pn; };
struct Gemm { const bf16_t* A; const bf16_t* Bt; int M, N, K; };

struct StaticOrder {
    int nM, nN, nwg, G, c;
    __host__ __device__ void init(int M, int N, int G_, int c_) { nM = M / BM; nN = N / BM; nwg = nM * nN; G = G_; c = c_; }
    __host__ __device__ bool next(int i, Unit& u) const {
        const long L = (long)i * G + c; if (L >= nwg) return false;
        int wgid = (int)L; { const int q = nwg / NXCD, r = nwg % NXCD, xcd = wgid % NXCD, off = wgid / NXCD; wgid = (xcd < r ? xcd * (q + 1) : r * (q + 1) + (xcd - r) * q) + off; }
        const int nig = WGM * nN, gid = wgid / nig, fm = gid * WGM, gsz = (nM - fm) < WGM ? (nM - fm) : WGM;
        u.pm = fm + ((wgid % nig) % gsz); u.pn = (wgid % nig) / gsz; return true;
    }
    __device__ __forceinline__ void a_ready(const Unit&) const {}
    __device__ __forceinline__ void done(const Unit&) const {}
};

__device__ __forceinline__ unsigned cvt_pk_bf16(float lo, float hi) { unsigned r; asm volatile("v_cvt_pk_bf16_f32 %0, %1, %2" : "=v"(r) : "v"(lo), "v"(hi)); return r; }
template <class Epi, class Sched, bool ALIGN_EPI = false, bool SP2 = false>
__device__ __forceinline__ void gemm_phase(PG8_LAS unsigned char* lds, const Gemm g, const Sched& S, const Epi& E, int wave_in) {
    const int lane = lane_id_v(), wid = __builtin_amdgcn_readfirstlane(wave_in), tid = wid * 64 + lane, wr = wid >> 2, wc = wid & 3, fr = lane & 15, fq = lane >> 4;
    const int K = g.K, nt = K / BK;
    unsigned voffA[2], voffB[2];
#pragma unroll
    for (int i = 0; i < 2; ++i) { int R, C; stage_rc(tid * 16 + i * 8192, R, C); const int Rb = Epi::PERM ? ((R & ~31) + perm32(R & 31)) : R;
        voffA[i] = (unsigned)(R * K + C) * 2u; voffB[i] = (unsigned)(Rb * K + C) * 2u; }
    const size_t kstep = (size_t)(BK * 2);
    const size_t hstep = (size_t)HALF * K * 2;
    const size_t tstep = 2 * hstep;
    const unsigned ldsw = (unsigned)wid * 1024u;
    const int aoff = lds_byte(wr * 64 + fr, fq * 8), boff = lds_byte(wc * 32 + fr, fq * 8);
#define PG8_SA(b, h) (((b) * 2 + (h)) * HTB)
#define PG8_SB(b, h) ((4 + (b) * 2 + (h)) * HTB)
#define PG8_STAGE(bufoff, gbase, voff) do { _Pragma("unroll") for (int _i = 0; _i < 2; ++_i) \
        __builtin_amdgcn_global_load_lds((const unsigned*)((const char*)(gbase) + (voff)[_i]), (PG8_LAS unsigned*)(lds + (bufoff) + ldsw + _i * 8192), 16, 0, 0); } while (0)
#define PG8_LDA(dst, b, h) do { _Pragma("unroll") for (int m = 0; m < 4; ++m) _Pragma("unroll") for (int k = 0; k < 2; ++k) dst[m][k] = *(const PG8_LAS bf16x8*)(lds + PG8_SA(b, h) + aoff + m * 2048 + k * 1024); } while (0)
#define PG8_LDB(dst, b, h) do { _Pragma("unroll") for (int n = 0; n < 2; ++n) _Pragma("unroll") for (int k = 0; k < 2; ++k) dst[n][k] = *(const PG8_LAS bf16x8*)(lds + PG8_SB(b, h) + boff + n * 2048 + k * 1024); } while (0)
#define PG8_MMA(ai, bj, At, Bt) do { __builtin_amdgcn_s_setprio(1); _Pragma("unroll") for (int m = 0; m < 4; ++m) _Pragma("unroll") for (int n = 0; n < 2; ++n) _Pragma("unroll") for (int k = 0; k < 2; ++k) \
        acc[ai][bj][m][n] = __builtin_amdgcn_mfma_f32_16x16x32_bf16(Bt[n][k], At[m][k], acc[ai][bj][m][n], 0, 0, 0); __builtin_amdgcn_s_setprio(0); } while (0)
#define PG8_WAIT_V(n) asm volatile("s_waitcnt vmcnt(" #n ")" ::: "memory")
#define PG8_WAIT_L(n) asm volatile("s_waitcnt lgkmcnt(" #n ")" ::: "memory")
#define PG8_BAR __builtin_amdgcn_s_barrier()
#define PG8_SCHED __builtin_amdgcn_sched_barrier(0)
    Unit cur, nxt; int ui = 0;
    if (!S.next(0, cur)) return;
    f32x4 acc[2][2][4][2];
#pragma unroll
    for (int a = 0; a < 2; ++a)
#pragma unroll
        for (int b = 0; b < 2; ++b)
#pragma unroll
            for (int m = 0; m < 4; ++m)
#pragma unroll
                for (int n = 0; n < 2; ++n) acc[a][b][m][n] = (f32x4){0.f, 0.f, 0.f, 0.f};
    bf16x8 At[4][2], B0[2][2], B1[2][2];
    const char* cA = (const char*)g.A + (size_t)cur.pm * tstep; const char* cB = (const char*)g.Bt + (size_t)cur.pn * tstep;
    S.a_ready(cur);
    if constexpr (SP2) {
        PG8_STAGE(PG8_SB(0, 0), cB, voffB); PG8_STAGE(PG8_SB(0, 1), cB + hstep, voffB); PG8_STAGE(PG8_SA(0, 0), cA, voffA); PG8_STAGE(PG8_SA(0, 1), cA + hstep, voffA);
        if (wr == 1) PG8_BAR;
        PG8_WAIT_V(2); PG8_BAR;
        PG8_STAGE(PG8_SB(1, 0), cB + kstep, voffB); PG8_STAGE(PG8_SA(1, 0), cA + kstep, voffA); PG8_STAGE(PG8_SB(1, 1), cB + hstep + kstep, voffB);
        PG8_WAIT_V(6); PG8_BAR;
    } else {
        PG8_STAGE(PG8_SB(0, 0), cB, voffB); PG8_STAGE(PG8_SA(0, 0), cA, voffA); PG8_STAGE(PG8_SB(0, 1), cB + hstep, voffB); PG8_STAGE(PG8_SA(0, 1), cA + hstep, voffA);
        if (wr == 1) PG8_BAR;
        PG8_WAIT_V(4); PG8_BAR;
        PG8_STAGE(PG8_SB(1, 0), cB + kstep, voffB); PG8_STAGE(PG8_SA(1, 0), cA + kstep, voffA); PG8_STAGE(PG8_SB(1, 1), cB + hstep + kstep, voffB);
        PG8_WAIT_V(6); PG8_BAR;
    }
    for (;;) {
        const bool has_next = S.next(ui + 1, nxt);
        const char* nA = has_next ? (const char*)g.A + (size_t)nxt.pm * tstep : cA; const char* nB = has_next ? (const char*)g.Bt + (size_t)nxt.pn * tstep : cB;
        for (int t = 0; t < nt; t += 2) {
            const bool last = (t == nt - 2);
            const char* a1 = cA + (size_t)(t + 1) * kstep;
            const char* a2 = last ? nA : cA + (size_t)(t + 2) * kstep; const char* b2 = last ? nB : cB + (size_t)(t + 2) * kstep;
            const char* a3 = a2 + kstep; const char* b3 = b2 + kstep;
            if (last && has_next) S.a_ready(nxt);
            if constexpr (SP2) {
            PG8_LDB(B0, 0, 0); PG8_LDB(B1, 0, 1); PG8_SCHED; PG8_LDA(At, 0, 0); PG8_STAGE(PG8_SA(1, 1), a1 + hstep, voffA);
            PG8_WAIT_V(8); PG8_WAIT_L(0); PG8_BAR; PG8_MMA(0, 0, At, B0); PG8_MMA(0, 1, At, B1); PG8_BAR; PG8_SCHED;
            PG8_LDA(At, 0, 1); PG8_STAGE(PG8_SB(0, 0), b2, voffB); PG8_STAGE(PG8_SB(0, 1), b2 + hstep, voffB); PG8_STAGE(PG8_SA(0, 0), a2, voffA);
            PG8_WAIT_V(8); PG8_WAIT_L(0); PG8_BAR; PG8_MMA(1, 0, At, B0); PG8_MMA(1, 1, At, B1); PG8_BAR; PG8_SCHED;
            PG8_LDB(B0, 1, 0); PG8_LDB(B1, 1, 1); PG8_SCHED; PG8_LDA(At, 1, 0); PG8_STAGE(PG8_SA(0, 1), a2 + hstep, voffA);
            PG8_WAIT_V(8); PG8_WAIT_L(0); PG8_BAR; PG8_MMA(0, 0, At, B0); PG8_MMA(0, 1, At, B1); PG8_BAR; PG8_SCHED;
            PG8_LDA(At, 1, 1); PG8_STAGE(PG8_SB(1, 0), b3, voffB); PG8_STAGE(PG8_SB(1, 1), b3 + hstep, voffB); PG8_STAGE(PG8_SA(1, 0), a3, voffA);
            PG8_WAIT_V(8); PG8_WAIT_L(0); PG8_BAR; PG8_MMA(1, 0, At, B0); PG8_MMA(1, 1, At, B1); PG8_BAR; PG8_SCHED;
            } else {
            PG8_LDB(B0, 0, 0); PG8_SCHED; PG8_LDA(At, 0, 0); PG8_STAGE(PG8_SA(1, 1), a1 + hstep, voffA);
            PG8_WAIT_L(8); PG8_BAR; PG8_WAIT_L(0); PG8_MMA(0, 0, At, B0); PG8_BAR; PG8_SCHED;
            PG8_LDB(B1, 0, 1); PG8_STAGE(PG8_SB(0, 0), b2, voffB);
            PG8_BAR; PG8_WAIT_L(0); PG8_MMA(0, 1, At, B1); PG8_BAR;
            PG8_LDA(At, 0, 1); PG8_STAGE(PG8_SA(0, 0), a2, voffA);
            PG8_BAR; PG8_WAIT_L(0); PG8_MMA(1, 0, At, B0); PG8_BAR; PG8_SCHED;
            PG8_STAGE(PG8_SB(0, 1), b2 + hstep, voffB);
            PG8_WAIT_V(6); PG8_BAR; PG8_MMA(1, 1, At, B1); PG8_BAR;
            PG8_LDB(B0, 1, 0); PG8_SCHED; PG8_LDA(At, 1, 0); PG8_STAGE(PG8_SA(0, 1), a2 + hstep, voffA);
            PG8_WAIT_L(8); PG8_BAR; PG8_WAIT_L(0); PG8_MMA(0, 0, At, B0); PG8_BAR; PG8_SCHED;
            PG8_LDB(B1, 1, 1); PG8_STAGE(PG8_SB(1, 0), b3, voffB);
            PG8_BAR; PG8_WAIT_L(0); PG8_MMA(0, 1, At, B1); PG8_BAR;
            PG8_LDA(At, 1, 1); PG8_STAGE(PG8_SA(1, 0), a3, voffA);
            PG8_BAR; PG8_WAIT_L(0); PG8_MMA(1, 0, At, B0); PG8_BAR; PG8_SCHED;
            PG8_STAGE(PG8_SB(1, 1), b3 + hstep, voffB);
            PG8_WAIT_V(6); PG8_BAR; PG8_MMA(1, 1, At, B1); PG8_BAR;
            }
        }
        if constexpr (ALIGN_EPI) { if (wr == 0) PG8_BAR; }
        if constexpr (!Epi::AFTER_DRAIN) { E(acc, cur, wr, wc, fr, fq); S.done(cur); }
        if (!has_next) break;
#pragma unroll
        for (int a = 0; a < 2; ++a)
#pragma unroll
            for (int b = 0; b < 2; ++b)
#pragma unroll
                for (int m = 0; m < 4; ++m)
#pragma unroll
                    for (int n = 0; n < 2; ++n) acc[a][b][m][n] = (f32x4){0.f, 0.f, 0.f, 0.f};
        cur = nxt; cA = nA; cB = nB; ++ui;
        if constexpr (ALIGN_EPI) { if (wr == 1) PG8_BAR; }
    }
    PG8_WAIT_V(0);
    if constexpr (!ALIGN_EPI) { if (wr == 0) PG8_BAR; }
    PG8_BAR;
    if constexpr (Epi::AFTER_DRAIN) { E.fused(acc, cur, wr, wc, fr, fq, lds, wid, lane); S.done(cur); }
#undef PG8_SA
#undef PG8_SB
#undef PG8_STAGE
#undef PG8_LDA
#undef PG8_LDB
#undef PG8_MMA
#undef PG8_WAIT_V
#undef PG8_WAIT_L
#undef PG8_BAR
#undef PG8_SCHED
}
}

#define LAS __attribute__((address_space(3)))
typedef unsigned short bf16_t;
typedef short bf16x8 __attribute__((ext_vector_type(8)));
typedef short s16x4 __attribute__((ext_vector_type(4)));
typedef float f32x4 __attribute__((ext_vector_type(4)));
typedef float f32x16 __attribute__((ext_vector_type(16)));
typedef unsigned u32x4 __attribute__((ext_vector_type(4)));
typedef unsigned u32x2 __attribute__((ext_vector_type(2)));

constexpr int T = 16 * 2048;
constexpr int NMETA = 16;
constexpr int R = T + NMETA;
constexpr int DM = 1024, DFF = 4096;
constexpr float ALPHA = 1.4142135623730951f;
constexpr float QSCALE = 0.125f * 1.4426950408889634f;

constexpr size_t SZ_WAB = (size_t)2048 * 1024 * 2, SZ_WGLU = (size_t)512 * 512 * 2, SZ_W1M = (size_t)1024 * 1024 * 2, SZ_W4M = (size_t)4096 * 1024 * 2;
constexpr size_t OFF_WAB = 0, OFF_WGLU = OFF_WAB + SZ_WAB, OFF_WOAB = OFF_WGLU + SZ_WGLU, OFF_WC = OFF_WOAB + SZ_W1M, OFF_WOC = OFF_WC + SZ_W4M,
                 OFF_WUP0 = OFF_WOC + SZ_W1M, OFF_WUP1 = OFF_WUP0 + SZ_W4M, OFF_WDN0 = OFF_WUP1 + SZ_W4M, OFF_WDN1 = OFF_WDN0 + SZ_W4M,
                 OFF_HB = OFF_WDN1 + SZ_W4M, OFF_Z = OFF_HB + (size_t)R * 1024 * 2, OFF_BIG = OFF_Z + (size_t)R * 1024 * 4, WS_END = OFF_BIG + (size_t)R * 4096 * 2;
constexpr size_t OFF_ST = (WS_END + 255) & ~(size_t)255;
constexpr size_t SZ_ST = (size_t)5 * R * 2 * 4;
constexpr size_t OFF_SV = OFF_ST + SZ_ST, OFF_TV = OFF_SV + (size_t)3 * 4096 * 4, OFF_BAR = OFF_TV + (size_t)3 * 4096 * 4, ZERO_END = OFF_BAR + (size_t)XCD_BAR_WORDS * 4;
constexpr size_t BIG_PROJ = 0, BIG_APRE = (size_t)R * 2048 * 2, BIG_CAT = BIG_APRE + (size_t)R * 512 * 2;

struct Params { const float* in[26]; float* out; unsigned char* ws; };

__device__ __forceinline__ unsigned pk2(float lo, float hi) {
    typedef __bf16 bf2 __attribute__((ext_vector_type(2)));
    typedef float fl2 __attribute__((ext_vector_type(2)));
    fl2 v = {lo, hi}; bf2 r = __builtin_convertvector(v, bf2); return __builtin_bit_cast(unsigned, r);
}
__device__ __forceinline__ bf16_t f2bf(float x) { return (bf16_t)(pk2(x, 0.f) & 0xffffu); }
__device__ __forceinline__ float bf2f(bf16_t v) { return __uint_as_float((unsigned)v << 16); }
__device__ __forceinline__ float bflo(unsigned w) { return __uint_as_float(w << 16); }
__device__ __forceinline__ float bfhi(unsigned w) { return __uint_as_float(w & 0xffff0000u); }
__device__ __forceinline__ float sigmoidf_(float x) { return 1.0f / (1.0f + __expf(-x)); }
#define LDS_WAIT() asm volatile("s_waitcnt lgkmcnt(0)" ::: "memory")
#define MFMA16(a, b, c) __builtin_amdgcn_mfma_f32_16x16x32_bf16((a), (b), (c), 0, 0, 0)
#define MFMA32(a, b, c) __builtin_amdgcn_mfma_f32_32x32x16_bf16((a), (b), (c), 0, 0, 0)

struct RowCtx { float mu, rstd; };
__device__ __forceinline__ RowCtx ln_ctx(const float* st, int row) {
    const float sum = st[2 * (size_t)row], sq = st[2 * (size_t)row + 1];
    RowCtx rc; rc.mu = sum * (1.0f / 1024.0f); const float var = fmaxf(sq * (1.0f / 1024.0f) - rc.mu * rc.mu, 0.f); rc.rstd = 1.0f / sqrtf(var + 1e-5f); return rc;
}
struct NoCtx {};
struct EpInAB {
    static constexpr bool MAKES_STATS = false; static constexpr int BATCH = 8;
    typedef NoCtx ColCtx; typedef NoCtx Pre;
    bf16_t* O;
    __device__ __forceinline__ ColCtx col_ctx(int) const { return NoCtx{}; }
    template <bool META> __device__ __forceinline__ Pre pre(int, int) const { return NoCtx{}; }
    __device__ __forceinline__ RowCtx row_ctx(int) const { return RowCtx{0.f, 1.f}; }
    __device__ __forceinline__ float* st_ptr() const { return nullptr; }
    __device__ __forceinline__ void apply8(int row, int col, f32x4 a, f32x4 b, const RowCtx&, const ColCtx&, const Pre&, float&, float&) const {
        const float s = (col >= 512 && col < 1024) ? QSCALE : 1.0f;
        u32x4 w; w.x = pk2(a[0] * s, a[1] * s); w.y = pk2(a[2] * s, a[3] * s); w.z = pk2(b[0] * s, b[1] * s); w.w = pk2(b[2] * s, b[3] * s);
        *(u32x4*)(O + (size_t)row * 2048 + col) = w;
    }
};
struct EpGlu {
    static constexpr bool MAKES_STATS = false; static constexpr int BATCH = 4;
    struct ColCtx { f32x4 b0, b1; }; struct Pre { u32x4 ap; };
    const bf16_t* APRE; const float* bias; bf16_t* CAT;
    __device__ __forceinline__ ColCtx col_ctx(int col) const { return ColCtx{*(const f32x4*)(bias + col), *(const f32x4*)(bias + col + 4)}; }
    template <bool META> __device__ __forceinline__ Pre pre(int row, int col) const { return Pre{*(const u32x4*)((const char*)APRE + ((unsigned)row * 1024u + (unsigned)col * 2u))}; }
    __device__ __forceinline__ RowCtx row_ctx(int) const { return RowCtx{0.f, 1.f}; }
    __device__ __forceinline__ float* st_ptr() const { return nullptr; }
    __device__ __forceinline__ void apply8(int row, int col, f32x4 a, f32x4 b, const RowCtx&, const ColCtx& cc, const Pre& pr, float&, float&) const {
        const u32x4 ap = pr.ap;
        float v[8] = {a[0] + cc.b0[0], a[1] + cc.b0[1], a[2] + cc.b0[2], a[3] + cc.b0[3], b[0] + cc.b1[0], b[1] + cc.b1[1], b[2] + cc.b1[2], b[3] + cc.b1[3]};
        float y[8] = {bflo(ap.x), bfhi(ap.x), bflo(ap.y), bfhi(ap.y), bflo(ap.z), bfhi(ap.z), bflo(ap.w), bfhi(ap.w)};
#pragma unroll
        for (int i = 0; i < 8; ++i) y[i] = y[i] * sigmoidf_(v[i]);
        u32x4 w; w.x = pk2(y[0], y[1]); w.y = pk2(y[2], y[3]); w.z = pk2(y[4], y[5]); w.w = pk2(y[6], y[7]);
        *(u32x4*)(CAT + (size_t)row * 1024 + col) = w;
    }
};
template <int NB_> struct EpRes {
    static constexpr bool MAKES_STATS = true; static constexpr int BATCH = NB_;
    struct ColCtx { f32x4 ag0, ag1, ab0, ab1; }; struct Pre { u32x4 h; };
    bf16_t* HBp; const float* bias;
    const float* st_prev; const float* g; const float* bta; float* st_out;
    __device__ __forceinline__ ColCtx col_ctx(int col) const {
        ColCtx c; const f32x4 one = {1.f, 1.f, 1.f, 1.f}, zero = {0.f, 0.f, 0.f, 0.f};
        const f32x4 g0 = st_prev ? *(const f32x4*)(g + col) : one, g1 = st_prev ? *(const f32x4*)(g + col + 4) : one;
        const f32x4 t0 = st_prev ? *(const f32x4*)(bta + col) : zero, t1 = st_prev ? *(const f32x4*)(bta + col + 4) : zero;
        const f32x4 b0 = bias ? *(const f32x4*)(bias + col) : zero, b1 = bias ? *(const f32x4*)(bias + col + 4) : zero;
        c.ag0 = g0 * ALPHA; c.ag1 = g1 * ALPHA; c.ab0 = t0 * ALPHA + b0; c.ab1 = t1 * ALPHA + b1; return c;
    }
    template <bool META> __device__ __forceinline__ Pre pre(int row, int col) const { return Pre{*(const u32x4*)((const char*)HBp + ((unsigned)row * 2048u + (unsigned)col * 2u))}; }
    __device__ __forceinline__ RowCtx row_ctx(int row) const { return st_prev ? ln_ctx(st_prev, row) : RowCtx{0.f, 1.f}; }
    __device__ __forceinline__ float* st_ptr() const { return st_out; }
    __device__ __forceinline__ void apply8(int row, int col, f32x4 a, f32x4 b, const RowCtx& rc, const ColCtx& cc, const Pre& pr, float& s, float& q) const {
        const f32x4 h0 = {bflo(pr.h.x), bfhi(pr.h.x), bflo(pr.h.y), bfhi(pr.h.y)}, h1 = {bflo(pr.h.z), bfhi(pr.h.z), bflo(pr.h.w), bfhi(pr.h.w)};
        const f32x4 o0 = (h0 - rc.mu) * rc.rstd * cc.ag0 + cc.ab0 + a, o1 = (h1 - rc.mu) * rc.rstd * cc.ag1 + cc.ab1 + b;
        u32x4 w; w.x = pk2(o0[0], o0[1]); w.y = pk2(o0[2], o0[3]); w.z = pk2(o1[0], o1[1]); w.w = pk2(o1[2], o1[3]);
        *(u32x4*)((char*)HBp + ((unsigned)row * 2048u + (unsigned)col * 2u)) = w;
        s += ((o0[0] + o0[1]) + (o0[2] + o0[3])) + ((o1[0] + o1[1]) + (o1[2] + o1[3]));
        q += ((o0[0] * o0[0] + o0[1] * o0[1]) + (o0[2] * o0[2] + o0[3] * o0[3])) + ((o1[0] * o1[0] + o1[1] * o1[1]) + (o1[2] * o1[2] + o1[3] * o1[3]));
    }
};
struct EpUp {
    static constexpr bool MAKES_STATS = false; static constexpr int BATCH = 8;
    struct ColCtx { f32x4 s0, s1, t0, t1; }; typedef NoCtx Pre;
    bf16_t* H; const float* bias; const float* st_prev; const float* sv; const float* tv;
    __device__ __forceinline__ ColCtx col_ctx(int col) const {
        return ColCtx{*(const f32x4*)(sv + col), *(const f32x4*)(sv + col + 4), *(const f32x4*)(tv + col) + *(const f32x4*)(bias + col), *(const f32x4*)(tv + col + 4) + *(const f32x4*)(bias + col + 4)};
    }
    template <bool META> __device__ __forceinline__ Pre pre(int, int) const { return NoCtx{}; }
    __device__ __forceinline__ RowCtx row_ctx(int row) const { return ln_ctx(st_prev, row); }
    __device__ __forceinline__ float* st_ptr() const { return nullptr; }
    __device__ __forceinline__ void apply8(int row, int col, f32x4 a, f32x4 b, const RowCtx& rc, const ColCtx& cc, const Pre&, float&, float&) const {
        f32x4 v0 = (a - rc.mu * cc.s0) * rc.rstd + cc.t0, v1 = (b - rc.mu * cc.s1) * rc.rstd + cc.t1;
#pragma unroll
        for (int i = 0; i < 4; ++i) { v0[i] = fmaxf(v0[i], 0.f); v0[i] *= v0[i]; v1[i] = fmaxf(v1[i], 0.f); v1[i] *= v1[i]; }
        u32x4 w; w.x = pk2(v0[0], v0[1]); w.y = pk2(v0[2], v0[3]); w.z = pk2(v1[0], v1[1]); w.w = pk2(v1[2], v1[3]);
        *(u32x4*)(H + (size_t)row * 4096 + col) = w;
    }
};
struct EpInC {
    static constexpr bool MAKES_STATS = false; static constexpr int BATCH = 8;
    struct ColCtx { f32x4 s0, s1, t0, t1, lb0, lb1; }; typedef NoCtx Pre;
    unsigned short* PC; const float* gamma; const float* st_prev; const float* sv; const float* tv;
    __device__ __forceinline__ ColCtx col_ctx(int col) const {
        ColCtx c{*(const f32x4*)(sv + col), *(const f32x4*)(sv + col + 4), *(const f32x4*)(tv + col), *(const f32x4*)(tv + col + 4), {0.f, 0.f, 0.f, 0.f}, {0.f, 0.f, 0.f, 0.f}};
        if (col >= 1024 && col < 2048) {
            const f32x4 ga = *(const f32x4*)(gamma + col - 1024), gb = *(const f32x4*)(gamma + col - 1020), gc = *(const f32x4*)(gamma + col), gd = *(const f32x4*)(gamma + col + 4);
#pragma unroll
            for (int i = 0; i < 4; ++i) { c.lb0[i] = 1.0f / (1.0f + __expf(ga[i] - gc[i])); c.lb1[i] = 1.0f / (1.0f + __expf(gb[i] - gd[i])); }
        }
        return c;
    }
    template <bool META> __device__ __forceinline__ Pre pre(int, int) const { return NoCtx{}; }
    __device__ __forceinline__ RowCtx row_ctx(int row) const { return ln_ctx(st_prev, row); }
    __device__ __forceinline__ float* st_ptr() const { return nullptr; }
    __device__ __forceinline__ void apply8(int row, int col, f32x4 a, f32x4 b, const RowCtx& rc, const ColCtx& cc, const Pre&, float&, float&) const {
        a = (a - rc.mu * cc.s0) * rc.rstd + cc.t0;
        b = (b - rc.mu * cc.s1) * rc.rstd + cc.t1;
        u32x4 w;
        if (col >= 1024 && col < 2048) {
            float v[8] = {a[0], a[1], a[2], a[3], b[0], b[1], b[2], b[3]};
            float lb[8] = {cc.lb0[0], cc.lb0[1], cc.lb0[2], cc.lb0[3], cc.lb1[0], cc.lb1[1], cc.lb1[2], cc.lb1[3]};
            unsigned short h[8];
#pragma unroll
            for (int i = 0; i < 8; ++i) {
                const float f = lb[i] + (1.0f - lb[i]) * sigmoidf_(v[i]);
                const _Float16 hf = (_Float16)__logf(f);
                h[i] = __builtin_bit_cast(unsigned short, hf);
            }
            w.x = h[0] | ((unsigned)h[1] << 16); w.y = h[2] | ((unsigned)h[3] << 16); w.z = h[4] | ((unsigned)h[5] << 16); w.w = h[6] | ((unsigned)h[7] << 16);
        } else { w.x = pk2(a[0], a[1]); w.y = pk2(a[2], a[3]); w.z = pk2(b[0], b[1]); w.w = pk2(b[2], b[3]); }
        *(u32x4*)(PC + (size_t)row * 4096 + col) = w;
    }
};
template <class F> struct EpiAdapt {
    static constexpr bool PERM = true, AFTER_DRAIN = false; F f;
    __device__ __forceinline__ void operator()(const f32x4 (&acc)[2][2][4][2], const pg8::Unit& u, int wr, int wc, int, int) const {
        const int lane_ = lane_id_v(), fr = lane_ & 15, fq = lane_ >> 4;
        const int col0 = u.pn * 256 + wc * 32 + 8 * fq, row0 = u.pm * 256 + wr * 64 + fr;
        constexpr int NB = F::BATCH;
#pragma unroll
        for (int bt = 0; bt < 8 / NB; ++bt) {
            const typename F::ColCtx cc[2] = {f.col_ctx(col0), f.col_ctx(col0 + 128)};
            RowCtx rc[NB];
            typename F::Pre pr[NB][2];
#pragma unroll
            for (int i = 0; i < NB; ++i) { const int r8 = bt * NB + i, row = row0 + (r8 >> 2) * 128 + (r8 & 3) * 16;
                rc[i] = f.row_ctx(row); pr[i][0] = f.template pre<false>(row, col0); pr[i][1] = f.template pre<false>(row, col0 + 128); }
#pragma unroll
            for (int i = 0; i < NB; ++i) { const int r8 = bt * NB + i, ai = r8 >> 2, m = r8 & 3, row = row0 + ai * 128 + m * 16;
                float s = 0.f, q = 0.f;
                f.apply8(row, col0, acc[ai][0][m][0], acc[ai][0][m][1], rc[i], cc[0], pr[i][0], s, q);
                f.apply8(row, col0 + 128, acc[ai][1][m][0], acc[ai][1][m][1], rc[i], cc[1], pr[i][1], s, q);
                if (F::MAKES_STATS) {
                    s += __shfl_xor(s, 16); s += __shfl_xor(s, 32); q += __shfl_xor(q, 16); q += __shfl_xor(q, 32);
                    if (fq == 0) { float* st = (float*)((char*)f.st_ptr() + (unsigned)row * 8u); unsafeAtomicAdd(st, s); unsafeAtomicAdd(st + 1, q); }
                }
            }
            asm volatile("" ::: "memory");
        }
    }
};
template <class F> __device__ __forceinline__ void meta_gemm(const bf16_t* A16  , const bf16_t* Bt, int N, int K, const F& f, int blk, int G, int wave, int lane) {
    const int l15 = lane & 15, quad = lane >> 4;
    for (int item = blk + G * wave; item < N / 32; item += G * 8) {
        const int c0 = item * 32;
        const bf16_t* ap = A16 + (size_t)l15 * K + 8 * quad;
        const bf16_t* w0 = Bt + (size_t)(c0 + 8 * (l15 >> 2) + (l15 & 3)) * K + 8 * quad;
        const bf16_t* w1 = w0 + (size_t)4 * K;
        f32x4 acc0 = {0.f, 0.f, 0.f, 0.f}, acc1 = {0.f, 0.f, 0.f, 0.f};
#pragma unroll 8
        for (int k = 0; k < K; k += 32) {
            const bf16x8 xa = *(const bf16x8*)(ap + k), b0 = *(const bf16x8*)(w0 + k), b1 = *(const bf16x8*)(w1 + k);
            acc0 = MFMA16(b0, xa, acc0); acc1 = MFMA16(b1, xa, acc1);
        }
        const RowCtx rc = f.row_ctx(T + l15);
        const typename F::ColCtx cc = f.col_ctx(c0 + 8 * quad);
        const typename F::Pre pr = f.template pre<true>(T + l15, c0 + 8 * quad);
        float s = 0.f, q = 0.f;
        f.apply8(T + l15, c0 + 8 * quad, acc0, acc1, rc, cc, pr, s, q);
        if (F::MAKES_STATS) {
            s += __shfl_xor(s, 16); s += __shfl_xor(s, 32); q += __shfl_xor(q, 16); q += __shfl_xor(q, 32);
            if (quad == 0) { float* st = f.st_ptr() + 2 * (size_t)(T + l15); unsafeAtomicAdd(st, s); unsafeAtomicAdd(st + 1, q); }
        }
    }
}
template <class F> __device__ __forceinline__ void run_gemm(LAS unsigned char* lds, const bf16_t* A, const bf16_t* Bt, int N, int K, const F& f, bool with_meta, int blk, int G, int wave) {
    pg8::Gemm g{A, Bt, T, N, K}; pg8::StaticOrder S; S.init(T, N, G, blk);
    EpiAdapt<F> E{f};
    pg8::gemm_phase<EpiAdapt<F>, pg8::StaticOrder, true, true>((PG8_LAS unsigned char*)lds, g, S, E, wave);
    if (with_meta) meta_gemm<F>(A + (size_t)T * K, Bt, N, K, f, blk, G, wave, lane_id_v());
}

__device__ __forceinline__ void transpose_item(const float* W, int K, int N, bf16_t* WT, LAS float* scr, int item, int lane) {
    const int nblk = N / 32, kb = item / nblk, nb = item % nblk, k0 = 64 * kb, n0 = 32 * nb;
    float wv_[32];
#pragma unroll
    for (int i = 0; i < 32; ++i) wv_[i] = W[(size_t)(k0 + 2 * i + (lane >> 5)) * N + n0 + (lane & 31)];
#pragma unroll
    for (int i = 0; i < 32; ++i) scr[(2 * i + (lane >> 5)) * 33 + (lane & 31)] = wv_[i];
    LDS_WAIT();
    const int c = lane & 7;
#pragma unroll
    for (int j = 0; j < 4; ++j) { const int n = (lane >> 3) + 8 * j; const LAS float* s = scr + (8 * c) * 33 + n;
        u32x4 o; o.x = pk2(s[0 * 33], s[1 * 33]); o.y = pk2(s[2 * 33], s[3 * 33]); o.z = pk2(s[4 * 33], s[5 * 33]); o.w = pk2(s[6 * 33], s[7 * 33]);
        *(u32x4*)(WT + (size_t)(n0 + n) * K + k0 + 8 * c) = o; }
    LDS_WAIT();
}
__device__ __forceinline__ void transpose_item_fold(const float* W, int K, int N, bf16_t* WT, LAS float* scr, int item, int lane, const float* g, const float* bta, float* sv, float* tv) {
    const int nblk = N / 32, kb = item / nblk, nb = item % nblk, k0 = 64 * kb, n0 = 32 * nb;
    float wv_[32];
#pragma unroll
    for (int i = 0; i < 32; ++i) wv_[i] = W[(size_t)(k0 + 2 * i + (lane >> 5)) * N + n0 + (lane & 31)];
#pragma unroll
    for (int i = 0; i < 32; ++i) scr[(2 * i + (lane >> 5)) * 33 + (lane & 31)] = wv_[i];
    LDS_WAIT();
    const int c = lane & 7;
    const f32x4 g0 = *(const f32x4*)(g + k0 + 8 * c), g1 = *(const f32x4*)(g + k0 + 8 * c + 4), b0 = *(const f32x4*)(bta + k0 + 8 * c), b1 = *(const f32x4*)(bta + k0 + 8 * c + 4);
#pragma unroll
    for (int j = 0; j < 4; ++j) { const int n = (lane >> 3) + 8 * j; const LAS float* s = scr + (8 * c) * 33 + n;
        const float w0 = s[0 * 33], w1 = s[1 * 33], w2 = s[2 * 33], w3 = s[3 * 33], w4 = s[4 * 33], w5 = s[5 * 33], w6 = s[6 * 33], w7 = s[7 * 33];
        u32x4 o; o.x = pk2(g0[0] * w0, g0[1] * w1); o.y = pk2(g0[2] * w2, g0[3] * w3); o.z = pk2(g1[0] * w4, g1[1] * w5); o.w = pk2(g1[2] * w6, g1[3] * w7);
        *(u32x4*)(WT + (size_t)(n0 + n) * K + k0 + 8 * c) = o;
        float ss = ((bflo(o.x) + bfhi(o.x)) + (bflo(o.y) + bfhi(o.y))) + ((bflo(o.z) + bfhi(o.z)) + (bflo(o.w) + bfhi(o.w)));
        float tt = ((b0[0] * w0 + b0[1] * w1) + (b0[2] * w2 + b0[3] * w3)) + ((b1[0] * w4 + b1[1] * w5) + (b1[2] * w6 + b1[3] * w7));
        ss += __shfl_xor(ss, 1); ss += __shfl_xor(ss, 2); ss += __shfl_xor(ss, 4);
        tt += __shfl_xor(tt, 1); tt += __shfl_xor(tt, 2); tt += __shfl_xor(tt, 4);
        if (c == 0) { unsafeAtomicAdd(sv + n0 + n, ss); unsafeAtomicAdd(tv + n0 + n, tt); } }
    LDS_WAIT();
}
__device__ __forceinline__ void weight_items(const Params& P, LAS float* scr, int gw, int NGW, int lane, int part) {
    unsigned char* ws = P.ws;
    constexpr int I_AB = 16 * 64, I_GLU = 8 * 16, I_1M = 16 * 32, I_C = 16 * 128, I_UP = 16 * 128, I_DN = 64 * 32;
    constexpr int NREST = I_GLU + I_1M + I_C + I_1M + 2 * I_UP + 2 * I_DN;
    if (part == 0) { for (int it = gw; it < I_AB; it += NGW) transpose_item(P.in[2], 1024, 2048, (bf16_t*)(ws + OFF_WAB), scr, it, lane); return; }
    for (int it = gw; it < NREST; it += NGW) {
        int r = it;
        if (r < I_GLU) { transpose_item(P.in[11], 512, 512, (bf16_t*)(ws + OFF_WGLU), scr, r, lane); continue; } r -= I_GLU;
        if (r < I_1M) { transpose_item(P.in[13], 1024, 1024, (bf16_t*)(ws + OFF_WOAB), scr, r, lane); continue; } r -= I_1M;
        if (r < I_UP) { transpose_item_fold(P.in[20], 1024, 4096, (bf16_t*)(ws + OFF_WUP0), scr, r, lane, P.in[18], P.in[19], (float*)(ws + OFF_SV), (float*)(ws + OFF_TV)); continue; } r -= I_UP;
        if (r < I_DN) { transpose_item(P.in[22], 4096, 1024, (bf16_t*)(ws + OFF_WDN0), scr, r, lane); continue; } r -= I_DN;
        if (r < I_C) { transpose_item_fold(P.in[14], 1024, 4096, (bf16_t*)(ws + OFF_WC), scr, r, lane, P.in[24], P.in[25], (float*)(ws + OFF_SV) + 4096, (float*)(ws + OFF_TV) + 4096); continue; } r -= I_C;
        if (r < I_1M) { transpose_item(P.in[17], 1024, 1024, (bf16_t*)(ws + OFF_WOC), scr, r, lane); continue; } r -= I_1M;
        if (r < I_UP) { transpose_item_fold(P.in[20] + (size_t)1024 * 4096, 1024, 4096, (bf16_t*)(ws + OFF_WUP1), scr, r, lane, P.in[18] + 1024, P.in[19] + 1024, (float*)(ws + OFF_SV) + 8192, (float*)(ws + OFF_TV) + 8192); continue; } r -= I_UP;
        transpose_item(P.in[22] + (size_t)4096 * 1024, 4096, 1024, (bf16_t*)(ws + OFF_WDN1), scr, r, lane);
    }
}
__device__ __forceinline__ void prologue_phase(const Params& P, LAS unsigned char* lds, int blk, int G, int wave) {
    const int lane = lane_id_v(), tid = wave * 64 + lane;
    unsigned char* ws = P.ws;
    weight_items(P, (LAS float*)(lds + wave * 8448), blk * 8 + wave, G * 8, lane, 0);
    bf16_t* HB = (bf16_t*)(ws + OFF_HB);
    const size_t n8 = (size_t)R * 1024 / 8;
#pragma unroll 4
    for (size_t i = (size_t)blk * 512 + tid; i < n8; i += (size_t)G * 512) {
        const size_t e = i * 8;
        const float* src = e < (size_t)T * 1024 ? P.in[0] + e : P.in[1] + (e - (size_t)T * 1024);
        const f32x4 a = *(const f32x4*)src, b = *(const f32x4*)(src + 4);
        u32x4 w; w.x = pk2(a[0], a[1]); w.y = pk2(a[2], a[3]); w.z = pk2(b[0], b[1]); w.w = pk2(b[2], b[3]);
        *(u32x4*)(HB + e) = w;
    }
}

__device__ __forceinline__ void ln_phase(const float* Zin, float* Fout, bf16_t* Bout, const float* g, const float* bta, int nrows, int blk, int G, int wave) {
    const int lane = lane_id_v();
    for (int row = blk * 8 + wave; row < nrows; row += G * 8) {
        const f32x4* xr = (const f32x4*)(Zin + (size_t)row * 1024) + lane;
        f32x4 v[4]; float s = 0.f;
#pragma unroll
        for (int j = 0; j < 4; ++j) { v[j] = xr[64 * j]; s += (v[j][0] + v[j][1]) + (v[j][2] + v[j][3]); }
#pragma unroll
        for (int o = 1; o < 64; o <<= 1) s += __shfl_xor(s, o);
        const float mean = s * (1.f / 1024.f); float s2 = 0.f;
#pragma unroll
        for (int j = 0; j < 4; ++j) { v[j] = v[j] - mean; s2 += (v[j][0] * v[j][0] + v[j][1] * v[j][1]) + (v[j][2] * v[j][2] + v[j][3] * v[j][3]); }
#pragma unroll
        for (int o = 1; o < 64; o <<= 1) s2 += __shfl_xor(s2, o);
        const float rstd = 1.0f / sqrtf(s2 * (1.f / 1024.f) + 1e-5f);
#pragma unroll
        for (int j = 0; j < 4; ++j) {
            const int col = 4 * (lane + 64 * j);
            const f32x4 gg = *(const f32x4*)(g + col), bb = *(const f32x4*)(bta + col);
            const f32x4 o = v[j] * rstd * gg + bb;
            *(f32x4*)(Fout + (size_t)row * 1024 + col) = o;
            if (Bout) { u32x2 w; w.x = pk2(o[0], o[1]); w.y = pk2(o[2], o[3]); *(u32x2*)(Bout + (size_t)row * 1024 + col) = w; }
        }
    }
}

__device__ __forceinline__ void final_ln_phase(const bf16_t* Zb, const float* st, float* out, const float* g, const float* bta, int blk, int G, int wave) {
    const int lane = lane_id_v();
    for (int row0 = (blk * 8 + wave) * 4; row0 < T; row0 += G * 8 * 4) {
        u32x4 v[4][2];
#pragma unroll
        for (int rr = 0; rr < 4; ++rr)
#pragma unroll
            for (int j = 0; j < 2; ++j) v[rr][j] = *(const u32x4*)((const char*)Zb + ((unsigned)(row0 + rr) * 2048u + (unsigned)(8 * (lane + 64 * j)) * 2u));
#pragma unroll
        for (int rr = 0; rr < 4; ++rr) {
            const int row = row0 + rr;
            const RowCtx rc = ln_ctx(st, row);
#pragma unroll
            for (int j = 0; j < 2; ++j) {
                const int col = 8 * (lane + 64 * j);
                const f32x4 h0 = {bflo(v[rr][j].x), bfhi(v[rr][j].x), bflo(v[rr][j].y), bfhi(v[rr][j].y)}, h1 = {bflo(v[rr][j].z), bfhi(v[rr][j].z), bflo(v[rr][j].w), bfhi(v[rr][j].w)};
                float* op = out + (size_t)row * 1024 + col;
                *(f32x4*)op = (h0 - rc.mu) * rc.rstd * *(const f32x4*)(g + col) + *(const f32x4*)(bta + col);
                *(f32x4*)(op + 4) = (h1 - rc.mu) * rc.rstd * *(const f32x4*)(g + col + 4) + *(const f32x4*)(bta + col + 4);
            }
        }
    }
}

__device__ __forceinline__ void lam_coef(const float* lam_re, const float* lam_im, float dt, int idx, float& lbr, float& lbi, float& cr, float& ci) {
    const float lr = lam_re[idx], li = lam_im[idx];
    const float er = __expf(lr * dt);
    float ang = li * dt;
    const float kk = rintf(ang * 0.15915494309189535f);
    ang = fmaf(-kk, 6.2831854820251465f, ang); ang = fmaf(-kk, -1.7484555e-7f, ang);
    lbr = er * __cosf(ang); lbi = er * __sinf(ang);
    const float nr = lbr - 1.0f, ni = lbi, den = 1.0f / (lr * lr + li * li);
    cr = (nr * lr + ni * li) * den; ci = (ni * lr - nr * li) * den;
}
__device__ __forceinline__ void s5_phase(const Params& P, LAS unsigned char* lds, int blk, int G, int wave) {
    const int lane = lane_id_v(), l15 = lane & 15, quad = lane >> 4;
    LAS float* bu = (LAS float*)(lds + wave * 12800);
    LAS unsigned* sl = (LAS unsigned*)(lds + wave * 12800 + 8448);
    const bf16_t* PROJ = (const bf16_t*)(P.ws + OFF_BIG + BIG_PROJ);
    bf16_t* APRE = (bf16_t*)(P.ws + OFF_BIG + BIG_APRE);
    for (int item = blk + G * wave; item < 512; item += G * 8) {
        const int b = item >> 5, g = item & 31;
        const float dt = __expf(P.in[5][g]);
        float lbr, lbi, cr_, ci_;
        lam_coef(P.in[3], P.in[4], dt, g * 64 + lane, lbr, lbi, cr_, ci_);
        bf16x8 bfrag[8];
#pragma unroll
        for (int tile = 0; tile < 8; ++tile) {
            const int comp = 16 * tile + l15, st = comp & 63, isim = comp >> 6;
            float a0, a1, cr, ci; lam_coef(P.in[3], P.in[4], dt, g * 64 + st, a0, a1, cr, ci);
            bf16x8 fr = {0, 0, 0, 0, 0, 0, 0, 0};
            if (quad < 2) {
                const float* bre = P.in[6] + (size_t)(g * 64 + st) * 16 + 8 * quad;
                const float* bim = P.in[7] + (size_t)(g * 64 + st) * 16 + 8 * quad;
#pragma unroll
                for (int j = 0; j < 8; ++j) { const float v = isim ? (cr * bim[j] + ci * bre[j]) : (cr * bre[j] - ci * bim[j]); fr[j] = (short)f2bf(v); }
            }
            bfrag[tile] = fr;
        }
        bf16x8 cfrag[4];
#pragma unroll
        for (int ks = 0; ks < 4; ++ks) {
#pragma unroll
            for (int j = 0; j < 8; ++j) {
                const int k = 32 * ks + 8 * quad + j, p = k >> 1;
                const float v = (k & 1) ? -P.in[9][(size_t)(g * 16 + l15) * 64 + p] : P.in[8][(size_t)(g * 16 + l15) * 64 + p];
                cfrag[ks][j] = (short)f2bf(v);
            }
        }
        const float dh = P.in[10][g * 16 + l15];
        float sr = 0.f, si = 0.f;
        const bf16x8 zero8 = {0, 0, 0, 0, 0, 0, 0, 0};
        bf16x8 ua_n = *(const bf16x8*)(PROJ + (size_t)(T + l15) * 2048 + g * 16 + 8 * (quad & 1));
        unsigned short ue_n[4];
#pragma unroll
        for (int r = 0; r < 4; ++r) ue_n[r] = PROJ[(size_t)(T + 4 * quad + r) * 2048 + g * 16 + l15];
        for (int chunk = 0; chunk < 129; ++chunk) {
            const int rowbase = chunk == 0 ? T : b * 2048 + (chunk - 1) * 16;
            const bf16x8 ua = quad < 2 ? ua_n : zero8;
            unsigned short ue[4];
#pragma unroll
            for (int r = 0; r < 4; ++r) ue[r] = ue_n[r];
            {
                const int cn = chunk + 1 < 129 ? chunk + 1 : 128;
                const int rbn = b * 2048 + (cn - 1) * 16;
                ua_n = *(const bf16x8*)(PROJ + (size_t)(rbn + l15) * 2048 + g * 16 + 8 * (quad & 1));
#pragma unroll
                for (int r = 0; r < 4; ++r) ue_n[r] = PROJ[(size_t)(rbn + 4 * quad + r) * 2048 + g * 16 + l15];
            }
#pragma unroll
            for (int tile = 0; tile < 8; ++tile) {
                f32x4 acc = {0.f, 0.f, 0.f, 0.f};
                acc = MFMA16(ua, bfrag[tile], acc);
#pragma unroll
                for (int r = 0; r < 4; ++r) bu[(4 * quad + r) * 132 + 16 * tile + l15] = acc[r];
            }
            LDS_WAIT();
#pragma unroll
            for (int t = 0; t < 16; ++t) {
                const float br = bu[t * 132 + lane], bi = bu[t * 132 + 64 + lane];
                const float nsr = fmaf(lbr, sr, fmaf(-lbi, si, br)), nsi = fmaf(lbr, si, fmaf(lbi, sr, bi));
                sr = nsr; si = nsi;
                sl[t * 68 + lane] = pk2(sr, si);
            }
            LDS_WAIT();
            f32x4 y = {0.f, 0.f, 0.f, 0.f};
#pragma unroll
            for (int ks = 0; ks < 4; ++ks) {
                const bf16x8 sa = *(const LAS bf16x8*)((const LAS bf16_t*)sl + l15 * 136 + 32 * ks + 8 * quad);
                y = MFMA16(sa, cfrag[ks], y);
            }
            if (chunk > 0 || b == 0) {
#pragma unroll
                for (int r = 0; r < 4; ++r) {
                    const size_t row = (size_t)(rowbase + 4 * quad + r);
                    const float u = bf2f(ue[r]);
                    const float v = y[r] + dh * u;
                    const float a2 = 1.5957691216057308f * (v + 0.044715f * v * v * v);
                    APRE[row * 512 + g * 16 + l15] = f2bf(v * sigmoidf_(a2));
                }
            }
            LDS_WAIT();
        }
    }
}

template <bool MASKED>
__device__ __forceinline__ void attn_tile_sub(const LAS bf16_t* Kl, const LAS bf16_t* Vl, const bf16x8 (&qf)[4], int sub, int keybase  ,
                                              int iq, int l31, int h, bool pick0, f32x16& o0, f32x16& o1, float& Rrun) {
    bf16x8 ka[4];
#pragma unroll
    for (int s = 0; s < 4; ++s) ka[s] = *(const LAS bf16x8*)(Kl + (32 * sub + l31) * 72 + 16 * s + 8 * h);
    bf16x8 va[2][2];
#pragma unroll
    for (int s2 = 0; s2 < 2; ++s2)
#pragma unroll
        for (int mt = 0; mt < 2; ++mt) {
            const LAS bf16_t* vp = Vl + (32 * mt + l31) * 68 + 32 * sub + 16 * s2 + 4 * h;
            const s16x4 lo = *(const LAS s16x4*)vp, hi = *(const LAS s16x4*)(vp + 8);
            va[s2][mt] = __builtin_shufflevector(lo, hi, 0, 1, 2, 3, 4, 5, 6, 7);
        }
    __builtin_amdgcn_sched_barrier(0);
    f32x16 st;
#pragma unroll
    for (int i = 0; i < 16; ++i) st[i] = 0.f;
#pragma unroll
    for (int s = 0; s < 4; ++s) st = MFMA32(ka[s], qf[s], st);
    float kp[16], be[16];
#pragma unroll
    for (int i = 0; i < 16; ++i) {
        const float e = __builtin_amdgcn_exp2f(st[i]);
        float r = __builtin_amdgcn_rcpf(1.0f + e);
        if (MASKED) {
            const int kl = 32 * sub + (i & 3) + 8 * (i >> 2) + 4 * h;
            const bool vis = keybase >= 0 ? (keybase + kl < iq) : (kl < 16);
            r = vis ? r : 1.0f;
        }
        kp[i] = r; be[i] = 1.0f - r;
    }
    float ga[4], pa[4];
#pragma unroll
    for (int a = 0; a < 4; ++a) {
        ga[a] = (kp[4 * a] * kp[4 * a + 1]) * (kp[4 * a + 2] * kp[4 * a + 3]);
        const auto sw = __builtin_amdgcn_permlane32_swap(__float_as_uint(ga[a]), __float_as_uint(ga[a]), false, false);
        pa[a] = __uint_as_float(pick0 ? sw[0] : sw[1]);
    }
    float run = Rrun; float w[16];
#pragma unroll
    for (int a = 3; a >= 0; --a) {
        const float P3 = h ? run : run * pa[a];
        const float P2 = P3 * kp[4 * a + 3], P1 = P2 * kp[4 * a + 2], P0 = P1 * kp[4 * a + 1];
        w[4 * a + 3] = be[4 * a + 3] * P3; w[4 * a + 2] = be[4 * a + 2] * P2; w[4 * a + 1] = be[4 * a + 1] * P1; w[4 * a + 0] = be[4 * a + 0] * P0;
        run *= ga[a] * pa[a];
    }
    Rrun = run;
#pragma unroll
    for (int s2 = 0; s2 < 2; ++s2) {
        u32x4 pw; pw.x = pk2(w[8 * s2], w[8 * s2 + 1]); pw.y = pk2(w[8 * s2 + 2], w[8 * s2 + 3]); pw.z = pk2(w[8 * s2 + 4], w[8 * s2 + 5]); pw.w = pk2(w[8 * s2 + 6], w[8 * s2 + 7]);
        const bf16x8 pb = __builtin_bit_cast(bf16x8, pw);
        o0 = MFMA32(va[s2][0], pb, o0); o1 = MFMA32(va[s2][1], pb, o1);
    }
}
__device__ __forceinline__ void attn_phase(const Params& P, LAS unsigned char* lds, int blk, int G, int wave) {
    const int lane = lane_id_v(), tid = wave * 64 + lane, l31 = lane & 31, h = lane >> 5;
    const bf16_t* PROJ = (const bf16_t*)(P.ws + OFF_BIG + BIG_PROJ);
    bf16_t* CAT = (bf16_t*)(P.ws + OFF_BIG + BIG_CAT);
    if (blk == G - 1) {
        LAS float* wm = (LAS float*)(lds + 40960);
        if (tid < 128) {
            const int t = tid & 15, hd = tid >> 4;
            const bf16_t* qp = PROJ + (size_t)(T + t) * 2048 + 512 + hd * 64;
            float run = 1.f;
            for (int j = 15; j >= 0; --j) {
                float wv = 0.f;
                if (j < t) {
                    const bf16_t* kp = PROJ + (size_t)(T + j) * 2048 + 1024 + hd * 64;
                    float z = 0.f;
                    for (int d = 0; d < 64; ++d) z = fmaf(bf2f(qp[d]), bf2f(kp[d]), z);
                    const float r = __builtin_amdgcn_rcpf(1.0f + __builtin_amdgcn_exp2f(z));
                    wv = (1.0f - r) * run; run *= r;
                }
                wm[tid * 16 + j] = wv;
            }
        }
        __syncthreads();
        for (int idx = tid; idx < 16 * 512; idx += 512) {
            const int t = idx >> 9, c = idx & 511, hd = c >> 6;
            float o = 0.f;
            for (int j = 0; j < 16; ++j) o = fmaf(wm[(hd * 16 + t) * 16 + j], bf2f(PROJ[(size_t)(T + j) * 2048 + 1536 + c]), o);
            CAT[(size_t)(T + t) * 1024 + 512 + c] = f2bf(o);
        }
        __syncthreads();
    }
    bool pick0;
    { const auto hs = __builtin_amdgcn_permlane32_swap((unsigned)h, (unsigned)h, false, false); pick0 = hs[0] != (unsigned)h; }
    LAS bf16_t* Kl0 = (LAS bf16_t*)lds;
    LAS bf16_t* Vl0 = (LAS bf16_t*)(lds + 2 * 9216);
    const int lkey = tid >> 3, lpart = tid & 7;
    for (int j4 = 0; j4 < 4; ++j4) {
        const int item = blk + G * j4;
        if (item >= 1024) break;
        const int c = item % 256, jj = item / 256, bh = c >> 1, par = c & 1;
        const int qb = par == 0 ? (jj == 0 ? 7 : jj == 1 ? 0 : jj == 2 ? 4 : 3) : (jj == 0 ? 6 : jj == 1 ? 1 : jj == 2 ? 5 : 2);
        const int b = bh >> 3, hd = bh & 7;
        const int iq = 256 * qb + 32 * wave + l31;
        const size_t qrow = (size_t)b * 2048 + iq;
        bf16x8 qf[4];
#pragma unroll
        for (int s = 0; s < 4; ++s) qf[s] = *(const bf16x8*)(PROJ + qrow * 2048 + 512 + hd * 64 + 16 * s + 8 * h);
        f32x16 o0, o1;
#pragma unroll
        for (int i = 0; i < 16; ++i) { o0[i] = 0.f; o1[i] = 0.f; }
        float Rrun = 1.0f;
        const int nt = 4 * qb + 5;
        u32x4 kreg, vreg;
#define ATT_LOAD(it_) do { const int kt_ = 4 * qb + 3 - (it_); size_t row_; bool ok_ = true; \
            if (kt_ >= 0) row_ = (size_t)b * 2048 + 64 * kt_ + lkey; else { row_ = (size_t)T + lkey; ok_ = lkey < 16; } \
            if (ok_) { const bf16_t* p_ = PROJ + row_ * 2048 + 1024 + hd * 64 + lpart * 8; kreg = *(const u32x4*)p_; vreg = *(const u32x4*)(p_ + 512); } \
            else { kreg = (u32x4){0u, 0u, 0u, 0u}; vreg = kreg; } } while (0)
#define ATT_STORE(buf_) do { *(LAS u32x4*)(Kl0 + (buf_) * 4608 + lkey * 72 + lpart * 8) = kreg; \
            LAS bf16_t* vt_ = Vl0 + (buf_) * 4352 + (lpart * 8) * 68 + lkey; \
            vt_[0 * 68] = (bf16_t)(vreg.x & 0xffffu); vt_[1 * 68] = (bf16_t)(vreg.x >> 16); \
            vt_[2 * 68] = (bf16_t)(vreg.y & 0xffffu); vt_[3 * 68] = (bf16_t)(vreg.y >> 16); \
            vt_[4 * 68] = (bf16_t)(vreg.z & 0xffffu); vt_[5 * 68] = (bf16_t)(vreg.z >> 16); \
            vt_[6 * 68] = (bf16_t)(vreg.w & 0xffffu); vt_[7 * 68] = (bf16_t)(vreg.w >> 16); } while (0)
        ATT_LOAD(0); ATT_STORE(0);
        __syncthreads();
        int cur = 0;
        for (int it = 0; it < nt; ++it) {
            if (it + 1 < nt) ATT_LOAD(it + 1);
            const int kt = 4 * qb + 3 - it;
            const int keybase = kt >= 0 ? 64 * kt : -1;
            const int wq_end = 256 * qb + 32 * wave + 32;
            const LAS bf16_t* Kl = Kl0 + cur * 4608; const LAS bf16_t* Vl = Vl0 + cur * 4352;
            if (kt < 0) { attn_tile_sub<true>(Kl, Vl, qf, 0, -1, iq, l31, h, pick0, o0, o1, Rrun); }
            else {
                const int wq_beg = wq_end - 32;
                if (keybase + 64 <= wq_beg) { attn_tile_sub<false>(Kl, Vl, qf, 1, keybase, iq, l31, h, pick0, o0, o1, Rrun); attn_tile_sub<false>(Kl, Vl, qf, 0, keybase, iq, l31, h, pick0, o0, o1, Rrun); }
                else {
                    if (keybase + 32 < wq_end) attn_tile_sub<true>(Kl, Vl, qf, 1, keybase, iq, l31, h, pick0, o0, o1, Rrun);
                    if (keybase < wq_end) attn_tile_sub<true>(Kl, Vl, qf, 0, keybase, iq, l31, h, pick0, o0, o1, Rrun);
                }
            }
            if (it + 1 < nt) ATT_STORE(cur ^ 1);
            __syncthreads();
            cur ^= 1;
        }
        bf16_t* op = CAT + qrow * 1024 + 512 + hd * 64;
#pragma unroll
        for (int a = 0; a < 4; ++a) {
            u32x2 w0; w0.x = pk2(o0[4 * a], o0[4 * a + 1]); w0.y = pk2(o0[4 * a + 2], o0[4 * a + 3]);
            u32x2 w1; w1.x = pk2(o1[4 * a], o1[4 * a + 1]); w1.y = pk2(o1[4 * a + 2], o1[4 * a + 3]);
            *(u32x2*)(op + 8 * a + 4 * h) = w0; *(u32x2*)(op + 32 + 8 * a + 4 * h) = w1;
        }
    }
}

__device__ __forceinline__ void hgrn_phase(const Params& P, LAS unsigned char* lds, int blk, int G, int wave) {
    const int lane = lane_id_v(), tid = wave * 64 + lane, l15 = lane & 15, quad = lane >> 4;
    LAS bf16_t* qd = (LAS bf16_t*)lds;
    LAS bf16_t* kd = qd + 64 * 136;
    LAS bf16_t* klT = kd + 64 * 136;
    LAS bf16_t* vT = klT + 128 * 72;
    LAS bf16_t* sc = vT + 128 * 72;
    LAS float* ebl = (LAS float*)(sc + 64 * 72);
    LAS float* segtot = ebl + 128;
    LAS float* red = segtot + 1024;
    const unsigned short* PC = (const unsigned short*)(P.ws + OFF_BIG);
    bf16_t* MIXC = (bf16_t*)P.out;
    const float* ng = P.in[16];
    for (int item = blk; item < 128; item += G) {
        const int b = item >> 3, hd = item & 7;
        f32x4 Sacc[8];
#pragma unroll
        for (int i = 0; i < 8; ++i) Sacc[i] = (f32x4){0.f, 0.f, 0.f, 0.f};
        const int dp = tid & 63, sg = tid >> 6;
        unsigned lfc[8], qc[8], vc[8];
#define HG_OFF0(cc_) ((unsigned)((cc_) > 0 ? b * 2048 + ((cc_) - 1) * 64 + 8 * sg : T + (sg >= 6 ? 8 * (sg - 6) : 0)) * 8192u + (unsigned)(hd * 128 + 2 * dp) * 2u)
#define HG_LOAD(cc_, LF_, Q_, V_) do { const unsigned o0_ = HG_OFF0(cc_); _Pragma("unroll") for (int tt_ = 0; tt_ < 8; ++tt_) { const unsigned o_ = o0_ + (unsigned)tt_ * 8192u; \
            Q_[tt_] = *(const unsigned*)((const char*)PC + o_); LF_[tt_] = *(const unsigned*)((const char*)PC + o_ + 2048u); V_[tt_] = *(const unsigned*)((const char*)PC + o_ + 4096u); } } while (0)
        HG_LOAD(0, lfc, qc, vc);
        for (int c = 0; c < 33; ++c) {
            unsigned lfn[8], qn[8], vn[8];
            { const int cn = c + 1 < 33 ? c + 1 : 32; HG_LOAD(cn, lfn, qn, vn); }
            {
                float cs0[8], cs1[8]; float run0 = 0.f, run1 = 0.f;
#pragma unroll
                for (int tt = 0; tt < 8; ++tt) {
                    const bool ok = c > 0 || (8 * sg + tt) >= 48;
                    const float l0 = ok ? 1.4426950408889634f * (float)__builtin_bit_cast(_Float16, (unsigned short)(lfc[tt] & 0xffffu)) : 0.f;
                    const float l1 = ok ? 1.4426950408889634f * (float)__builtin_bit_cast(_Float16, (unsigned short)(lfc[tt] >> 16)) : 0.f;
                    run0 += l0; run1 += l1; cs0[tt] = run0; cs1[tt] = run1;
                }
                segtot[sg * 128 + 2 * dp] = run0; segtot[sg * 128 + 2 * dp + 1] = run1;
                __syncthreads();
                float off0 = 0.f, off1 = 0.f, bl0 = 0.f, bl1 = 0.f;
#pragma unroll
                for (int s2 = 0; s2 < 8; ++s2) {
                    const float a0 = segtot[s2 * 128 + 2 * dp], a1 = segtot[s2 * 128 + 2 * dp + 1];
                    bl0 += a0; bl1 += a1; if (s2 < sg) { off0 += a0; off1 += a1; }
                }
                const float ebl0 = __builtin_amdgcn_exp2f(bl0), ebl1 = __builtin_amdgcn_exp2f(bl1);
                if (sg == 7) { ebl[2 * dp] = ebl0; ebl[2 * dp + 1] = ebl1; }
                float eip0 = __builtin_amdgcn_exp2f(-off0), eip1 = __builtin_amdgcn_exp2f(-off1);
                unsigned kl0[4], kl1[4], v0[4], v1[4];
#pragma unroll
                for (int tp = 0; tp < 4; ++tp) {
                    float klv0[2], klv1[2];
#pragma unroll
                    for (int e = 0; e < 2; ++e) {
                        const int tt = 2 * tp + e, t = 8 * sg + tt;
                        const bool ok = c > 0 || t >= 48;
                        const float bt0 = off0 + cs0[tt], bt1 = off1 + cs1[tt];
                        const float q0 = ok ? bflo(qc[tt]) : 0.f, q1 = ok ? bfhi(qc[tt]) : 0.f;
                        const float eb0 = __builtin_amdgcn_exp2f(bt0), eb1 = __builtin_amdgcn_exp2f(bt1);
                        const float ei0 = __builtin_amdgcn_rcpf(eb0), ei1 = __builtin_amdgcn_rcpf(eb1);
                        const float k0 = 1.0f - eb0 * eip0, k1 = 1.0f - eb1 * eip1;
                        eip0 = ei0; eip1 = ei1;
                        const float kd0 = k0 * ei0, kd1 = k1 * ei1;
                        *(LAS unsigned*)(qd + t * 136 + 2 * dp) = pk2(q0 * eb0, q1 * eb1);
                        *(LAS unsigned*)(kd + t * 136 + 2 * dp) = pk2(kd0, kd1);
                        klv0[e] = kd0 * ebl0; klv1[e] = kd1 * ebl1;
                    }
                    kl0[tp] = pk2(klv0[0], klv0[1]); kl1[tp] = pk2(klv1[0], klv1[1]);
                    const bool okA = c > 0 || (8 * sg + 2 * tp) >= 48, okB = c > 0 || (8 * sg + 2 * tp + 1) >= 48;
                    const unsigned va = okA ? vc[2 * tp] : 0u, vb = okB ? vc[2 * tp + 1] : 0u;
                    v0[tp] = (va & 0xffffu) | (vb << 16); v1[tp] = (va >> 16) | (vb & 0xffff0000u);
                }
                *(LAS u32x4*)(klT + (2 * dp) * 72 + 8 * sg) = (u32x4){kl0[0], kl0[1], kl0[2], kl0[3]};
                *(LAS u32x4*)(klT + (2 * dp + 1) * 72 + 8 * sg) = (u32x4){kl1[0], kl1[1], kl1[2], kl1[3]};
                *(LAS u32x4*)(vT + (2 * dp) * 72 + 8 * sg) = (u32x4){v0[0], v0[1], v0[2], v0[3]};
                *(LAS u32x4*)(vT + (2 * dp + 1) * 72 + 8 * sg) = (u32x4){v1[0], v1[1], v1[2], v1[3]};
            }
            __syncthreads();
            f32x4 oacc[4];
#pragma unroll
            for (int i = 0; i < 4; ++i) oacc[i] = (f32x4){0.f, 0.f, 0.f, 0.f};
#pragma unroll
            for (int kh = 0; kh < 2; ++kh) {
                s16x4 alo[2][4], ahi[2][4];
#pragma unroll
                for (int k2 = 0; k2 < 2; ++k2)
#pragma unroll
                    for (int tt = 0; tt < 4; ++tt) { const LAS bf16_t* ap = qd + (16 * tt + l15) * 136 + 32 * (2 * kh + k2) + 4 * quad; alo[k2][tt] = *(const LAS s16x4*)ap; ahi[k2][tt] = *(const LAS s16x4*)(ap + 16); }
                __builtin_amdgcn_sched_barrier(0);
#pragma unroll
                for (int k2 = 0; k2 < 2; ++k2) {
                    const int ks = 2 * kh + k2;
                    u32x4 sw; sw.x = pk2(Sacc[2 * ks][0], Sacc[2 * ks][1]); sw.y = pk2(Sacc[2 * ks][2], Sacc[2 * ks][3]);
                    sw.z = pk2(Sacc[2 * ks + 1][0], Sacc[2 * ks + 1][1]); sw.w = pk2(Sacc[2 * ks + 1][2], Sacc[2 * ks + 1][3]);
                    const bf16x8 sb = __builtin_bit_cast(bf16x8, sw);
#pragma unroll
                    for (int tt = 0; tt < 4; ++tt) oacc[tt] = MFMA16(__builtin_shufflevector(alo[k2][tt], ahi[k2][tt], 0, 1, 2, 3, 4, 5, 6, 7), sb, oacc[tt]);
                }
                __builtin_amdgcn_sched_barrier(0);
            }
#pragma unroll
            for (int e = 0; e < 2; ++e) {
                const int tile = 2 * wave + e, tt = tile >> 2, ss = tile & 3;
                bf16x8 fa[4], fb[4];
#pragma unroll
                for (int ks = 0; ks < 4; ++ks) { fa[ks] = *(const LAS bf16x8*)(qd + (16 * tt + l15) * 136 + 32 * ks + 8 * quad); fb[ks] = *(const LAS bf16x8*)(kd + (16 * ss + l15) * 136 + 32 * ks + 8 * quad); }
                __builtin_amdgcn_sched_barrier(0);
                f32x4 sa = {0.f, 0.f, 0.f, 0.f};
#pragma unroll
                for (int ks = 0; ks < 4; ++ks) sa = MFMA16(fa[ks], fb[ks], sa);
#pragma unroll
                for (int r = 0; r < 4; ++r) { const int tg = 16 * tt + 4 * quad + r, sg_ = 16 * ss + l15; sc[tg * 72 + sg_] = f2bf(sg_ <= tg ? sa[r] : 0.f); }
                __builtin_amdgcn_sched_barrier(0);
            }
            __syncthreads();
            unsigned short gr[16];
            {
                const int cg_ = c > 0 ? c : 1;
#pragma unroll
                for (int tt = 0; tt < 4; ++tt)
#pragma unroll
                    for (int r = 0; r < 4; ++r) gr[4 * tt + r] = *(const unsigned short*)((const char*)PC + ((unsigned)(b * 2048 + (cg_ - 1) * 64 + 16 * tt + 4 * quad + r) * 8192u + (unsigned)(3072 + hd * 128 + 16 * wave + l15) * 2u));
            }
            {
#pragma unroll
                for (int dt = 0; dt < 8; ++dt) Sacc[dt] *= *(const LAS f32x4*)(ebl + 16 * dt + 4 * quad);
                __builtin_amdgcn_sched_barrier(0);
#pragma unroll
                for (int ks = 0; ks < 2; ++ks) {
                    bf16x8 fsc[4], fkl[8];
                    const bf16x8 vb = *(const LAS bf16x8*)(vT + (16 * wave + l15) * 72 + 32 * ks + 8 * quad);
#pragma unroll
                    for (int tt = 0; tt < 4; ++tt) fsc[tt] = *(const LAS bf16x8*)(sc + (16 * tt + l15) * 72 + 32 * ks + 8 * quad);
#pragma unroll
                    for (int dt = 0; dt < 8; ++dt) fkl[dt] = *(const LAS bf16x8*)(klT + (16 * dt + l15) * 72 + 32 * ks + 8 * quad);
                    __builtin_amdgcn_sched_barrier(0);
#pragma unroll
                    for (int tt = 0; tt < 4; ++tt) oacc[tt] = MFMA16(fsc[tt], vb, oacc[tt]);
#pragma unroll
                    for (int dt = 0; dt < 8; ++dt) Sacc[dt] = MFMA16(fkl[dt], vb, Sacc[dt]);
                    __builtin_amdgcn_sched_barrier(0);
                }
            }
#pragma unroll
            for (int tt = 0; tt < 4; ++tt)
#pragma unroll
                for (int r = 0; r < 4; ++r) {
                    float sq = oacc[tt][r] * oacc[tt][r];
                    sq += __int_as_float(__builtin_amdgcn_update_dpp(0, __float_as_int(sq), 0xB1, 0xf, 0xf, false));
                    sq += __int_as_float(__builtin_amdgcn_update_dpp(0, __float_as_int(sq), 0x4E, 0xf, 0xf, false));
                    sq += __int_as_float(__builtin_amdgcn_update_dpp(0, __float_as_int(sq), 0x141, 0xf, 0xf, false));
                    sq += __int_as_float(__builtin_amdgcn_update_dpp(0, __float_as_int(sq), 0x140, 0xf, 0xf, false));
                    if (l15 == 0) red[(16 * tt + 4 * quad + r) * 8 + wave] = sq;
                }
            __syncthreads();
            if (c > 0) {
                const int dvg = hd * 128 + 16 * wave + l15;
                const float gn = ng[dvg];
#pragma unroll
                for (int tt = 0; tt < 4; ++tt)
#pragma unroll
                    for (int r = 0; r < 4; ++r) {
                        const int t = 16 * tt + 4 * quad + r;
                        const f32x4 r0 = *(const LAS f32x4*)(red + t * 8), r1 = *(const LAS f32x4*)(red + t * 8 + 4);
                        const float ssum = ((r0[0] + r0[1]) + (r0[2] + r0[3])) + ((r1[0] + r1[1]) + (r1[2] + r1[3]));
                        const float rs = __builtin_amdgcn_rsqf(ssum * (1.0f / 128.0f) + 1e-6f);
                        const unsigned moff = (unsigned)(b * 2048 + (c - 1) * 64 + t) * 2048u + (unsigned)dvg * 2u;
                        const float gv = bf2f(gr[4 * tt + r]);
                        *(bf16_t*)((char*)MIXC + moff) = f2bf(oacc[tt][r] * rs * gn * gv * __builtin_amdgcn_rcpf(1.0f + __builtin_amdgcn_exp2f(-1.4426950408889634f * gv)));
                    }
            }
#pragma unroll
            for (int i = 0; i < 8; ++i) { lfc[i] = lfn[i]; qc[i] = qn[i]; vc[i] = vn[i]; }
        }
        __syncthreads();
    }
}

__global__ void __launch_bounds__(512, 2) fwd_megakernel(Params P) {
    extern __shared__ __attribute__((aligned(16))) unsigned char lds_raw[];
    LAS unsigned char* lds = (LAS unsigned char*)lds_raw;
    cg::grid_group grid = cg::this_grid();
    const int blk = blockIdx.x, G = gridDim.x, wave = __builtin_amdgcn_readfirstlane((int)(threadIdx.x >> 6));
    unsigned char* ws = P.ws;
    bf16_t* HB = (bf16_t*)(ws + OFF_HB);
    float* Z = (float*)(ws + OFF_Z);
    bf16_t* PROJ = (bf16_t*)(ws + OFF_BIG + BIG_PROJ);
    bf16_t* APRE = (bf16_t*)(ws + OFF_BIG + BIG_APRE);
    bf16_t* CAT = (bf16_t*)(ws + OFF_BIG + BIG_CAT);
    bf16_t* HID = (bf16_t*)(ws + OFF_BIG);
    unsigned short* PC = (unsigned short*)(ws + OFF_BIG);

    volatile LAS unsigned* xst = (volatile LAS unsigned*)(lds + 131072);
    if (wave == 0 && lane_id_v() < 4) xst[lane_id_v()] = 0u;
    __syncthreads();
    const XcdBarrier xb = xcd_barrier_post((unsigned*)(ws + OFF_BAR), xst, wave);
    prologue_phase(P, lds, blk, G, wave);
#if PROBE_DUP_PRO
    __syncthreads();
    prologue_phase(P, lds, blk, G, wave);
#endif
    grid.sync();
    run_gemm(lds, HB, (const bf16_t*)(ws + OFF_WAB), 2048, 1024, EpInAB{PROJ}, true, blk, G, wave);
#if PROBE_GEMMS
    __syncthreads();
    run_gemm(lds, HB, (const bf16_t*)(ws + OFF_WAB), 2048, 1024, EpInAB{PROJ}, true, blk, G, wave);
#endif
    xcd_barrier(xb, wave);
    if (wave >= 2) weight_items(P, (LAS float*)(lds + 25600 + (wave - 2) * 8448), blk * 6 + (wave - 2), G * 6, lane_id_v(), 1);
    s5_phase(P, lds, blk, G, wave);
    __syncthreads();
#if PROBE_DUP_S5
    s5_phase(P, lds, blk, G, wave);
    __syncthreads();
#endif
    attn_phase(P, lds, blk, G, wave);
#if PROBE_DUP_ATTN
    __syncthreads();
    attn_phase(P, lds, blk, G, wave);
#endif
    xcd_barrier(xb, wave);
    run_gemm(lds, APRE, (const bf16_t*)(ws + OFF_WGLU), 512, 512, EpGlu{APRE, P.in[12], CAT}, true, blk, G, wave);
    xcd_barrier(xb, wave);
    float* ST = (float*)(ws + OFF_ST); const float* SV = (const float*)(ws + OFF_SV); const float* TV = (const float*)(ws + OFF_TV);
    float *ST1 = ST, *ST2 = ST + 2 * (size_t)R, *ST3 = ST + 4 * (size_t)R, *ST4 = ST + 6 * (size_t)R;
#if PROBE_DUP_OUTAB
    run_gemm(lds, CAT, (const bf16_t*)(ws + OFF_WOAB), 1024, 1024, EpRes<NB_OUTAB>{HB, nullptr, nullptr, nullptr, nullptr, ST + 8 * (size_t)R}, true, blk, G, wave);
    __syncthreads();
#endif
    run_gemm(lds, CAT, (const bf16_t*)(ws + OFF_WOAB), 1024, 1024, EpRes<NB_OUTAB>{HB, nullptr, nullptr, nullptr, nullptr, ST1}, true, blk, G, wave);
    xcd_barrier(xb, wave);
    run_gemm(lds, HB, (const bf16_t*)(ws + OFF_WUP0), 4096, 1024, EpUp{HID, P.in[21], ST1, SV, TV}, true, blk, G, wave);
#if PROBE_DUP_UP0
    __syncthreads();
    run_gemm(lds, HB, (const bf16_t*)(ws + OFF_WUP0), 4096, 1024, EpUp{HID, P.in[21], ST1, SV, TV}, true, blk, G, wave);
#endif
#if PROBE_SYNCS
    for (int i_ = 0; i_ < PROBE_SYNCS; ++i_) xcd_barrier(xb, wave);
#endif
    xcd_barrier(xb, wave);
#if PROBE_GEMMS
    run_gemm(lds, HID, (const bf16_t*)(ws + OFF_WDN0), 1024, 4096, EpInAB{(bf16_t*)P.out}, false, blk, G, wave);
    __syncthreads();
#endif
    run_gemm(lds, HID, (const bf16_t*)(ws + OFF_WDN0), 1024, 4096, EpRes<NB_DN0>{HB, P.in[23], ST1, P.in[18], P.in[19], ST2}, true, blk, G, wave);
    xcd_barrier(xb, wave);
    run_gemm(lds, HB, (const bf16_t*)(ws + OFF_WC), 4096, 1024, EpInC{PC, P.in[15], ST2, SV + 4096, TV + 4096}, true, blk, G, wave);
#if PROBE_DUP_INC
    __syncthreads();
    run_gemm(lds, HB, (const bf16_t*)(ws + OFF_WC), 4096, 1024, EpInC{PC, P.in[15], ST2, SV + 4096, TV + 4096}, true, blk, G, wave);
#endif
    xcd_barrier(xb, wave);
    hgrn_phase(P, lds, blk, G, wave);
#if PROBE_DUP_HGRN
    __syncthreads();
    hgrn_phase(P, lds, blk, G, wave);
#endif
    xcd_barrier(xb, wave);
    run_gemm(lds, (const bf16_t*)P.out  , (const bf16_t*)(ws + OFF_WOC), 1024, 1024, EpRes<NB_OUTC>{HB, nullptr, ST2, P.in[24], P.in[25], ST3}, false, blk, G, wave);
    xcd_barrier(xb, wave);
    run_gemm(lds, HB, (const bf16_t*)(ws + OFF_WUP1), 4096, 1024, EpUp{HID, P.in[21] + 4096, ST3, SV + 8192, TV + 8192}, false, blk, G, wave);
    xcd_barrier(xb, wave);
    run_gemm(lds, HID, (const bf16_t*)(ws + OFF_WDN1), 1024, 4096, EpRes<NB_DN1>{HB, P.in[23] + 1024, ST3, P.in[18] + 1024, P.in[19] + 1024, ST4}, false, blk, G, wave);
    xcd_barrier(xb, wave);
    final_ln_phase(HB, ST4, P.out, P.in[24] + 1024, P.in[25] + 1024, blk, G, wave);
}

extern "C" void kernel_launch(void* const* d_in, const int* in_sizes, int n_in, void* d_out, int out_size, void* d_ws, size_t ws_size, hipStream_t stream) {
    constexpr size_t kDynLds = 131072 + 256;
    static int grid_blocks = 0;
    if (!grid_blocks) {
        if (n_in != 26 || ws_size < ZERO_END) { fprintf(stderr, "kernel_launch: expected 26 inputs and >= %zu bytes of workspace (got %d, %zu)\n", (size_t)ZERO_END, n_in, ws_size); grid_blocks = -1; return; }
        int dev = 0, cus = 0, per_cu = 0;
        hipGetDevice(&dev);
        hipDeviceGetAttribute(&cus, hipDeviceAttributeMultiprocessorCount, dev);
        hipFuncSetAttribute((const void*)fwd_megakernel, hipFuncAttributeMaxDynamicSharedMemorySize, (int)kDynLds);
        hipOccupancyMaxActiveBlocksPerMultiprocessor(&per_cu, (const void*)fwd_megakernel, 512, kDynLds);
        if (per_cu < 1) { fprintf(stderr, "kernel_launch: occupancy query says %d blocks per CU\n", per_cu); per_cu = 1; }
        grid_blocks = cus * (per_cu > 1 ? 1 : per_cu);
        if (grid_blocks != 256) fprintf(stderr, "kernel_launch: note: grid is %d workgroups (tuned for 256)\n", grid_blocks);
    }
    if (grid_blocks < 1) return;
    Params p{};
    for (int i = 0; i < 26; ++i) p.in[i] = (const float*)d_in[i];
    p.out = (float*)d_out; p.ws = (unsigned char*)d_ws;
    hipMemsetAsync((char*)d_ws + OFF_ST, 0, ZERO_END - OFF_ST, stream);
    void* args[] = {&p};
    hipError_t e = hipLaunchCooperativeKernel((const void*)fwd_megakernel, dim3(grid_blocks), dim3(512), args, kDynLds, stream);
    if (e != hipSuccess) fprintf(stderr, "cooperative launch failed: %s (grid %d)\n", hipGetErrorString(e), grid_blocks);
}
```

```cpp
#define NB_OUTAB 4
#define NB_DN0 2
#define NB_OUTC 4
#define NB_DN1 2
#include <hip/hip_runtime.h>
#include <hip/hip_cooperative_groups.h>
#include <cstdio>
#include <cstdint>
namespace cg = cooperative_groups;
#ifndef PROBE_DUP_S5
#define PROBE_DUP_S5 0
#endif
#ifndef PROBE_DUP_ATTN
#define PROBE_DUP_ATTN 0
#endif
#ifndef PROBE_DUP_HGRN
#define PROBE_DUP_HGRN 0
#endif
#ifndef PROBE_DUP_INC
#define PROBE_DUP_INC 0
#endif
__device__ __forceinline__ int lane_id_v() { int l; asm volatile("v_mbcnt_lo_u32_b32 %0, -1, 0\n\tv_mbcnt_hi_u32_b32 %0, -1, %0" : "=v"(l)); return l; }
#ifndef PROBE_DUP_UP0
#define PROBE_DUP_UP0 0
#endif
#ifndef PROBE_SYNCS
#define PROBE_SYNCS 0
#endif
#ifndef NB_OUTAB
#define NB_OUTAB 4
#endif
#ifndef NB_DN0
#define NB_DN0 4
#endif
#ifndef NB_OUTC
#define NB_OUTC 4
#endif
#ifndef NB_DN1
#define NB_DN1 4
#endif
#ifndef PROBE_GEMMS
#define PROBE_GEMMS 0
#endif
#ifndef PROBE_DUP_PRO
#define PROBE_DUP_PRO 0
#endif
#ifndef PROBE_DUP_OUTAB
#define PROBE_DUP_OUTAB 0
#endif
#ifndef HGRN_TWO_PHASE
#define HGRN_TWO_PHASE 0
#endif
#define XB_TMO      128
#define XB_XCNT(j)  (256  + 64 * (j))
#define XB_XSUB(j)  (1280 + 64 * (j))
#define XB_XGEN(j)  (2304 + 64 * (j))
#define XB_TOP      3328
#define XB_TOPGEN   3392
#define XCD_BAR_WORDS 3456
#define XB_SPIN_CAP (1u << 18)

__device__ __forceinline__ unsigned xb_ld(unsigned* p)              { return __hip_atomic_load(p, __ATOMIC_RELAXED, __HIP_MEMORY_SCOPE_AGENT); }
__device__ __forceinline__ unsigned xb_add(unsigned* p, unsigned v) { return __hip_atomic_fetch_add(p, v, __ATOMIC_RELAXED, __HIP_MEMORY_SCOPE_AGENT); }
__device__ __forceinline__ unsigned xb_xcc_id() { return (unsigned)__builtin_amdgcn_s_getreg((3 << 11) | 20) & 0xFu; }
#define XB_SPIN(cond, bar) do { unsigned _sp = 0; while (cond) { __builtin_amdgcn_s_sleep(1); \
    if ((++_sp & 255u) == 0u) { if (xb_ld(&(bar)[XB_TMO])) break; if (_sp > XB_SPIN_CAP) { atomicAdd(&(bar)[XB_TMO], 1u); break; } } } } while (0)

struct XcdBarrier {
    unsigned* bar; unsigned x;
    volatile __attribute__((address_space(3))) unsigned* st;
};

__device__ __forceinline__ XcdBarrier xcd_barrier_post(unsigned* bar, volatile __attribute__((address_space(3))) unsigned* st, int wave_in) {
    XcdBarrier b; b.bar = bar; b.x = xb_xcc_id(); b.st = st;
    if (wave_in == 0 && lane_id_v() == 0) (void)xb_add(&bar[XB_XCNT(b.x)], 1u);
    return b;
}
__device__ __forceinline__ void xcd_barrier_complete(unsigned* bar, unsigned x, unsigned& nloc, unsigned& nx) {
    const unsigned G = gridDim.x * gridDim.y * gridDim.z;
    unsigned sum, cnt, mine, sp = 0u;
    for (;;) {
        sum = 0u; cnt = 0u; mine = 0u;
#pragma unroll
        for (unsigned j = 0; j < 16; ++j) { const unsigned c = xb_ld(&bar[XB_XCNT(j)]); sum += c; cnt += (c > 0u) ? 1u : 0u; mine = (j == x) ? c : mine; }
        if (sum == G) break;
        __builtin_amdgcn_s_sleep(1);
        if ((++sp & 255u) == 0u) { if (xb_ld(&bar[XB_TMO])) break; if (sp > XB_SPIN_CAP) { atomicAdd(&bar[XB_TMO], 1u); break; } }
    }
    nloc = mine > 0u ? mine : 1u; nx = cnt > 0u ? cnt : 1u;
}

__device__ __forceinline__ void xcd_barrier(const XcdBarrier& b, int wave_in) {
    asm volatile("s_waitcnt vmcnt(0)" ::: "memory");
    __syncthreads();
    if (wave_in == 0 && lane_id_v() == 0) {
        unsigned* bar = b.bar;
        __builtin_amdgcn_s_waitcnt(0);
        unsigned nloc = b.st[0], nx = b.st[1];
        if (nloc == 0u) { xcd_barrier_complete(bar, b.x, nloc, nx); b.st[0] = nloc; b.st[1] = nx; }
        const unsigned old = xb_add(&bar[XB_XSUB(b.x)], 1u);
        const unsigned gen = old / nloc;
        if (old + 1u == (gen + 1u) * nloc) {
            __builtin_amdgcn_fence(__ATOMIC_RELEASE, "agent");
            asm volatile("s_waitcnt vmcnt(0)" ::: "memory");
            const unsigned og = xb_add(&bar[XB_TOP], 1u);
            const unsigned tg = og / nx;
            if (og + 1u == (tg + 1u) * nx) xb_add(&bar[XB_TOPGEN], 1u);
            else XB_SPIN(xb_ld(&bar[XB_TOPGEN]) == tg, bar);
            __builtin_amdgcn_fence(__ATOMIC_ACQUIRE, "agent");
            xb_add(&bar[XB_XGEN(b.x)], 1u);
            asm volatile("s_waitcnt vmcnt(0)" ::: "memory");
        } else {
            XB_SPIN(xb_ld(&bar[XB_XGEN(b.x)]) == gen, bar);
            __builtin_amdgcn_fence(__ATOMIC_ACQUIRE, "agent");
            asm volatile("s_waitcnt vmcnt(0)" ::: "memory");
        }
    }
    __syncthreads();
}

namespace pg8 {
#define PG8_LAS __attribute__((address_space(3)))
typedef unsigned short bf16_t;
typedef short bf16x8 __attribute__((ext_vector_type(8)));
typedef float f32x4 __attribute__((ext_vector_type(4)));
typedef unsigned u32x4 __attribute__((ext_vector_type(4)));
constexpr int BM = 256, BK = 64, HALF = 128, HTB = HALF * BK * 2  , STAGE_BYTES = 8 * HTB, NXCD = 8, WGM = 8;

__host__ __device__ __forceinline__ int lds_byte(int r, int c) { const int st = (r >> 4) * 2 + (c >> 5), rr = r & 15, cc = c & 31, ob = rr * 64 + cc * 2; return st * 1024 + (ob ^ (((ob >> 9) & 1) << 5)); }
__host__ __device__ __forceinline__ void stage_rc(int b, int& R, int& C) { const int st = b / 1024, sb = b % 1024, swz = sb ^ (((sb >> 9) & 1) << 5); R = (st >> 1) * 16 + swz / 64; C = (st & 1) * 32 + (swz % 64) / 2; }
__host__ __device__ __forceinline__ int perm32(int rho) { const int n = rho >> 4, i = rho & 15; return 8 * (i >> 2) + 4 * n + (i & 3); }

struct Unit { int pm, pn; };
struct Gemm { const bf16_t* A; const bf16_t* Bt; int M, N, K; };

struct StaticOrder {
    int nM, nN, nwg, G, c;
    __host__ __device__ void init(int M, int N, int G_, int c_) { nM = M / BM; nN = N / BM; nwg = nM * nN; G = G_; c = c_; }
    __host__ __device__ bool next(int i, Unit& u) const {
        const long L = (long)i * G + c; if (L >= nwg) return false;
        int wgid = (int)L; { const int q = nwg / NXCD, r = nwg % NXCD, xcd = wgid % NXCD, off = wgid / NXCD; wgid = (xcd < r ? xcd * (q + 1) : r * (q + 1) + (xcd - r) * q) + off; }
        const int nig = WGM * nN, gid = wgid / nig, fm = gid * WGM, gsz = (nM - fm) < WGM ? (nM - fm) : WGM;
        u.pm = fm + ((wgid % nig) % gsz); u.pn = (wgid % nig) / gsz; return true;
    }
    __device__ __forceinline__ void a_ready(const Unit&) const {}
    __device__ __forceinline__ void done(const Unit&) const {}
};

__device__ __forceinline__ unsigned cvt_pk_bf16(float lo, float hi) { unsigned r; asm volatile("v_cvt_pk_bf16_f32 %0, %1, %2" : "=v"(r) : "v"(lo), "v"(hi)); return r; }
template <class Epi, class Sched, bool ALIGN_EPI = false, bool SP2 = false>
__device__ __forceinline__ void gemm_phase(PG8_LAS unsigned char* lds, const Gemm g, const Sched& S, const Epi& E, int wave_in) {
    const int lane = lane_id_v(), wid = __builtin_amdgcn_readfirstlane(wave_in), tid = wid * 64 + lane, wr = wid >> 2, wc = wid & 3, fr = lane & 15, fq = lane >> 4;
    const int K = g.K, nt = K / BK;
    unsigned voffA[2], voffB[2];
#pragma unroll
    for (int i = 0; i < 2; ++i) { int R, C; stage_rc(tid * 16 + i * 8192, R, C); const int Rb = Epi::PERM ? ((R & ~31) + perm32(R & 31)) : R;
        voffA[i] = (unsigned)(R * K + C) * 2u; voffB[i] = (unsigned)(Rb * K + C) * 2u; }
    const size_t kstep = (size_t)(BK * 2);
    const size_t hstep = (size_t)HALF * K * 2;
    const size_t tstep = 2 * hstep;
    const unsigned ldsw = (unsigned)wid * 1024u;
    const int aoff = lds_byte(wr * 64 + fr, fq * 8), boff = lds_byte(wc * 32 + fr, fq * 8);
#define PG8_SA(b, h) (((b) * 2 + (h)) * HTB)
#define PG8_SB(b, h) ((4 + (b) * 2 + (h)) * HTB)
#define PG8_STAGE(bufoff, gbase, voff) do { _Pragma("unroll") for (int _i = 0; _i < 2; ++_i) \
        __builtin_amdgcn_global_load_lds((const unsigned*)((const char*)(gbase) + (voff)[_i]), (PG8_LAS unsigned*)(lds + (bufoff) + ldsw + _i * 8192), 16, 0, 0); } while (0)
#define PG8_LDA(dst, b, h) do { _Pragma("unroll") for (int m = 0; m < 4; ++m) _Pragma("unroll") for (int k = 0; k < 2; ++k) dst[m][k] = *(const PG8_LAS bf16x8*)(lds + PG8_SA(b, h) + aoff + m * 2048 + k * 1024); } while (0)
#define PG8_LDB(dst, b, h) do { _Pragma("unroll") for (int n = 0; n < 2; ++n) _Pragma("unroll") for (int k = 0; k < 2; ++k) dst[n][k] = *(const PG8_LAS bf16x8*)(lds + PG8_SB(b, h) + boff + n * 2048 + k * 1024); } while (0)
#define PG8_MMA(ai, bj, At, Bt) do { __builtin_amdgcn_s_setprio(1); _Pragma("unroll") for (int m = 0; m < 4; ++m) _Pragma("unroll") for (int n = 0; n < 2; ++n) _Pragma("unroll") for (int k = 0; k < 2; ++k) \
        acc[ai][bj][m][n] = __builtin_amdgcn_mfma_f32_16x16x32_bf16(Bt[n][k], At[m][k], acc[ai][bj][m][n], 0, 0, 0); __builtin_amdgcn_s_setprio(0); } while (0)
#define PG8_WAIT_V(n) asm volatile("s_waitcnt vmcnt(" #n ")" ::: "memory")
#define PG8_WAIT_L(n) asm volatile("s_waitcnt lgkmcnt(" #n ")" ::: "memory")
#define PG8_BAR __builtin_amdgcn_s_barrier()
#define PG8_SCHED __builtin_amdgcn_sched_barrier(0)
    Unit cur, nxt; int ui = 0;
    if (!S.next(0, cur)) return;
    f32x4 acc[2][2][4][2];
#pragma unroll
    for (int a = 0; a < 2; ++a)
#pragma unroll
        for (int b = 0; b < 2; ++b)
#pragma unroll
            for (int m = 0; m < 4; ++m)
#pragma unroll
                for (int n = 0; n < 2; ++n) acc[a][b][m][n] = (f32x4){0.f, 0.f, 0.f, 0.f};
    bf16x8 At[4][2], B0[2][2], B1[2][2];
    const char* cA = (const char*)g.A + (size_t)cur.pm * tstep; const char* cB = (const char*)g.Bt + (size_t)cur.pn * tstep;
    S.a_ready(cur);
    if constexpr (SP2) {
        PG8_STAGE(PG8_SB(0, 0), cB, voffB); PG8_STAGE(PG8_SB(0, 1), cB + hstep, voffB); PG8_STAGE(PG8_SA(0, 0), cA, voffA); PG8_STAGE(PG8_SA(0, 1), cA + hstep, voffA);
        if (wr == 1) PG8_BAR;
        PG8_WAIT_V(2); PG8_BAR;
        PG8_STAGE(PG8_SB(1, 0), cB + kstep, voffB); PG8_STAGE(PG8_SA(1, 0), cA + kstep, voffA); PG8_STAGE(PG8_SB(1, 1), cB + hstep + kstep, voffB);
        PG8_WAIT_V(6); PG8_BAR;
    } else {
        PG8_STAGE(PG8_SB(0, 0), cB, voffB); PG8_STAGE(PG8_SA(0, 0), cA, voffA); PG8_STAGE(PG8_SB(0, 1), cB + hstep, voffB); PG8_STAGE(PG8_SA(0, 1), cA + hstep, voffA);
        if (wr == 1) PG8_BAR;
        PG8_WAIT_V(4); PG8_BAR;
        PG8_STAGE(PG8_SB(1, 0), cB + kstep, voffB); PG8_STAGE(PG8_SA(1, 0), cA + kstep, voffA); PG8_STAGE(PG8_SB(1, 1), cB + hstep + kstep, voffB);
        PG8_WAIT_V(6); PG8_BAR;
    }
    for (;;) {
        const bool has_next = S.next(ui + 1, nxt);
        const char* nA = has_next ? (const char*)g.A + (size_t)nxt.pm * tstep : cA; const char* nB = has_next ? (const char*)g.Bt + (size_t)nxt.pn * tstep : cB;
        for (int t = 0; t < nt; t += 2) {
            const bool last = (t == nt - 2);
            const char* a1 = cA + (size_t)(t + 1) * kstep;
            const char* a2 = last ? nA : cA + (size_t)(t + 2) * kstep; const char* b2 = last ? nB : cB + (size_t)(t + 2) * kstep;
            const char* a3 = a2 + kstep; const char* b3 = b2 + kstep;
            if (last && has_next) S.a_ready(nxt);
            if constexpr (SP2) {
            PG8_LDB(B0, 0, 0); PG8_LDB(B1, 0, 1); PG8_SCHED; PG8_LDA(At, 0, 0); PG8_STAGE(PG8_SA(1, 1), a1 + hstep, voffA);
            PG8_WAIT_V(8); PG8_WAIT_L(0); PG8_BAR; PG8_MMA(0, 0, At, B0); PG8_MMA(0, 1, At, B1); PG8_BAR; PG8_SCHED;
            PG8_LDA(At, 0, 1); PG8_STAGE(PG8_SB(0, 0), b2, voffB); PG8_STAGE(PG8_SB(0, 1), b2 + hstep, voffB); PG8_STAGE(PG8_SA(0, 0), a2, voffA);
            PG8_WAIT_V(8); PG8_WAIT_L(0); PG8_BAR; PG8_MMA(1, 0, At, B0); PG8_MMA(1, 1, At, B1); PG8_BAR; PG8_SCHED;
            PG8_LDB(B0, 1, 0); PG8_LDB(B1, 1, 1); PG8_SCHED; PG8_LDA(At, 1, 0); PG8_STAGE(PG8_SA(0, 1), a2 + hstep, voffA);
            PG8_WAIT_V(8); PG8_WAIT_L(0); PG8_BAR; PG8_MMA(0, 0, At, B0); PG8_MMA(0, 1, At, B1); PG8_BAR; PG8_SCHED;
            PG8_LDA(At, 1, 1); PG8_STAGE(PG8_SB(1, 0), b3, voffB); PG8_STAGE(PG8_SB(1, 1), b3 + hstep, voffB); PG8_STAGE(PG8_SA(1, 0), a3, voffA);
            PG8_WAIT_V(8); PG8_WAIT_L(0); PG8_BAR; PG8_MMA(1, 0, At, B0); PG8_MMA(1, 1, At, B1); PG8_BAR; PG8_SCHED;
            } else {
            PG8_LDB(B0, 0, 0); PG8_SCHED; PG8_LDA(At, 0, 0); PG8_STAGE(PG8_SA(1, 1), a1 + hstep, voffA);
            PG8_WAIT_L(8); PG8_BAR; PG8_WAIT_L(0); PG8_MMA(0, 0, At, B0); PG8_BAR; PG8_SCHED;
            PG8_LDB(B1, 0, 1); PG8_STAGE(PG8_SB(0, 0), b2, voffB);
            PG8_BAR; PG8_WAIT_L(0); PG8_MMA(0, 1, At, B1); PG8_BAR;
            PG8_LDA(At, 0, 1); PG8_STAGE(PG8_SA(0, 0), a2, voffA);
            PG8_BAR; PG8_WAIT_L(0); PG8_MMA(1, 0, At, B0); PG8_BAR; PG8_SCHED;
            PG8_STAGE(PG8_SB(0, 1), b2 + hstep, voffB);
            PG8_WAIT_V(6); PG8_BAR; PG8_MMA(1, 1, At, B1); PG8_BAR;
            PG8_LDB(B0, 1, 0); PG8_SCHED; PG8_LDA(At, 1, 0); PG8_STAGE(PG8_SA(0, 1), a2 + hstep, voffA);
            PG8_WAIT_L(8); PG8_BAR; PG8_WAIT_L(0); PG8_MMA(0, 0, At, B0); PG8_BAR; PG8_SCHED;
            PG8_LDB(B1, 1, 1); PG8_STAGE(PG8_SB(1, 0), b3, voffB);
            PG8_BAR; PG8_WAIT_L(0); PG8_MMA(0, 1, At, B1); PG8_BAR;
            PG8_LDA(At, 1, 1); PG8_STAGE(PG8_SA(1, 0), a3, voffA);
            PG8_BAR; PG8_WAIT_L(0); PG8_MMA(1, 0, At, B0); PG8_BAR; PG8_SCHED;
            PG8_STAGE(PG8_SB(1, 1), b3 + hstep, voffB);
            PG8_WAIT_V(6); PG8_BAR; PG8_MMA(1, 1, At, B1); PG8_BAR;
            }
        }
        if constexpr (ALIGN_EPI) { if (wr == 0) PG8_BAR; }
        if constexpr (!Epi::AFTER_DRAIN) { E(acc, cur, wr, wc, fr, fq); S.done(cur); }
        if (!has_next) break;
#pragma unroll
        for (int a = 0; a < 2; ++a)
#pragma unroll
            for (int b = 0; b < 2; ++b)
#pragma unroll
                for (int m = 0; m < 4; ++m)
#pragma unroll
                    for (int n = 0; n < 2; ++n) acc[a][b][m][n] = (f32x4){0.f, 0.f, 0.f, 0.f};
        cur = nxt; cA = nA; cB = nB; ++ui;
        if constexpr (ALIGN_EPI) { if (wr == 1) PG8_BAR; }
    }
    PG8_WAIT_V(0);
    if constexpr (!ALIGN_EPI) { if (wr == 0) PG8_BAR; }
    PG8_BAR;
    if constexpr (Epi::AFTER_DRAIN) { E.fused(acc, cur, wr, wc, fr, fq, lds, wid, lane); S.done(cur); }
#undef PG8_SA
#undef PG8_SB
#undef PG8_STAGE
#undef PG8_LDA
#undef PG8_LDB
#undef PG8_MMA
#undef PG8_WAIT_V
#undef PG8_WAIT_L
#undef PG8_BAR
#undef PG8_SCHED
}
}

#define LAS __attribute__((address_space(3)))
typedef unsigned short bf16_t;
typedef short bf16x8 __attribute__((ext_vector_type(8)));
typedef short s16x4 __attribute__((ext_vector_type(4)));
typedef float f32x4 __attribute__((ext_vector_type(4)));
typedef float f32x16 __attribute__((ext_vector_type(16)));
typedef unsigned u32x4 __attribute__((ext_vector_type(4)));
typedef unsigned u32x2 __attribute__((ext_vector_type(2)));

constexpr int T = 16 * 2048;
constexpr int NMETA = 16;
constexpr int R = T + NMETA;
constexpr int DM = 1024, DFF = 4096;
constexpr float ALPHA = 1.4142135623730951f;
constexpr float QSCALE = 0.125f * 1.4426950408889634f;

constexpr size_t SZ_WAB = (size_t)2048 * 1024 * 2, SZ_WGLU = (size_t)512 * 512 * 2, SZ_W1M = (size_t)1024 * 1024 * 2, SZ_W4M = (size_t)4096 * 1024 * 2;
constexpr size_t OFF_WAB = 0, OFF_WGLU = OFF_WAB + SZ_WAB, OFF_WOAB = OFF_WGLU + SZ_WGLU, OFF_WC = OFF_WOAB + SZ_W1M, OFF_WOC = OFF_WC + SZ_W4M,
                 OFF_WUP0 = OFF_WOC + SZ_W1M, OFF_WUP1 = OFF_WUP0 + SZ_W4M, OFF_WDN0 = OFF_WUP1 + SZ_W4M, OFF_WDN1 = OFF_WDN0 + SZ_W4M,
                 OFF_HB = OFF_WDN1 + SZ_W4M, OFF_Z = OFF_HB + (size_t)R * 1024 * 2, OFF_BIG = OFF_Z + (size_t)R * 1024 * 4, WS_END = OFF_BIG + (size_t)R * 4096 * 2;
constexpr size_t OFF_ST = (WS_END + 255) & ~(size_t)255;
constexpr size_t SZ_ST = (size_t)5 * R * 2 * 4;
constexpr size_t OFF_SV = OFF_ST + SZ_ST, OFF_TV = OFF_SV + (size_t)3 * 4096 * 4, OFF_BAR = OFF_TV + (size_t)3 * 4096 * 4, ZERO_END = OFF_BAR + (size_t)XCD_BAR_WORDS * 4;
constexpr size_t BIG_PROJ = 0, BIG_APRE = (size_t)R * 2048 * 2, BIG_CAT = BIG_APRE + (size_t)R * 512 * 2;

struct Params { const float* in[26]; float* out; unsigned char* ws; };

__device__ __forceinline__ unsigned pk2(float lo, float hi) {
    typedef __bf16 bf2 __attribute__((ext_vector_type(2)));
    typedef float fl2 __attribute__((ext_vector_type(2)));
    fl2 v = {lo, hi}; bf2 r = __builtin_convertvector(v, bf2); return __builtin_bit_cast(unsigned, r);
}
__device__ __forceinline__ bf16_t f2bf(float x) { return (bf16_t)(pk2(x, 0.f) & 0xffffu); }
__device__ __forceinline__ float bf2f(bf16_t v) { return __uint_as_float((unsigned)v << 16); }
__device__ __forceinline__ float bflo(unsigned w) { return __uint_as_float(w << 16); }
__device__ __forceinline__ float bfhi(unsigned w) { return __uint_as_float(w & 0xffff0000u); }
__device__ __forceinline__ float sigmoidf_(float x) { return 1.0f / (1.0f + __expf(-x)); }
#define LDS_WAIT() asm volatile("s_waitcnt lgkmcnt(0)" ::: "memory")
#define MFMA16(a, b, c) __builtin_amdgcn_mfma_f32_16x16x32_bf16((a), (b), (c), 0, 0, 0)
#define MFMA32(a, b, c) __builtin_amdgcn_mfma_f32_32x32x16_bf16((a), (b), (c), 0, 0, 0)

struct RowCtx { float mu, rstd; };
__device__ __forceinline__ RowCtx ln_ctx(const float* st, int row) {
    const float sum = st[2 * (size_t)row], sq = st[2 * (size_t)row + 1];
    RowCtx rc; rc.mu = sum * (1.0f / 1024.0f); const float var = fmaxf(sq * (1.0f / 1024.0f) - rc.mu * rc.mu, 0.f); rc.rstd = 1.0f / sqrtf(var + 1e-5f); return rc;
}
struct NoCtx {};
struct EpInAB {
    static constexpr bool MAKES_STATS = false; static constexpr int BATCH = 8;
    typedef NoCtx ColCtx; typedef NoCtx Pre;
    bf16_t* O;
    __device__ __forceinline__ ColCtx col_ctx(int) const { return NoCtx{}; }
    template <bool META> __device__ __forceinline__ Pre pre(int, int) const { return NoCtx{}; }
    __device__ __forceinline__ RowCtx row_ctx(int) const { return RowCtx{0.f, 1.f}; }
    __device__ __forceinline__ float* st_ptr() const { return nullptr; }
    __device__ __forceinline__ void apply8(int row, int col, f32x4 a, f32x4 b, const RowCtx&, const ColCtx&, const Pre&, float&, float&) const {
        const float s = (col >= 512 && col < 1024) ? QSCALE : 1.0f;
        u32x4 w; w.x = pk2(a[0] * s, a[1] * s); w.y = pk2(a[2] * s, a[3] * s); w.z = pk2(b[0] * s, b[1] * s); w.w = pk2(b[2] * s, b[3] * s);
        *(u32x4*)(O + (size_t)row * 2048 + col) = w;
    }
};
struct EpGlu {
    static constexpr bool MAKES_STATS = false; static constexpr int BATCH = 4;
    struct ColCtx { f32x4 b0, b1; }; struct Pre { u32x4 ap; };
    const bf16_t* APRE; const float* bias; bf16_t* CAT;
    __device__ __forceinline__ ColCtx col_ctx(int col) const { return ColCtx{*(const f32x4*)(bias + col), *(const f32x4*)(bias + col + 4)}; }
    template <bool META> __device__ __forceinline__ Pre pre(int row, int col) const { return Pre{*(const u32x4*)((const char*)APRE + ((unsigned)row * 1024u + (unsigned)col * 2u))}; }
    __device__ __forceinline__ RowCtx row_ctx(int) const { return RowCtx{0.f, 1.f}; }
    __device__ __forceinline__ float* st_ptr() const { return nullptr; }
    __device__ __forceinline__ void apply8(int row, int col, f32x4 a, f32x4 b, const RowCtx&, const ColCtx& cc, const Pre& pr, float&, float&) const {
        const u32x4 ap = pr.ap;
        float v[8] = {a[0] + cc.b0[0], a[1] + cc.b0[1], a[2] + cc.b0[2], a[3] + cc.b0[3], b[0] + cc.b1[0], b[1] + cc.b1[1], b[2] + cc.b1[2], b[3] + cc.b1[3]};
        float y[8] = {bflo(ap.x), bfhi(ap.x), bflo(ap.y), bfhi(ap.y), bflo(ap.z), bfhi(ap.z), bflo(ap.w), bfhi(ap.w)};
#pragma unroll
        for (int i = 0; i < 8; ++i) y[i] = y[i] * sigmoidf_(v[i]);
        u32x4 w; w.x = pk2(y[0], y[1]); w.y = pk2(y[2], y[3]); w.z = pk2(y[4], y[5]); w.w = pk2(y[6], y[7]);
        *(u32x4*)(CAT + (size_t)row * 1024 + col) = w;
    }
};
template <int NB_> struct EpRes {
    static constexpr bool MAKES_STATS = true; static constexpr int BATCH = NB_;
    struct ColCtx { f32x4 ag0, ag1, ab0, ab1; }; struct Pre { u32x4 h; };
    bf16_t* HBp; const float* bias;
    const float* st_prev; const float* g; const float* bta; float* st_out;
    __device__ __forceinline__ ColCtx col_ctx(int col) const {
        ColCtx c; const f32x4 one = {1.f, 1.f, 1.f, 1.f}, zero = {0.f, 0.f, 0.f, 0.f};
        const f32x4 g0 = st_prev ? *(const f32x4*)(g + col) : one, g1 = st_prev ? *(const f32x4*)(g + col + 4) : one;
        const f32x4 t0 = st_prev ? *(const f32x4*)(bta + col) : zero, t1 = st_prev ? *(const f32x4*)(bta + col + 4) : zero;
        const f32x4 b0 = bias ? *(const f32x4*)(bias + col) : zero, b1 = bias ? *(const f32x4*)(bias + col + 4) : zero;
        c.ag0 = g0 * ALPHA; c.ag1 = g1 * ALPHA; c.ab0 = t0 * ALPHA + b0; c.ab1 = t1 * ALPHA + b1; return c;
    }
    template <bool META> __device__ __forceinline__ Pre pre(int row, int col) const { return Pre{*(const u32x4*)((const char*)HBp + ((unsigned)row * 2048u + (unsigned)col * 2u))}; }
    __device__ __forceinline__ RowCtx row_ctx(int row) const { return st_prev ? ln_ctx(st_prev, row) : RowCtx{0.f, 1.f}; }
    __device__ __forceinline__ float* st_ptr() const { return st_out; }
    __device__ __forceinline__ void apply8(int row, int col, f32x4 a, f32x4 b, const RowCtx& rc, const ColCtx& cc, const Pre& pr, float& s, float& q) const {
        const f32x4 h0 = {bflo(pr.h.x), bfhi(pr.h.x), bflo(pr.h.y), bfhi(pr.h.y)}, h1 = {bflo(pr.h.z), bfhi(pr.h.z), bflo(pr.h.w), bfhi(pr.h.w)};
        const f32x4 o0 = (h0 - rc.mu) * rc.rstd * cc.ag0 + cc.ab0 + a, o1 = (h1 - rc.mu) * rc.rstd * cc.ag1 + cc.ab1 + b;
        u32x4 w; w.x = pk2(o0[0], o0[1]); w.y = pk2(o0[2], o0[3]); w.z = pk2(o1[0], o1[1]); w.w = pk2(o1[2], o1[3]);
        *(u32x4*)((char*)HBp + ((unsigned)row * 2048u + (unsigned)col * 2u)) = w;
        s += ((o0[0] + o0[1]) + (o0[2] + o0[3])) + ((o1[0] + o1[1]) + (o1[2] + o1[3]));
        q += ((o0[0] * o0[0] + o0[1] * o0[1]) + (o0[2] * o0[2] + o0[3] * o0[3])) + ((o1[0] * o1[0] + o1[1] * o1[1]) + (o1[2] * o1[2] + o1[3] * o1[3]));
    }
};
struct EpUp {
    static constexpr bool MAKES_STATS = false; static constexpr int BATCH = 8;
    struct ColCtx { f32x4 s0, s1, t0, t1; }; typedef NoCtx Pre;
    bf16_t* H; const float* bias; const float* st_prev; const float* sv; const float* tv;
    __device__ __forceinline__ ColCtx col_ctx(int col) const {
        return ColCtx{*(const f32x4*)(sv + col), *(const f32x4*)(sv + col + 4), *(const f32x4*)(tv + col) + *(const f32x4*)(bias + col), *(const f32x4*)(tv + col + 4) + *(const f32x4*)(bias + col + 4)};
    }
    template <bool META> __device__ __forceinline__ Pre pre(int, int) const { return NoCtx{}; }
    __device__ __forceinline__ RowCtx row_ctx(int row) const { return ln_ctx(st_prev, row); }
    __device__ __forceinline__ float* st_ptr() const { return nullptr; }
    __device__ __forceinline__ void apply8(int row, int col, f32x4 a, f32x4 b, const RowCtx& rc, const ColCtx& cc, const Pre&, float&, float&) const {
        f32x4 v0 = (a - rc.mu * cc.s0) * rc.rstd + cc.t0, v1 = (b - rc.mu * cc.s1) * rc.rstd + cc.t1;
#pragma unroll
        for (int i = 0; i < 4; ++i) { v0[i] = fmaxf(v0[i], 0.f); v0[i] *= v0[i]; v1[i] = fmaxf(v1[i], 0.f); v1[i] *= v1[i]; }
        u32x4 w; w.x = pk2(v0[0], v0[1]); w.y = pk2(v0[2], v0[3]); w.z = pk2(v1[0], v1[1]); w.w = pk2(v1[2], v1[3]);
        *(u32x4*)(H + (size_t)row * 4096 + col) = w;
    }
};
struct EpInC {
    static constexpr bool MAKES_STATS = false; static constexpr int BATCH = 8;
    struct ColCtx { f32x4 s0, s1, t0, t1, lb0, lb1; }; typedef NoCtx Pre;
    unsigned short* PC; const float* gamma; const float* st_prev; const float* sv; const float* tv;
    __device__ __forceinline__ ColCtx col_ctx(int col) const {
        ColCtx c{*(const f32x4*)(sv + col), *(const f32x4*)(sv + col + 4), *(const f32x4*)(tv + col), *(const f32x4*)(tv + col + 4), {0.f, 0.f, 0.f, 0.f}, {0.f, 0.f, 0.f, 0.f}};
        if (col >= 1024 && col < 2048) {
            const f32x4 ga = *(const f32x4*)(gamma + col - 1024), gb = *(const f32x4*)(gamma + col - 1020), gc = *(const f32x4*)(gamma + col), gd = *(const f32x4*)(gamma + col + 4);
#pragma unroll
            for (int i = 0; i < 4; ++i) { c.lb0[i] = 1.0f / (1.0f + __expf(ga[i] - gc[i])); c.lb1[i] = 1.0f / (1.0f + __expf(gb[i] - gd[i])); }
        }
        return c;
    }
    template <bool META> __device__ __forceinline__ Pre pre(int, int) const { return NoCtx{}; }
    __device__ __forceinline__ RowCtx row_ctx(int row) const { return ln_ctx(st_prev, row); }
    __device__ __forceinline__ float* st_ptr() const { return nullptr; }
    __device__ __forceinline__ void apply8(int row, int col, f32x4 a, f32x4 b, const RowCtx& rc, const ColCtx& cc, const Pre&, float&, float&) const {
        a = (a - rc.mu * cc.s0) * rc.rstd + cc.t0;
        b = (b - rc.mu * cc.s1) * rc.rstd + cc.t1;
        u32x4 w;
        if (col >= 1024 && col < 2048) {
            float v[8] = {a[0], a[1], a[2], a[3], b[0], b[1], b[2], b[3]};
            float lb[8] = {cc.lb0[0], cc.lb0[1], cc.lb0[2], cc.lb0[3], cc.lb1[0], cc.lb1[1], cc.lb1[2], cc.lb1[3]};
            unsigned short h[8];
#pragma unroll
            for (int i = 0; i < 8; ++i) {
                const float f = lb[i] + (1.0f - lb[i]) * sigmoidf_(v[i]);
                const _Float16 hf = (_Float16)__logf(f);
                h[i] = __builtin_bit_cast(unsigned short, hf);
            }
            w.x = h[0] | ((unsigned)h[1] << 16); w.y = h[2] | ((unsigned)h[3] << 16); w.z = h[4] | ((unsigned)h[5] << 16); w.w = h[6] | ((unsigned)h[7] << 16);
        } else { w.x = pk2(a[0], a[1]); w.y = pk2(a[2], a[3]); w.z = pk2(b[0], b[1]); w.w = pk2(b[2], b[3]); }
        *(u32x4*)(PC + (size_t)row * 4096 + col) = w;
    }
};
template <class F> struct EpiAdapt {
    static constexpr bool PERM = true, AFTER_DRAIN = false; F f;
    __device__ __forceinline__ void operator()(const f32x4 (&acc)[2][2][4][2], const pg8::Unit& u, int wr, int wc, int, int) const {
        const int lane_ = lane_id_v(), fr = lane_ & 15, fq = lane_ >> 4;
        const int col0 = u.pn * 256 + wc * 32 + 8 * fq, row0 = u.pm * 256 + wr * 64 + fr;
        constexpr int NB = F::BATCH;
#pragma unroll
        for (int bt = 0; bt < 8 / NB; ++bt) {
            const typename F::ColCtx cc[2] = {f.col_ctx(col0), f.col_ctx(col0 + 128)};
            RowCtx rc[NB];
            typename F::Pre pr[NB][2];
#pragma unroll
            for (int i = 0; i < NB; ++i) { const int r8 = bt * NB + i, row = row0 + (r8 >> 2) * 128 + (r8 & 3) * 16;
                rc[i] = f.row_ctx(row); pr[i][0] = f.template pre<false>(row, col0); pr[i][1] = f.template pre<false>(row, col0 + 128); }
#pragma unroll
            for (int i = 0; i < NB; ++i) { const int r8 = bt * NB + i, ai = r8 >> 2, m = r8 & 3, row = row0 + ai * 128 + m * 16;
                float s = 0.f, q = 0.f;
                f.apply8(row, col0, acc[ai][0][m][0], acc[ai][0][m][1], rc[i], cc[0], pr[i][0], s, q);
                f.apply8(row, col0 + 128, acc[ai][1][m][0], acc[ai][1][m][1], rc[i], cc[1], pr[i][1], s, q);
                if (F::MAKES_STATS) {
                    s += __shfl_xor(s, 16); s += __shfl_xor(s, 32); q += __shfl_xor(q, 16); q += __shfl_xor(q, 32);
                    if (fq == 0) { float* st = (float*)((char*)f.st_ptr() + (unsigned)row * 8u); unsafeAtomicAdd(st, s); unsafeAtomicAdd(st + 1, q); }
                }
            }
            asm volatile("" ::: "memory");
        }
    }
};
template <class F> __device__ __forceinline__ void meta_gemm(const bf16_t* A16  , const bf16_t* Bt, int N, int K, const F& f, int blk, int G, int wave, int lane) {
    const int l15 = lane & 15, quad = lane >> 4;
    for (int item = blk + G * wave; item < N / 32; item += G * 8) {
        const int c0 = item * 32;
        const bf16_t* ap = A16 + (size_t)l15 * K + 8 * quad;
        const bf16_t* w0 = Bt + (size_t)(c0 + 8 * (l15 >> 2) + (l15 & 3)) * K + 8 * quad;
        const bf16_t* w1 = w0 + (size_t)4 * K;
        f32x4 acc0 = {0.f, 0.f, 0.f, 0.f}, acc1 = {0.f, 0.f, 0.f, 0.f};
#pragma unroll 8
        for (int k = 0; k < K; k += 32) {
            const bf16x8 xa = *(const bf16x8*)(ap + k), b0 = *(const bf16x8*)(w0 + k), b1 = *(const bf16x8*)(w1 + k);
            acc0 = MFMA16(b0, xa, acc0); acc1 = MFMA16(b1, xa, acc1);
        }
        const RowCtx rc = f.row_ctx(T + l15);
        const typename F::ColCtx cc = f.col_ctx(c0 + 8 * quad);
        const typename F::Pre pr = f.template pre<true>(T + l15, c0 + 8 * quad);
        float s = 0.f, q = 0.f;
        f.apply8(T + l15, c0 + 8 * quad, acc0, acc1, rc, cc, pr, s, q);
        if (F::MAKES_STATS) {
            s += __shfl_xor(s, 16); s += __shfl_xor(s, 32); q += __shfl_xor(q, 16); q += __shfl_xor(q, 32);
            if (quad == 0) { float* st = f.st_ptr() + 2 * (size_t)(T + l15); unsafeAtomicAdd(st, s); unsafeAtomicAdd(st + 1, q); }
        }
    }
}
template <class F> __device__ __forceinline__ void run_gemm(LAS unsigned char* lds, const bf16_t* A, const bf16_t* Bt, int N, int K, const F& f, bool with_meta, int blk, int G, int wave) {
    pg8::Gemm g{A, Bt, T, N, K}; pg8::StaticOrder S; S.init(T, N, G, blk);
    EpiAdapt<F> E{f};
    pg8::gemm_phase<EpiAdapt<F>, pg8::StaticOrder, true, true>((PG8_LAS unsigned char*)lds, g, S, E, wave);
    if (with_meta) meta_gemm<F>(A + (size_t)T * K, Bt, N, K, f, blk, G, wave, lane_id_v());
}

__device__ __forceinline__ void transpose_item(const float* W, int K, int N, bf16_t* WT, LAS float* scr, int item, int lane) {
    const int nblk = N / 32, kb = item / nblk, nb = item % nblk, k0 = 64 * kb, n0 = 32 * nb;
    float wv_[32];
#pragma unroll
    for (int i = 0; i < 32; ++i) wv_[i] = W[(size_t)(k0 + 2 * i + (lane >> 5)) * N + n0 + (lane & 31)];
#pragma unroll
    for (int i = 0; i < 32; ++i) scr[(2 * i + (lane >> 5)) * 33 + (lane & 31)] = wv_[i];
    LDS_WAIT();
    const int c = lane & 7;
#pragma unroll
    for (int j = 0; j < 4; ++j) { const int n = (lane >> 3) + 8 * j; const LAS float* s = scr + (8 * c) * 33 + n;
        u32x4 o; o.x = pk2(s[0 * 33], s[1 * 33]); o.y = pk2(s[2 * 33], s[3 * 33]); o.z = pk2(s[4 * 33], s[5 * 33]); o.w = pk2(s[6 * 33], s[7 * 33]);
        *(u32x4*)(WT + (size_t)(n0 + n) * K + k0 + 8 * c) = o; }
    LDS_WAIT();
}
__device__ __forceinline__ void transpose_item_fold(const float* W, int K, int N, bf16_t* WT, LAS float* scr, int item, int lane, const float* g, const float* bta, float* sv, float* tv) {
    const int nblk = N / 32, kb = item / nblk, nb = item % nblk, k0 = 64 * kb, n0 = 32 * nb;
    float wv_[32];
#pragma unroll
    for (int i = 0; i < 32; ++i) wv_[i] = W[(size_t)(k0 + 2 * i + (lane >> 5)) * N + n0 + (lane & 31)];
#pragma unroll
    for (int i = 0; i < 32; ++i) scr[(2 * i + (lane >> 5)) * 33 + (lane & 31)] = wv_[i];
    LDS_WAIT();
    const int c = lane & 7;
    const f32x4 g0 = *(const f32x4*)(g + k0 + 8 * c), g1 = *(const f32x4*)(g + k0 + 8 * c + 4), b0 = *(const f32x4*)(bta + k0 + 8 * c), b1 = *(const f32x4*)(bta + k0 + 8 * c + 4);
#pragma unroll
    for (int j = 0; j < 4; ++j) { const int n = (lane >> 3) + 8 * j; const LAS float* s = scr + (8 * c) * 33 + n;
        const float w0 = s[0 * 33], w1 = s[1 * 33], w2 = s[2 * 33], w3 = s[3 * 33], w4 = s[4 * 33], w5 = s[5 * 33], w6 = s[6 * 33], w7 = s[7 * 33];
        u32x4 o; o.x = pk2(g0[0] * w0, g0[1] * w1); o.y = pk2(g0[2] * w2, g0[3] * w3); o.z = pk2(g1[0] * w4, g1[1] * w5); o.w = pk2(g1[2] * w6, g1[3] * w7);
        *(u32x4*)(WT + (size_t)(n0 + n) * K + k0 + 8 * c) = o;
        float ss = ((bflo(o.x) + bfhi(o.x)) + (bflo(o.y) + bfhi(o.y))) + ((bflo(o.z) + bfhi(o.z)) + (bflo(o.w) + bfhi(o.w)));
        float tt = ((b0[0] * w0 + b0[1] * w1) + (b0[2] * w2 + b0[3] * w3)) + ((b1[0] * w4 + b1[1] * w5) + (b1[2] * w6 + b1[3] * w7));
        ss += __shfl_xor(ss, 1); ss += __shfl_xor(ss, 2); ss += __shfl_xor(ss, 4);
        tt += __shfl_xor(tt, 1); tt += __shfl_xor(tt, 2); tt += __shfl_xor(tt, 4);
        if (c == 0) { unsafeAtomicAdd(sv + n0 + n, ss); unsafeAtomicAdd(tv + n0 + n, tt); } }
    LDS_WAIT();
}
__device__ __forceinline__ void weight_items(const Params& P, LAS float* scr, int gw, int NGW, int lane, int part) {
    unsigned char* ws = P.ws;
    constexpr int I_AB = 16 * 64, I_GLU = 8 * 16, I_1M = 16 * 32, I_C = 16 * 128, I_UP = 16 * 128, I_DN = 64 * 32;
    constexpr int NREST = I_GLU + I_1M + I_C + I_1M + 2 * I_UP + 2 * I_DN;
    if (part == 0) { for (int it = gw; it < I_AB; it += NGW) transpose_item(P.in[2], 1024, 2048, (bf16_t*)(ws + OFF_WAB), scr, it, lane); return; }
    for (int it = gw; it < NREST; it += NGW) {
        int r = it;
        if (r < I_GLU) { transpose_item(P.in[11], 512, 512, (bf16_t*)(ws + OFF_WGLU), scr, r, lane); continue; } r -= I_GLU;
        if (r < I_1M) { transpose_item(P.in[13], 1024, 1024, (bf16_t*)(ws + OFF_WOAB), scr, r, lane); continue; } r -= I_1M;
        if (r < I_UP) { transpose_item_fold(P.in[20], 1024, 4096, (bf16_t*)(ws + OFF_WUP0), scr, r, lane, P.in[18], P.in[19], (float*)(ws + OFF_SV), (float*)(ws + OFF_TV)); continue; } r -= I_UP;
        if (r < I_DN) { transpose_item(P.in[22], 4096, 1024, (bf16_t*)(ws + OFF_WDN0), scr, r, lane); continue; } r -= I_DN;
        if (r < I_C) { transpose_item_fold(P.in[14], 1024, 4096, (bf16_t*)(ws + OFF_WC), scr, r, lane, P.in[24], P.in[25], (float*)(ws + OFF_SV) + 4096, (float*)(ws + OFF_TV) + 4096); continue; } r -= I_C;
        if (r < I_1M) { transpose_item(P.in[17], 1024, 1024, (bf16_t*)(ws + OFF_WOC), scr, r, lane); continue; } r -= I_1M;
        if (r < I_UP) { transpose_item_fold(P.in[20] + (size_t)1024 * 4096, 1024, 4096, (bf16_t*)(ws + OFF_WUP1), scr, r, lane, P.in[18] + 1024, P.in[19] + 1024, (float*)(ws + OFF_SV) + 8192, (float*)(ws + OFF_TV) + 8192); continue; } r -= I_UP;
        transpose_item(P.in[22] + (size_t)4096 * 1024, 4096, 1024, (bf16_t*)(ws + OFF_WDN1), scr, r, lane);
    }
}
__device__ __forceinline__ void prologue_phase(const Params& P, LAS unsigned char* lds, int blk, int G, int wave) {
    const int lane = lane_id_v(), tid = wave * 64 + lane;
    unsigned char* ws = P.ws;
    weight_items(P, (LAS float*)(lds + wave * 8448), blk * 8 + wave, G * 8, lane, 0);
    bf16_t* HB = (bf16_t*)(ws + OFF_HB);
    const size_t n8 = (size_t)R * 1024 / 8;
#pragma unroll 4
    for (size_t i = (size_t)blk * 512 + tid; i < n8; i += (size_t)G * 512) {
        const size_t e = i * 8;
        const float* src = e < (size_t)T * 1024 ? P.in[0] + e : P.in[1] + (e - (size_t)T * 1024);
        const f32x4 a = *(const f32x4*)src, b = *(const f32x4*)(src + 4);
        u32x4 w; w.x = pk2(a[0], a[1]); w.y = pk2(a[2], a[3]); w.z = pk2(b[0], b[1]); w.w = pk2(b[2], b[3]);
        *(u32x4*)(HB + e) = w;
    }
}

__device__ __forceinline__ void ln_phase(const float* Zin, float* Fout, bf16_t* Bout, const float* g, const float* bta, int nrows, int blk, int G, int wave) {
    const int lane = lane_id_v();
    for (int row = blk * 8 + wave; row < nrows; row += G * 8) {
        const f32x4* xr = (const f32x4*)(Zin + (size_t)row * 1024) + lane;
        f32x4 v[4]; float s = 0.f;
#pragma unroll
        for (int j = 0; j < 4; ++j) { v[j] = xr[64 * j]; s += (v[j][0] + v[j][1]) + (v[j][2] + v[j][3]); }
#pragma unroll
        for (int o = 1; o < 64; o <<= 1) s += __shfl_xor(s, o);
        const float mean = s * (1.f / 1024.f); float s2 = 0.f;
#pragma unroll
        for (int j = 0; j < 4; ++j) { v[j] = v[j] - mean; s2 += (v[j][0] * v[j][0] + v[j][1] * v[j][1]) + (v[j][2] * v[j][2] + v[j][3] * v[j][3]); }
#pragma unroll
        for (int o = 1; o < 64; o <<= 1) s2 += __shfl_xor(s2, o);
        const float rstd = 1.0f / sqrtf(s2 * (1.f / 1024.f) + 1e-5f);
#pragma unroll
        for (int j = 0; j < 4; ++j) {
            const int col = 4 * (lane + 64 * j);
            const f32x4 gg = *(const f32x4*)(g + col), bb = *(const f32x4*)(bta + col);
            const f32x4 o = v[j] * rstd * gg + bb;
            *(f32x4*)(Fout + (size_t)row * 1024 + col) = o;
            if (Bout) { u32x2 w; w.x = pk2(o[0], o[1]); w.y = pk2(o[2], o[3]); *(u32x2*)(Bout + (size_t)row * 1024 + col) = w; }
        }
    }
}

__device__ __forceinline__ void final_ln_phase(const bf16_t* Zb, const float* st, float* out, const float* g, const float* bta, int blk, int G, int wave) {
    const int lane = lane_id_v();
    for (int row0 = (blk * 8 + wave) * 4; row0 < T; row0 += G * 8 * 4) {
        u32x4 v[4][2];
#pragma unroll
        for (int rr = 0; rr < 4; ++rr)
#pragma unroll
            for (int j = 0; j < 2; ++j) v[rr][j] = *(const u32x4*)((const char*)Zb + ((unsigned)(row0 + rr) * 2048u + (unsigned)(8 * (lane + 64 * j)) * 2u));
#pragma unroll
        for (int rr = 0; rr < 4; ++rr) {
            const int row = row0 + rr;
            const RowCtx rc = ln_ctx(st, row);
#pragma unroll
            for (int j = 0; j < 2; ++j) {
                const int col = 8 * (lane + 64 * j);
                const f32x4 h0 = {bflo(v[rr][j].x), bfhi(v[rr][j].x), bflo(v[rr][j].y), bfhi(v[rr][j].y)}, h1 = {bflo(v[rr][j].z), bfhi(v[rr][j].z), bflo(v[rr][j].w), bfhi(v[rr][j].w)};
                float* op = out + (size_t)row * 1024 + col;
                *(f32x4*)op = (h0 - rc.mu) * rc.rstd * *(const f32x4*)(g + col) + *(const f32x4*)(bta + col);
                *(f32x4*)(op + 4) = (h1 - rc.mu) * rc.rstd * *(const f32x4*)(g + col + 4) + *(const f32x4*)(bta + col + 4);
            }
        }
    }
}

__device__ __forceinline__ void lam_coef(const float* lam_re, const float* lam_im, float dt, int idx, float& lbr, float& lbi, float& cr, float& ci) {
    const float lr = lam_re[idx], li = lam_im[idx];
    const float er = __expf(lr * dt);
    float ang = li * dt;
    const float kk = rintf(ang * 0.15915494309189535f);
    ang = fmaf(-kk, 6.2831854820251465f, ang); ang = fmaf(-kk, -1.7484555e-7f, ang);
    lbr = er * __cosf(ang); lbi = er * __sinf(ang);
    const float nr = lbr - 1.0f, ni = lbi, den = 1.0f / (lr * lr + li * li);
    cr = (nr * lr + ni * li) * den; ci = (ni * lr - nr * li) * den;
}
__device__ __forceinline__ void s5_phase(const Params& P, LAS unsigned char* lds, int blk, int G, int wave) {
    const int lane = lane_id_v(), l15 = lane & 15, quad = lane >> 4;
    LAS float* bu = (LAS float*)(lds + wave * 12800);
    LAS unsigned* sl = (LAS unsigned*)(lds + wave * 12800 + 8448);
    const bf16_t* PROJ = (const bf16_t*)(P.ws + OFF_BIG + BIG_PROJ);
    bf16_t* APRE = (bf16_t*)(P.ws + OFF_BIG + BIG_APRE);
    for (int item = blk + G * wave; item < 512; item += G * 8) {
        const int b = item >> 5, g = item & 31;
        const float dt = __expf(P.in[5][g]);
        float lbr, lbi, cr_, ci_;
        lam_coef(P.in[3], P.in[4], dt, g * 64 + lane, lbr, lbi, cr_, ci_);
        bf16x8 bfrag[8];
#pragma unroll
        for (int tile = 0; tile < 8; ++tile) {
            const int comp = 16 * tile + l15, st = comp & 63, isim = comp >> 6;
            float a0, a1, cr, ci; lam_coef(P.in[3], P.in[4], dt, g * 64 + st, a0, a1, cr, ci);
            bf16x8 fr = {0, 0, 0, 0, 0, 0, 0, 0};
            if (quad < 2) {
                const float* bre = P.in[6] + (size_t)(g * 64 + st) * 16 + 8 * quad;
                const float* bim = P.in[7] + (size_t)(g * 64 + st) * 16 + 8 * quad;
#pragma unroll
                for (int j = 0; j < 8; ++j) { const float v = isim ? (cr * bim[j] + ci * bre[j]) : (cr * bre[j] - ci * bim[j]); fr[j] = (short)f2bf(v); }
            }
            bfrag[tile] = fr;
        }
        bf16x8 cfrag[4];
#pragma unroll
        for (int ks = 0; ks < 4; ++ks) {
#pragma unroll
            for (int j = 0; j < 8; ++j) {
                const int k = 32 * ks + 8 * quad + j, p = k >> 1;
                const float v = (k & 1) ? -P.in[9][(size_t)(g * 16 + l15) * 64 + p] : P.in[8][(size_t)(g * 16 + l15) * 64 + p];
                cfrag[ks][j] = (short)f2bf(v);
            }
        }
        const float dh = P.in[10][g * 16 + l15];
        float sr = 0.f, si = 0.f;
        const bf16x8 zero8 = {0, 0, 0, 0, 0, 0, 0, 0};
        bf16x8 ua_n = *(const bf16x8*)(PROJ + (size_t)(T + l15) * 2048 + g * 16 + 8 * (quad & 1));
        unsigned short ue_n[4];
#pragma unroll
        for (int r = 0; r < 4; ++r) ue_n[r] = PROJ[(size_t)(T + 4 * quad + r) * 2048 + g * 16 + l15];
        for (int chunk = 0; chunk < 129; ++chunk) {
            const int rowbase = chunk == 0 ? T : b * 2048 + (chunk - 1) * 16;
            const bf16x8 ua = quad < 2 ? ua_n : zero8;
            unsigned short ue[4];
#pragma unroll
            for (int r = 0; r < 4; ++r) ue[r] = ue_n[r];
            {
                const int cn = chunk + 1 < 129 ? chunk + 1 : 128;
                const int rbn = b * 2048 + (cn - 1) * 16;
                ua_n = *(const bf16x8*)(PROJ + (size_t)(rbn + l15) * 2048 + g * 16 + 8 * (quad & 1));
#pragma unroll
                for (int r = 0; r < 4; ++r) ue_n[r] = PROJ[(size_t)(rbn + 4 * quad + r) * 2048 + g * 16 + l15];
            }
#pragma unroll
            for (int tile = 0; tile < 8; ++tile) {
                f32x4 acc = {0.f, 0.f, 0.f, 0.f};
                acc = MFMA16(ua, bfrag[tile], acc);
#pragma unroll
                for (int r = 0; r < 4; ++r) bu[(4 * quad + r) * 132 + 16 * tile + l15] = acc[r];
            }
            LDS_WAIT();
#pragma unroll
            for (int t = 0; t < 16; ++t) {
                const float br = bu[t * 132 + lane], bi = bu[t * 132 + 64 + lane];
                const float nsr = fmaf(lbr, sr, fmaf(-lbi, si, br)), nsi = fmaf(lbr, si, fmaf(lbi, sr, bi));
                sr = nsr; si = nsi;
                sl[t * 68 + lane] = pk2(sr, si);
            }
            LDS_WAIT();
            f32x4 y = {0.f, 0.f, 0.f, 0.f};
#pragma unroll
            for (int ks = 0; ks < 4; ++ks) {
                const bf16x8 sa = *(const LAS bf16x8*)((const LAS bf16_t*)sl + l15 * 136 + 32 * ks + 8 * quad);
                y = MFMA16(sa, cfrag[ks], y);
            }
            if (chunk > 0 || b == 0) {
#pragma unroll
                for (int r = 0; r < 4; ++r) {
                    const size_t row = (size_t)(rowbase + 4 * quad + r);
                    const float u = bf2f(ue[r]);
                    const float v = y[r] + dh * u;
                    const float a2 = 1.5957691216057308f * (v + 0.044715f * v * v * v);
                    APRE[row * 512 + g * 16 + l15] = f2bf(v * sigmoidf_(a2));
                }
            }
            LDS_WAIT();
        }
    }
}

template <bool MASKED>
__device__ __forceinline__ void attn_tile_sub(const LAS bf16_t* Kl, const LAS bf16_t* Vl, const bf16x8 (&qf)[4], int sub, int keybase  ,
                                              int iq, int l31, int h, bool pick0, f32x16& o0, f32x16& o1, float& Rrun) {
    bf16x8 ka[4];
#pragma unroll
    for (int s = 0; s < 4; ++s) ka[s] = *(const LAS bf16x8*)(Kl + (32 * sub + l31) * 72 + 16 * s + 8 * h);
    bf16x8 va[2][2];
#pragma unroll
    for (int s2 = 0; s2 < 2; ++s2)
#pragma unroll
        for (int mt = 0; mt < 2; ++mt) {
            const LAS bf16_t* vp = Vl + (32 * mt + l31) * 68 + 32 * sub + 16 * s2 + 4 * h;
            const s16x4 lo = *(const LAS s16x4*)vp, hi = *(const LAS s16x4*)(vp + 8);
            va[s2][mt] = __builtin_shufflevector(lo, hi, 0, 1, 2, 3, 4, 5, 6, 7);
        }
    __builtin_amdgcn_sched_barrier(0);
    f32x16 st;
#pragma unroll
    for (int i = 0; i < 16; ++i) st[i] = 0.f;
#pragma unroll
    for (int s = 0; s < 4; ++s) st = MFMA32(ka[s], qf[s], st);
    float kp[16], be[16];
#pragma unroll
    for (int i = 0; i < 16; ++i) {
        const float e = __builtin_amdgcn_exp2f(st[i]);
        float r = __builtin_amdgcn_rcpf(1.0f + e);
        if (MASKED) {
            const int kl = 32 * sub + (i & 3) + 8 * (i >> 2) + 4 * h;
            const bool vis = keybase >= 0 ? (keybase + kl < iq) : (kl < 16);
            r = vis ? r : 1.0f;
        }
        kp[i] = r; be[i] = 1.0f - r;
    }
    float ga[4], pa[4];
#pragma unroll
    for (int a = 0; a < 4; ++a) {
        ga[a] = (kp[4 * a] * kp[4 * a + 1]) * (kp[4 * a + 2] * kp[4 * a + 3]);
        const auto sw = __builtin_amdgcn_permlane32_swap(__float_as_uint(ga[a]), __float_as_uint(ga[a]), false, false);
        pa[a] = __uint_as_float(pick0 ? sw[0] : sw[1]);
    }
    float run = Rrun; float w[16];
#pragma unroll
    for (int a = 3; a >= 0; --a) {
        const float P3 = h ? run : run * pa[a];
        const float P2 = P3 * kp[4 * a + 3], P1 = P2 * kp[4 * a + 2], P0 = P1 * kp[4 * a + 1];
        w[4 * a + 3] = be[4 * a + 3] * P3; w[4 * a + 2] = be[4 * a + 2] * P2; w[4 * a + 1] = be[4 * a + 1] * P1; w[4 * a + 0] = be[4 * a + 0] * P0;
        run *= ga[a] * pa[a];
    }
    Rrun = run;
#pragma unroll
    for (int s2 = 0; s2 < 2; ++s2) {
        u32x4 pw; pw.x = pk2(w[8 * s2], w[8 * s2 + 1]); pw.y = pk2(w[8 * s2 + 2], w[8 * s2 + 3]); pw.z = pk2(w[8 * s2 + 4], w[8 * s2 + 5]); pw.w = pk2(w[8 * s2 + 6], w[8 * s2 + 7]);
        const bf16x8 pb = __builtin_bit_cast(bf16x8, pw);
        o0 = MFMA32(va[s2][0], pb, o0); o1 = MFMA32(va[s2][1], pb, o1);
    }
}
__device__ __forceinline__ void attn_phase(const Params& P, LAS unsigned char* lds, int blk, int G, int wave) {
    const int lane = lane_id_v(), tid = wave * 64 + lane, l31 = lane & 31, h = lane >> 5;
    const bf16_t* PROJ = (const bf16_t*)(P.ws + OFF_BIG + BIG_PROJ);
    bf16_t* CAT = (bf16_t*)(P.ws + OFF_BIG + BIG_CAT);
    if (blk == G - 1) {
        LAS float* wm = (LAS float*)(lds + 40960);
        if (tid < 128) {
            const int t = tid & 15, hd = tid >> 4;
            const bf16_t* qp = PROJ + (size_t)(T + t) * 2048 + 512 + hd * 64;
            float run = 1.f;
            for (int j = 15; j >= 0; --j) {
                float wv = 0.f;
                if (j < t) {
                    const bf16_t* kp = PROJ + (size_t)(T + j) * 2048 + 1024 + hd * 64;
                    float z = 0.f;
                    for (int d = 0; d < 64; ++d) z = fmaf(bf2f(qp[d]), bf2f(kp[d]), z);
                    const float r = __builtin_amdgcn_rcpf(1.0f + __builtin_amdgcn_exp2f(z));
                    wv = (1.0f - r) * run; run *= r;
                }
                wm[tid * 16 + j] = wv;
            }
        }
        __syncthreads();
        for (int idx = tid; idx < 16 * 512; idx += 512) {
            const int t = idx >> 9, c = idx & 511, hd = c >> 6;
            float o = 0.f;
            for (int j = 0; j < 16; ++j) o = fmaf(wm[(hd * 16 + t) * 16 + j], bf2f(PROJ[(size_t)(T + j) * 2048 + 1536 + c]), o);
            CAT[(size_t)(T + t) * 1024 + 512 + c] = f2bf(o);
        }
        __syncthreads();
    }
    bool pick0;
    { const auto hs = __builtin_amdgcn_permlane32_swap((unsigned)h, (unsigned)h, false, false); pick0 = hs[0] != (unsigned)h; }
    LAS bf16_t* Kl0 = (LAS bf16_t*)lds;
    LAS bf16_t* Vl0 = (LAS bf16_t*)(lds + 2 * 9216);
    const int lkey = tid >> 3, lpart = tid & 7;
    for (int j4 = 0; j4 < 4; ++j4) {
        const int item = blk + G * j4;
        if (item >= 1024) break;
        const int c = item % 256, jj = item / 256, bh = c >> 1, par = c & 1;
        const int qb = par == 0 ? (jj == 0 ? 7 : jj == 1 ? 0 : jj == 2 ? 4 : 3) : (jj == 0 ? 6 : jj == 1 ? 1 : jj == 2 ? 5 : 2);
        const int b = bh >> 3, hd = bh & 7;
        const int iq = 256 * qb + 32 * wave + l31;
        const size_t qrow = (size_t)b * 2048 + iq;
        bf16x8 qf[4];
#pragma unroll
        for (int s = 0; s < 4; ++s) qf[s] = *(const bf16x8*)(PROJ + qrow * 2048 + 512 + hd * 64 + 16 * s + 8 * h);
        f32x16 o0, o1;
#pragma unroll
        for (int i = 0; i < 16; ++i) { o0[i] = 0.f; o1[i] = 0.f; }
        float Rrun = 1.0f;
        const int nt = 4 * qb + 5;
        u32x4 kreg, vreg;
#define ATT_LOAD(it_) do { const int kt_ = 4 * qb + 3 - (it_); size_t row_; bool ok_ = true; \
            if (kt_ >= 0) row_ = (size_t)b * 2048 + 64 * kt_ + lkey; else { row_ = (size_t)T + lkey; ok_ = lkey < 16; } \
            if (ok_) { const bf16_t* p_ = PROJ + row_ * 2048 + 1024 + hd * 64 + lpart * 8; kreg = *(const u32x4*)p_; vreg = *(const u32x4*)(p_ + 512); } \
            else { kreg = (u32x4){0u, 0u, 0u, 0u}; vreg = kreg; } } while (0)
#define ATT_STORE(buf_) do { *(LAS u32x4*)(Kl0 + (buf_) * 4608 + lkey * 72 + lpart * 8) = kreg; \
            LAS bf16_t* vt_ = Vl0 + (buf_) * 4352 + (lpart * 8) * 68 + lkey; \
            vt_[0 * 68] = (bf16_t)(vreg.x & 0xffffu); vt_[1 * 68] = (bf16_t)(vreg.x >> 16); \
            vt_[2 * 68] = (bf16_t)(vreg.y & 0xffffu); vt_[3 * 68] = (bf16_t)(vreg.y >> 16); \
            vt_[4 * 68] = (bf16_t)(vreg.z & 0xffffu); vt_[5 * 68] = (bf16_t)(vreg.z >> 16); \
            vt_[6 * 68] = (bf16_t)(vreg.w & 0xffffu); vt_[7 * 68] = (bf16_t)(vreg.w >> 16); } while (0)
        ATT_LOAD(0); ATT_STORE(0);
        __syncthreads();
        int cur = 0;
        for (int it = 0; it < nt; ++it) {
            if (it + 1 < nt) ATT_LOAD(it + 1);
            const int kt = 4 * qb + 3 - it;
            const int keybase = kt >= 0 ? 64 * kt : -1;
            const int wq_end = 256 * qb + 32 * wave + 32;
            const LAS bf16_t* Kl = Kl0 + cur * 4608; const LAS bf16_t* Vl = Vl0 + cur * 4352;
            if (kt < 0) { attn_tile_sub<true>(Kl, Vl, qf, 0, -1, iq, l31, h, pick0, o0, o1, Rrun); }
            else {
                const int wq_beg = wq_end - 32;
                if (keybase + 64 <= wq_beg) { attn_tile_sub<false>(Kl, Vl, qf, 1, keybase, iq, l31, h, pick0, o0, o1, Rrun); attn_tile_sub<false>(Kl, Vl, qf, 0, keybase, iq, l31, h, pick0, o0, o1, Rrun); }
                else {
                    if (keybase + 32 < wq_end) attn_tile_sub<true>(Kl, Vl, qf, 1, keybase, iq, l31, h, pick0, o0, o1, Rrun);
                    if (keybase < wq_end) attn_tile_sub<true>(Kl, Vl, qf, 0, keybase, iq, l31, h, pick0, o0, o1, Rrun);
                }
            }
            if (it + 1 < nt) ATT_STORE(cur ^ 1);
            __syncthreads();
            cur ^= 1;
        }
        bf16_t* op = CAT + qrow * 1024 + 512 + hd * 64;
#pragma unroll
        for (int a = 0; a < 4; ++a) {
            u32x2 w0; w0.x = pk2(o0[4 * a], o0[4 * a + 1]); w0.y = pk2(o0[4 * a + 2], o0[4 * a + 3]);
            u32x2 w1; w1.x = pk2(o1[4 * a], o1[4 * a + 1]); w1.y = pk2(o1[4 * a + 2], o1[4 * a + 3]);
            *(u32x2*)(op + 8 * a + 4 * h) = w0; *(u32x2*)(op + 32 + 8 * a + 4 * h) = w1;
        }
    }
}

__device__ __forceinline__ void hgrn_phase(const Params& P, LAS unsigned char* lds, int blk, int G, int wave) {
    const int lane = lane_id_v(), tid = wave * 64 + lane, l15 = lane & 15, quad = lane >> 4;
    LAS bf16_t* qd = (LAS bf16_t*)lds;
    LAS bf16_t* kd = qd + 64 * 136;
    LAS bf16_t* klT = kd + 64 * 136;
    LAS bf16_t* vT = klT + 128 * 72;
    LAS bf16_t* sc = vT + 128 * 72;
    LAS float* ebl = (LAS float*)(sc + 64 * 72);
    LAS float* segtot = ebl + 128;
    LAS float* red = segtot + 1024;
    const unsigned short* PC = (const unsigned short*)(P.ws + OFF_BIG);
    bf16_t* MIXC = (bf16_t*)P.out;
    const float* ng = P.in[16];
    for (int item = blk; item < 128; item += G) {
        const int b = item >> 3, hd = item & 7;
        f32x4 Sacc[8];
#pragma unroll
        for (int i = 0; i < 8; ++i) Sacc[i] = (f32x4){0.f, 0.f, 0.f, 0.f};
        const int dp = tid & 63, sg = tid >> 6;
        unsigned lfc[8], qc[8], vc[8];
#define HG_OFF0(cc_) ((unsigned)((cc_) > 0 ? b * 2048 + ((cc_) - 1) * 64 + 8 * sg : T + (sg >= 6 ? 8 * (sg - 6) : 0)) * 8192u + (unsigned)(hd * 128 + 2 * dp) * 2u)
#define HG_LOAD(cc_, LF_, Q_, V_) do { const unsigned o0_ = HG_OFF0(cc_); _Pragma("unroll") for (int tt_ = 0; tt_ < 8; ++tt_) { const unsigned o_ = o0_ + (unsigned)tt_ * 8192u; \
            Q_[tt_] = *(const unsigned*)((const char*)PC + o_); LF_[tt_] = *(const unsigned*)((const char*)PC + o_ + 2048u); V_[tt_] = *(const unsigned*)((const char*)PC + o_ + 4096u); } } while (0)
        HG_LOAD(0, lfc, qc, vc);
        for (int c = 0; c < 33; ++c) {
            unsigned lfn[8], qn[8], vn[8];
            { const int cn = c + 1 < 33 ? c + 1 : 32; HG_LOAD(cn, lfn, qn, vn); }
            {
                float cs0[8], cs1[8]; float run0 = 0.f, run1 = 0.f;
#pragma unroll
                for (int tt = 0; tt < 8; ++tt) {
                    const bool ok = c > 0 || (8 * sg + tt) >= 48;
                    const float l0 = ok ? 1.4426950408889634f * (float)__builtin_bit_cast(_Float16, (unsigned short)(lfc[tt] & 0xffffu)) : 0.f;
                    const float l1 = ok ? 1.4426950408889634f * (float)__builtin_bit_cast(_Float16, (unsigned short)(lfc[tt] >> 16)) : 0.f;
                    run0 += l0; run1 += l1; cs0[tt] = run0; cs1[tt] = run1;
                }
                segtot[sg * 128 + 2 * dp] = run0; segtot[sg * 128 + 2 * dp + 1] = run1;
                __syncthreads();
                float off0 = 0.f, off1 = 0.f, bl0 = 0.f, bl1 = 0.f;
#pragma unroll
                for (int s2 = 0; s2 < 8; ++s2) {
                    const float a0 = segtot[s2 * 128 + 2 * dp], a1 = segtot[s2 * 128 + 2 * dp + 1];
                    bl0 += a0; bl1 += a1; if (s2 < sg) { off0 += a0; off1 += a1; }
                }
                const float ebl0 = __builtin_amdgcn_exp2f(bl0), ebl1 = __builtin_amdgcn_exp2f(bl1);
                if (sg == 7) { ebl[2 * dp] = ebl0; ebl[2 * dp + 1] = ebl1; }
                float eip0 = __builtin_amdgcn_exp2f(-off0), eip1 = __builtin_amdgcn_exp2f(-off1);
                unsigned kl0[4], kl1[4], v0[4], v1[4];
#pragma unroll
                for (int tp = 0; tp < 4; ++tp) {
                    float klv0[2], klv1[2];
#pragma unroll
                    for (int e = 0; e < 2; ++e) {
                        const int tt = 2 * tp + e, t = 8 * sg + tt;
                        const bool ok = c > 0 || t >= 48;
                        const float bt0 = off0 + cs0[tt], bt1 = off1 + cs1[tt];
                        const float q0 = ok ? bflo(qc[tt]) : 0.f, q1 = ok ? bfhi(qc[tt]) : 0.f;
                        const float eb0 = __builtin_amdgcn_exp2f(bt0), eb1 = __builtin_amdgcn_exp2f(bt1);
                        const float ei0 = __builtin_amdgcn_rcpf(eb0), ei1 = __builtin_amdgcn_rcpf(eb1);
                        const float k0 = 1.0f - eb0 * eip0, k1 = 1.0f - eb1 * eip1;
                        eip0 = ei0; eip1 = ei1;
                        const float kd0 = k0 * ei0, kd1 = k1 * ei1;
                        *(LAS unsigned*)(qd + t * 136 + 2 * dp) = pk2(q0 * eb0, q1 * eb1);
                        *(LAS unsigned*)(kd + t * 136 + 2 * dp) = pk2(kd0, kd1);
                        klv0[e] = kd0 * ebl0; klv1[e] = kd1 * ebl1;
                    }
                    kl0[tp] = pk2(klv0[0], klv0[1]); kl1[tp] = pk2(klv1[0], klv1[1]);
                    const bool okA = c > 0 || (8 * sg + 2 * tp) >= 48, okB = c > 0 || (8 * sg + 2 * tp + 1) >= 48;
                    const unsigned va = okA ? vc[2 * tp] : 0u, vb = okB ? vc[2 * tp + 1] : 0u;
                    v0[tp] = (va & 0xffffu) | (vb << 16); v1[tp] = (va >> 16) | (vb & 0xffff0000u);
                }
                *(LAS u32x4*)(klT + (2 * dp) * 72 + 8 * sg) = (u32x4){kl0[0], kl0[1], kl0[2], kl0[3]};
                *(LAS u32x4*)(klT + (2 * dp + 1) * 72 + 8 * sg) = (u32x4){kl1[0], kl1[1], kl1[2], kl1[3]};
                *(LAS u32x4*)(vT + (2 * dp) * 72 + 8 * sg) = (u32x4){v0[0], v0[1], v0[2], v0[3]};
                *(LAS u32x4*)(vT + (2 * dp + 1) * 72 + 8 * sg) = (u32x4){v1[0], v1[1], v1[2], v1[3]};
            }
            __syncthreads();
            f32x4 oacc[4];
#pragma unroll
            for (int i = 0; i < 4; ++i) oacc[i] = (f32x4){0.f, 0.f, 0.f, 0.f};
#pragma unroll
            for (int kh = 0; kh < 2; ++kh) {
                s16x4 alo[2][4], ahi[2][4];
#pragma unroll
                for (int k2 = 0; k2 < 2; ++k2)
#pragma unroll
                    for (int tt = 0; tt < 4; ++tt) { const LAS bf16_t* ap = qd + (16 * tt + l15) * 136 + 32 * (2 * kh + k2) + 4 * quad; alo[k2][tt] = *(const LAS s16x4*)ap; ahi[k2][tt] = *(const LAS s16x4*)(ap + 16); }
                __builtin_amdgcn_sched_barrier(0);
#pragma unroll
                for (int k2 = 0; k2 < 2; ++k2) {
                    const int ks = 2 * kh + k2;
                    u32x4 sw; sw.x = pk2(Sacc[2 * ks][0], Sacc[2 * ks][1]); sw.y = pk2(Sacc[2 * ks][2], Sacc[2 * ks][3]);
                    sw.z = pk2(Sacc[2 * ks + 1][0], Sacc[2 * ks + 1][1]); sw.w = pk2(Sacc[2 * ks + 1][2], Sacc[2 * ks + 1][3]);
                    const bf16x8 sb = __builtin_bit_cast(bf16x8, sw);
#pragma unroll
                    for (int tt = 0; tt < 4; ++tt) oacc[tt] = MFMA16(__builtin_shufflevector(alo[k2][tt], ahi[k2][tt], 0, 1, 2, 3, 4, 5, 6, 7), sb, oacc[tt]);
                }
                __builtin_amdgcn_sched_barrier(0);
            }
#pragma unroll
            for (int e = 0; e < 2; ++e) {
                const int tile = 2 * wave + e, tt = tile >> 2, ss = tile & 3;
                bf16x8 fa[4], fb[4];
#pragma unroll
                for (int ks = 0; ks < 4; ++ks) { fa[ks] = *(const LAS bf16x8*)(qd + (16 * tt + l15) * 136 + 32 * ks + 8 * quad); fb[ks] = *(const LAS bf16x8*)(kd + (16 * ss + l15) * 136 + 32 * ks + 8 * quad); }
                __builtin_amdgcn_sched_barrier(0);
                f32x4 sa = {0.f, 0.f, 0.f, 0.f};
#pragma unroll
                for (int ks = 0; ks < 4; ++ks) sa = MFMA16(fa[ks], fb[ks], sa);
#pragma unroll
                for (int r = 0; r < 4; ++r) { const int tg = 16 * tt + 4 * quad + r, sg_ = 16 * ss + l15; sc[tg * 72 + sg_] = f2bf(sg_ <= tg ? sa[r] : 0.f); }
                __builtin_amdgcn_sched_barrier(0);
            }
            __syncthreads();
            unsigned short gr[16];
            {
                const int cg_ = c > 0 ? c : 1;
#pragma unroll
                for (int tt = 0; tt < 4; ++tt)
#pragma unroll
                    for (int r = 0; r < 4; ++r) gr[4 * tt + r] = *(const unsigned short*)((const char*)PC + ((unsigned)(b * 2048 + (cg_ - 1) * 64 + 16 * tt + 4 * quad + r) * 8192u + (unsigned)(3072 + hd * 128 + 16 * wave + l15) * 2u));
            }
            {
#pragma unroll
                for (int dt = 0; dt < 8; ++dt) Sacc[dt] *= *(const LAS f32x4*)(ebl + 16 * dt + 4 * quad);
                __builtin_amdgcn_sched_barrier(0);
#pragma unroll
                for (int ks = 0; ks < 2; ++ks) {
                    bf16x8 fsc[4], fkl[8];
                    const bf16x8 vb = *(const LAS bf16x8*)(vT + (16 * wave + l15) * 72 + 32 * ks + 8 * quad);
#pragma unroll
                    for (int tt = 0; tt < 4; ++tt) fsc[tt] = *(const LAS bf16x8*)(sc + (16 * tt + l15) * 72 + 32 * ks + 8 * quad);
#pragma unroll
                    for (int dt = 0; dt < 8; ++dt) fkl[dt] = *(const LAS bf16x8*)(klT + (16 * dt + l15) * 72 + 32 * ks + 8 * quad);
                    __builtin_amdgcn_sched_barrier(0);
#pragma unroll
                    for (int tt = 0; tt < 4; ++tt) oacc[tt] = MFMA16(fsc[tt], vb, oacc[tt]);
#pragma unroll
                    for (int dt = 0; dt < 8; ++dt) Sacc[dt] = MFMA16(fkl[dt], vb, Sacc[dt]);
                    __builtin_amdgcn_sched_barrier(0);
                }
            }
#pragma unroll
            for (int tt = 0; tt < 4; ++tt)
#pragma unroll
                for (int r = 0; r < 4; ++r) {
                    float sq = oacc[tt][r] * oacc[tt][r];
                    sq += __int_as_float(__builtin_amdgcn_update_dpp(0, __float_as_int(sq), 0xB1, 0xf, 0xf, false));
                    sq += __int_as_float(__builtin_amdgcn_update_dpp(0, __float_as_int(sq), 0x4E, 0xf, 0xf, false));
                    sq += __int_as_float(__builtin_amdgcn_update_dpp(0, __float_as_int(sq), 0x141, 0xf, 0xf, false));
                    sq += __int_as_float(__builtin_amdgcn_update_dpp(0, __float_as_int(sq), 0x140, 0xf, 0xf, false));
                    if (l15 == 0) red[(16 * tt + 4 * quad + r) * 8 + wave] = sq;
                }
            __syncthreads();
            if (c > 0) {
                const int dvg = hd * 128 + 16 * wave + l15;
                const float gn = ng[dvg];
#pragma unroll
                for (int tt = 0; tt < 4; ++tt)
#pragma unroll
                    for (int r = 0; r < 4; ++r) {
                        const int t = 16 * tt + 4 * quad + r;
                        const f32x4 r0 = *(const LAS f32x4*)(red + t * 8), r1 = *(const LAS f32x4*)(red + t * 8 + 4);
                        const float ssum = ((r0[0] + r0[1]) + (r0[2] + r0[3])) + ((r1[0] + r1[1]) + (r1[2] + r1[3]));
                        const float rs = __builtin_amdgcn_rsqf(ssum * (1.0f / 128.0f) + 1e-6f);
                        const unsigned moff = (unsigned)(b * 2048 + (c - 1) * 64 + t) * 2048u + (unsigned)dvg * 2u;
                        const float gv = bf2f(gr[4 * tt + r]);
                        *(bf16_t*)((char*)MIXC + moff) = f2bf(oacc[tt][r] * rs * gn * gv * __builtin_amdgcn_rcpf(1.0f + __builtin_amdgcn_exp2f(-1.4426950408889634f * gv)));
                    }
            }
#pragma unroll
            for (int i = 0; i < 8; ++i) { lfc[i] = lfn[i]; qc[i] = qn[i]; vc[i] = vn[i]; }
        }
        __syncthreads();
    }
}

constexpr size_t HG_QDX_OFF = 67108864;
constexpr size_t HG_KLX = 0, HG_SCX = 67108864, HG_EBX = HG_SCX + 33554432, HG_META = HG_EBX + 2097152;
__device__ __forceinline__ void hgrn_prep_phase(const Params& P, LAS unsigned char* lds, int blk, int G, int wave) {
    const int lane = lane_id_v(), tid = wave * 64 + lane, l15 = lane & 15, quad = lane >> 4;
    LAS bf16_t* qd = (LAS bf16_t*)lds;
    LAS bf16_t* kd = qd + 64 * 136;
    LAS bf16_t* sc = kd + 64 * 136;
    LAS float* segtot = (LAS float*)(sc + 64 * 72);
    const unsigned short* PC = (const unsigned short*)(P.ws + OFF_BIG);
    char* ZR = (char*)(P.ws + OFF_Z);
    char* QDX = (char*)P.out + HG_QDX_OFF;
    const int dp = tid & 63, sg = tid >> 6;
    constexpr int NIT = 4096 + 8;
#define H1_DEC(it_, b_, hd_, c_) const int b_ = (it_) < 4096 ? (it_) >> 8 : 0, hd_ = (it_) < 4096 ? ((it_) >> 5) & 7 : (it_) - 4096, c_ = (it_) < 4096 ? ((it_) & 31) + 1 : 0
#define H1_OFF0(b_, hd_, c_) ((unsigned)((c_) > 0 ? (b_) * 2048 + ((c_) - 1) * 64 + 8 * sg : T + (sg >= 6 ? 8 * (sg - 6) : 0)) * 8192u + (unsigned)((hd_) * 128 + 2 * dp) * 2u)
#define H1_LOAD(it_, LF_, Q_) do { H1_DEC(it_, b__, hd__, c__); const unsigned o0_ = H1_OFF0(b__, hd__, c__); _Pragma("unroll") for (int tt_ = 0; tt_ < 8; ++tt_) { const unsigned o_ = o0_ + (unsigned)tt_ * 8192u; \
            Q_[tt_] = *(const unsigned*)((const char*)PC + o_); LF_[tt_] = *(const unsigned*)((const char*)PC + o_ + 2048u); } } while (0)
    unsigned lfc[8], qc[8];
    if (blk < NIT) H1_LOAD(blk, lfc, qc);
    for (int it = blk; it < NIT; it += G) {
        H1_DEC(it, b, hd, c);
        (void)b;
        unsigned lfn[8], qn[8];
        { const int itn = it + G < NIT ? it + G : it; H1_LOAD(itn, lfn, qn); }
        char *gQD, *gKL, *gSC, *gEB;
        if (c > 0) { const unsigned ix = (unsigned)(it >> 5) * 32u + (unsigned)(it & 31); gQD = QDX + (size_t)ix * 16384; gKL = ZR + HG_KLX + (size_t)ix * 16384; gSC = ZR + HG_SCX + (size_t)ix * 8192; gEB = ZR + HG_EBX + (size_t)ix * 512; }
        else { char* mb = ZR + HG_META + (size_t)hd * 41472; gQD = mb; gKL = mb + 16384; gSC = mb + 32768; gEB = mb + 40960; }
        {
            float cs0[8], cs1[8]; float run0 = 0.f, run1 = 0.f;
#pragma unroll
            for (int tt = 0; tt < 8; ++tt) {
                const bool ok = c > 0 || (8 * sg + tt) >= 48;
                const float l0 = ok ? 1.4426950408889634f * (float)__builtin_bit_cast(_Float16, (unsigned short)(lfc[tt] & 0xffffu)) : 0.f;
                const float l1 = ok ? 1.4426950408889634f * (float)__builtin_bit_cast(_Float16, (unsigned short)(lfc[tt] >> 16)) : 0.f;
                run0 += l0; run1 += l1; cs0[tt] = run0; cs1[tt] = run1;
            }
            segtot[sg * 128 + 2 * dp] = run0; segtot[sg * 128 + 2 * dp + 1] = run1;
            __syncthreads();
            float off0 = 0.f, off1 = 0.f, bl0 = 0.f, bl1 = 0.f;
#pragma unroll
            for (int s2 = 0; s2 < 8; ++s2) {
                const float a0 = segtot[s2 * 128 + 2 * dp], a1 = segtot[s2 * 128 + 2 * dp + 1];
                bl0 += a0; bl1 += a1; if (s2 < sg) { off0 += a0; off1 += a1; }
            }
            const float ebl0 = __builtin_amdgcn_exp2f(bl0), ebl1 = __builtin_amdgcn_exp2f(bl1);
            if (sg == 7) { *(float*)(gEB + (2 * dp) * 4) = ebl0; *(float*)(gEB + (2 * dp + 1) * 4) = ebl1; }
            float eip0 = __builtin_amdgcn_exp2f(-off0), eip1 = __builtin_amdgcn_exp2f(-off1);
            unsigned kl0[4], kl1[4];
#pragma unroll
            for (int tp = 0; tp < 4; ++tp) {
                float klv0[2], klv1[2];
#pragma unroll
                for (int e = 0; e < 2; ++e) {
                    const int tt = 2 * tp + e, t = 8 * sg + tt;
                    const bool ok = c > 0 || t >= 48;
                    const float bt0 = off0 + cs0[tt], bt1 = off1 + cs1[tt];
                    const float q0 = ok ? bflo(qc[tt]) : 0.f, q1 = ok ? bfhi(qc[tt]) : 0.f;
                    const float eb0 = __builtin_amdgcn_exp2f(bt0), eb1 = __builtin_amdgcn_exp2f(bt1);
                    const float ei0 = __builtin_amdgcn_rcpf(eb0), ei1 = __builtin_amdgcn_rcpf(eb1);
                    const float k0 = 1.0f - eb0 * eip0, k1 = 1.0f - eb1 * eip1;
                    eip0 = ei0; eip1 = ei1;
                    const float kd0 = k0 * ei0, kd1 = k1 * ei1;
                    const unsigned qw = pk2(q0 * eb0, q1 * eb1);
                    *(LAS unsigned*)(qd + t * 136 + 2 * dp) = qw;
                    *(unsigned*)(gQD + (unsigned)(t * 128 + 2 * dp) * 2u) = qw;
                    *(LAS unsigned*)(kd + t * 136 + 2 * dp) = pk2(kd0, kd1);
                    klv0[e] = kd0 * ebl0; klv1[e] = kd1 * ebl1;
                }
                kl0[tp] = pk2(klv0[0], klv0[1]); kl1[tp] = pk2(klv1[0], klv1[1]);
            }
            *(u32x4*)(gKL + (unsigned)((2 * dp) * 64 + 8 * sg) * 2u) = (u32x4){kl0[0], kl0[1], kl0[2], kl0[3]};
            *(u32x4*)(gKL + (unsigned)((2 * dp + 1) * 64 + 8 * sg) * 2u) = (u32x4){kl1[0], kl1[1], kl1[2], kl1[3]};
        }
        __syncthreads();
#pragma unroll
        for (int e = 0; e < 2; ++e) {
            const int tile = 2 * wave + e, tt = tile >> 2, ss = tile & 3;
            bf16x8 fa[4], fb[4];
#pragma unroll
            for (int ks = 0; ks < 4; ++ks) { fa[ks] = *(const LAS bf16x8*)(qd + (16 * tt + l15) * 136 + 32 * ks + 8 * quad); fb[ks] = *(const LAS bf16x8*)(kd + (16 * ss + l15) * 136 + 32 * ks + 8 * quad); }
            __builtin_amdgcn_sched_barrier(0);
            f32x4 sa = {0.f, 0.f, 0.f, 0.f};
#pragma unroll
            for (int ks = 0; ks < 4; ++ks) sa = MFMA16(fa[ks], fb[ks], sa);
#pragma unroll
            for (int r = 0; r < 4; ++r) { const int tg = 16 * tt + 4 * quad + r, sg_ = 16 * ss + l15; sc[tg * 72 + sg_] = f2bf(sg_ <= tg ? sa[r] : 0.f); }
            __builtin_amdgcn_sched_barrier(0);
        }
        __syncthreads();
        { const int row = tid >> 3, seg = tid & 7; *(u32x4*)(gSC + (unsigned)(row * 64 + seg * 8) * 2u) = *(const LAS u32x4*)(sc + row * 72 + seg * 8); }
#pragma unroll
        for (int i = 0; i < 8; ++i) { lfc[i] = lfn[i]; qc[i] = qn[i]; }
    }
    __syncthreads();
}
__device__ __forceinline__ void hgrn_core_phase(const Params& P, LAS unsigned char* lds, int blk, int G, int wave) {
    const int lane = lane_id_v(), tid = wave * 64 + lane, l15 = lane & 15, quad = lane >> 4;
    LAS bf16_t* qd = (LAS bf16_t*)lds;
    LAS bf16_t* klT = qd + 64 * 136;
    LAS bf16_t* vT = klT + 128 * 72;
    LAS bf16_t* sc = vT + 128 * 72;
    LAS float* ebl = (LAS float*)(sc + 64 * 72);
    LAS float* red = ebl + 128;
    const unsigned short* PC = (const unsigned short*)(P.ws + OFF_BIG);
    const char* ZR = (const char*)(P.ws + OFF_Z);
    const char* QDX = (const char*)P.out + HG_QDX_OFF;
    bf16_t* MIXC = (bf16_t*)P.out;
    const float* ng = P.in[16];
    const int dp = tid & 63, sg = tid >> 6;
    for (int item = blk; item < 128; item += G) {
        const int b = item >> 3, hd = item & 7;
        f32x4 Sacc[8];
#pragma unroll
        for (int i = 0; i < 8; ++i) Sacc[i] = (f32x4){0.f, 0.f, 0.f, 0.f};
        u32x4 rq[2], rk[2], rs, re; unsigned rv[8];
#define H2_LOAD(cc_) do { const char *gQD_, *gKL_, *gSC_, *gEB_; \
            if ((cc_) > 0) { const unsigned ix_ = (unsigned)item * 32u + (unsigned)((cc_) - 1); gQD_ = QDX + (size_t)ix_ * 16384; gKL_ = ZR + HG_KLX + (size_t)ix_ * 16384; gSC_ = ZR + HG_SCX + (size_t)ix_ * 8192; gEB_ = ZR + HG_EBX + (size_t)ix_ * 512; } \
            else { const char* mb_ = ZR + HG_META + (size_t)hd * 41472; gQD_ = mb_; gKL_ = mb_ + 16384; gSC_ = mb_ + 32768; gEB_ = mb_ + 40960; } \
            rq[0] = *(const u32x4*)(gQD_ + tid * 16); rq[1] = *(const u32x4*)(gQD_ + 8192 + tid * 16); \
            rk[0] = *(const u32x4*)(gKL_ + tid * 16); rk[1] = *(const u32x4*)(gKL_ + 8192 + tid * 16); \
            rs = *(const u32x4*)(gSC_ + tid * 16); re = *(const u32x4*)(gEB_ + (tid & 31) * 16); \
            const unsigned o0_ = (unsigned)((cc_) > 0 ? b * 2048 + ((cc_) - 1) * 64 + 8 * sg : T + (sg >= 6 ? 8 * (sg - 6) : 0)) * 8192u + (unsigned)(2048 + hd * 128 + 2 * dp) * 2u; \
            _Pragma("unroll") for (int tt_ = 0; tt_ < 8; ++tt_) rv[tt_] = *(const unsigned*)((const char*)PC + o0_ + (unsigned)tt_ * 8192u); } while (0)
        H2_LOAD(0);
        for (int c = 0; c < 33; ++c) {
            {
#pragma unroll
                for (int j = 0; j < 2; ++j) { const int e = tid * 8 + j * 4096; *(LAS u32x4*)(qd + (e >> 7) * 136 + (e & 127)) = rq[j]; *(LAS u32x4*)(klT + (e >> 6) * 72 + (e & 63)) = rk[j]; }
                { const int e = tid * 8; *(LAS u32x4*)(sc + (e >> 6) * 72 + (e & 63)) = rs; }
                if (tid < 32) *(LAS u32x4*)(ebl + tid * 4) = re;
                unsigned v0[4], v1[4];
#pragma unroll
                for (int tp = 0; tp < 4; ++tp) {
                    const bool okA = c > 0 || (8 * sg + 2 * tp) >= 48, okB = c > 0 || (8 * sg + 2 * tp + 1) >= 48;
                    const unsigned va = okA ? rv[2 * tp] : 0u, vb = okB ? rv[2 * tp + 1] : 0u;
                    v0[tp] = (va & 0xffffu) | (vb << 16); v1[tp] = (va >> 16) | (vb & 0xffff0000u);
                }
                *(LAS u32x4*)(vT + (2 * dp) * 72 + 8 * sg) = (u32x4){v0[0], v0[1], v0[2], v0[3]};
                *(LAS u32x4*)(vT + (2 * dp + 1) * 72 + 8 * sg) = (u32x4){v1[0], v1[1], v1[2], v1[3]};
            }
            __syncthreads();
            { const int cn = c + 1 < 33 ? c + 1 : 32; H2_LOAD(cn); }
            unsigned short gr[16];
            {
                const int cg_ = c > 0 ? c : 1;
#pragma unroll
                for (int tt = 0; tt < 4; ++tt)
#pragma unroll
                    for (int r = 0; r < 4; ++r) gr[4 * tt + r] = *(const unsigned short*)((const char*)PC + ((unsigned)(b * 2048 + (cg_ - 1) * 64 + 16 * tt + 4 * quad + r) * 8192u + (unsigned)(3072 + hd * 128 + 16 * wave + l15) * 2u));
            }
            f32x4 oacc[4];
#pragma unroll
            for (int i = 0; i < 4; ++i) oacc[i] = (f32x4){0.f, 0.f, 0.f, 0.f};
#pragma unroll
            for (int kh = 0; kh < 2; ++kh) {
                s16x4 alo[2][4], ahi[2][4];
#pragma unroll
                for (int k2 = 0; k2 < 2; ++k2)
#pragma unroll
                    for (int tt = 0; tt < 4; ++tt) { const LAS bf16_t* ap = qd + (16 * tt + l15) * 136 + 32 * (2 * kh + k2) + 4 * quad; alo[k2][tt] = *(const LAS s16x4*)ap; ahi[k2][tt] = *(const LAS s16x4*)(ap + 16); }
                __builtin_amdgcn_sched_barrier(0);
#pragma unroll
                for (int k2 = 0; k2 < 2; ++k2) {
                    const int ks = 2 * kh + k2;
                    u32x4 sw; sw.x = pk2(Sacc[2 * ks][0], Sacc[2 * ks][1]); sw.y = pk2(Sacc[2 * ks][2], Sacc[2 * ks][3]);
                    sw.z = pk2(Sacc[2 * ks + 1][0], Sacc[2 * ks + 1][1]); sw.w = pk2(Sacc[2 * ks + 1][2], Sacc[2 * ks + 1][3]);
                    const bf16x8 sb = __builtin_bit_cast(bf16x8, sw);
#pragma unroll
                    for (int tt = 0; tt < 4; ++tt) oacc[tt] = MFMA16(__builtin_shufflevector(alo[k2][tt], ahi[k2][tt], 0, 1, 2, 3, 4, 5, 6, 7), sb, oacc[tt]);
                }
                __builtin_amdgcn_sched_barrier(0);
            }
            {
#pragma unroll
                for (int dt = 0; dt < 8; ++dt) Sacc[dt] *= *(const LAS f32x4*)(ebl + 16 * dt + 4 * quad);
                __builtin_amdgcn_sched_barrier(0);
#pragma unroll
                for (int ks = 0; ks < 2; ++ks) {
                    bf16x8 fsc[4], fkl[8];
                    const bf16x8 vb = *(const LAS bf16x8*)(vT + (16 * wave + l15) * 72 + 32 * ks + 8 * quad);
#pragma unroll
                    for (int tt = 0; tt < 4; ++tt) fsc[tt] = *(const LAS bf16x8*)(sc + (16 * tt + l15) * 72 + 32 * ks + 8 * quad);
#pragma unroll
                    for (int dt = 0; dt < 8; ++dt) fkl[dt] = *(const LAS bf16x8*)(klT + (16 * dt + l15) * 72 + 32 * ks + 8 * quad);
                    __builtin_amdgcn_sched_barrier(0);
#pragma unroll
                    for (int tt = 0; tt < 4; ++tt) oacc[tt] = MFMA16(fsc[tt], vb, oacc[tt]);
#pragma unroll
                    for (int dt = 0; dt < 8; ++dt) Sacc[dt] = MFMA16(fkl[dt], vb, Sacc[dt]);
                    __builtin_amdgcn_sched_barrier(0);
                }
            }
#pragma unroll
            for (int tt = 0; tt < 4; ++tt)
#pragma unroll
                for (int r = 0; r < 4; ++r) {
                    float sq = oacc[tt][r] * oacc[tt][r];
                    sq += __int_as_float(__builtin_amdgcn_update_dpp(0, __float_as_int(sq), 0xB1, 0xf, 0xf, false));
                    sq += __int_as_float(__builtin_amdgcn_update_dpp(0, __float_as_int(sq), 0x4E, 0xf, 0xf, false));
                    sq += __int_as_float(__builtin_amdgcn_update_dpp(0, __float_as_int(sq), 0x141, 0xf, 0xf, false));
                    sq += __int_as_float(__builtin_amdgcn_update_dpp(0, __float_as_int(sq), 0x140, 0xf, 0xf, false));
                    if (l15 == 0) red[(16 * tt + 4 * quad + r) * 8 + wave] = sq;
                }
            __syncthreads();
            if (c > 0) {
                const int dvg = hd * 128 + 16 * wave + l15;
                const float gn = ng[dvg];
#pragma unroll
                for (int tt = 0; tt < 4; ++tt)
#pragma unroll
                    for (int r = 0; r < 4; ++r) {
                        const int t = 16 * tt + 4 * quad + r;
                        const f32x4 r0 = *(const LAS f32x4*)(red + t * 8), r1 = *(const LAS f32x4*)(red + t * 8 + 4);
                        const float ssum = ((r0[0] + r0[1]) + (r0[2] + r0[3])) + ((r1[0] + r1[1]) + (r1[2] + r1[3]));
                        const float rs_ = __builtin_amdgcn_rsqf(ssum * (1.0f / 128.0f) + 1e-6f);
                        const unsigned moff = (unsigned)(b * 2048 + (c - 1) * 64 + t) * 2048u + (unsigned)dvg * 2u;
                        const float gv = bf2f(gr[4 * tt + r]);
                        *(bf16_t*)((char*)MIXC + moff) = f2bf(oacc[tt][r] * rs_ * gn * gv * __builtin_amdgcn_rcpf(1.0f + __builtin_amdgcn_exp2f(-1.4426950408889634f * gv)));
                    }
            }
        }
        __syncthreads();
    }
}

__global__ void __launch_bounds__(512, 2) fwd_megakernel(Params P) {
    extern __shared__ __attribute__((aligned(16))) unsigned char lds_raw[];
    LAS unsigned char* lds = (LAS unsigned char*)lds_raw;
    cg::grid_group grid = cg::this_grid();
    const int blk = blockIdx.x, G = gridDim.x, wave = __builtin_amdgcn_readfirstlane((int)(threadIdx.x >> 6));
    unsigned char* ws = P.ws;
    bf16_t* HB = (bf16_t*)(ws + OFF_HB);
    float* Z = (float*)(ws + OFF_Z);
    bf16_t* PROJ = (bf16_t*)(ws + OFF_BIG + BIG_PROJ);
    bf16_t* APRE = (bf16_t*)(ws + OFF_BIG + BIG_APRE);
    bf16_t* CAT = (bf16_t*)(ws + OFF_BIG + BIG_CAT);
    bf16_t* HID = (bf16_t*)(ws + OFF_BIG);
    unsigned short* PC = (unsigned short*)(ws + OFF_BIG);

    volatile LAS unsigned* xst = (volatile LAS unsigned*)(lds + 131072);
    if (wave == 0 && lane_id_v() < 4) xst[lane_id_v()] = 0u;
    __syncthreads();
    const XcdBarrier xb = xcd_barrier_post((unsigned*)(ws + OFF_BAR), xst, wave);
    prologue_phase(P, lds, blk, G, wave);
#if PROBE_DUP_PRO
    __syncthreads();
    prologue_phase(P, lds, blk, G, wave);
#endif
    if (G == 0x7fffffff) grid.sync();
    xcd_barrier(xb, wave);
    run_gemm(lds, HB, (const bf16_t*)(ws + OFF_WAB), 2048, 1024, EpInAB{PROJ}, true, blk, G, wave);
#if PROBE_GEMMS
    __syncthreads();
    run_gemm(lds, HB, (const bf16_t*)(ws + OFF_WAB), 2048, 1024, EpInAB{PROJ}, true, blk, G, wave);
#endif
    xcd_barrier(xb, wave);
    if (wave >= 2) weight_items(P, (LAS float*)(lds + 25600 + (wave - 2) * 8448), blk * 6 + (wave - 2), G * 6, lane_id_v(), 1);
    s5_phase(P, lds, blk, G, wave);
    __syncthreads();
#if PROBE_DUP_S5
    s5_phase(P, lds, blk, G, wave);
    __syncthreads();
#endif
    attn_phase(P, lds, blk, G, wave);
#if PROBE_DUP_ATTN
    __syncthreads();
    attn_phase(P, lds, blk, G, wave);
#endif
    xcd_barrier(xb, wave);
    run_gemm(lds, APRE, (const bf16_t*)(ws + OFF_WGLU), 512, 512, EpGlu{APRE, P.in[12], CAT}, true, blk, G, wave);
    xcd_barrier(xb, wave);
    float* ST = (float*)(ws + OFF_ST); const float* SV = (const float*)(ws + OFF_SV); const float* TV = (const float*)(ws + OFF_TV);
    float *ST1 = ST, *ST2 = ST + 2 * (size_t)R, *ST3 = ST + 4 * (size_t)R, *ST4 = ST + 6 * (size_t)R;
#if PROBE_DUP_OUTAB
    run_gemm(lds, CAT, (const bf16_t*)(ws + OFF_WOAB), 1024, 1024, EpRes<NB_OUTAB>{HB, nullptr, nullptr, nullptr, nullptr, ST + 8 * (size_t)R}, true, blk, G, wave);
    __syncthreads();
#endif
    run_gemm(lds, CAT, (const bf16_t*)(ws + OFF_WOAB), 1024, 1024, EpRes<NB_OUTAB>{HB, nullptr, nullptr, nullptr, nullptr, ST1}, true, blk, G, wave);
    xcd_barrier(xb, wave);
    run_gemm(lds, HB, (const bf16_t*)(ws + OFF_WUP0), 4096, 1024, EpUp{HID, P.in[21], ST1, SV, TV}, true, blk, G, wave);
#if PROBE_DUP_UP0
    __syncthreads();
    run_gemm(lds, HB, (const bf16_t*)(ws + OFF_WUP0), 4096, 1024, EpUp{HID, P.in[21], ST1, SV, TV}, true, blk, G, wave);
#endif
#if PROBE_SYNCS
    for (int i_ = 0; i_ < PROBE_SYNCS; ++i_) xcd_barrier(xb, wave);
#endif
    xcd_barrier(xb, wave);
#if PROBE_GEMMS
    run_gemm(lds, HID, (const bf16_t*)(ws + OFF_WDN0), 1024, 4096, EpInAB{(bf16_t*)P.out}, false, blk, G, wave);
    __syncthreads();
#endif
    run_gemm(lds, HID, (const bf16_t*)(ws + OFF_WDN0), 1024, 4096, EpRes<NB_DN0>{HB, P.in[23], ST1, P.in[18], P.in[19], ST2}, true, blk, G, wave);
    xcd_barrier(xb, wave);
    run_gemm(lds, HB, (const bf16_t*)(ws + OFF_WC), 4096, 1024, EpInC{PC, P.in[15], ST2, SV + 4096, TV + 4096}, true, blk, G, wave);
#if PROBE_DUP_INC
    __syncthreads();
    run_gemm(lds, HB, (const bf16_t*)(ws + OFF_WC), 4096, 1024, EpInC{PC, P.in[15], ST2, SV + 4096, TV + 4096}, true, blk, G, wave);
#endif
    xcd_barrier(xb, wave);
#if HGRN_TWO_PHASE
    hgrn_prep_phase(P, lds, blk, G, wave);
    xcd_barrier(xb, wave);
    hgrn_core_phase(P, lds, blk, G, wave);
#else
    hgrn_phase(P, lds, blk, G, wave);
#endif
    xcd_barrier(xb, wave);
    run_gemm(lds, (const bf16_t*)P.out  , (const bf16_t*)(ws + OFF_WOC), 1024, 1024, EpRes<NB_OUTC>{HB, nullptr, ST2, P.in[24], P.in[25], ST3}, false, blk, G, wave);
    xcd_barrier(xb, wave);
    run_gemm(lds, HB, (const bf16_t*)(ws + OFF_WUP1), 4096, 1024, EpUp{HID, P.in[21] + 4096, ST3, SV + 8192, TV + 8192}, false, blk, G, wave);
    xcd_barrier(xb, wave);
    run_gemm(lds, HID, (const bf16_t*)(ws + OFF_WDN1), 1024, 4096, EpRes<NB_DN1>{HB, P.in[23] + 1024, ST3, P.in[18] + 1024, P.in[19] + 1024, ST4}, false, blk, G, wave);
    xcd_barrier(xb, wave);
    final_ln_phase(HB, ST4, P.out, P.in[24] + 1024, P.in[25] + 1024, blk, G, wave);
}

extern "C" void kernel_launch(void* const* d_in, const int* in_sizes, int n_in, void* d_out, int out_size, void* d_ws, size_t ws_size, hipStream_t stream) {
    constexpr size_t kDynLds = 131072 + 256;
    static int grid_blocks = 0;
    if (!grid_blocks) {
        if (n_in != 26 || ws_size < ZERO_END) { fprintf(stderr, "kernel_launch: expected 26 inputs and >= %zu bytes of workspace (got %d, %zu)\n", (size_t)ZERO_END, n_in, ws_size); grid_blocks = -1; return; }
        int dev = 0, cus = 0, per_cu = 0;
        hipGetDevice(&dev);
        hipDeviceGetAttribute(&cus, hipDeviceAttributeMultiprocessorCount, dev);
        hipFuncSetAttribute((const void*)fwd_megakernel, hipFuncAttributeMaxDynamicSharedMemorySize, (int)kDynLds);
        hipOccupancyMaxActiveBlocksPerMultiprocessor(&per_cu, (const void*)fwd_megakernel, 512, kDynLds);
        if (per_cu < 1) { fprintf(stderr, "kernel_launch: occupancy query says %d blocks per CU\n", per_cu); per_cu = 1; }
        grid_blocks = cus * (per_cu > 1 ? 1 : per_cu);
        if (grid_blocks != 256) fprintf(stderr, "kernel_launch: note: grid is %d workgroups (tuned for 256)\n", grid_blocks);
    }
    if (grid_blocks < 1) return;
    Params p{};
    for (int i = 0; i < 26; ++i) p.in[i] = (const float*)d_in[i];
    p.out = (float*)d_out; p.ws = (unsigned char*)d_ws;
    hipMemsetAsync((char*)d_ws + OFF_ST, 0, ZERO_END - OFF_ST, stream);
    void* args[] = {&p};
    hipError_t e = hipLaunchCooperativeKernel((const void*)fwd_megakernel, dim3(grid_blocks), dim3(512), args, kDynLds, stream);
    if (e != hipSuccess) fprintf(stderr, "cooperative launch failed: %s (grid %d)\n", hipGetErrorString(e), grid_blocks);
}
```

```cpp
#define NB_OUTAB 4
#define NB_DN0 2
#define NB_OUTC 4
#define NB_DN1 2
#include <hip/hip_runtime.h>
#include <hip/hip_cooperative_groups.h>
#include <cstdio>
#include <cstdint>
namespace cg = cooperative_groups;
#ifndef PROBE_DUP_S5
#define PROBE_DUP_S5 0
#endif
#ifndef PROBE_DUP_ATTN
#define PROBE_DUP_ATTN 0
#endif
#ifndef PROBE_DUP_HGRN
#define PROBE_DUP_HGRN 0
#endif
#ifndef PROBE_DUP_INC
#define PROBE_DUP_INC 0
#endif
__device__ __forceinline__ int lane_id_v() { int l; asm volatile("v_mbcnt_lo_u32_b32 %0, -1, 0\n\tv_mbcnt_hi_u32_b32 %0, -1, %0" : "=v"(l)); return l; }
#ifndef PROBE_DUP_UP0
#define PROBE_DUP_UP0 0
#endif
#ifndef PROBE_SYNCS
#define PROBE_SYNCS 0
#endif
#ifndef NB_OUTAB
#define NB_OUTAB 4
#endif
#ifndef NB_DN0
#define NB_DN0 4
#endif
#ifndef NB_OUTC
#define NB_OUTC 4
#endif
#ifndef NB_DN1
#define NB_DN1 4
#endif
#ifndef PROBE_GEMMS
#define PROBE_GEMMS 0
#endif
#ifndef PROBE_DUP_PRO
#define PROBE_DUP_PRO 0
#endif
#ifndef PROBE_DUP_OUTAB
#define PROBE_DUP_OUTAB 0
#endif
#ifndef HGRN_TWO_PHASE
#define HGRN_TWO_PHASE 0
#endif
#define XB_TMO      128
#define XB_XCNT(j)  (256  + 64 * (j))
#define XB_XSUB(j)  (1280 + 64 * (j))
#define XB_XGEN(j)  (2304 + 64 * (j))
#define XB_TOP      3328
#define XB_TOPGEN   3392
#define XCD_BAR_WORDS 3456
#define XB_SPIN_CAP (1u << 18)

__device__ __forceinline__ unsigned xb_ld(unsigned* p)              { return __hip_atomic_load(p, __ATOMIC_RELAXED, __HIP_MEMORY_SCOPE_AGENT); }
__device__ __forceinline__ unsigned xb_add(unsigned* p, unsigned v) { return __hip_atomic_fetch_add(p, v, __ATOMIC_RELAXED, __HIP_MEMORY_SCOPE_AGENT); }
__device__ __forceinline__ unsigned xb_xcc_id() { return (unsigned)__builtin_amdgcn_s_getreg((3 << 11) | 20) & 0xFu; }
#define XB_SPIN(cond, bar) do { unsigned _sp = 0; while (cond) { __builtin_amdgcn_s_sleep(1); \
    if ((++_sp & 255u) == 0u) { if (xb_ld(&(bar)[XB_TMO])) break; if (_sp > XB_SPIN_CAP) { atomicAdd(&(bar)[XB_TMO], 1u); break; } } } } while (0)

struct XcdBarrier {
    unsigned* bar; unsigned x;
    volatile __attribute__((address_space(3))) unsigned* st;
};

__device__ __forceinline__ XcdBarrier xcd_barrier_post(unsigned* bar, volatile __attribute__((address_space(3))) unsigned* st, int wave_in) {
    XcdBarrier b; b.bar = bar; b.x = xb_xcc_id(); b.st = st;
    if (wave_in == 0 && lane_id_v() == 0) (void)xb_add(&bar[XB_XCNT(b.x)], 1u);
    return b;
}
__device__ __forceinline__ void xcd_barrier_complete(unsigned* bar, unsigned x, unsigned& nloc, unsigned& nx) {
    const unsigned G = gridDim.x * gridDim.y * gridDim.z;
    unsigned sum, cnt, mine, sp = 0u;
    for (;;) {
        sum = 0u; cnt = 0u; mine = 0u;
#pragma unroll
        for (unsigned j = 0; j < 16; ++j) { const unsigned c = xb_ld(&bar[XB_XCNT(j)]); sum += c; cnt += (c > 0u) ? 1u : 0u; mine = (j == x) ? c : mine; }
        if (sum == G) break;
        __builtin_amdgcn_s_sleep(1);
        if ((++sp & 255u) == 0u) { if (xb_ld(&bar[XB_TMO])) break; if (sp > XB_SPIN_CAP) { atomicAdd(&bar[XB_TMO], 1u); break; } }
    }
    nloc = mine > 0u ? mine : 1u; nx = cnt > 0u ? cnt : 1u;
}

__device__ __forceinline__ void xcd_barrier(const XcdBarrier& b, int wave_in) {
    asm volatile("s_waitcnt vmcnt(0)" ::: "memory");
    __syncthreads();
    if (wave_in == 0 && lane_id_v() == 0) {
        unsigned* bar = b.bar;
        __builtin_amdgcn_s_waitcnt(0);
        unsigned nloc = b.st[0], nx = b.st[1];
        if (nloc == 0u) { xcd_barrier_complete(bar, b.x, nloc, nx); b.st[0] = nloc; b.st[1] = nx; }
        const unsigned old = xb_add(&bar[XB_XSUB(b.x)], 1u);
        const unsigned gen = old / nloc;
        if (old + 1u == (gen + 1u) * nloc) {
            __builtin_amdgcn_fence(__ATOMIC_RELEASE, "agent");
            asm volatile("s_waitcnt vmcnt(0)" ::: "memory");
            const unsigned og = xb_add(&bar[XB_TOP], 1u);
            const unsigned tg = og / nx;
            if (og + 1u == (tg + 1u) * nx) xb_add(&bar[XB_TOPGEN], 1u);
            else XB_SPIN(xb_ld(&bar[XB_TOPGEN]) == tg, bar);
            __builtin_amdgcn_fence(__ATOMIC_ACQUIRE, "agent");
            xb_add(&bar[XB_XGEN(b.x)], 1u);
            asm volatile("s_waitcnt vmcnt(0)" ::: "memory");
        } else {
            XB_SPIN(xb_ld(&bar[XB_XGEN(b.x)]) == gen, bar);
            __builtin_amdgcn_fence(__ATOMIC_ACQUIRE, "agent");
            asm volatile("s_waitcnt vmcnt(0)" ::: "memory");
        }
    }
    __syncthreads();
}

namespace pg8 {
#define PG8_LAS __attribute__((address_space(3)))
typedef unsigned short bf16_t;
typedef short bf16x8 __attribute__((ext_vector_type(8)));
typedef float f32x4 __attribute__((ext_vector_type(4)));
typedef unsigned u32x4 __attribute__((ext_vector_type(4)));
constexpr int BM = 256, BK = 64, HALF = 128, HTB = HALF * BK * 2  , STAGE_BYTES = 8 * HTB, NXCD = 8, WGM = 8;

__host__ __device__ __forceinline__ int lds_byte(int r, int c) { const int st = (r >> 4) * 2 + (c >> 5), rr = r & 15, cc = c & 31, ob = rr * 64 + cc * 2; return st * 1024 + (ob ^ (((ob >> 9) & 1) << 5)); }
__host__ __device__ __forceinline__ void stage_rc(int b, int& R, int& C) { const int st = b / 1024, sb = b % 1024, swz = sb ^ (((sb >> 9) & 1) << 5); R = (st >> 1) * 16 + swz / 64; C = (st & 1) * 32 + (swz % 64) / 2; }
__host__ __device__ __forceinline__ int perm32(int rho) { const int n = rho >> 4, i = rho & 15; return 8 * (i >> 2) + 4 * n + (i & 3); }

struct Unit { int pm, pn; };
struct Gemm { const bf16_t* A; const bf16_t* Bt; int M, N, K; };

struct StaticOrder {
    int nM, nN, nwg, G, c;
    __host__ __device__ void init(int M, int N, int G_, int c_) { nM = M / BM; nN = N / BM; nwg = nM * nN; G = G_; c = c_; }
    __host__ __device__ bool next(int i, Unit& u) const {
        const long L = (long)i * G + c; if (L >= nwg) return false;
        int wgid = (int)L; { const int q = nwg / NXCD, r = nwg % NXCD, xcd = wgid % NXCD, off = wgid / NXCD; wgid = (xcd < r ? xcd * (q + 1) : r * (q + 1) + (xcd - r) * q) + off; }
        const int nig = WGM * nN, gid = wgid / nig, fm = gid * WGM, gsz = (nM - fm) < WGM ? (nM - fm) : WGM;
        u.pm = fm + ((wgid % nig) % gsz); u.pn = (wgid % nig) / gsz; return true;
    }
    __device__ __forceinline__ void a_ready(const Unit&) const {}
    __device__ __forceinline__ void done(const Unit&) const {}
};

__device__ __forceinline__ unsigned cvt_pk_bf16(float lo, float hi) { unsigned r; asm volatile("v_cvt_pk_bf16_f32 %0, %1, %2" : "=v"(r) : "v"(lo), "v"(hi)); return r; }
template <class Epi, class Sched, bool ALIGN_EPI = false, bool SP2 = false>
__device__ __forceinline__ void gemm_phase(PG8_LAS unsigned char* lds, const Gemm g, const Sched& S, const Epi& E, int wave_in) {
    const int lane = lane_id_v(), wid = __builtin_amdgcn_readfirstlane(wave_in), tid = wid * 64 + lane, wr = wid >> 2, wc = wid & 3, fr = lane & 15, fq = lane >> 4;
    const int K = g.K, nt = K / BK;
    unsigned voffA[2], voffB[2];
#pragma unroll
    for (int i = 0; i < 2; ++i) { int R, C; stage_rc(tid * 16 + i * 8192, R, C); const int Rb = Epi::PERM ? ((R & ~31) + perm32(R & 31)) : R;
        voffA[i] = (unsigned)(R * K + C) * 2u; voffB[i] = (unsigned)(Rb * K + C) * 2u; }
    const size_t kstep = (size_t)(BK * 2);
    const size_t hstep = (size_t)HALF * K * 2;
    const size_t tstep = 2 * hstep;
    const unsigned ldsw = (unsigned)wid * 1024u;
    const int aoff = lds_byte(wr * 64 + fr, fq * 8), boff = lds_byte(wc * 32 + fr, fq * 8);
#define PG8_SA(b, h) (((b) * 2 + (h)) * HTB)
#define PG8_SB(b, h) ((4 + (b) * 2 + (h)) * HTB)
#define PG8_STAGE(bufoff, gbase, voff) do { _Pragma("unroll") for (int _i = 0; _i < 2; ++_i) \
        __builtin_amdgcn_global_load_lds((const unsigned*)((const char*)(gbase) + (voff)[_i]), (PG8_LAS unsigned*)(lds + (bufoff) + ldsw + _i * 8192), 16, 0, 0); } while (0)
#define PG8_LDA(dst, b, h) do { _Pragma("unroll") for (int m = 0; m < 4; ++m) _Pragma("unroll") for (int k = 0; k < 2; ++k) dst[m][k] = *(const PG8_LAS bf16x8*)(lds + PG8_SA(b, h) + aoff + m * 2048 + k * 1024); } while (0)
#define PG8_LDB(dst, b, h) do { _Pragma("unroll") for (int n = 0; n < 2; ++n) _Pragma("unroll") for (int k = 0; k < 2; ++k) dst[n][k] = *(const PG8_LAS bf16x8*)(lds + PG8_SB(b, h) + boff + n * 2048 + k * 1024); } while (0)
#define PG8_MMA(ai, bj, At, Bt) do { __builtin_amdgcn_s_setprio(1); _Pragma("unroll") for (int m = 0; m < 4; ++m) _Pragma("unroll") for (int n = 0; n < 2; ++n) _Pragma("unroll") for (int k = 0; k < 2; ++k) \
        acc[ai][bj][m][n] = __builtin_amdgcn_mfma_f32_16x16x32_bf16(Bt[n][k], At[m][k], acc[ai][bj][m][n], 0, 0, 0); __builtin_amdgcn_s_setprio(0); } while (0)
#define PG8_WAIT_V(n) asm volatile("s_waitcnt vmcnt(" #n ")" ::: "memory")
#define PG8_WAIT_L(n) asm volatile("s_waitcnt lgkmcnt(" #n ")" ::: "memory")
#define PG8_BAR __builtin_amdgcn_s_barrier()
#define PG8_SCHED __builtin_amdgcn_sched_barrier(0)
    Unit cur, nxt; int ui = 0;
    if (!S.next(0, cur)) return;
    f32x4 acc[2][2][4][2];
#pragma unroll
    for (int a = 0; a < 2; ++a)
#pragma unroll
        for (int b = 0; b < 2; ++b)
#pragma unroll
            for (int m = 0; m < 4; ++m)
#pragma unroll
                for (int n = 0; n < 2; ++n) acc[a][b][m][n] = (f32x4){0.f, 0.f, 0.f, 0.f};
    bf16x8 At[4][2], B0[2][2], B1[2][2];
    const char* cA = (const char*)g.A + (size_t)cur.pm * tstep; const char* cB = (const char*)g.Bt + (size_t)cur.pn * tstep;
    S.a_ready(cur);
    if constexpr (SP2) {
        PG8_STAGE(PG8_SB(0, 0), cB, voffB); PG8_STAGE(PG8_SB(0, 1), cB + hstep, voffB); PG8_STAGE(PG8_SA(0, 0), cA, voffA); PG8_STAGE(PG8_SA(0, 1), cA + hstep, voffA);
        if (wr == 1) PG8_BAR;
        PG8_WAIT_V(2); PG8_BAR;
        PG8_STAGE(PG8_SB(1, 0), cB + kstep, voffB); PG8_STAGE(PG8_SA(1, 0), cA + kstep, voffA); PG8_STAGE(PG8_SB(1, 1), cB + hstep + kstep, voffB);
        PG8_WAIT_V(6); PG8_BAR;
    } else {
        PG8_STAGE(PG8_SB(0, 0), cB, voffB); PG8_STAGE(PG8_SA(0, 0), cA, voffA); PG8_STAGE(PG8_SB(0, 1), cB + hstep, voffB); PG8_STAGE(PG8_SA(0, 1), cA + hstep, voffA);
        if (wr == 1) PG8_BAR;
        PG8_WAIT_V(4); PG8_BAR;
        PG8_STAGE(PG8_SB(1, 0), cB + kstep, voffB); PG8_STAGE(PG8_SA(1, 0), cA + kstep, voffA); PG8_STAGE(PG8_SB(1, 1), cB + hstep + kstep, voffB);
        PG8_WAIT_V(6); PG8_BAR;
    }
    for (;;) {
        const bool has_next = S.next(ui + 1, nxt);
        const char* nA = has_next ? (const char*)g.A + (size_t)nxt.pm * tstep : cA; const char* nB = has_next ? (const char*)g.Bt + (size_t)nxt.pn * tstep : cB;
        for (int t = 0; t < nt; t += 2) {
            const bool last = (t == nt - 2);
            const char* a1 = cA + (size_t)(t + 1) * kstep;
            const char* a2 = last ? nA : cA + (size_t)(t + 2) * kstep; const char* b2 = last ? nB : cB + (size_t)(t + 2) * kstep;
            const char* a3 = a2 + kstep; const char* b3 = b2 + kstep;
            if (last && has_next) S.a_ready(nxt);
            if constexpr (SP2) {
            PG8_LDB(B0, 0, 0); PG8_LDB(B1, 0, 1); PG8_SCHED; PG8_LDA(At, 0, 0); PG8_STAGE(PG8_SA(1, 1), a1 + hstep, voffA);
            PG8_WAIT_V(8); PG8_WAIT_L(0); PG8_BAR; PG8_MMA(0, 0, At, B0); PG8_MMA(0, 1, At, B1); PG8_BAR; PG8_SCHED;
            PG8_LDA(At, 0, 1); PG8_STAGE(PG8_SB(0, 0), b2, voffB); PG8_STAGE(PG8_SB(0, 1), b2 + hstep, voffB); PG8_STAGE(PG8_SA(0, 0), a2, voffA);
            PG8_WAIT_V(8); PG8_WAIT_L(0); PG8_BAR; PG8_MMA(1, 0, At, B0); PG8_MMA(1, 1, At, B1); PG8_BAR; PG8_SCHED;
            PG8_LDB(B0, 1, 0); PG8_LDB(B1, 1, 1); PG8_SCHED; PG8_LDA(At, 1, 0); PG8_STAGE(PG8_SA(0, 1), a2 + hstep, voffA);
            PG8_WAIT_V(8); PG8_WAIT_L(0); PG8_BAR; PG8_MMA(0, 0, At, B0); PG8_MMA(0, 1, At, B1); PG8_BAR; PG8_SCHED;
            PG8_LDA(At, 1, 1); PG8_STAGE(PG8_SB(1, 0), b3, voffB); PG8_STAGE(PG8_SB(1, 1), b3 + hstep, voffB); PG8_STAGE(PG8_SA(1, 0), a3, voffA);
            PG8_WAIT_V(8); PG8_WAIT_L(0); PG8_BAR; PG8_MMA(1, 0, At, B0); PG8_MMA(1, 1, At, B1); PG8_BAR; PG8_SCHED;
            } else {
            PG8_LDB(B0, 0, 0); PG8_SCHED; PG8_LDA(At, 0, 0); PG8_STAGE(PG8_SA(1, 1), a1 + hstep, voffA);
            PG8_WAIT_L(8); PG8_BAR; PG8_WAIT_L(0); PG8_MMA(0, 0, At, B0); PG8_BAR; PG8_SCHED;
            PG8_LDB(B1, 0, 1); PG8_STAGE(PG8_SB(0, 0), b2, voffB);
            PG8_BAR; PG8_WAIT_L(0); PG8_MMA(0, 1, At, B1); PG8_BAR;
            PG8_LDA(At, 0, 1); PG8_STAGE(PG8_SA(0, 0), a2, voffA);
            PG8_BAR; PG8_WAIT_L(0); PG8_MMA(1, 0, At, B0); PG8_BAR; PG8_SCHED;
            PG8_STAGE(PG8_SB(0, 1), b2 + hstep, voffB);
            PG8_WAIT_V(6); PG8_BAR; PG8_MMA(1, 1, At, B1); PG8_BAR;
            PG8_LDB(B0, 1, 0); PG8_SCHED; PG8_LDA(At, 1, 0); PG8_STAGE(PG8_SA(0, 1), a2 + hstep, voffA);
            PG8_WAIT_L(8); PG8_BAR; PG8_WAIT_L(0); PG8_MMA(0, 0, At, B0); PG8_BAR; PG8_SCHED;
            PG8_LDB(B1, 1, 1); PG8_STAGE(PG8_SB(1, 0), b3, voffB);
            PG8_BAR; PG8_WAIT_L(0); PG8_MMA(0, 1, At, B1); PG8_BAR;
            PG8_LDA(At, 1, 1); PG8_STAGE(PG8_SA(1, 0), a3, voffA);
            PG8_BAR; PG8_WAIT_L(0); PG8_MMA(1, 0, At, B0); PG8_BAR; PG8_SCHED;
            PG8_STAGE(PG8_SB(1, 1), b3 + hstep, voffB);
            PG8_WAIT_V(6); PG8_BAR; PG8_MMA(1, 1, At, B1); PG8_BAR;
            }
        }
        if constexpr (ALIGN_EPI) { if (wr == 0) PG8_BAR; }
        if constexpr (!Epi::AFTER_DRAIN) { E(acc, cur, wr, wc, fr, fq); S.done(cur); }
        if (!has_next) break;
#pragma unroll
        for (int a = 0; a < 2; ++a)
#pragma unroll
            for (int b = 0; b < 2; ++b)
#pragma unroll
                for (int m = 0; m < 4; ++m)
#pragma unroll
                    for (int n = 0; n < 2; ++n) acc[a][b][m][n] = (f32x4){0.f, 0.f, 0.f, 0.f};
        cur = nxt; cA = nA; cB = nB; ++ui;
        if constexpr (ALIGN_EPI) { if (wr == 1) PG8_BAR; }
    }
    PG8_WAIT_V(0);
    if constexpr (!ALIGN_EPI) { if (wr == 0) PG8_BAR; }
    PG8_BAR;
    if constexpr (Epi::AFTER_DRAIN) { E.fused(acc, cur, wr, wc, fr, fq, lds, wid, lane); S.done(cur); }
#undef PG8_SA
#undef PG8_SB
#undef PG8_STAGE
#undef PG8_LDA
#undef PG8_LDB
#undef PG8_MMA
#undef PG8_WAIT_V
#undef PG8_WAIT_L
#undef PG8_BAR
#undef PG8_SCHED
}
}

#define LAS __attribute__((address_space(3)))
typedef unsigned short bf16_t;
typedef short bf16x8 __attribute__((ext_vector_type(8)));
typedef short s16x4 __attribute__((ext_vector_type(4)));
typedef float f32x4 __attribute__((ext_vector_type(4)));
typedef float f32x16 __attribute__((ext_vector_type(16)));
typedef unsigned u32x4 __attribute__((ext_vector_type(4)));
typedef unsigned u32x2 __attribute__((ext_vector_type(2)));

constexpr int T = 16 * 2048;
constexpr int NMETA = 16;
constexpr int R = T + NMETA;
constexpr int DM = 1024, DFF = 4096;
constexpr float ALPHA = 1.4142135623730951f;
constexpr float QSCALE = 0.125f * 1.4426950408889634f;

constexpr size_t SZ_WAB = (size_t)2048 * 1024 * 2, SZ_WGLU = (size_t)512 * 512 * 2, SZ_W1M = (size_t)1024 * 1024 * 2, SZ_W4M = (size_t)4096 * 1024 * 2;
constexpr size_t OFF_WAB = 0, OFF_WGLU = OFF_WAB + SZ_WAB, OFF_WOAB = OFF_WGLU + SZ_WGLU, OFF_WC = OFF_WOAB + SZ_W1M, OFF_WOC = OFF_WC + SZ_W4M,
                 OFF_WUP0 = OFF_WOC + SZ_W1M, OFF_WUP1 = OFF_WUP0 + SZ_W4M, OFF_WDN0 = OFF_WUP1 + SZ_W4M, OFF_WDN1 = OFF_WDN0 + SZ_W4M,
                 OFF_HB = OFF_WDN1 + SZ_W4M, OFF_Z = OFF_HB + (size_t)R * 1024 * 2, OFF_BIG = OFF_Z + (size_t)R * 1024 * 4, WS_END = OFF_BIG + (size_t)R * 4096 * 2;
constexpr size_t OFF_ST = (WS_END + 255) & ~(size_t)255;
constexpr size_t SZ_ST = (size_t)5 * R * 2 * 4;
constexpr size_t OFF_SV = OFF_ST + SZ_ST, OFF_TV = OFF_SV + (size_t)3 * 4096 * 4, OFF_BAR = OFF_TV + (size_t)3 * 4096 * 4, OFF_ZROW = OFF_BIG + ((OFF_BAR + (size_t)XCD_BAR_WORDS * 4 - OFF_BIG + 8191) / 8192) * 8192, ZERO_END = OFF_ZROW + (size_t)8 * 8192;
constexpr size_t BIG_PROJ = 0, BIG_APRE = (size_t)R * 2048 * 2, BIG_CAT = BIG_APRE + (size_t)R * 512 * 2;

struct Params { const float* in[26]; float* out; unsigned char* ws; };

__device__ __forceinline__ unsigned pk2(float lo, float hi) {
    typedef __bf16 bf2 __attribute__((ext_vector_type(2)));
    typedef float fl2 __attribute__((ext_vector_type(2)));
    fl2 v = {lo, hi}; bf2 r = __builtin_convertvector(v, bf2); return __builtin_bit_cast(unsigned, r);
}
__device__ __forceinline__ bf16_t f2bf(float x) { return (bf16_t)(pk2(x, 0.f) & 0xffffu); }
__device__ __forceinline__ float bf2f(bf16_t v) { return __uint_as_float((unsigned)v << 16); }
__device__ __forceinline__ float bflo(unsigned w) { return __uint_as_float(w << 16); }
__device__ __forceinline__ float bfhi(unsigned w) { return __uint_as_float(w & 0xffff0000u); }
__device__ __forceinline__ float sigmoidf_(float x) { return 1.0f / (1.0f + __expf(-x)); }
#define LDS_WAIT() asm volatile("s_waitcnt lgkmcnt(0)" ::: "memory")
#define MFMA16(a, b, c) __builtin_amdgcn_mfma_f32_16x16x32_bf16((a), (b), (c), 0, 0, 0)
#define MFMA32(a, b, c) __builtin_amdgcn_mfma_f32_32x32x16_bf16((a), (b), (c), 0, 0, 0)

struct RowCtx { float mu, rstd; };
__device__ __forceinline__ RowCtx ln_ctx(const float* st, int row) {
    const float sum = st[2 * (size_t)row], sq = st[2 * (size_t)row + 1];
    RowCtx rc; rc.mu = sum * (1.0f / 1024.0f); const float var = fmaxf(sq * (1.0f / 1024.0f) - rc.mu * rc.mu, 0.f); rc.rstd = 1.0f / sqrtf(var + 1e-5f); return rc;
}
struct NoCtx {};
struct EpInAB {
    static constexpr bool MAKES_STATS = false; static constexpr int BATCH = 8;
    typedef NoCtx ColCtx; typedef NoCtx Pre;
    bf16_t* O;
    __device__ __forceinline__ ColCtx col_ctx(int) const { return NoCtx{}; }
    template <bool META> __device__ __forceinline__ Pre pre(int, int) const { return NoCtx{}; }
    __device__ __forceinline__ RowCtx row_ctx(int) const { return RowCtx{0.f, 1.f}; }
    __device__ __forceinline__ float* st_ptr() const { return nullptr; }
    __device__ __forceinline__ void apply8(int row, int col, f32x4 a, f32x4 b, const RowCtx&, const ColCtx&, const Pre&, float&, float&) const {
        const float s = (col >= 512 && col < 1024) ? QSCALE : 1.0f;
        u32x4 w; w.x = pk2(a[0] * s, a[1] * s); w.y = pk2(a[2] * s, a[3] * s); w.z = pk2(b[0] * s, b[1] * s); w.w = pk2(b[2] * s, b[3] * s);
        *(u32x4*)(O + (size_t)row * 2048 + col) = w;
    }
};
struct EpGlu {
    static constexpr bool MAKES_STATS = false; static constexpr int BATCH = 4;
    struct ColCtx { f32x4 b0, b1; }; struct Pre { u32x4 ap; };
    const bf16_t* APRE; const float* bias; bf16_t* CAT;
    __device__ __forceinline__ ColCtx col_ctx(int col) const { return ColCtx{*(const f32x4*)(bias + col), *(const f32x4*)(bias + col + 4)}; }
    template <bool META> __device__ __forceinline__ Pre pre(int row, int col) const { return Pre{*(const u32x4*)((const char*)APRE + ((unsigned)row * 1024u + (unsigned)col * 2u))}; }
    __device__ __forceinline__ RowCtx row_ctx(int) const { return RowCtx{0.f, 1.f}; }
    __device__ __forceinline__ float* st_ptr() const { return nullptr; }
    __device__ __forceinline__ void apply8(int row, int col, f32x4 a, f32x4 b, const RowCtx&, const ColCtx& cc, const Pre& pr, float&, float&) const {
        const u32x4 ap = pr.ap;
        float v[8] = {a[0] + cc.b0[0], a[1] + cc.b0[1], a[2] + cc.b0[2], a[3] + cc.b0[3], b[0] + cc.b1[0], b[1] + cc.b1[1], b[2] + cc.b1[2], b[3] + cc.b1[3]};
        float y[8] = {bflo(ap.x), bfhi(ap.x), bflo(ap.y), bfhi(ap.y), bflo(ap.z), bfhi(ap.z), bflo(ap.w), bfhi(ap.w)};
#pragma unroll
        for (int i = 0; i < 8; ++i) y[i] = y[i] * sigmoidf_(v[i]);
        u32x4 w; w.x = pk2(y[0], y[1]); w.y = pk2(y[2], y[3]); w.z = pk2(y[4], y[5]); w.w = pk2(y[6], y[7]);
        *(u32x4*)(CAT + (size_t)row * 1024 + col) = w;
    }
};
template <int NB_> struct EpRes {
    static constexpr bool MAKES_STATS = true; static constexpr int BATCH = NB_;
    struct ColCtx { f32x4 ag0, ag1, ab0, ab1; }; struct Pre { u32x4 h; };
    bf16_t* HBp; const float* bias;
    const float* st_prev; const float* g; const float* bta; float* st_out;
    __device__ __forceinline__ ColCtx col_ctx(int col) const {
        ColCtx c; const f32x4 one = {1.f, 1.f, 1.f, 1.f}, zero = {0.f, 0.f, 0.f, 0.f};
        const f32x4 g0 = st_prev ? *(const f32x4*)(g + col) : one, g1 = st_prev ? *(const f32x4*)(g + col + 4) : one;
        const f32x4 t0 = st_prev ? *(const f32x4*)(bta + col) : zero, t1 = st_prev ? *(const f32x4*)(bta + col + 4) : zero;
        const f32x4 b0 = bias ? *(const f32x4*)(bias + col) : zero, b1 = bias ? *(const f32x4*)(bias + col + 4) : zero;
        c.ag0 = g0 * ALPHA; c.ag1 = g1 * ALPHA; c.ab0 = t0 * ALPHA + b0; c.ab1 = t1 * ALPHA + b1; return c;
    }
    template <bool META> __device__ __forceinline__ Pre pre(int row, int col) const { return Pre{*(const u32x4*)((const char*)HBp + ((unsigned)row * 2048u + (unsigned)col * 2u))}; }
    __device__ __forceinline__ RowCtx row_ctx(int row) const { return st_prev ? ln_ctx(st_prev, row) : RowCtx{0.f, 1.f}; }
    __device__ __forceinline__ float* st_ptr() const { return st_out; }
    __device__ __forceinline__ void apply8(int row, int col, f32x4 a, f32x4 b, const RowCtx& rc, const ColCtx& cc, const Pre& pr, float& s, float& q) const {
        const f32x4 h0 = {bflo(pr.h.x), bfhi(pr.h.x), bflo(pr.h.y), bfhi(pr.h.y)}, h1 = {bflo(pr.h.z), bfhi(pr.h.z), bflo(pr.h.w), bfhi(pr.h.w)};
        const f32x4 o0 = (h0 - rc.mu) * rc.rstd * cc.ag0 + cc.ab0 + a, o1 = (h1 - rc.mu) * rc.rstd * cc.ag1 + cc.ab1 + b;
        u32x4 w; w.x = pk2(o0[0], o0[1]); w.y = pk2(o0[2], o0[3]); w.z = pk2(o1[0], o1[1]); w.w = pk2(o1[2], o1[3]);
        *(u32x4*)((char*)HBp + ((unsigned)row * 2048u + (unsigned)col * 2u)) = w;
        s += ((o0[0] + o0[1]) + (o0[2] + o0[3])) + ((o1[0] + o1[1]) + (o1[2] + o1[3]));
        q += ((o0[0] * o0[0] + o0[1] * o0[1]) + (o0[2] * o0[2] + o0[3] * o0[3])) + ((o1[0] * o1[0] + o1[1] * o1[1]) + (o1[2] * o1[2] + o1[3] * o1[3]));
    }
};
struct EpUp {
    static constexpr bool MAKES_STATS = false; static constexpr int BATCH = 8;
    struct ColCtx { f32x4 s0, s1, t0, t1; }; typedef NoCtx Pre;
    bf16_t* H; const float* bias; const float* st_prev; const float* sv; const float* tv;
    __device__ __forceinline__ ColCtx col_ctx(int col) const {
        return ColCtx{*(const f32x4*)(sv + col), *(const f32x4*)(sv + col + 4), *(const f32x4*)(tv + col) + *(const f32x4*)(bias + col), *(const f32x4*)(tv + col + 4) + *(const f32x4*)(bias + col + 4)};
    }
    template <bool META> __device__ __forceinline__ Pre pre(int, int) const { return NoCtx{}; }
    __device__ __forceinline__ RowCtx row_ctx(int row) const { return ln_ctx(st_prev, row); }
    __device__ __forceinline__ float* st_ptr() const { return nullptr; }
    __device__ __forceinline__ void apply8(int row, int col, f32x4 a, f32x4 b, const RowCtx& rc, const ColCtx& cc, const Pre&, float&, float&) const {
        f32x4 v0 = (a - rc.mu * cc.s0) * rc.rstd + cc.t0, v1 = (b - rc.mu * cc.s1) * rc.rstd + cc.t1;
#pragma unroll
        for (int i = 0; i < 4; ++i) { v0[i] = fmaxf(v0[i], 0.f); v0[i] *= v0[i]; v1[i] = fmaxf(v1[i], 0.f); v1[i] *= v1[i]; }
        u32x4 w; w.x = pk2(v0[0], v0[1]); w.y = pk2(v0[2], v0[3]); w.z = pk2(v1[0], v1[1]); w.w = pk2(v1[2], v1[3]);
        *(u32x4*)(H + (size_t)row * 4096 + col) = w;
    }
};
struct EpInC {
    static constexpr bool MAKES_STATS = false; static constexpr int BATCH = 8;
    struct ColCtx { f32x4 s0, s1, t0, t1, lb0, lb1; }; typedef NoCtx Pre;
    unsigned short* PC; const float* gamma; const float* st_prev; const float* sv; const float* tv;
    __device__ __forceinline__ ColCtx col_ctx(int col) const {
        ColCtx c{*(const f32x4*)(sv + col), *(const f32x4*)(sv + col + 4), *(const f32x4*)(tv + col), *(const f32x4*)(tv + col + 4), {0.f, 0.f, 0.f, 0.f}, {0.f, 0.f, 0.f, 0.f}};
        if (col >= 1024 && col < 2048) {
            const f32x4 ga = *(const f32x4*)(gamma + col - 1024), gb = *(const f32x4*)(gamma + col - 1020), gc = *(const f32x4*)(gamma + col), gd = *(const f32x4*)(gamma + col + 4);
#pragma unroll
            for (int i = 0; i < 4; ++i) { c.lb0[i] = 1.0f / (1.0f + __expf(ga[i] - gc[i])); c.lb1[i] = 1.0f / (1.0f + __expf(gb[i] - gd[i])); }
        }
        return c;
    }
    template <bool META> __device__ __forceinline__ Pre pre(int, int) const { return NoCtx{}; }
    __device__ __forceinline__ RowCtx row_ctx(int row) const { return ln_ctx(st_prev, row); }
    __device__ __forceinline__ float* st_ptr() const { return nullptr; }
    __device__ __forceinline__ void apply8(int row, int col, f32x4 a, f32x4 b, const RowCtx& rc, const ColCtx& cc, const Pre&, float&, float&) const {
        a = (a - rc.mu * cc.s0) * rc.rstd + cc.t0;
        b = (b - rc.mu * cc.s1) * rc.rstd + cc.t1;
        u32x4 w;
        if (col >= 1024 && col < 2048) {
            float v[8] = {a[0], a[1], a[2], a[3], b[0], b[1], b[2], b[3]};
            float lb[8] = {cc.lb0[0], cc.lb0[1], cc.lb0[2], cc.lb0[3], cc.lb1[0], cc.lb1[1], cc.lb1[2], cc.lb1[3]};
            unsigned short h[8];
#pragma unroll
            for (int i = 0; i < 8; ++i) {
                const float f = lb[i] + (1.0f - lb[i]) * sigmoidf_(v[i]);
                const _Float16 hf = (_Float16)__logf(f);
                h[i] = __builtin_bit_cast(unsigned short, hf);
            }
            w.x = h[0] | ((unsigned)h[1] << 16); w.y = h[2] | ((unsigned)h[3] << 16); w.z = h[4] | ((unsigned)h[5] << 16); w.w = h[6] | ((unsigned)h[7] << 16);
        } else { w.x = pk2(a[0], a[1]); w.y = pk2(a[2], a[3]); w.z = pk2(b[0], b[1]); w.w = pk2(b[2], b[3]); }
        *(u32x4*)(PC + (size_t)row * 4096 + col) = w;
    }
};
template <class F> struct EpiAdapt {
    static constexpr bool PERM = true, AFTER_DRAIN = false; F f;
    __device__ __forceinline__ void operator()(const f32x4 (&acc)[2][2][4][2], const pg8::Unit& u, int wr, int wc, int, int) const {
        const int lane_ = lane_id_v(), fr = lane_ & 15, fq = lane_ >> 4;
        const int col0 = u.pn * 256 + wc * 32 + 8 * fq, row0 = u.pm * 256 + wr * 64 + fr;
        constexpr int NB = F::BATCH;
#pragma unroll
        for (int bt = 0; bt < 8 / NB; ++bt) {
            const typename F::ColCtx cc[2] = {f.col_ctx(col0), f.col_ctx(col0 + 128)};
            RowCtx rc[NB];
            typename F::Pre pr[NB][2];
#pragma unroll
            for (int i = 0; i < NB; ++i) { const int r8 = bt * NB + i, row = row0 + (r8 >> 2) * 128 + (r8 & 3) * 16;
                rc[i] = f.row_ctx(row); pr[i][0] = f.template pre<false>(row, col0); pr[i][1] = f.template pre<false>(row, col0 + 128); }
#pragma unroll
            for (int i = 0; i < NB; ++i) { const int r8 = bt * NB + i, ai = r8 >> 2, m = r8 & 3, row = row0 + ai * 128 + m * 16;
                float s = 0.f, q = 0.f;
                f.apply8(row, col0, acc[ai][0][m][0], acc[ai][0][m][1], rc[i], cc[0], pr[i][0], s, q);
                f.apply8(row, col0 + 128, acc[ai][1][m][0], acc[ai][1][m][1], rc[i], cc[1], pr[i][1], s, q);
                if (F::MAKES_STATS) {
                    s += __shfl_xor(s, 16); s += __shfl_xor(s, 32); q += __shfl_xor(q, 16); q += __shfl_xor(q, 32);
                    if (fq == 0) { float* st = (float*)((char*)f.st_ptr() + (unsigned)row * 8u); unsafeAtomicAdd(st, s); unsafeAtomicAdd(st + 1, q); }
                }
            }
            asm volatile("" ::: "memory");
        }
    }
};
template <class F> __device__ __forceinline__ void meta_gemm(const bf16_t* A16  , const bf16_t* Bt, int N, int K, const F& f, int blk, int G, int wave, int lane, LAS float* red  ) {
    const int l15 = lane & 15, quad = lane >> 4, kw = K >> 3;
    for (int item = blk; item < N / 32; item += G) {
        const int c0 = item * 32;
        const bf16_t* ap = A16 + (size_t)l15 * K + 8 * quad + wave * kw;
        const bf16_t* w0 = Bt + (size_t)(c0 + 8 * (l15 >> 2) + (l15 & 3)) * K + 8 * quad + wave * kw;
        const bf16_t* w1 = w0 + (size_t)4 * K;
        f32x4 acc0 = {0.f, 0.f, 0.f, 0.f}, acc1 = {0.f, 0.f, 0.f, 0.f};
#pragma unroll 4
        for (int k = 0; k < kw; k += 32) {
            const bf16x8 xa = *(const bf16x8*)(ap + k), b0 = *(const bf16x8*)(w0 + k), b1 = *(const bf16x8*)(w1 + k);
            acc0 = MFMA16(b0, xa, acc0); acc1 = MFMA16(b1, xa, acc1);
        }
        *(LAS f32x4*)(red + (wave * 64 + lane) * 8) = acc0; *(LAS f32x4*)(red + (wave * 64 + lane) * 8 + 4) = acc1;
        __syncthreads();
        if (wave == 0) {
#pragma unroll
            for (int w = 1; w < 8; ++w) { acc0 += *(const LAS f32x4*)(red + (w * 64 + lane) * 8); acc1 += *(const LAS f32x4*)(red + (w * 64 + lane) * 8 + 4); }
            const RowCtx rc = f.row_ctx(T + l15);
            const typename F::ColCtx cc = f.col_ctx(c0 + 8 * quad);
            const typename F::Pre pr = f.template pre<true>(T + l15, c0 + 8 * quad);
            float s = 0.f, q = 0.f;
            f.apply8(T + l15, c0 + 8 * quad, acc0, acc1, rc, cc, pr, s, q);
            if (F::MAKES_STATS) {
                s += __shfl_xor(s, 16); s += __shfl_xor(s, 32); q += __shfl_xor(q, 16); q += __shfl_xor(q, 32);
                if (quad == 0) { float* st = f.st_ptr() + 2 * (size_t)(T + l15); unsafeAtomicAdd(st, s); unsafeAtomicAdd(st + 1, q); }
            }
        }
        __syncthreads();
    }
}
template <class F> __device__ __forceinline__ void run_gemm(LAS unsigned char* lds, const bf16_t* A, const bf16_t* Bt, int N, int K, const F& f, bool with_meta, int blk, int G, int wave) {
    pg8::Gemm g{A, Bt, T, N, K}; pg8::StaticOrder S; S.init(T, N, G, blk);
    EpiAdapt<F> E{f};
    pg8::gemm_phase<EpiAdapt<F>, pg8::StaticOrder, true, true>((PG8_LAS unsigned char*)lds, g, S, E, wave);
    if (with_meta) meta_gemm<F>(A + (size_t)T * K, Bt, N, K, f, blk, G, wave, lane_id_v(), (LAS float*)lds);
}

__device__ __forceinline__ void transpose_item(const float* W, int K, int N, bf16_t* WT, LAS float* scr, int item, int lane) {
    const int nblk = N / 32, kb = item / nblk, nb = item % nblk, k0 = 64 * kb, n0 = 32 * nb;
    float wv_[32];
#pragma unroll
    for (int i = 0; i < 32; ++i) wv_[i] = W[(size_t)(k0 + 2 * i + (lane >> 5)) * N + n0 + (lane & 31)];
#pragma unroll
    for (int i = 0; i < 32; ++i) scr[(2 * i + (lane >> 5)) * 33 + (lane & 31)] = wv_[i];
    LDS_WAIT();
    const int c = lane & 7;
#pragma unroll
    for (int j = 0; j < 4; ++j) { const int n = (lane >> 3) + 8 * j; const LAS float* s = scr + (8 * c) * 33 + n;
        u32x4 o; o.x = pk2(s[0 * 33], s[1 * 33]); o.y = pk2(s[2 * 33], s[3 * 33]); o.z = pk2(s[4 * 33], s[5 * 33]); o.w = pk2(s[6 * 33], s[7 * 33]);
        *(u32x4*)(WT + (size_t)(n0 + n) * K + k0 + 8 * c) = o; }
    LDS_WAIT();
}
__device__ __forceinline__ void transpose_item_fold(const float* W, int K, int N, bf16_t* WT, LAS float* scr, int item, int lane, const float* g, const float* bta, float* sv, float* tv) {
    const int nblk = N / 32, kb = item / nblk, nb = item % nblk, k0 = 64 * kb, n0 = 32 * nb;
    float wv_[32];
#pragma unroll
    for (int i = 0; i < 32; ++i) wv_[i] = W[(size_t)(k0 + 2 * i + (lane >> 5)) * N + n0 + (lane & 31)];
#pragma unroll
    for (int i = 0; i < 32; ++i) scr[(2 * i + (lane >> 5)) * 33 + (lane & 31)] = wv_[i];
    LDS_WAIT();
    const int c = lane & 7;
    const f32x4 g0 = *(const f32x4*)(g + k0 + 8 * c), g1 = *(const f32x4*)(g + k0 + 8 * c + 4), b0 = *(const f32x4*)(bta + k0 + 8 * c), b1 = *(const f32x4*)(bta + k0 + 8 * c + 4);
#pragma unroll
    for (int j = 0; j < 4; ++j) { const int n = (lane >> 3) + 8 * j; const LAS float* s = scr + (8 * c) * 33 + n;
        const float w0 = s[0 * 33], w1 = s[1 * 33], w2 = s[2 * 33], w3 = s[3 * 33], w4 = s[4 * 33], w5 = s[5 * 33], w6 = s[6 * 33], w7 = s[7 * 33];
        u32x4 o; o.x = pk2(g0[0] * w0, g0[1] * w1); o.y = pk2(g0[2] * w2, g0[3] * w3); o.z = pk2(g1[0] * w4, g1[1] * w5); o.w = pk2(g1[2] * w6, g1[3] * w7);
        *(u32x4*)(WT + (size_t)(n0 + n) * K + k0 + 8 * c) = o;
        float ss = ((bflo(o.x) + bfhi(o.x)) + (bflo(o.y) + bfhi(o.y))) + ((bflo(o.z) + bfhi(o.z)) + (bflo(o.w) + bfhi(o.w)));
        float tt = ((b0[0] * w0 + b0[1] * w1) + (b0[2] * w2 + b0[3] * w3)) + ((b1[0] * w4 + b1[1] * w5) + (b1[2] * w6 + b1[3] * w7));
        ss += __shfl_xor(ss, 1); ss += __shfl_xor(ss, 2); ss += __shfl_xor(ss, 4);
        tt += __shfl_xor(tt, 1); tt += __shfl_xor(tt, 2); tt += __shfl_xor(tt, 4);
        if (c == 0) { unsafeAtomicAdd(sv + n0 + n, ss); unsafeAtomicAdd(tv + n0 + n, tt); } }
    LDS_WAIT();
}
__device__ __forceinline__ void weight_items(const Params& P, LAS float* scr, int gw, int NGW, int lane, int part) {
    unsigned char* ws = P.ws;
    constexpr int I_AB = 16 * 64, I_GLU = 8 * 16, I_1M = 16 * 32, I_C = 16 * 128, I_UP = 16 * 128, I_DN = 64 * 32;
    constexpr int NREST = I_GLU + I_1M + I_C + I_1M + 2 * I_UP + 2 * I_DN;
    if (part == 0) { for (int it = gw; it < I_AB; it += NGW) transpose_item(P.in[2], 1024, 2048, (bf16_t*)(ws + OFF_WAB), scr, it, lane); return; }
    for (int it = gw; it < NREST; it += NGW) {
        int r = it;
        if (r < I_GLU) { transpose_item(P.in[11], 512, 512, (bf16_t*)(ws + OFF_WGLU), scr, r, lane); continue; } r -= I_GLU;
        if (r < I_1M) { transpose_item(P.in[13], 1024, 1024, (bf16_t*)(ws + OFF_WOAB), scr, r, lane); continue; } r -= I_1M;
        if (r < I_UP) { transpose_item_fold(P.in[20], 1024, 4096, (bf16_t*)(ws + OFF_WUP0), scr, r, lane, P.in[18], P.in[19], (float*)(ws + OFF_SV), (float*)(ws + OFF_TV)); continue; } r -= I_UP;
        if (r < I_DN) { transpose_item(P.in[22], 4096, 1024, (bf16_t*)(ws + OFF_WDN0), scr, r, lane); continue; } r -= I_DN;
        if (r < I_C) { transpose_item_fold(P.in[14], 1024, 4096, (bf16_t*)(ws + OFF_WC), scr, r, lane, P.in[24], P.in[25], (float*)(ws + OFF_SV) + 4096, (float*)(ws + OFF_TV) + 4096); continue; } r -= I_C;
        if (r < I_1M) { transpose_item(P.in[17], 1024, 1024, (bf16_t*)(ws + OFF_WOC), scr, r, lane); continue; } r -= I_1M;
        if (r < I_UP) { transpose_item_fold(P.in[20] + (size_t)1024 * 4096, 1024, 4096, (bf16_t*)(ws + OFF_WUP1), scr, r, lane, P.in[18] + 1024, P.in[19] + 1024, (float*)(ws + OFF_SV) + 8192, (float*)(ws + OFF_TV) + 8192); continue; } r -= I_UP;
        transpose_item(P.in[22] + (size_t)4096 * 1024, 4096, 1024, (bf16_t*)(ws + OFF_WDN1), scr, r, lane);
    }
}
__device__ __forceinline__ void prologue_phase(const Params& P, LAS unsigned char* lds, int blk, int G, int wave) {
    const int lane = lane_id_v(), tid = wave * 64 + lane;
    unsigned char* ws = P.ws;
    weight_items(P, (LAS float*)(lds + wave * 8448), blk * 8 + wave, G * 8, lane, 0);
    bf16_t* HB = (bf16_t*)(ws + OFF_HB);
    const size_t n8 = (size_t)R * 1024 / 8;
#pragma unroll 4
    for (size_t i = (size_t)blk * 512 + tid; i < n8; i += (size_t)G * 512) {
        const size_t e = i * 8;
        const float* src = e < (size_t)T * 1024 ? P.in[0] + e : P.in[1] + (e - (size_t)T * 1024);
        const f32x4 a = *(const f32x4*)src, b = *(const f32x4*)(src + 4);
        u32x4 w; w.x = pk2(a[0], a[1]); w.y = pk2(a[2], a[3]); w.z = pk2(b[0], b[1]); w.w = pk2(b[2], b[3]);
        *(u32x4*)(HB + e) = w;
    }
}

__device__ __forceinline__ void ln_phase(const float* Zin, float* Fout, bf16_t* Bout, const float* g, const float* bta, int nrows, int blk, int G, int wave) {
    const int lane = lane_id_v();
    for (int row = blk * 8 + wave; row < nrows; row += G * 8) {
        const f32x4* xr = (const f32x4*)(Zin + (size_t)row * 1024) + lane;
        f32x4 v[4]; float s = 0.f;
#pragma unroll
        for (int j = 0; j < 4; ++j) { v[j] = xr[64 * j]; s += (v[j][0] + v[j][1]) + (v[j][2] + v[j][3]); }
#pragma unroll
        for (int o = 1; o < 64; o <<= 1) s += __shfl_xor(s, o);
        const float mean = s * (1.f / 1024.f); float s2 = 0.f;
#pragma unroll
        for (int j = 0; j < 4; ++j) { v[j] = v[j] - mean; s2 += (v[j][0] * v[j][0] + v[j][1] * v[j][1]) + (v[j][2] * v[j][2] + v[j][3] * v[j][3]); }
#pragma unroll
        for (int o = 1; o < 64; o <<= 1) s2 += __shfl_xor(s2, o);
        const float rstd = 1.0f / sqrtf(s2 * (1.f / 1024.f) + 1e-5f);
#pragma unroll
        for (int j = 0; j < 4; ++j) {
            const int col = 4 * (lane + 64 * j);
            const f32x4 gg = *(const f32x4*)(g + col), bb = *(const f32x4*)(bta + col);
            const f32x4 o = v[j] * rstd * gg + bb;
            *(f32x4*)(Fout + (size_t)row * 1024 + col) = o;
            if (Bout) { u32x2 w; w.x = pk2(o[0], o[1]); w.y = pk2(o[2], o[3]); *(u32x2*)(Bout + (size_t)row * 1024 + col) = w; }
        }
    }
}

__device__ __forceinline__ void final_ln_phase(const bf16_t* Zb, const float* st, float* out, const float* g, const float* bta, int blk, int G, int wave) {
    const int lane = lane_id_v();
    for (int row0 = (blk * 8 + wave) * 4; row0 < T; row0 += G * 8 * 4) {
        u32x4 v[4][2];
#pragma unroll
        for (int rr = 0; rr < 4; ++rr)
#pragma unroll
            for (int j = 0; j < 2; ++j) v[rr][j] = *(const u32x4*)((const char*)Zb + ((unsigned)(row0 + rr) * 2048u + (unsigned)(8 * (lane + 64 * j)) * 2u));
#pragma unroll
        for (int rr = 0; rr < 4; ++rr) {
            const int row = row0 + rr;
            const RowCtx rc = ln_ctx(st, row);
#pragma unroll
            for (int j = 0; j < 2; ++j) {
                const int col = 8 * (lane + 64 * j);
                const f32x4 h0 = {bflo(v[rr][j].x), bfhi(v[rr][j].x), bflo(v[rr][j].y), bfhi(v[rr][j].y)}, h1 = {bflo(v[rr][j].z), bfhi(v[rr][j].z), bflo(v[rr][j].w), bfhi(v[rr][j].w)};
                float* op = out + (size_t)row * 1024 + col;
                *(f32x4*)op = (h0 - rc.mu) * rc.rstd * *(const f32x4*)(g + col) + *(const f32x4*)(bta + col);
                *(f32x4*)(op + 4) = (h1 - rc.mu) * rc.rstd * *(const f32x4*)(g + col + 4) + *(const f32x4*)(bta + col + 4);
            }
        }
    }
}

__device__ __forceinline__ void lam_coef(const float* lam_re, const float* lam_im, float dt, int idx, float& lbr, float& lbi, float& cr, float& ci) {
    const float lr = lam_re[idx], li = lam_im[idx];
    const float er = __expf(lr * dt);
    float ang = li * dt;
    const float kk = rintf(ang * 0.15915494309189535f);
    ang = fmaf(-kk, 6.2831854820251465f, ang); ang = fmaf(-kk, -1.7484555e-7f, ang);
    lbr = er * __cosf(ang); lbi = er * __sinf(ang);
    const float nr = lbr - 1.0f, ni = lbi, den = 1.0f / (lr * lr + li * li);
    cr = (nr * lr + ni * li) * den; ci = (ni * lr - nr * li) * den;
}
__device__ __forceinline__ void s5_phase(const Params& P, LAS unsigned char* lds, int blk, int G, int wave) {
    const int lane = lane_id_v(), l15 = lane & 15, quad = lane >> 4;
    LAS float* bu = (LAS float*)(lds + wave * 12800);
    LAS unsigned* sl = (LAS unsigned*)(lds + wave * 12800 + 8448);
    const bf16_t* PROJ = (const bf16_t*)(P.ws + OFF_BIG + BIG_PROJ);
    bf16_t* APRE = (bf16_t*)(P.ws + OFF_BIG + BIG_APRE);
    for (int vw = wave; blk + G * (vw >> 1) < 512; vw += 8) {
        const int item = blk + G * (vw >> 1), seg = vw & 1;
        const int b = item >> 5, g = item & 31;
        const int c_end = seg ? 129 : 65, c_out = seg ? 65 : 0;
        const float dt = __expf(P.in[5][g]);
        float lbr, lbi, cr_, ci_;
        lam_coef(P.in[3], P.in[4], dt, g * 64 + lane, lbr, lbi, cr_, ci_);
        bf16x8 bfrag[8];
#pragma unroll
        for (int tile = 0; tile < 8; ++tile) {
            const int comp = 16 * tile + l15, st = comp & 63, isim = comp >> 6;
            float a0, a1, cr, ci; lam_coef(P.in[3], P.in[4], dt, g * 64 + st, a0, a1, cr, ci);
            bf16x8 fr = {0, 0, 0, 0, 0, 0, 0, 0};
            if (quad < 2) {
                const float* bre = P.in[6] + (size_t)(g * 64 + st) * 16 + 8 * quad;
                const float* bim = P.in[7] + (size_t)(g * 64 + st) * 16 + 8 * quad;
#pragma unroll
                for (int j = 0; j < 8; ++j) { const float v = isim ? (cr * bim[j] + ci * bre[j]) : (cr * bre[j] - ci * bim[j]); fr[j] = (short)f2bf(v); }
            }
            bfrag[tile] = fr;
        }
        bf16x8 cfrag[4];
#pragma unroll
        for (int ks = 0; ks < 4; ++ks) {
#pragma unroll
            for (int j = 0; j < 8; ++j) {
                const int k = 32 * ks + 8 * quad + j, p = k >> 1;
                const float v = (k & 1) ? -P.in[9][(size_t)(g * 16 + l15) * 64 + p] : P.in[8][(size_t)(g * 16 + l15) * 64 + p];
                cfrag[ks][j] = (short)f2bf(v);
            }
        }
        const float dh = P.in[10][g * 16 + l15];
        float sr = 0.f, si = 0.f;
        const bf16x8 zero8 = {0, 0, 0, 0, 0, 0, 0, 0};
        bf16x8 ua_n = *(const bf16x8*)(PROJ + (size_t)(T + l15) * 2048 + g * 16 + 8 * (quad & 1));
        unsigned short ue_n[4];
#pragma unroll
        for (int r = 0; r < 4; ++r) ue_n[r] = PROJ[(size_t)(T + 4 * quad + r) * 2048 + g * 16 + l15];
        for (int chunk = 0; chunk < c_end; ++chunk) {
            const bool outp = chunk >= c_out;
            const int rowbase = chunk == 0 ? T : b * 2048 + (chunk - 1) * 16;
            const bf16x8 ua = quad < 2 ? ua_n : zero8;
            unsigned short ue[4];
#pragma unroll
            for (int r = 0; r < 4; ++r) ue[r] = ue_n[r];
            {
                const int cn = chunk + 1 < 129 ? chunk + 1 : 128;
                const int rbn = b * 2048 + (cn - 1) * 16;
                ua_n = *(const bf16x8*)(PROJ + (size_t)(rbn + l15) * 2048 + g * 16 + 8 * (quad & 1));
#pragma unroll
                for (int r = 0; r < 4; ++r) ue_n[r] = PROJ[(size_t)(rbn + 4 * quad + r) * 2048 + g * 16 + l15];
            }
#pragma unroll
            for (int tile = 0; tile < 8; ++tile) {
                f32x4 acc = {0.f, 0.f, 0.f, 0.f};
                acc = MFMA16(ua, bfrag[tile], acc);
#pragma unroll
                for (int r = 0; r < 4; ++r) bu[(4 * quad + r) * 132 + 16 * tile + l15] = acc[r];
            }
            LDS_WAIT();
            if (!outp) {
#pragma unroll
                for (int t = 0; t < 16; ++t) {
                    const float br = bu[t * 132 + lane], bi = bu[t * 132 + 64 + lane];
                    const float nsr = fmaf(lbr, sr, fmaf(-lbi, si, br)), nsi = fmaf(lbr, si, fmaf(lbi, sr, bi));
                    sr = nsr; si = nsi;
                }
                LDS_WAIT();
                continue;
            }
#pragma unroll
            for (int t = 0; t < 16; ++t) {
                const float br = bu[t * 132 + lane], bi = bu[t * 132 + 64 + lane];
                const float nsr = fmaf(lbr, sr, fmaf(-lbi, si, br)), nsi = fmaf(lbr, si, fmaf(lbi, sr, bi));
                sr = nsr; si = nsi;
                sl[t * 68 + lane] = pk2(sr, si);
            }
            LDS_WAIT();
            f32x4 y = {0.f, 0.f, 0.f, 0.f};
#pragma unroll
            for (int ks = 0; ks < 4; ++ks) {
                const bf16x8 sa = *(const LAS bf16x8*)((const LAS bf16_t*)sl + l15 * 136 + 32 * ks + 8 * quad);
                y = MFMA16(sa, cfrag[ks], y);
            }
            if (chunk > 0 || b == 0) {
#pragma unroll
                for (int r = 0; r < 4; ++r) {
                    const size_t row = (size_t)(rowbase + 4 * quad + r);
                    const float u = bf2f(ue[r]);
                    const float v = y[r] + dh * u;
                    const float a2 = 1.5957691216057308f * (v + 0.044715f * v * v * v);
                    APRE[row * 512 + g * 16 + l15] = f2bf(v * sigmoidf_(a2));
                }
            }
            LDS_WAIT();
        }
    }
}

template <bool MASKED>
__device__ __forceinline__ void attn_tile_sub(const LAS bf16_t* Kl, const LAS bf16_t* Vl, const bf16x8 (&qf)[4], int sub, int keybase  ,
                                              int iq, int l31, int h, bool pick0, f32x16& o0, f32x16& o1, float& Rrun) {
    bf16x8 ka[4];
#pragma unroll
    for (int s = 0; s < 4; ++s) ka[s] = *(const LAS bf16x8*)(Kl + (32 * sub + l31) * 72 + 16 * s + 8 * h);
    bf16x8 va[2][2];
#pragma unroll
    for (int s2 = 0; s2 < 2; ++s2)
#pragma unroll
        for (int mt = 0; mt < 2; ++mt) {
            const LAS bf16_t* vp = Vl + (32 * mt + l31) * 68 + 32 * sub + 16 * s2 + 4 * h;
            const s16x4 lo = *(const LAS s16x4*)vp, hi = *(const LAS s16x4*)(vp + 8);
            va[s2][mt] = __builtin_shufflevector(lo, hi, 0, 1, 2, 3, 4, 5, 6, 7);
        }
    __builtin_amdgcn_sched_barrier(0);
    f32x16 st;
#pragma unroll
    for (int i = 0; i < 16; ++i) st[i] = 0.f;
#pragma unroll
    for (int s = 0; s < 4; ++s) st = MFMA32(ka[s], qf[s], st);
    float kp[16], be[16];
#pragma unroll
    for (int i = 0; i < 16; ++i) {
        const float e = __builtin_amdgcn_exp2f(st[i]);
        float r = __builtin_amdgcn_rcpf(1.0f + e);
        if (MASKED) {
            const int kl = 32 * sub + (i & 3) + 8 * (i >> 2) + 4 * h;
            const bool vis = keybase >= 0 ? (keybase + kl < iq) : (kl < 16);
            r = vis ? r : 1.0f;
        }
        kp[i] = r; be[i] = 1.0f - r;
    }
    float ga[4], pa[4];
#pragma unroll
    for (int a = 0; a < 4; ++a) {
        ga[a] = (kp[4 * a] * kp[4 * a + 1]) * (kp[4 * a + 2] * kp[4 * a + 3]);
        const auto sw = __builtin_amdgcn_permlane32_swap(__float_as_uint(ga[a]), __float_as_uint(ga[a]), false, false);
        pa[a] = __uint_as_float(pick0 ? sw[0] : sw[1]);
    }
    float run = Rrun; float w[16];
#pragma unroll
    for (int a = 3; a >= 0; --a) {
        const float P3 = h ? run : run * pa[a];
        const float P2 = P3 * kp[4 * a + 3], P1 = P2 * kp[4 * a + 2], P0 = P1 * kp[4 * a + 1];
        w[4 * a + 3] = be[4 * a + 3] * P3; w[4 * a + 2] = be[4 * a + 2] * P2; w[4 * a + 1] = be[4 * a + 1] * P1; w[4 * a + 0] = be[4 * a + 0] * P0;
        run *= ga[a] * pa[a];
    }
    Rrun = run;
#pragma unroll
    for (int s2 = 0; s2 < 2; ++s2) {
        u32x4 pw; pw.x = pk2(w[8 * s2], w[8 * s2 + 1]); pw.y = pk2(w[8 * s2 + 2], w[8 * s2 + 3]); pw.z = pk2(w[8 * s2 + 4], w[8 * s2 + 5]); pw.w = pk2(w[8 * s2 + 6], w[8 * s2 + 7]);
        const bf16x8 pb = __builtin_bit_cast(bf16x8, pw);
        o0 = MFMA32(va[s2][0], pb, o0); o1 = MFMA32(va[s2][1], pb, o1);
    }
}
__device__ __forceinline__ void attn_phase(const Params& P, LAS unsigned char* lds, int blk, int G, int wave) {
    const int lane = lane_id_v(), tid = wave * 64 + lane, l31 = lane & 31, h = lane >> 5;
    const bf16_t* PROJ = (const bf16_t*)(P.ws + OFF_BIG + BIG_PROJ);
    bf16_t* CAT = (bf16_t*)(P.ws + OFF_BIG + BIG_CAT);
    if (blk == G - 1) {
        LAS float* wm = (LAS float*)(lds + 40960);
        if (tid < 128) {
            const int t = tid & 15, hd = tid >> 4;
            const bf16_t* qp = PROJ + (size_t)(T + t) * 2048 + 512 + hd * 64;
            float run = 1.f;
            for (int j = 15; j >= 0; --j) {
                float wv = 0.f;
                if (j < t) {
                    const bf16_t* kp = PROJ + (size_t)(T + j) * 2048 + 1024 + hd * 64;
                    float z = 0.f;
                    for (int d = 0; d < 64; ++d) z = fmaf(bf2f(qp[d]), bf2f(kp[d]), z);
                    const float r = __builtin_amdgcn_rcpf(1.0f + __builtin_amdgcn_exp2f(z));
                    wv = (1.0f - r) * run; run *= r;
                }
                wm[tid * 16 + j] = wv;
            }
        }
        __syncthreads();
        for (int idx = tid; idx < 16 * 512; idx += 512) {
            const int t = idx >> 9, c = idx & 511, hd = c >> 6;
            float o = 0.f;
            for (int j = 0; j < 16; ++j) o = fmaf(wm[(hd * 16 + t) * 16 + j], bf2f(PROJ[(size_t)(T + j) * 2048 + 1536 + c]), o);
            CAT[(size_t)(T + t) * 1024 + 512 + c] = f2bf(o);
        }
        __syncthreads();
    }
    bool pick0;
    { const auto hs = __builtin_amdgcn_permlane32_swap((unsigned)h, (unsigned)h, false, false); pick0 = hs[0] != (unsigned)h; }
    LAS bf16_t* Kl0 = (LAS bf16_t*)lds;
    LAS bf16_t* Vl0 = (LAS bf16_t*)(lds + 2 * 9216);
    const int lkey = tid >> 3, lpart = tid & 7;
    for (int j4 = 0; j4 < 4; ++j4) {
        const int item = blk + G * j4;
        if (item >= 1024) break;
        const int c = item % 256, jj = item / 256, bh = c >> 1, par = c & 1;
        const int qb = par == 0 ? (jj == 0 ? 7 : jj == 1 ? 0 : jj == 2 ? 4 : 3) : (jj == 0 ? 6 : jj == 1 ? 1 : jj == 2 ? 5 : 2);
        const int b = bh >> 3, hd = bh & 7;
        const int iq = 256 * qb + 32 * wave + l31;
        const size_t qrow = (size_t)b * 2048 + iq;
        bf16x8 qf[4];
#pragma unroll
        for (int s = 0; s < 4; ++s) qf[s] = *(const bf16x8*)(PROJ + qrow * 2048 + 512 + hd * 64 + 16 * s + 8 * h);
        f32x16 o0, o1;
#pragma unroll
        for (int i = 0; i < 16; ++i) { o0[i] = 0.f; o1[i] = 0.f; }
        float Rrun = 1.0f;
        const int nt = 4 * qb + 5;
        u32x4 kreg, vreg;
#define ATT_LOAD(it_) do { const int kt_ = 4 * qb + 3 - (it_); size_t row_; bool ok_ = true; \
            if (kt_ >= 0) row_ = (size_t)b * 2048 + 64 * kt_ + lkey; else { row_ = (size_t)T + lkey; ok_ = lkey < 16; } \
            if (ok_) { const bf16_t* p_ = PROJ + row_ * 2048 + 1024 + hd * 64 + lpart * 8; kreg = *(const u32x4*)p_; vreg = *(const u32x4*)(p_ + 512); } \
            else { kreg = (u32x4){0u, 0u, 0u, 0u}; vreg = kreg; } } while (0)
#define ATT_STORE(buf_) do { *(LAS u32x4*)(Kl0 + (buf_) * 4608 + lkey * 72 + lpart * 8) = kreg; \
            LAS bf16_t* vt_ = Vl0 + (buf_) * 4352 + (lpart * 8) * 68 + lkey; \
            vt_[0 * 68] = (bf16_t)(vreg.x & 0xffffu); vt_[1 * 68] = (bf16_t)(vreg.x >> 16); \
            vt_[2 * 68] = (bf16_t)(vreg.y & 0xffffu); vt_[3 * 68] = (bf16_t)(vreg.y >> 16); \
            vt_[4 * 68] = (bf16_t)(vreg.z & 0xffffu); vt_[5 * 68] = (bf16_t)(vreg.z >> 16); \
            vt_[6 * 68] = (bf16_t)(vreg.w & 0xffffu); vt_[7 * 68] = (bf16_t)(vreg.w >> 16); } while (0)
        ATT_LOAD(0); ATT_STORE(0);
        __syncthreads();
        int cur = 0;
        for (int it = 0; it < nt; ++it) {
            if (it + 1 < nt) ATT_LOAD(it + 1);
            const int kt = 4 * qb + 3 - it;
            const int keybase = kt >= 0 ? 64 * kt : -1;
            const int wq_end = 256 * qb + 32 * wave + 32;
            const LAS bf16_t* Kl = Kl0 + cur * 4608; const LAS bf16_t* Vl = Vl0 + cur * 4352;
            if (kt < 0) { attn_tile_sub<true>(Kl, Vl, qf, 0, -1, iq, l31, h, pick0, o0, o1, Rrun); }
            else {
                const int wq_beg = wq_end - 32;
                if (keybase + 64 <= wq_beg) { attn_tile_sub<false>(Kl, Vl, qf, 1, keybase, iq, l31, h, pick0, o0, o1, Rrun); attn_tile_sub<false>(Kl, Vl, qf, 0, keybase, iq, l31, h, pick0, o0, o1, Rrun); }
                else {
                    if (keybase + 32 < wq_end) attn_tile_sub<true>(Kl, Vl, qf, 1, keybase, iq, l31, h, pick0, o0, o1, Rrun);
                    if (keybase < wq_end) attn_tile_sub<true>(Kl, Vl, qf, 0, keybase, iq, l31, h, pick0, o0, o1, Rrun);
                }
            }
            if (it + 1 < nt) ATT_STORE(cur ^ 1);
            __syncthreads();
            cur ^= 1;
        }
        bf16_t* op = CAT + qrow * 1024 + 512 + hd * 64;
#pragma unroll
        for (int a = 0; a < 4; ++a) {
            u32x2 w0; w0.x = pk2(o0[4 * a], o0[4 * a + 1]); w0.y = pk2(o0[4 * a + 2], o0[4 * a + 3]);
            u32x2 w1; w1.x = pk2(o1[4 * a], o1[4 * a + 1]); w1.y = pk2(o1[4 * a + 2], o1[4 * a + 3]);
            *(u32x2*)(op + 8 * a + 4 * h) = w0; *(u32x2*)(op + 32 + 8 * a + 4 * h) = w1;
        }
    }
}

__device__ __forceinline__ void hgrn_phase(const Params& P, LAS unsigned char* lds, int blk, int G, int wave) {
    const int lane = lane_id_v(), tid = wave * 64 + lane, l15 = lane & 15, quad = lane >> 4;
    LAS bf16_t* qd = (LAS bf16_t*)lds;
    LAS bf16_t* kd = qd + 64 * 136;
    LAS bf16_t* klT = kd + 64 * 136;
    LAS bf16_t* vT = klT + 128 * 72;
    LAS bf16_t* sc = vT + 128 * 72;
    LAS float* ebl = (LAS float*)(sc + 64 * 72);
    LAS float* segtot = ebl + 128;
    LAS float* red = segtot + 1024;
    const unsigned short* PC = (const unsigned short*)(P.ws + OFF_BIG);
    bf16_t* MIXC = (bf16_t*)P.out;
    const float* ng = P.in[16];
    for (int item = blk; item < 128; item += G) {
        const int b = item >> 3, hd = item & 7;
        f32x4 Sacc[8];
#pragma unroll
        for (int i = 0; i < 8; ++i) Sacc[i] = (f32x4){0.f, 0.f, 0.f, 0.f};
        const int dp = tid & 63, sg = tid >> 6;
        unsigned lfc[8], qc[8], vc[8];
#define HG_OFF0(cc_) ((unsigned)((cc_) > 0 ? b * 2048 + ((cc_) - 1) * 64 + 8 * sg : (sg >= 6 ? T + 8 * (sg - 6) : (int)((OFF_ZROW - OFF_BIG) / 8192))) * 8192u + (unsigned)(hd * 128 + 2 * dp) * 2u)
#define HG_LOAD(cc_, LF_, Q_, V_) do { const unsigned o0_ = HG_OFF0(cc_); _Pragma("unroll") for (int tt_ = 0; tt_ < 8; ++tt_) { const unsigned o_ = o0_ + (unsigned)tt_ * 8192u; \
            Q_[tt_] = *(const unsigned*)((const char*)PC + o_); LF_[tt_] = *(const unsigned*)((const char*)PC + o_ + 2048u); V_[tt_] = *(const unsigned*)((const char*)PC + o_ + 4096u); } } while (0)
        HG_LOAD(0, lfc, qc, vc);
        if (tid < 64) red[tid] = 0.f;
        for (int c = 0; c < 33; ++c) {
            unsigned lfn[8], qn[8], vn[8];
            { const int cn = c + 1 < 33 ? c + 1 : 32; HG_LOAD(cn, lfn, qn, vn); }
            {
                float cs0[8], cs1[8]; float run0 = 0.f, run1 = 0.f;
#pragma unroll
                for (int tt = 0; tt < 8; ++tt) {
                    const float l0 = 1.4426950408889634f * (float)__builtin_bit_cast(_Float16, (unsigned short)(lfc[tt] & 0xffffu));
                    const float l1 = 1.4426950408889634f * (float)__builtin_bit_cast(_Float16, (unsigned short)(lfc[tt] >> 16));
                    run0 += l0; run1 += l1; cs0[tt] = run0; cs1[tt] = run1;
                }
                segtot[sg * 128 + 2 * dp] = run0; segtot[sg * 128 + 2 * dp + 1] = run1;
                __syncthreads();
                if (tid < 64) red[((c + 1) & 1) * 64 + tid] = 0.f;
                float off0 = 0.f, off1 = 0.f, bl0 = 0.f, bl1 = 0.f;
#pragma unroll
                for (int s2 = 0; s2 < 8; ++s2) {
                    const float a0 = segtot[s2 * 128 + 2 * dp], a1 = segtot[s2 * 128 + 2 * dp + 1];
                    bl0 += a0; bl1 += a1; if (s2 < sg) { off0 += a0; off1 += a1; }
                }
                const float ebl0 = __builtin_amdgcn_exp2f(bl0), ebl1 = __builtin_amdgcn_exp2f(bl1);
                if (sg == 7) { ebl[2 * dp] = ebl0; ebl[2 * dp + 1] = ebl1; }
                float eip0 = __builtin_amdgcn_exp2f(-off0), eip1 = __builtin_amdgcn_exp2f(-off1);
                unsigned kl0[4], kl1[4], v0[4], v1[4];
#pragma unroll
                for (int tp = 0; tp < 4; ++tp) {
                    float klv0[2], klv1[2];
#pragma unroll
                    for (int e = 0; e < 2; ++e) {
                        const int tt = 2 * tp + e, t = 8 * sg + tt;
                        const float bt0 = off0 + cs0[tt], bt1 = off1 + cs1[tt];
                        const float q0 = bflo(qc[tt]), q1 = bfhi(qc[tt]);
                        const float eb0 = __builtin_amdgcn_exp2f(bt0), eb1 = __builtin_amdgcn_exp2f(bt1);
                        const float ei0 = __builtin_amdgcn_rcpf(eb0), ei1 = __builtin_amdgcn_rcpf(eb1);
                        const float k0 = 1.0f - eb0 * eip0, k1 = 1.0f - eb1 * eip1;
                        eip0 = ei0; eip1 = ei1;
                        const float kd0 = k0 * ei0, kd1 = k1 * ei1;
                        *(LAS unsigned*)(qd + t * 136 + 2 * dp) = pk2(q0 * eb0, q1 * eb1);
                        *(LAS unsigned*)(kd + t * 136 + 2 * dp) = pk2(kd0, kd1);
                        klv0[e] = kd0 * ebl0; klv1[e] = kd1 * ebl1;
                    }
                    kl0[tp] = pk2(klv0[0], klv0[1]); kl1[tp] = pk2(klv1[0], klv1[1]);
                    const unsigned va = vc[2 * tp], vb = vc[2 * tp + 1];
                    v0[tp] = (va & 0xffffu) | (vb << 16); v1[tp] = (va >> 16) | (vb & 0xffff0000u);
                }
                *(LAS u32x4*)(klT + (2 * dp) * 72 + 8 * sg) = (u32x4){kl0[0], kl0[1], kl0[2], kl0[3]};
                *(LAS u32x4*)(klT + (2 * dp + 1) * 72 + 8 * sg) = (u32x4){kl1[0], kl1[1], kl1[2], kl1[3]};
                *(LAS u32x4*)(vT + (2 * dp) * 72 + 8 * sg) = (u32x4){v0[0], v0[1], v0[2], v0[3]};
                *(LAS u32x4*)(vT + (2 * dp + 1) * 72 + 8 * sg) = (u32x4){v1[0], v1[1], v1[2], v1[3]};
            }
            __syncthreads();
            f32x4 oacc[4];
#pragma unroll
            for (int i = 0; i < 4; ++i) oacc[i] = (f32x4){0.f, 0.f, 0.f, 0.f};
#pragma unroll
            for (int kh = 0; kh < 2; ++kh) {
                s16x4 alo[2][4], ahi[2][4];
#pragma unroll
                for (int k2 = 0; k2 < 2; ++k2)
#pragma unroll
                    for (int tt = 0; tt < 4; ++tt) { const LAS bf16_t* ap = qd + (16 * tt + l15) * 136 + 32 * (2 * kh + k2) + 4 * quad; alo[k2][tt] = *(const LAS s16x4*)ap; ahi[k2][tt] = *(const LAS s16x4*)(ap + 16); }
                __builtin_amdgcn_sched_barrier(0);
#pragma unroll
                for (int k2 = 0; k2 < 2; ++k2) {
                    const int ks = 2 * kh + k2;
                    u32x4 sw; sw.x = pk2(Sacc[2 * ks][0], Sacc[2 * ks][1]); sw.y = pk2(Sacc[2 * ks][2], Sacc[2 * ks][3]);
                    sw.z = pk2(Sacc[2 * ks + 1][0], Sacc[2 * ks + 1][1]); sw.w = pk2(Sacc[2 * ks + 1][2], Sacc[2 * ks + 1][3]);
                    const bf16x8 sb = __builtin_bit_cast(bf16x8, sw);
#pragma unroll
                    for (int tt = 0; tt < 4; ++tt) oacc[tt] = MFMA16(__builtin_shufflevector(alo[k2][tt], ahi[k2][tt], 0, 1, 2, 3, 4, 5, 6, 7), sb, oacc[tt]);
                }
                __builtin_amdgcn_sched_barrier(0);
            }
#pragma unroll
            for (int e = 0; e < 2; ++e) {
                const int tile = 2 * wave + e, tt = tile >> 2, ss = tile & 3;
                bf16x8 fa[4], fb[4];
#pragma unroll
                for (int ks = 0; ks < 4; ++ks) { fa[ks] = *(const LAS bf16x8*)(qd + (16 * tt + l15) * 136 + 32 * ks + 8 * quad); fb[ks] = *(const LAS bf16x8*)(kd + (16 * ss + l15) * 136 + 32 * ks + 8 * quad); }
                __builtin_amdgcn_sched_barrier(0);
                f32x4 sa = {0.f, 0.f, 0.f, 0.f};
#pragma unroll
                for (int ks = 0; ks < 4; ++ks) sa = MFMA16(fa[ks], fb[ks], sa);
#pragma unroll
                for (int r = 0; r < 4; ++r) { const int tg = 16 * tt + 4 * quad + r, sg_ = 16 * ss + l15; sc[tg * 72 + sg_] = f2bf(sg_ <= tg ? sa[r] : 0.f); }
                __builtin_amdgcn_sched_barrier(0);
            }
            __syncthreads();
            unsigned short gr[16];
            {
                const int cg_ = c > 0 ? c : 1;
#pragma unroll
                for (int tt = 0; tt < 4; ++tt)
#pragma unroll
                    for (int r = 0; r < 4; ++r) gr[4 * tt + r] = *(const unsigned short*)((const char*)PC + ((unsigned)(b * 2048 + (cg_ - 1) * 64 + 16 * tt + 4 * quad + r) * 8192u + (unsigned)(3072 + hd * 128 + 16 * wave + l15) * 2u));
            }
            {
#pragma unroll
                for (int dt = 0; dt < 8; ++dt) Sacc[dt] *= *(const LAS f32x4*)(ebl + 16 * dt + 4 * quad);
                __builtin_amdgcn_sched_barrier(0);
#pragma unroll
                for (int ks = 0; ks < 2; ++ks) {
                    bf16x8 fsc[4], fkl[8];
                    const bf16x8 vb = *(const LAS bf16x8*)(vT + (16 * wave + l15) * 72 + 32 * ks + 8 * quad);
#pragma unroll
                    for (int tt = 0; tt < 4; ++tt) fsc[tt] = *(const LAS bf16x8*)(sc + (16 * tt + l15) * 72 + 32 * ks + 8 * quad);
#pragma unroll
                    for (int dt = 0; dt < 8; ++dt) fkl[dt] = *(const LAS bf16x8*)(klT + (16 * dt + l15) * 72 + 32 * ks + 8 * quad);
                    __builtin_amdgcn_sched_barrier(0);
#pragma unroll
                    for (int tt = 0; tt < 4; ++tt) oacc[tt] = MFMA16(fsc[tt], vb, oacc[tt]);
#pragma unroll
                    for (int dt = 0; dt < 8; ++dt) Sacc[dt] = MFMA16(fkl[dt], vb, Sacc[dt]);
                    __builtin_amdgcn_sched_barrier(0);
                }
            }
#pragma unroll
            for (int tt = 0; tt < 4; ++tt)
#pragma unroll
                for (int r = 0; r < 4; ++r) {
                    float sq = oacc[tt][r] * oacc[tt][r];
                    sq += __int_as_float(__builtin_amdgcn_update_dpp(0, __float_as_int(sq), 0xB1, 0xf, 0xf, false));
                    sq += __int_as_float(__builtin_amdgcn_update_dpp(0, __float_as_int(sq), 0x4E, 0xf, 0xf, false));
                    sq += __int_as_float(__builtin_amdgcn_update_dpp(0, __float_as_int(sq), 0x141, 0xf, 0xf, false));
                    sq += __int_as_float(__builtin_amdgcn_update_dpp(0, __float_as_int(sq), 0x140, 0xf, 0xf, false));
                    if (l15 == 0) __hip_atomic_fetch_add(red + (c & 1) * 64 + 16 * tt + 4 * quad + r, sq, __ATOMIC_RELAXED, __HIP_MEMORY_SCOPE_WORKGROUP);
                }
            __syncthreads();
            if (c > 0) {
                const int dvg = hd * 128 + 16 * wave + l15;
                const float gn = ng[dvg];
#pragma unroll
                for (int tt = 0; tt < 4; ++tt)
#pragma unroll
                    for (int r = 0; r < 4; ++r) {
                        const int t = 16 * tt + 4 * quad + r;
                        const float ssum = red[(c & 1) * 64 + t];
                        const float rs = __builtin_amdgcn_rsqf(ssum * (1.0f / 128.0f) + 1e-6f);
                        const unsigned moff = (unsigned)(b * 2048 + (c - 1) * 64 + t) * 2048u + (unsigned)dvg * 2u;
                        const float gv = bf2f(gr[4 * tt + r]);
                        *(bf16_t*)((char*)MIXC + moff) = f2bf(oacc[tt][r] * rs * gn * gv * __builtin_amdgcn_rcpf(1.0f + __builtin_amdgcn_exp2f(-1.4426950408889634f * gv)));
                    }
            }
#pragma unroll
            for (int i = 0; i < 8; ++i) { lfc[i] = lfn[i]; qc[i] = qn[i]; vc[i] = vn[i]; }
        }
        __syncthreads();
    }
}

constexpr size_t HG_QDX_OFF = 67108864;
constexpr size_t HG_KLX = 0, HG_SCX = 67108864, HG_EBX = HG_SCX + 33554432, HG_META = HG_EBX + 2097152;
__device__ __forceinline__ void hgrn_prep_phase(const Params& P, LAS unsigned char* lds, int blk, int G, int wave) {
    const int lane = lane_id_v(), tid = wave * 64 + lane, l15 = lane & 15, quad = lane >> 4;
    LAS bf16_t* qd = (LAS bf16_t*)lds;
    LAS bf16_t* kd = qd + 64 * 136;
    LAS bf16_t* sc = kd + 64 * 136;
    LAS float* segtot = (LAS float*)(sc + 64 * 72);
    const unsigned short* PC = (const unsigned short*)(P.ws + OFF_BIG);
    char* ZR = (char*)(P.ws + OFF_Z);
    char* QDX = (char*)P.out + HG_QDX_OFF;
    const int dp = tid & 63, sg = tid >> 6;
    constexpr int NIT = 4096 + 8;
#define H1_DEC(it_, b_, hd_, c_) const int b_ = (it_) < 4096 ? (it_) >> 8 : 0, hd_ = (it_) < 4096 ? ((it_) >> 5) & 7 : (it_) - 4096, c_ = (it_) < 4096 ? ((it_) & 31) + 1 : 0
#define H1_OFF0(b_, hd_, c_) ((unsigned)((c_) > 0 ? (b_) * 2048 + ((c_) - 1) * 64 + 8 * sg : T + (sg >= 6 ? 8 * (sg - 6) : 0)) * 8192u + (unsigned)((hd_) * 128 + 2 * dp) * 2u)
#define H1_LOAD(it_, LF_, Q_) do { H1_DEC(it_, b__, hd__, c__); const unsigned o0_ = H1_OFF0(b__, hd__, c__); _Pragma("unroll") for (int tt_ = 0; tt_ < 8; ++tt_) { const unsigned o_ = o0_ + (unsigned)tt_ * 8192u; \
            Q_[tt_] = *(const unsigned*)((const char*)PC + o_); LF_[tt_] = *(const unsigned*)((const char*)PC + o_ + 2048u); } } while (0)
    unsigned lfc[8], qc[8];
    if (blk < NIT) H1_LOAD(blk, lfc, qc);
    for (int it = blk; it < NIT; it += G) {
        H1_DEC(it, b, hd, c);
        (void)b;
        unsigned lfn[8], qn[8];
        { const int itn = it + G < NIT ? it + G : it; H1_LOAD(itn, lfn, qn); }
        char *gQD, *gKL, *gSC, *gEB;
        if (c > 0) { const unsigned ix = (unsigned)(it >> 5) * 32u + (unsigned)(it & 31); gQD = QDX + (size_t)ix * 16384; gKL = ZR + HG_KLX + (size_t)ix * 16384; gSC = ZR + HG_SCX + (size_t)ix * 8192; gEB = ZR + HG_EBX + (size_t)ix * 512; }
        else { char* mb = ZR + HG_META + (size_t)hd * 41472; gQD = mb; gKL = mb + 16384; gSC = mb + 32768; gEB = mb + 40960; }
        {
            float cs0[8], cs1[8]; float run0 = 0.f, run1 = 0.f;
#pragma unroll
            for (int tt = 0; tt < 8; ++tt) {
                const bool ok = c > 0 || (8 * sg + tt) >= 48;
                const float l0 = ok ? 1.4426950408889634f * (float)__builtin_bit_cast(_Float16, (unsigned short)(lfc[tt] & 0xffffu)) : 0.f;
                const float l1 = ok ? 1.4426950408889634f * (float)__builtin_bit_cast(_Float16, (unsigned short)(lfc[tt] >> 16)) : 0.f;
                run0 += l0; run1 += l1; cs0[tt] = run0; cs1[tt] = run1;
            }
            segtot[sg * 128 + 2 * dp] = run0; segtot[sg * 128 + 2 * dp + 1] = run1;
            __syncthreads();
            float off0 = 0.f, off1 = 0.f, bl0 = 0.f, bl1 = 0.f;
#pragma unroll
            for (int s2 = 0; s2 < 8; ++s2) {
                const float a0 = segtot[s2 * 128 + 2 * dp], a1 = segtot[s2 * 128 + 2 * dp + 1];
                bl0 += a0; bl1 += a1; if (s2 < sg) { off0 += a0; off1 += a1; }
            }
            const float ebl0 = __builtin_amdgcn_exp2f(bl0), ebl1 = __builtin_amdgcn_exp2f(bl1);
            if (sg == 7) { *(float*)(gEB + (2 * dp) * 4) = ebl0; *(float*)(gEB + (2 * dp + 1) * 4) = ebl1; }
            float eip0 = __builtin_amdgcn_exp2f(-off0), eip1 = __builtin_amdgcn_exp2f(-off1);
            unsigned kl0[4], kl1[4];
#pragma unroll
            for (int tp = 0; tp < 4; ++tp) {
                float klv0[2], klv1[2];
#pragma unroll
                for (int e = 0; e < 2; ++e) {
                    const int tt = 2 * tp + e, t = 8 * sg + tt;
                    const bool ok = c > 0 || t >= 48;
                    const float bt0 = off0 + cs0[tt], bt1 = off1 + cs1[tt];
                    const float q0 = ok ? bflo(qc[tt]) : 0.f, q1 = ok ? bfhi(qc[tt]) : 0.f;
                    const float eb0 = __builtin_amdgcn_exp2f(bt0), eb1 = __builtin_amdgcn_exp2f(bt1);
                    const float ei0 = __builtin_amdgcn_rcpf(eb0), ei1 = __builtin_amdgcn_rcpf(eb1);
                    const float k0 = 1.0f - eb0 * eip0, k1 = 1.0f - eb1 * eip1;
                    eip0 = ei0; eip1 = ei1;
                    const float kd0 = k0 * ei0, kd1 = k1 * ei1;
                    const unsigned qw = pk2(q0 * eb0, q1 * eb1);
                    *(LAS unsigned*)(qd + t * 136 + 2 * dp) = qw;
                    *(unsigned*)(gQD + (unsigned)(t * 128 + 2 * dp) * 2u) = qw;
                    *(LAS unsigned*)(kd + t * 136 + 2 * dp) = pk2(kd0, kd1);
                    klv0[e] = kd0 * ebl0; klv1[e] = kd1 * ebl1;
                }
                kl0[tp] = pk2(klv0[0], klv0[1]); kl1[tp] = pk2(klv1[0], klv1[1]);
            }
            *(u32x4*)(gKL + (unsigned)((2 * dp) * 64 + 8 * sg) * 2u) = (u32x4){kl0[0], kl0[1], kl0[2], kl0[3]};
            *(u32x4*)(gKL + (unsigned)((2 * dp + 1) * 64 + 8 * sg) * 2u) = (u32x4){kl1[0], kl1[1], kl1[2], kl1[3]};
        }
        __syncthreads();
#pragma unroll
        for (int e = 0; e < 2; ++e) {
            const int tile = 2 * wave + e, tt = tile >> 2, ss = tile & 3;
            bf16x8 fa[4], fb[4];
#pragma unroll
            for (int ks = 0; ks < 4; ++ks) { fa[ks] = *(const LAS bf16x8*)(qd + (16 * tt + l15) * 136 + 32 * ks + 8 * quad); fb[ks] = *(const LAS bf16x8*)(kd + (16 * ss + l15) * 136 + 32 * ks + 8 * quad); }
            __builtin_amdgcn_sched_barrier(0);
            f32x4 sa = {0.f, 0.f, 0.f, 0.f};
#pragma unroll
            for (int ks = 0; ks < 4; ++ks) sa = MFMA16(fa[ks], fb[ks], sa);
#pragma unroll
            for (int r = 0; r < 4; ++r) { const int tg = 16 * tt + 4 * quad + r, sg_ = 16 * ss + l15; sc[tg * 72 + sg_] = f2bf(sg_ <= tg ? sa[r] : 0.f); }
            __builtin_amdgcn_sched_barrier(0);
        }
        __syncthreads();
        { const int row = tid >> 3, seg = tid & 7; *(u32x4*)(gSC + (unsigned)(row * 64 + seg * 8) * 2u) = *(const LAS u32x4*)(sc + row * 72 + seg * 8); }
#pragma unroll
        for (int i = 0; i < 8; ++i) { lfc[i] = lfn[i]; qc[i] = qn[i]; }
    }
    __syncthreads();
}
__device__ __forceinline__ void hgrn_core_phase(const Params& P, LAS unsigned char* lds, int blk, int G, int wave) {
    const int lane = lane_id_v(), tid = wave * 64 + lane, l15 = lane & 15, quad = lane >> 4;
    LAS bf16_t* qd = (LAS bf16_t*)lds;
    LAS bf16_t* klT = qd + 64 * 136;
    LAS bf16_t* vT = klT + 128 * 72;
    LAS bf16_t* sc = vT + 128 * 72;
    LAS float* ebl = (LAS float*)(sc + 64 * 72);
    LAS float* red = ebl + 128;
    const unsigned short* PC = (const unsigned short*)(P.ws + OFF_BIG);
    const char* ZR = (const char*)(P.ws + OFF_Z);
    const char* QDX = (const char*)P.out + HG_QDX_OFF;
    bf16_t* MIXC = (bf16_t*)P.out;
    const float* ng = P.in[16];
    const int dp = tid & 63, sg = tid >> 6;
    for (int item = blk; item < 128; item += G) {
        const int b = item >> 3, hd = item & 7;
        f32x4 Sacc[8];
#pragma unroll
        for (int i = 0; i < 8; ++i) Sacc[i] = (f32x4){0.f, 0.f, 0.f, 0.f};
        u32x4 rq[2], rk[2], rs, re; unsigned rv[8];
#define H2_LOAD(cc_) do { const char *gQD_, *gKL_, *gSC_, *gEB_; \
            if ((cc_) > 0) { const unsigned ix_ = (unsigned)item * 32u + (unsigned)((cc_) - 1); gQD_ = QDX + (size_t)ix_ * 16384; gKL_ = ZR + HG_KLX + (size_t)ix_ * 16384; gSC_ = ZR + HG_SCX + (size_t)ix_ * 8192; gEB_ = ZR + HG_EBX + (size_t)ix_ * 512; } \
            else { const char* mb_ = ZR + HG_META + (size_t)hd * 41472; gQD_ = mb_; gKL_ = mb_ + 16384; gSC_ = mb_ + 32768; gEB_ = mb_ + 40960; } \
            rq[0] = *(const u32x4*)(gQD_ + tid * 16); rq[1] = *(const u32x4*)(gQD_ + 8192 + tid * 16); \
            rk[0] = *(const u32x4*)(gKL_ + tid * 16); rk[1] = *(const u32x4*)(gKL_ + 8192 + tid * 16); \
            rs = *(const u32x4*)(gSC_ + tid * 16); re = *(const u32x4*)(gEB_ + (tid & 31) * 16); \
            const unsigned o0_ = (unsigned)((cc_) > 0 ? b * 2048 + ((cc_) - 1) * 64 + 8 * sg : T + (sg >= 6 ? 8 * (sg - 6) : 0)) * 8192u + (unsigned)(2048 + hd * 128 + 2 * dp) * 2u; \
            _Pragma("unroll") for (int tt_ = 0; tt_ < 8; ++tt_) rv[tt_] = *(const unsigned*)((const char*)PC + o0_ + (unsigned)tt_ * 8192u); } while (0)
        H2_LOAD(0);
        for (int c = 0; c < 33; ++c) {
            {
#pragma unroll
                for (int j = 0; j < 2; ++j) { const int e = tid * 8 + j * 4096; *(LAS u32x4*)(qd + (e >> 7) * 136 + (e & 127)) = rq[j]; *(LAS u32x4*)(klT + (e >> 6) * 72 + (e & 63)) = rk[j]; }
                { const int e = tid * 8; *(LAS u32x4*)(sc + (e >> 6) * 72 + (e & 63)) = rs; }
                if (tid < 32) *(LAS u32x4*)(ebl + tid * 4) = re;
                unsigned v0[4], v1[4];
#pragma unroll
                for (int tp = 0; tp < 4; ++tp) {
                    const bool okA = c > 0 || (8 * sg + 2 * tp) >= 48, okB = c > 0 || (8 * sg + 2 * tp + 1) >= 48;
                    const unsigned va = okA ? rv[2 * tp] : 0u, vb = okB ? rv[2 * tp + 1] : 0u;
                    v0[tp] = (va & 0xffffu) | (vb << 16); v1[tp] = (va >> 16) | (vb & 0xffff0000u);
                }
                *(LAS u32x4*)(vT + (2 * dp) * 72 + 8 * sg) = (u32x4){v0[0], v0[1], v0[2], v0[3]};
                *(LAS u32x4*)(vT + (2 * dp + 1) * 72 + 8 * sg) = (u32x4){v1[0], v1[1], v1[2], v1[3]};
            }
            __syncthreads();
            { const int cn = c + 1 < 33 ? c + 1 : 32; H2_LOAD(cn); }
            unsigned short gr[16];
            {
                const int cg_ = c > 0 ? c : 1;
#pragma unroll
                for (int tt = 0; tt < 4; ++tt)
#pragma unroll
                    for (int r = 0; r < 4; ++r) gr[4 * tt + r] = *(const unsigned short*)((const char*)PC + ((unsigned)(b * 2048 + (cg_ - 1) * 64 + 16 * tt + 4 * quad + r) * 8192u + (unsigned)(3072 + hd * 128 + 16 * wave + l15) * 2u));
            }
            f32x4 oacc[4];
#pragma unroll
            for (int i = 0; i < 4; ++i) oacc[i] = (f32x4){0.f, 0.f, 0.f, 0.f};
#pragma unroll
            for (int kh = 0; kh < 2; ++kh) {
                s16x4 alo[2][4], ahi[2][4];
#pragma unroll
                for (int k2 = 0; k2 < 2; ++k2)
#pragma unroll
                    for (int tt = 0; tt < 4; ++tt) { const LAS bf16_t* ap = qd + (16 * tt + l15) * 136 + 32 * (2 * kh + k2) + 4 * quad; alo[k2][tt] = *(const LAS s16x4*)ap; ahi[k2][tt] = *(const LAS s16x4*)(ap + 16); }
                __builtin_amdgcn_sched_barrier(0);
#pragma unroll
                for (int k2 = 0; k2 < 2; ++k2) {
                    const int ks = 2 * kh + k2;
                    u32x4 sw; sw.x = pk2(Sacc[2 * ks][0], Sacc[2 * ks][1]); sw.y = pk2(Sacc[2 * ks][2], Sacc[2 * ks][3]);
                    sw.z = pk2(Sacc[2 * ks + 1][0], Sacc[2 * ks + 1][1]); sw.w = pk2(Sacc[2 * ks + 1][2], Sacc[2 * ks + 1][3]);
                    const bf16x8 sb = __builtin_bit_cast(bf16x8, sw);
#pragma unroll
                    for (int tt = 0; tt < 4; ++tt) oacc[tt] = MFMA16(__builtin_shufflevector(alo[k2][tt], ahi[k2][tt], 0, 1, 2, 3, 4, 5, 6, 7), sb, oacc[tt]);
                }
                __builtin_amdgcn_sched_barrier(0);
            }
            {
#pragma unroll
                for (int dt = 0; dt < 8; ++dt) Sacc[dt] *= *(const LAS f32x4*)(ebl + 16 * dt + 4 * quad);
                __builtin_amdgcn_sched_barrier(0);
#pragma unroll
                for (int ks = 0; ks < 2; ++ks) {
                    bf16x8 fsc[4], fkl[8];
                    const bf16x8 vb = *(const LAS bf16x8*)(vT + (16 * wave + l15) * 72 + 32 * ks + 8 * quad);
#pragma unroll
                    for (int tt = 0; tt < 4; ++tt) fsc[tt] = *(const LAS bf16x8*)(sc + (16 * tt + l15) * 72 + 32 * ks + 8 * quad);
#pragma unroll
                    for (int dt = 0; dt < 8; ++dt) fkl[dt] = *(const LAS bf16x8*)(klT + (16 * dt + l15) * 72 + 32 * ks + 8 * quad);
                    __builtin_amdgcn_sched_barrier(0);
#pragma unroll
                    for (int tt = 0; tt < 4; ++tt) oacc[tt] = MFMA16(fsc[tt], vb, oacc[tt]);
#pragma unroll
                    for (int dt = 0; dt < 8; ++dt) Sacc[dt] = MFMA16(fkl[dt], vb, Sacc[dt]);
                    __builtin_amdgcn_sched_barrier(0);
                }
            }
#pragma unroll
            for (int tt = 0; tt < 4; ++tt)
#pragma unroll
                for (int r = 0; r < 4; ++r) {
                    float sq = oacc[tt][r] * oacc[tt][r];
                    sq += __int_as_float(__builtin_amdgcn_update_dpp(0, __float_as_int(sq), 0xB1, 0xf, 0xf, false));
                    sq += __int_as_float(__builtin_amdgcn_update_dpp(0, __float_as_int(sq), 0x4E, 0xf, 0xf, false));
                    sq += __int_as_float(__builtin_amdgcn_update_dpp(0, __float_as_int(sq), 0x141, 0xf, 0xf, false));
                    sq += __int_as_float(__builtin_amdgcn_update_dpp(0, __float_as_int(sq), 0x140, 0xf, 0xf, false));
                    if (l15 == 0) red[(16 * tt + 4 * quad + r) * 8 + wave] = sq;
                }
            __syncthreads();
            if (c > 0) {
                const int dvg = hd * 128 + 16 * wave + l15;
                const float gn = ng[dvg];
#pragma unroll
                for (int tt = 0; tt < 4; ++tt)
#pragma unroll
                    for (int r = 0; r < 4; ++r) {
                        const int t = 16 * tt + 4 * quad + r;
                        const f32x4 r0 = *(const LAS f32x4*)(red + t * 8), r1 = *(const LAS f32x4*)(red + t * 8 + 4);
                        const float ssum = ((r0[0] + r0[1]) + (r0[2] + r0[3])) + ((r1[0] + r1[1]) + (r1[2] + r1[3]));
                        const float rs_ = __builtin_amdgcn_rsqf(ssum * (1.0f / 128.0f) + 1e-6f);
                        const unsigned moff = (unsigned)(b * 2048 + (c - 1) * 64 + t) * 2048u + (unsigned)dvg * 2u;
                        const float gv = bf2f(gr[4 * tt + r]);
                        *(bf16_t*)((char*)MIXC + moff) = f2bf(oacc[tt][r] * rs_ * gn * gv * __builtin_amdgcn_rcpf(1.0f + __builtin_amdgcn_exp2f(-1.4426950408889634f * gv)));
                    }
            }
        }
        __syncthreads();
    }
}

__global__ void __launch_bounds__(512, 2) fwd_megakernel(Params P) {
    extern __shared__ __attribute__((aligned(16))) unsigned char lds_raw[];
    LAS unsigned char* lds = (LAS unsigned char*)lds_raw;
    cg::grid_group grid = cg::this_grid();
    const int blk = blockIdx.x, G = gridDim.x, wave = __builtin_amdgcn_readfirstlane((int)(threadIdx.x >> 6));
    unsigned char* ws = P.ws;
    bf16_t* HB = (bf16_t*)(ws + OFF_HB);
    float* Z = (float*)(ws + OFF_Z);
    bf16_t* PROJ = (bf16_t*)(ws + OFF_BIG + BIG_PROJ);
    bf16_t* APRE = (bf16_t*)(ws + OFF_BIG + BIG_APRE);
    bf16_t* CAT = (bf16_t*)(ws + OFF_BIG + BIG_CAT);
    bf16_t* HID = (bf16_t*)(ws + OFF_BIG);
    unsigned short* PC = (unsigned short*)(ws + OFF_BIG);

    volatile LAS unsigned* xst = (volatile LAS unsigned*)(lds + 131072);
    if (wave == 0 && lane_id_v() < 4) xst[lane_id_v()] = 0u;
    __syncthreads();
    const XcdBarrier xb = xcd_barrier_post((unsigned*)(ws + OFF_BAR), xst, wave);
    prologue_phase(P, lds, blk, G, wave);
#if PROBE_DUP_PRO
    __syncthreads();
    prologue_phase(P, lds, blk, G, wave);
#endif
    if (G == 0x7fffffff) grid.sync();
    xcd_barrier(xb, wave);
    run_gemm(lds, HB, (const bf16_t*)(ws + OFF_WAB), 2048, 1024, EpInAB{PROJ}, true, blk, G, wave);
#if PROBE_GEMMS
    __syncthreads();
    run_gemm(lds, HB, (const bf16_t*)(ws + OFF_WAB), 2048, 1024, EpInAB{PROJ}, true, blk, G, wave);
#endif
    xcd_barrier(xb, wave);
    if (wave >= 4) weight_items(P, (LAS float*)(lds + 51200 + (wave - 4) * 8448), blk * 4 + (wave - 4), G * 4, lane_id_v(), 1);
    s5_phase(P, lds, blk, G, wave);
    __syncthreads();
#if PROBE_DUP_S5
    s5_phase(P, lds, blk, G, wave);
    __syncthreads();
#endif
    attn_phase(P, lds, blk, G, wave);
#if PROBE_DUP_ATTN
    __syncthreads();
    attn_phase(P, lds, blk, G, wave);
#endif
    xcd_barrier(xb, wave);
    run_gemm(lds, APRE, (const bf16_t*)(ws + OFF_WGLU), 512, 512, EpGlu{APRE, P.in[12], CAT}, true, blk, G, wave);
    xcd_barrier(xb, wave);
    float* ST = (float*)(ws + OFF_ST); const float* SV = (const float*)(ws + OFF_SV); const float* TV = (const float*)(ws + OFF_TV);
    float *ST1 = ST, *ST2 = ST + 2 * (size_t)R, *ST3 = ST + 4 * (size_t)R, *ST4 = ST + 6 * (size_t)R;
#if PROBE_DUP_OUTAB
    run_gemm(lds, CAT, (const bf16_t*)(ws + OFF_WOAB), 1024, 1024, EpRes<NB_OUTAB>{HB, nullptr, nullptr, nullptr, nullptr, ST + 8 * (size_t)R}, true, blk, G, wave);
    __syncthreads();
#endif
    run_gemm(lds, CAT, (const bf16_t*)(ws + OFF_WOAB), 1024, 1024, EpRes<NB_OUTAB>{HB, nullptr, nullptr, nullptr, nullptr, ST1}, true, blk, G, wave);
    xcd_barrier(xb, wave);
    run_gemm(lds, HB, (const bf16_t*)(ws + OFF_WUP0), 4096, 1024, EpUp{HID, P.in[21], ST1, SV, TV}, true, blk, G, wave);
#if PROBE_DUP_UP0
    __syncthreads();
    run_gemm(lds, HB, (const bf16_t*)(ws + OFF_WUP0), 4096, 1024, EpUp{HID, P.in[21], ST1, SV, TV}, true, blk, G, wave);
#endif
#if PROBE_SYNCS
    for (int i_ = 0; i_ < PROBE_SYNCS; ++i_) xcd_barrier(xb, wave);
#endif
    xcd_barrier(xb, wave);
#if PROBE_GEMMS
    run_gemm(lds, HID, (const bf16_t*)(ws + OFF_WDN0), 1024, 4096, EpInAB{(bf16_t*)P.out}, false, blk, G, wave);
    __syncthreads();
#endif
    run_gemm(lds, HID, (const bf16_t*)(ws + OFF_WDN0), 1024, 4096, EpRes<NB_DN0>{HB, P.in[23], ST1, P.in[18], P.in[19], ST2}, true, blk, G, wave);
    xcd_barrier(xb, wave);
    run_gemm(lds, HB, (const bf16_t*)(ws + OFF_WC), 4096, 1024, EpInC{PC, P.in[15], ST2, SV + 4096, TV + 4096}, true, blk, G, wave);
#if PROBE_DUP_INC
    __syncthreads();
    run_gemm(lds, HB, (const bf16_t*)(ws + OFF_WC), 4096, 1024, EpInC{PC, P.in[15], ST2, SV + 4096, TV + 4096}, true, blk, G, wave);
#endif
    xcd_barrier(xb, wave);
#if HGRN_TWO_PHASE
    hgrn_prep_phase(P, lds, blk, G, wave);
    xcd_barrier(xb, wave);
    hgrn_core_phase(P, lds, blk, G, wave);
#else
    hgrn_phase(P, lds, blk, G, wave);
#endif
    xcd_barrier(xb, wave);
    run_gemm(lds, (const bf16_t*)P.out  , (const bf16_t*)(ws + OFF_WOC), 1024, 1024, EpRes<NB_OUTC>{HB, nullptr, ST2, P.in[24], P.in[25], ST3}, false, blk, G, wave);
    xcd_barrier(xb, wave);
    run_gemm(lds, HB, (const bf16_t*)(ws + OFF_WUP1), 4096, 1024, EpUp{HID, P.in[21] + 4096, ST3, SV + 8192, TV + 8192}, false, blk, G, wave);
    xcd_barrier(xb, wave);
    run_gemm(lds, HID, (const bf16_t*)(ws + OFF_WDN1), 1024, 4096, EpRes<NB_DN1>{HB, P.in[23] + 1024, ST3, P.in[18] + 1024, P.in[19] + 1024, ST4}, false, blk, G, wave);
    xcd_barrier(xb, wave);
    final_ln_phase(HB, ST4, P.out, P.in[24] + 1024, P.in[25] + 1024, blk, G, wave);
}

extern "C" void kernel_launch(void* const* d_in, const int* in_sizes, int n_in, void* d_out, int out_size, void* d_ws, size_t ws_size, hipStream_t stream) {
    constexpr size_t kDynLds = 131072 + 256;
    static int grid_blocks = 0;
    if (!grid_blocks) {
        if (n_in != 26 || ws_size < ZERO_END) { fprintf(stderr, "kernel_launch: expected 26 inputs and >= %zu bytes of workspace (got %d, %zu)\n", (size_t)ZERO_END, n_in, ws_size); grid_blocks = -1; return; }
        int dev = 0, cus = 0, per_cu = 0;
        hipGetDevice(&dev);
        hipDeviceGetAttribute(&cus, hipDeviceAttributeMultiprocessorCount, dev);
        hipFuncSetAttribute((const void*)fwd_megakernel, hipFuncAttributeMaxDynamicSharedMemorySize, (int)kDynLds);
        hipOccupancyMaxActiveBlocksPerMultiprocessor(&per_cu, (const void*)fwd_megakernel, 512, kDynLds);
        if (per_cu < 1) { fprintf(stderr, "kernel_launch: occupancy query says %d blocks per CU\n", per_cu); per_cu = 1; }
        grid_blocks = cus * (per_cu > 1 ? 1 : per_cu);
        if (grid_blocks != 256) fprintf(stderr, "kernel_launch: note: grid is %d workgroups (tuned for 256)\n", grid_blocks);
    }
    if (grid_blocks < 1) return;
    Params p{};
    for (int i = 0; i < 26; ++i) p.in[i] = (const float*)d_in[i];
    p.out = (float*)d_out; p.ws = (unsigned char*)d_ws;
    hipMemsetAsync((char*)d_ws + OFF_ST, 0, ZERO_END - OFF_ST, stream);
    void* args[] = {&p};
    hipError_t e = hipLaunchCooperativeKernel((const void*)fwd_megakernel, dim3(grid_blocks), dim3(512), args, kDynLds, stream);
    if (e != hipSuccess) fprintf(stderr, "cooperative launch failed: %s (grid %d)\n", hipGetErrorString(e), grid_blocks);
}
```

```cpp
#define NB_OUTAB 4
#define NB_DN0 2
#define NB_OUTC 4
#define NB_DN1 2
#include <hip/hip_runtime.h>
#include <hip/hip_cooperative_groups.h>
#include <cstdio>
#include <cstdint>
namespace cg = cooperative_groups;
#ifndef PROBE_DUP_S5
#define PROBE_DUP_S5 0
#endif
#ifndef PROBE_DUP_ATTN
#define PROBE_DUP_ATTN 0
#endif
#ifndef PROBE_DUP_HGRN
#define PROBE_DUP_HGRN 0
#endif
#ifndef PROBE_DUP_INC
#define PROBE_DUP_INC 0
#endif
__device__ __forceinline__ int lane_id_v() { int l; asm volatile("v_mbcnt_lo_u32_b32 %0, -1, 0\n\tv_mbcnt_hi_u32_b32 %0, -1, %0" : "=v"(l)); return l; }
#ifndef PROBE_DUP_UP0
#define PROBE_DUP_UP0 0
#endif
#ifndef PROBE_SYNCS
#define PROBE_SYNCS 0
#endif
#ifndef NB_OUTAB
#define NB_OUTAB 4
#endif
#ifndef NB_DN0
#define NB_DN0 4
#endif
#ifndef NB_OUTC
#define NB_OUTC 4
#endif
#ifndef NB_DN1
#define NB_DN1 4
#endif
#ifndef PROBE_GEMMS
#define PROBE_GEMMS 0
#endif
#ifndef PROBE_DUP_PRO
#define PROBE_DUP_PRO 0
#endif
#ifndef PROBE_DUP_OUTAB
#define PROBE_DUP_OUTAB 0
#endif
#ifndef HGRN_TWO_PHASE
#define HGRN_TWO_PHASE 0
#endif
#define XB_TMO      128
#define XB_XCNT(j)  (256  + 64 * (j))
#define XB_XSUB(j)  (1280 + 64 * (j))
#define XB_XGEN(j)  (2304 + 64 * (j))
#define XB_TOP      3328
#define XB_TOPGEN   3392
#define XCD_BAR_WORDS 3456
#define XB_SPIN_CAP (1u << 18)

__device__ __forceinline__ unsigned xb_ld(unsigned* p)              { return __hip_atomic_load(p, __ATOMIC_RELAXED, __HIP_MEMORY_SCOPE_AGENT); }
__device__ __forceinline__ unsigned xb_add(unsigned* p, unsigned v) { return __hip_atomic_fetch_add(p, v, __ATOMIC_RELAXED, __HIP_MEMORY_SCOPE_AGENT); }
__device__ __forceinline__ unsigned xb_xcc_id() { return (unsigned)__builtin_amdgcn_s_getreg((3 << 11) | 20) & 0xFu; }
#define XB_SPIN(cond, bar) do { unsigned _sp = 0; while (cond) { __builtin_amdgcn_s_sleep(1); \
    if ((++_sp & 255u) == 0u) { if (xb_ld(&(bar)[XB_TMO])) break; if (_sp > XB_SPIN_CAP) { atomicAdd(&(bar)[XB_TMO], 1u); break; } } } } while (0)

struct XcdBarrier {
    unsigned* bar; unsigned x;
    volatile __attribute__((address_space(3))) unsigned* st;
};

__device__ __forceinline__ XcdBarrier xcd_barrier_post(unsigned* bar, volatile __attribute__((address_space(3))) unsigned* st, int wave_in) {
    XcdBarrier b; b.bar = bar; b.x = xb_xcc_id(); b.st = st;
    if (wave_in == 0 && lane_id_v() == 0) (void)xb_add(&bar[XB_XCNT(b.x)], 1u);
    return b;
}
__device__ __forceinline__ void xcd_barrier_complete(unsigned* bar, unsigned x, unsigned& nloc, unsigned& nx) {
    const unsigned G = gridDim.x * gridDim.y * gridDim.z;
    unsigned sum, cnt, mine, sp = 0u;
    for (;;) {
        sum = 0u; cnt = 0u; mine = 0u;
#pragma unroll
        for (unsigned j = 0; j < 16; ++j) { const unsigned c = xb_ld(&bar[XB_XCNT(j)]); sum += c; cnt += (c > 0u) ? 1u : 0u; mine = (j == x) ? c : mine; }
        if (sum == G) break;
        __builtin_amdgcn_s_sleep(1);
        if ((++sp & 255u) == 0u) { if (xb_ld(&bar[XB_TMO])) break; if (sp > XB_SPIN_CAP) { atomicAdd(&bar[XB_TMO], 1u); break; } }
    }
    nloc = mine > 0u ? mine : 1u; nx = cnt > 0u ? cnt : 1u;
}

__device__ __forceinline__ void xcd_barrier(const XcdBarrier& b, int wave_in) {
    asm volatile("s_waitcnt vmcnt(0)" ::: "memory");
    __syncthreads();
    if (wave_in == 0 && lane_id_v() == 0) {
        unsigned* bar = b.bar;
        __builtin_amdgcn_s_waitcnt(0);
        unsigned nloc = b.st[0], nx = b.st[1];
        if (nloc == 0u) { xcd_barrier_complete(bar, b.x, nloc, nx); b.st[0] = nloc; b.st[1] = nx; }
        const unsigned old = xb_add(&bar[XB_XSUB(b.x)], 1u);
        const unsigned gen = old / nloc;
        if (old + 1u == (gen + 1u) * nloc) {
            __builtin_amdgcn_fence(__ATOMIC_RELEASE, "agent");
            asm volatile("s_waitcnt vmcnt(0)" ::: "memory");
            const unsigned og = xb_add(&bar[XB_TOP], 1u);
            const unsigned tg = og / nx;
            if (og + 1u == (tg + 1u) * nx) xb_add(&bar[XB_TOPGEN], 1u);
            else XB_SPIN(xb_ld(&bar[XB_TOPGEN]) == tg, bar);
            __builtin_amdgcn_fence(__ATOMIC_ACQUIRE, "agent");
            xb_add(&bar[XB_XGEN(b.x)], 1u);
            asm volatile("s_waitcnt vmcnt(0)" ::: "memory");
        } else {
            XB_SPIN(xb_ld(&bar[XB_XGEN(b.x)]) == gen, bar);
            __builtin_amdgcn_fence(__ATOMIC_ACQUIRE, "agent");
            asm volatile("s_waitcnt vmcnt(0)" ::: "memory");
        }
    }
    __syncthreads();
}

namespace pg8 {
#define PG8_LAS __attribute__((address_space(3)))
typedef unsigned short bf16_t;
typedef short bf16x8 __attribute__((ext_vector_type(8)));
typedef float f32x4 __attribute__((ext_vector_type(4)));
typedef unsigned u32x4 __attribute__((ext_vector_type(4)));
constexpr int BM = 256, BK = 64, HALF = 128, HTB = HALF * BK * 2  , STAGE_BYTES = 8 * HTB, NXCD = 8, WGM = 8;

__host__ __device__ __forceinline__ int lds_byte(int r, int c) { const int st = (r >> 4) * 2 + (c >> 5), rr = r & 15, cc = c & 31, ob = rr * 64 + cc * 2; return st * 1024 + (ob ^ (((ob >> 9) & 1) << 5)); }
__host__ __device__ __forceinline__ void stage_rc(int b, int& R, int& C) { const int st = b / 1024, sb = b % 1024, swz = sb ^ (((sb >> 9) & 1) << 5); R = (st >> 1) * 16 + swz / 64; C = (st & 1) * 32 + (swz % 64) / 2; }
__host__ __device__ __forceinline__ int perm32(int rho) { const int n = rho >> 4, i = rho & 15; return 8 * (i >> 2) + 4 * n + (i & 3); }

struct Unit { int pm, pn; };
struct Gemm { const bf16_t* A; const bf16_t* Bt; int M, N, K; };

struct StaticOrder {
    int nM, nN, nwg, G, c;
    __host__ __device__ void init(int M, int N, int G_, int c_) { nM = M / BM; nN = N / BM; nwg = nM * nN; G = G_; c = c_; }
    __host__ __device__ bool next(int i, Unit& u) const {
        const long L = (long)i * G + c; if (L >= nwg) return false;
        int wgid = (int)L; { const int q = nwg / NXCD, r = nwg % NXCD, xcd = wgid % NXCD, off = wgid / NXCD; wgid = (xcd < r ? xcd * (q + 1) : r * (q + 1) + (xcd - r) * q) + off; }
        const int nig = WGM * nN, gid = wgid / nig, fm = gid * WGM, gsz = (nM - fm) < WGM ? (nM - fm) : WGM;
        u.pm = fm + ((wgid % nig) % gsz); u.pn = (wgid % nig) / gsz; return true;
    }
    __device__ __forceinline__ void a_ready(const Unit&) const {}
    __device__ __forceinline__ void done(const Unit&) const {}
};

__device__ __forceinline__ unsigned cvt_pk_bf16(float lo, float hi) { unsigned r; asm volatile("v_cvt_pk_bf16_f32 %0, %1, %2" : "=v"(r) : "v"(lo), "v"(hi)); return r; }
template <class Epi, class Sched, bool ALIGN_EPI = false, bool SP2 = false>
__device__ __forceinline__ void gemm_phase(PG8_LAS unsigned char* lds, const Gemm g, const Sched& S, const Epi& E, int wave_in) {
    const int lane = lane_id_v(), wid = __builtin_amdgcn_readfirstlane(wave_in), tid = wid * 64 + lane, wr = wid >> 2, wc = wid & 3, fr = lane & 15, fq = lane >> 4;
    const int K = g.K, nt = K / BK;
    unsigned voffA[2], voffB[2];
#pragma unroll
    for (int i = 0; i < 2; ++i) { int R, C; stage_rc(tid * 16 + i * 8192, R, C); const int Rb = Epi::PERM ? ((R & ~31) + perm32(R & 31)) : R;
        voffA[i] = (unsigned)(R * K + C) * 2u; voffB[i] = (unsigned)(Rb * K + C) * 2u; }
    const size_t kstep = (size_t)(BK * 2);
    const size_t hstep = (size_t)HALF * K * 2;
    const size_t tstep = 2 * hstep;
    const unsigned ldsw = (unsigned)wid * 1024u;
    const int aoff = lds_byte(wr * 64 + fr, fq * 8), boff = lds_byte(wc * 32 + fr, fq * 8);
#define PG8_SA(b, h) (((b) * 2 + (h)) * HTB)
#define PG8_SB(b, h) ((4 + (b) * 2 + (h)) * HTB)
#define PG8_STAGE(bufoff, gbase, voff) do { _Pragma("unroll") for (int _i = 0; _i < 2; ++_i) \
        __builtin_amdgcn_global_load_lds((const unsigned*)((const char*)(gbase) + (voff)[_i]), (PG8_LAS unsigned*)(lds + (bufoff) + ldsw + _i * 8192), 16, 0, 0); } while (0)
#define PG8_LDA(dst, b, h) do { _Pragma("unroll") for (int m = 0; m < 4; ++m) _Pragma("unroll") for (int k = 0; k < 2; ++k) dst[m][k] = *(const PG8_LAS bf16x8*)(lds + PG8_SA(b, h) + aoff + m * 2048 + k * 1024); } while (0)
#define PG8_LDB(dst, b, h) do { _Pragma("unroll") for (int n = 0; n < 2; ++n) _Pragma("unroll") for (int k = 0; k < 2; ++k) dst[n][k] = *(const PG8_LAS bf16x8*)(lds + PG8_SB(b, h) + boff + n * 2048 + k * 1024); } while (0)
#define PG8_MMA(ai, bj, At, Bt) do { __builtin_amdgcn_s_setprio(1); _Pragma("unroll") for (int m = 0; m < 4; ++m) _Pragma("unroll") for (int n = 0; n < 2; ++n) _Pragma("unroll") for (int k = 0; k < 2; ++k) \
        acc[ai][bj][m][n] = __builtin_amdgcn_mfma_f32_16x16x32_bf16(Bt[n][k], At[m][k], acc[ai][bj][m][n], 0, 0, 0); __builtin_amdgcn_s_setprio(0); } while (0)
#define PG8_WAIT_V(n) asm volatile("s_waitcnt vmcnt(" #n ")" ::: "memory")
#define PG8_WAIT_L(n) asm volatile("s_waitcnt lgkmcnt(" #n ")" ::: "memory")
#define PG8_BAR __builtin_amdgcn_s_barrier()
#define PG8_SCHED __builtin_amdgcn_sched_barrier(0)
    Unit cur, nxt; int ui = 0;
    if (!S.next(0, cur)) return;
    f32x4 acc[2][2][4][2];
#pragma unroll
    for (int a = 0; a < 2; ++a)
#pragma unroll
        for (int b = 0; b < 2; ++b)
#pragma unroll
            for (int m = 0; m < 4; ++m)
#pragma unroll
                for (int n = 0; n < 2; ++n) acc[a][b][m][n] = (f32x4){0.f, 0.f, 0.f, 0.f};
    bf16x8 At[4][2], B0[2][2], B1[2][2];
    const char* cA = (const char*)g.A + (size_t)cur.pm * tstep; const char* cB = (const char*)g.Bt + (size_t)cur.pn * tstep;
    S.a_ready(cur);
    if constexpr (SP2) {
        PG8_STAGE(PG8_SB(0, 0), cB, voffB); PG8_STAGE(PG8_SB(0, 1), cB + hstep, voffB); PG8_STAGE(PG8_SA(0, 0), cA, voffA); PG8_STAGE(PG8_SA(0, 1), cA + hstep, voffA);
        if (wr == 1) PG8_BAR;
        PG8_WAIT_V(2); PG8_BAR;
        PG8_STAGE(PG8_SB(1, 0), cB + kstep, voffB); PG8_STAGE(PG8_SA(1, 0), cA + kstep, voffA); PG8_STAGE(PG8_SB(1, 1), cB + hstep + kstep, voffB);
        PG8_WAIT_V(6); PG8_BAR;
    } else {
        PG8_STAGE(PG8_SB(0, 0), cB, voffB); PG8_STAGE(PG8_SA(0, 0), cA, voffA); PG8_STAGE(PG8_SB(0, 1), cB + hstep, voffB); PG8_STAGE(PG8_SA(0, 1), cA + hstep, voffA);
        if (wr == 1) PG8_BAR;
        PG8_WAIT_V(4); PG8_BAR;
        PG8_STAGE(PG8_SB(1, 0), cB + kstep, voffB); PG8_STAGE(PG8_SA(1, 0), cA + kstep, voffA); PG8_STAGE(PG8_SB(1, 1), cB + hstep + kstep, voffB);
        PG8_WAIT_V(6); PG8_BAR;
    }
    for (;;) {
        const bool has_next = S.next(ui + 1, nxt);
        const char* nA = has_next ? (const char*)g.A + (size_t)nxt.pm * tstep : cA; const char* nB = has_next ? (const char*)g.Bt + (size_t)nxt.pn * tstep : cB;
        for (int t = 0; t < nt; t += 2) {
            const bool last = (t == nt - 2);
            const char* a1 = cA + (size_t)(t + 1) * kstep;
            const char* a2 = last ? nA : cA + (size_t)(t + 2) * kstep; const char* b2 = last ? nB : cB + (size_t)(t + 2) * kstep;
            const char* a3 = a2 + kstep; const char* b3 = b2 + kstep;
            if (last && has_next) S.a_ready(nxt);
            if constexpr (SP2) {
            PG8_LDB(B0, 0, 0); PG8_LDB(B1, 0, 1); PG8_SCHED; PG8_LDA(At, 0, 0); PG8_STAGE(PG8_SA(1, 1), a1 + hstep, voffA);
            PG8_WAIT_V(8); PG8_WAIT_L(0); PG8_BAR; PG8_MMA(0, 0, At, B0); PG8_MMA(0, 1, At, B1); PG8_BAR; PG8_SCHED;
            PG8_LDA(At, 0, 1); PG8_STAGE(PG8_SB(0, 0), b2, voffB); PG8_STAGE(PG8_SB(0, 1), b2 + hstep, voffB); PG8_STAGE(PG8_SA(0, 0), a2, voffA);
            PG8_WAIT_V(8); PG8_WAIT_L(0); PG8_BAR; PG8_MMA(1, 0, At, B0); PG8_MMA(1, 1, At, B1); PG8_BAR; PG8_SCHED;
            PG8_LDB(B0, 1, 0); PG8_LDB(B1, 1, 1); PG8_SCHED; PG8_LDA(At, 1, 0); PG8_STAGE(PG8_SA(0, 1), a2 + hstep, voffA);
            PG8_WAIT_V(8); PG8_WAIT_L(0); PG8_BAR; PG8_MMA(0, 0, At, B0); PG8_MMA(0, 1, At, B1); PG8_BAR; PG8_SCHED;
            PG8_LDA(At, 1, 1); PG8_STAGE(PG8_SB(1, 0), b3, voffB); PG8_STAGE(PG8_SB(1, 1), b3 + hstep, voffB); PG8_STAGE(PG8_SA(1, 0), a3, voffA);
            PG8_WAIT_V(8); PG8_WAIT_L(0); PG8_BAR; PG8_MMA(1, 0, At, B0); PG8_MMA(1, 1, At, B1); PG8_BAR; PG8_SCHED;
            } else {
            PG8_LDB(B0, 0, 0); PG8_SCHED; PG8_LDA(At, 0, 0); PG8_STAGE(PG8_SA(1, 1), a1 + hstep, voffA);
            PG8_WAIT_L(8); PG8_BAR; PG8_WAIT_L(0); PG8_MMA(0, 0, At, B0); PG8_BAR; PG8_SCHED;
            PG8_LDB(B1, 0, 1); PG8_STAGE(PG8_SB(0, 0), b2, voffB);
            PG8_BAR; PG8_WAIT_L(0); PG8_MMA(0, 1, At, B1); PG8_BAR;
            PG8_LDA(At, 0, 1); PG8_STAGE(PG8_SA(0, 0), a2, voffA);
            PG8_BAR; PG8_WAIT_L(0); PG8_MMA(1, 0, At, B0); PG8_BAR; PG8_SCHED;
            PG8_STAGE(PG8_SB(0, 1), b2 + hstep, voffB);
            PG8_WAIT_V(6); PG8_BAR; PG8_MMA(1, 1, At, B1); PG8_BAR;
            PG8_LDB(B0, 1, 0); PG8_SCHED; PG8_LDA(At, 1, 0); PG8_STAGE(PG8_SA(0, 1), a2 + hstep, voffA);
            PG8_WAIT_L(8); PG8_BAR; PG8_WAIT_L(0); PG8_MMA(0, 0, At, B0); PG8_BAR; PG8_SCHED;
            PG8_LDB(B1, 1, 1); PG8_STAGE(PG8_SB(1, 0), b3, voffB);
            PG8_BAR; PG8_WAIT_L(0); PG8_MMA(0, 1, At, B1); PG8_BAR;
            PG8_LDA(At, 1, 1); PG8_STAGE(PG8_SA(1, 0), a3, voffA);
            PG8_BAR; PG8_WAIT_L(0); PG8_MMA(1, 0, At, B0); PG8_BAR; PG8_SCHED;
            PG8_STAGE(PG8_SB(1, 1), b3 + hstep, voffB);
            PG8_WAIT_V(6); PG8_BAR; PG8_MMA(1, 1, At, B1); PG8_BAR;
            }
        }
        if constexpr (ALIGN_EPI) { if (wr == 0) PG8_BAR; }
        if constexpr (!Epi::AFTER_DRAIN) { E(acc, cur, wr, wc, fr, fq); S.done(cur); }
        if (!has_next) break;
#pragma unroll
        for (int a = 0; a < 2; ++a)
#pragma unroll
            for (int b = 0; b < 2; ++b)
#pragma unroll
                for (int m = 0; m < 4; ++m)
#pragma unroll
                    for (int n = 0; n < 2; ++n) acc[a][b][m][n] = (f32x4){0.f, 0.f, 0.f, 0.f};
        cur = nxt; cA = nA; cB = nB; ++ui;
        if constexpr (ALIGN_EPI) { if (wr == 1) PG8_BAR; }
    }
    PG8_WAIT_V(0);
    if constexpr (!ALIGN_EPI) { if (wr == 0) PG8_BAR; }
    PG8_BAR;
    if constexpr (Epi::AFTER_DRAIN) { E.fused(acc, cur, wr, wc, fr, fq, lds, wid, lane); S.done(cur); }
#undef PG8_SA
#undef PG8_SB
#undef PG8_STAGE
#undef PG8_LDA
#undef PG8_LDB
#undef PG8_MMA
#undef PG8_WAIT_V
#undef PG8_WAIT_L
#undef PG8_BAR
#undef PG8_SCHED
}
}

#define LAS __attribute__((address_space(3)))
typedef unsigned short bf16_t;
typedef short bf16x8 __attribute__((ext_vector_type(8)));
typedef short s16x4 __attribute__((ext_vector_type(4)));
typedef float f32x4 __attribute__((ext_vector_type(4)));
typedef float f32x16 __attribute__((ext_vector_type(16)));
typedef unsigned u32x4 __attribute__((ext_vector_type(4)));
typedef unsigned u32x2 __attribute__((ext_vector_type(2)));

constexpr int T = 16 * 2048;
constexpr int NMETA = 16;
constexpr int R = T + NMETA;
constexpr int DM = 1024, DFF = 4096;
constexpr float ALPHA = 1.4142135623730951f;
constexpr float QSCALE = 0.125f * 1.4426950408889634f;

constexpr size_t SZ_WAB = (size_t)2048 * 1024 * 2, SZ_WGLU = (size_t)512 * 512 * 2, SZ_W1M = (size_t)1024 * 1024 * 2, SZ_W4M = (size_t)4096 * 1024 * 2;
constexpr size_t OFF_WAB = 0, OFF_WGLU = OFF_WAB + SZ_WAB, OFF_WOAB = OFF_WGLU + SZ_WGLU, OFF_WC = OFF_WOAB + SZ_W1M, OFF_WOC = OFF_WC + SZ_W4M,
                 OFF_WUP0 = OFF_WOC + SZ_W1M, OFF_WUP1 = OFF_WUP0 + SZ_W4M, OFF_WDN0 = OFF_WUP1 + SZ_W4M, OFF_WDN1 = OFF_WDN0 + SZ_W4M,
                 OFF_HB = OFF_WDN1 + SZ_W4M, OFF_Z = OFF_HB + (size_t)R * 1024 * 2, OFF_BIG = OFF_Z + (size_t)R * 1024 * 4, WS_END = OFF_BIG + (size_t)R * 4096 * 2;
constexpr size_t OFF_ST = (WS_END + 255) & ~(size_t)255;
constexpr size_t SZ_ST = (size_t)5 * R * 2 * 4;
constexpr size_t OFF_SV = OFF_ST + SZ_ST, OFF_TV = OFF_SV + (size_t)3 * 4096 * 4, OFF_BAR = OFF_TV + (size_t)3 * 4096 * 4, OFF_ZROW = OFF_BIG + ((OFF_BAR + (size_t)XCD_BAR_WORDS * 4 - OFF_BIG + 8191) / 8192) * 8192, ZERO_END = OFF_ZROW + (size_t)8 * 8192;
constexpr size_t BIG_PROJ = 0, BIG_APRE = (size_t)R * 2048 * 2, BIG_CAT = BIG_APRE + (size_t)R * 512 * 2;

struct Params { const float* in[26]; float* out; unsigned char* ws; };

__device__ __forceinline__ unsigned pk2(float lo, float hi) {
    typedef __bf16 bf2 __attribute__((ext_vector_type(2)));
    typedef float fl2 __attribute__((ext_vector_type(2)));
    fl2 v = {lo, hi}; bf2 r = __builtin_convertvector(v, bf2); return __builtin_bit_cast(unsigned, r);
}
__device__ __forceinline__ bf16_t f2bf(float x) { return (bf16_t)(pk2(x, 0.f) & 0xffffu); }
__device__ __forceinline__ float bf2f(bf16_t v) { return __uint_as_float((unsigned)v << 16); }
__device__ __forceinline__ float bflo(unsigned w) { return __uint_as_float(w << 16); }
__device__ __forceinline__ float bfhi(unsigned w) { return __uint_as_float(w & 0xffff0000u); }
__device__ __forceinline__ float sigmoidf_(float x) { return 1.0f / (1.0f + __expf(-x)); }
#define LDS_WAIT() asm volatile("s_waitcnt lgkmcnt(0)" ::: "memory")
#define MFMA16(a, b, c) __builtin_amdgcn_mfma_f32_16x16x32_bf16((a), (b), (c), 0, 0, 0)
#define MFMA32(a, b, c) __builtin_amdgcn_mfma_f32_32x32x16_bf16((a), (b), (c), 0, 0, 0)

struct RowCtx { float mu, rstd; };
__device__ __forceinline__ RowCtx ln_ctx(const float* st, int row) {
    const float sum = st[2 * (size_t)row], sq = st[2 * (size_t)row + 1];
    RowCtx rc; rc.mu = sum * (1.0f / 1024.0f); const float var = fmaxf(sq * (1.0f / 1024.0f) - rc.mu * rc.mu, 0.f); rc.rstd = 1.0f / sqrtf(var + 1e-5f); return rc;
}
struct NoCtx {};
struct EpInAB {
    static constexpr bool MAKES_STATS = false; static constexpr int BATCH = 8;
    typedef NoCtx ColCtx; typedef NoCtx Pre;
    bf16_t* O;
    __device__ __forceinline__ ColCtx col_ctx(int) const { return NoCtx{}; }
    template <bool META> __device__ __forceinline__ Pre pre(int, int) const { return NoCtx{}; }
    __device__ __forceinline__ RowCtx row_ctx(int) const { return RowCtx{0.f, 1.f}; }
    __device__ __forceinline__ float* st_ptr() const { return nullptr; }
    __device__ __forceinline__ void apply8(int row, int col, f32x4 a, f32x4 b, const RowCtx&, const ColCtx&, const Pre&, float&, float&) const {
        const float s = (col >= 512 && col < 1024) ? QSCALE : 1.0f;
        u32x4 w; w.x = pk2(a[0] * s, a[1] * s); w.y = pk2(a[2] * s, a[3] * s); w.z = pk2(b[0] * s, b[1] * s); w.w = pk2(b[2] * s, b[3] * s);
        *(u32x4*)(O + (size_t)row * 2048 + col) = w;
    }
};
struct EpGlu {
    static constexpr bool MAKES_STATS = false; static constexpr int BATCH = 4;
    struct ColCtx { f32x4 b0, b1; }; struct Pre { u32x4 ap; };
    const bf16_t* APRE; const float* bias; bf16_t* CAT;
    __device__ __forceinline__ ColCtx col_ctx(int col) const { return ColCtx{*(const f32x4*)(bias + col), *(const f32x4*)(bias + col + 4)}; }
    template <bool META> __device__ __forceinline__ Pre pre(int row, int col) const { return Pre{*(const u32x4*)((const char*)APRE + ((unsigned)row * 1024u + (unsigned)col * 2u))}; }
    __device__ __forceinline__ RowCtx row_ctx(int) const { return RowCtx{0.f, 1.f}; }
    __device__ __forceinline__ float* st_ptr() const { return nullptr; }
    __device__ __forceinline__ void apply8(int row, int col, f32x4 a, f32x4 b, const RowCtx&, const ColCtx& cc, const Pre& pr, float&, float&) const {
        const u32x4 ap = pr.ap;
        float v[8] = {a[0] + cc.b0[0], a[1] + cc.b0[1], a[2] + cc.b0[2], a[3] + cc.b0[3], b[0] + cc.b1[0], b[1] + cc.b1[1], b[2] + cc.b1[2], b[3] + cc.b1[3]};
        float y[8] = {bflo(ap.x), bfhi(ap.x), bflo(ap.y), bfhi(ap.y), bflo(ap.z), bfhi(ap.z), bflo(ap.w), bfhi(ap.w)};
#pragma unroll
        for (int i = 0; i < 8; ++i) y[i] = y[i] * sigmoidf_(v[i]);
        u32x4 w; w.x = pk2(y[0], y[1]); w.y = pk2(y[2], y[3]); w.z = pk2(y[4], y[5]); w.w = pk2(y[6], y[7]);
        *(u32x4*)(CAT + (size_t)row * 1024 + col) = w;
    }
};
template <int NB_> struct EpRes {
    static constexpr bool MAKES_STATS = true; static constexpr int BATCH = NB_;
    struct ColCtx { f32x4 ag0, ag1, ab0, ab1; }; struct Pre { u32x4 h; };
    bf16_t* HBp; const float* bias;
    const float* st_prev; const float* g; const float* bta; float* st_out;
    __device__ __forceinline__ ColCtx col_ctx(int col) const {
        ColCtx c; const f32x4 one = {1.f, 1.f, 1.f, 1.f}, zero = {0.f, 0.f, 0.f, 0.f};
        const f32x4 g0 = st_prev ? *(const f32x4*)(g + col) : one, g1 = st_prev ? *(const f32x4*)(g + col + 4) : one;
        const f32x4 t0 = st_prev ? *(const f32x4*)(bta + col) : zero, t1 = st_prev ? *(const f32x4*)(bta + col + 4) : zero;
        const f32x4 b0 = bias ? *(const f32x4*)(bias + col) : zero, b1 = bias ? *(const f32x4*)(bias + col + 4) : zero;
        c.ag0 = g0 * ALPHA; c.ag1 = g1 * ALPHA; c.ab0 = t0 * ALPHA + b0; c.ab1 = t1 * ALPHA + b1; return c;
    }
    template <bool META> __device__ __forceinline__ Pre pre(int row, int col) const { return Pre{*(const u32x4*)((const char*)HBp + ((unsigned)row * 2048u + (unsigned)col * 2u))}; }
    __device__ __forceinline__ RowCtx row_ctx(int row) const { return st_prev ? ln_ctx(st_prev, row) : RowCtx{0.f, 1.f}; }
    __device__ __forceinline__ float* st_ptr() const { return st_out; }
    __device__ __forceinline__ void apply8(int row, int col, f32x4 a, f32x4 b, const RowCtx& rc, const ColCtx& cc, const Pre& pr, float& s, float& q) const {
        const f32x4 h0 = {bflo(pr.h.x), bfhi(pr.h.x), bflo(pr.h.y), bfhi(pr.h.y)}, h1 = {bflo(pr.h.z), bfhi(pr.h.z), bflo(pr.h.w), bfhi(pr.h.w)};
        const f32x4 o0 = (h0 - rc.mu) * rc.rstd * cc.ag0 + cc.ab0 + a, o1 = (h1 - rc.mu) * rc.rstd * cc.ag1 + cc.ab1 + b;
        u32x4 w; w.x = pk2(o0[0], o0[1]); w.y = pk2(o0[2], o0[3]); w.z = pk2(o1[0], o1[1]); w.w = pk2(o1[2], o1[3]);
        *(u32x4*)((char*)HBp + ((unsigned)row * 2048u + (unsigned)col * 2u)) = w;
        s += ((o0[0] + o0[1]) + (o0[2] + o0[3])) + ((o1[0] + o1[1]) + (o1[2] + o1[3]));
        q += ((o0[0] * o0[0] + o0[1] * o0[1]) + (o0[2] * o0[2] + o0[3] * o0[3])) + ((o1[0] * o1[0] + o1[1] * o1[1]) + (o1[2] * o1[2] + o1[3] * o1[3]));
    }
};
struct EpUp {
    static constexpr bool MAKES_STATS = false; static constexpr int BATCH = 8;
    struct ColCtx { f32x4 s0, s1, t0, t1; }; typedef NoCtx Pre;
    bf16_t* H; const float* bias; const float* st_prev; const float* sv; const float* tv;
    __device__ __forceinline__ ColCtx col_ctx(int col) const {
        return ColCtx{*(const f32x4*)(sv + col), *(const f32x4*)(sv + col + 4), *(const f32x4*)(tv + col) + *(const f32x4*)(bias + col), *(const f32x4*)(tv + col + 4) + *(const f32x4*)(bias + col + 4)};
    }
    template <bool META> __device__ __forceinline__ Pre pre(int, int) const { return NoCtx{}; }
    __device__ __forceinline__ RowCtx row_ctx(int row) const { return ln_ctx(st_prev, row); }
    __device__ __forceinline__ float* st_ptr() const { return nullptr; }
    __device__ __forceinline__ void apply8(int row, int col, f32x4 a, f32x4 b, const RowCtx& rc, const ColCtx& cc, const Pre&, float&, float&) const {
        f32x4 v0 = (a - rc.mu * cc.s0) * rc.rstd + cc.t0, v1 = (b - rc.mu * cc.s1) * rc.rstd + cc.t1;
#pragma unroll
        for (int i = 0; i < 4; ++i) { v0[i] = fmaxf(v0[i], 0.f); v0[i] *= v0[i]; v1[i] = fmaxf(v1[i], 0.f); v1[i] *= v1[i]; }
        u32x4 w; w.x = pk2(v0[0], v0[1]); w.y = pk2(v0[2], v0[3]); w.z = pk2(v1[0], v1[1]); w.w = pk2(v1[2], v1[3]);
        *(u32x4*)(H + (size_t)row * 4096 + col) = w;
    }
};
struct EpInC {
    static constexpr bool MAKES_STATS = false; static constexpr int BATCH = 8;
    struct ColCtx { f32x4 s0, s1, t0, t1, lb0, lb1; }; typedef NoCtx Pre;
    unsigned short* PC; const float* gamma; const float* st_prev; const float* sv; const float* tv;
    __device__ __forceinline__ ColCtx col_ctx(int col) const {
        ColCtx c{*(const f32x4*)(sv + col), *(const f32x4*)(sv + col + 4), *(const f32x4*)(tv + col), *(const f32x4*)(tv + col + 4), {0.f, 0.f, 0.f, 0.f}, {0.f, 0.f, 0.f, 0.f}};
        if (col >= 1024 && col < 2048) {
            const f32x4 ga = *(const f32x4*)(gamma + col - 1024), gb = *(const f32x4*)(gamma + col - 1020), gc = *(const f32x4*)(gamma + col), gd = *(const f32x4*)(gamma + col + 4);
#pragma unroll
            for (int i = 0; i < 4; ++i) { c.lb0[i] = 1.0f / (1.0f + __expf(ga[i] - gc[i])); c.lb1[i] = 1.0f / (1.0f + __expf(gb[i] - gd[i])); }
        }
        return c;
    }
    template <bool META> __device__ __forceinline__ Pre pre(int, int) const { return NoCtx{}; }
    __device__ __forceinline__ RowCtx row_ctx(int row) const { return ln_ctx(st_prev, row); }
    __device__ __forceinline__ float* st_ptr() const { return nullptr; }
    __device__ __forceinline__ void apply8(int row, int col, f32x4 a, f32x4 b, const RowCtx& rc, const ColCtx& cc, const Pre&, float&, float&) const {
        a = (a - rc.mu * cc.s0) * rc.rstd + cc.t0;
        b = (b - rc.mu * cc.s1) * rc.rstd + cc.t1;
        u32x4 w;
        if (col >= 1024 && col < 2048) {
            float v[8] = {a[0], a[1], a[2], a[3], b[0], b[1], b[2], b[3]};
            float lb[8] = {cc.lb0[0], cc.lb0[1], cc.lb0[2], cc.lb0[3], cc.lb1[0], cc.lb1[1], cc.lb1[2], cc.lb1[3]};
            unsigned short h[8];
#pragma unroll
            for (int i = 0; i < 8; ++i) {
                const float f = lb[i] + (1.0f - lb[i]) * sigmoidf_(v[i]);
                const _Float16 hf = (_Float16)__logf(f);
                h[i] = __builtin_bit_cast(unsigned short, hf);
            }
            w.x = h[0] | ((unsigned)h[1] << 16); w.y = h[2] | ((unsigned)h[3] << 16); w.z = h[4] | ((unsigned)h[5] << 16); w.w = h[6] | ((unsigned)h[7] << 16);
        } else { w.x = pk2(a[0], a[1]); w.y = pk2(a[2], a[3]); w.z = pk2(b[0], b[1]); w.w = pk2(b[2], b[3]); }
        *(u32x4*)(PC + (size_t)row * 4096 + col) = w;
    }
};
template <class F> struct EpiAdapt {
    static constexpr bool PERM = true, AFTER_DRAIN = false; F f;
    __device__ __forceinline__ void operator()(const f32x4 (&acc)[2][2][4][2], const pg8::Unit& u, int wr, int wc, int, int) const {
        const int lane_ = lane_id_v(), fr = lane_ & 15, fq = lane_ >> 4;
        const int col0 = u.pn * 256 + wc * 32 + 8 * fq, row0 = u.pm * 256 + wr * 64 + fr;
        constexpr int NB = F::BATCH;
#pragma unroll
        for (int bt = 0; bt < 8 / NB; ++bt) {
            const typename F::ColCtx cc[2] = {f.col_ctx(col0), f.col_ctx(col0 + 128)};
            RowCtx rc[NB];
            typename F::Pre pr[NB][2];
#pragma unroll
            for (int i = 0; i < NB; ++i) { const int r8 = bt * NB + i, row = row0 + (r8 >> 2) * 128 + (r8 & 3) * 16;
                rc[i] = f.row_ctx(row); pr[i][0] = f.template pre<false>(row, col0); pr[i][1] = f.template pre<false>(row, col0 + 128); }
#pragma unroll
            for (int i = 0; i < NB; ++i) { const int r8 = bt * NB + i, ai = r8 >> 2, m = r8 & 3, row = row0 + ai * 128 + m * 16;
                float s = 0.f, q = 0.f;
                f.apply8(row, col0, acc[ai][0][m][0], acc[ai][0][m][1], rc[i], cc[0], pr[i][0], s, q);
                f.apply8(row, col0 + 128, acc[ai][1][m][0], acc[ai][1][m][1], rc[i], cc[1], pr[i][1], s, q);
                if (F::MAKES_STATS) {
                    s += __shfl_xor(s, 16); s += __shfl_xor(s, 32); q += __shfl_xor(q, 16); q += __shfl_xor(q, 32);
                    if (fq == 0) { float* st = (float*)((char*)f.st_ptr() + (unsigned)row * 8u); unsafeAtomicAdd(st, s); unsafeAtomicAdd(st + 1, q); }
                }
            }
            asm volatile("" ::: "memory");
        }
    }
};
template <class F> __device__ __forceinline__ void meta_gemm(const bf16_t* A16  , const bf16_t* Bt, int N, int K, const F& f, int blk, int G, int wave, int lane, LAS float* red  ) {
    const int l15 = lane & 15, quad = lane >> 4, kw = K >> 3;
    for (int item = blk; item < N / 32; item += G) {
        const int c0 = item * 32;
        const bf16_t* ap = A16 + (size_t)l15 * K + 8 * quad + wave * kw;
        const bf16_t* w0 = Bt + (size_t)(c0 + 8 * (l15 >> 2) + (l15 & 3)) * K + 8 * quad + wave * kw;
        const bf16_t* w1 = w0 + (size_t)4 * K;
        f32x4 acc0 = {0.f, 0.f, 0.f, 0.f}, acc1 = {0.f, 0.f, 0.f, 0.f};
#pragma unroll 4
        for (int k = 0; k < kw; k += 32) {
            const bf16x8 xa = *(const bf16x8*)(ap + k), b0 = *(const bf16x8*)(w0 + k), b1 = *(const bf16x8*)(w1 + k);
            acc0 = MFMA16(b0, xa, acc0); acc1 = MFMA16(b1, xa, acc1);
        }
        *(LAS f32x4*)(red + (wave * 64 + lane) * 8) = acc0; *(LAS f32x4*)(red + (wave * 64 + lane) * 8 + 4) = acc1;
        __syncthreads();
        if (wave == 0) {
#pragma unroll
            for (int w = 1; w < 8; ++w) { acc0 += *(const LAS f32x4*)(red + (w * 64 + lane) * 8); acc1 += *(const LAS f32x4*)(red + (w * 64 + lane) * 8 + 4); }
            const RowCtx rc = f.row_ctx(T + l15);
            const typename F::ColCtx cc = f.col_ctx(c0 + 8 * quad);
            const typename F::Pre pr = f.template pre<true>(T + l15, c0 + 8 * quad);
            float s = 0.f, q = 0.f;
            f.apply8(T + l15, c0 + 8 * quad, acc0, acc1, rc, cc, pr, s, q);
            if (F::MAKES_STATS) {
                s += __shfl_xor(s, 16); s += __shfl_xor(s, 32); q += __shfl_xor(q, 16); q += __shfl_xor(q, 32);
                if (quad == 0) { float* st = f.st_ptr() + 2 * (size_t)(T + l15); unsafeAtomicAdd(st, s); unsafeAtomicAdd(st + 1, q); }
            }
        }
        __syncthreads();
    }
}
template <class F> __device__ __forceinline__ void run_gemm(LAS unsigned char* lds, const bf16_t* A, const bf16_t* Bt, int N, int K, const F& f, bool with_meta, int blk, int G, int wave) {
    pg8::Gemm g{A, Bt, T, N, K}; pg8::StaticOrder S; S.init(T, N, G, blk);
    EpiAdapt<F> E{f};
    pg8::gemm_phase<EpiAdapt<F>, pg8::StaticOrder, true, true>((PG8_LAS unsigned char*)lds, g, S, E, wave);
    if (with_meta) meta_gemm<F>(A + (size_t)T * K, Bt, N, K, f, blk, G, wave, lane_id_v(), (LAS float*)lds);
}

__device__ __forceinline__ void transpose_item(const float* W, int K, int N, bf16_t* WT, LAS float* scr, int item, int lane) {
    const int nblk = N / 32, kb = item / nblk, nb = item % nblk, k0 = 64 * kb, n0 = 32 * nb;
    float wv_[32];
#pragma unroll
    for (int i = 0; i < 32; ++i) wv_[i] = W[(size_t)(k0 + 2 * i + (lane >> 5)) * N + n0 + (lane & 31)];
#pragma unroll
    for (int i = 0; i < 32; ++i) scr[(2 * i + (lane >> 5)) * 33 + (lane & 31)] = wv_[i];
    LDS_WAIT();
    const int c = lane & 7;
#pragma unroll
    for (int j = 0; j < 4; ++j) { const int n = (lane >> 3) + 8 * j; const LAS float* s = scr + (8 * c) * 33 + n;
        u32x4 o; o.x = pk2(s[0 * 33], s[1 * 33]); o.y = pk2(s[2 * 33], s[3 * 33]); o.z = pk2(s[4 * 33], s[5 * 33]); o.w = pk2(s[6 * 33], s[7 * 33]);
        *(u32x4*)(WT + (size_t)(n0 + n) * K + k0 + 8 * c) = o; }
    LDS_WAIT();
}
__device__ __forceinline__ void transpose_item_fold(const float* W, int K, int N, bf16_t* WT, LAS float* scr, int item, int lane, const float* g, const float* bta, float* sv, float* tv) {
    const int nblk = N / 32, kb = item / nblk, nb = item % nblk, k0 = 64 * kb, n0 = 32 * nb;
    float wv_[32];
#pragma unroll
    for (int i = 0; i < 32; ++i) wv_[i] = W[(size_t)(k0 + 2 * i + (lane >> 5)) * N + n0 + (lane & 31)];
#pragma unroll
    for (int i = 0; i < 32; ++i) scr[(2 * i + (lane >> 5)) * 33 + (lane & 31)] = wv_[i];
    LDS_WAIT();
    const int c = lane & 7;
    const f32x4 g0 = *(const f32x4*)(g + k0 + 8 * c), g1 = *(const f32x4*)(g + k0 + 8 * c + 4), b0 = *(const f32x4*)(bta + k0 + 8 * c), b1 = *(const f32x4*)(bta + k0 + 8 * c + 4);
#pragma unroll
    for (int j = 0; j < 4; ++j) { const int n = (lane >> 3) + 8 * j; const LAS float* s = scr + (8 * c) * 33 + n;
        const float w0 = s[0 * 33], w1 = s[1 * 33], w2 = s[2 * 33], w3 = s[3 * 33], w4 = s[4 * 33], w5 = s[5 * 33], w6 = s[6 * 33], w7 = s[7 * 33];
        u32x4 o; o.x = pk2(g0[0] * w0, g0[1] * w1); o.y = pk2(g0[2] * w2, g0[3] * w3); o.z = pk2(g1[0] * w4, g1[1] * w5); o.w = pk2(g1[2] * w6, g1[3] * w7);
        *(u32x4*)(WT + (size_t)(n0 + n) * K + k0 + 8 * c) = o;
        float ss = ((bflo(o.x) + bfhi(o.x)) + (bflo(o.y) + bfhi(o.y))) + ((bflo(o.z) + bfhi(o.z)) + (bflo(o.w) + bfhi(o.w)));
        float tt = ((b0[0] * w0 + b0[1] * w1) + (b0[2] * w2 + b0[3] * w3)) + ((b1[0] * w4 + b1[1] * w5) + (b1[2] * w6 + b1[3] * w7));
        ss += __shfl_xor(ss, 1); ss += __shfl_xor(ss, 2); ss += __shfl_xor(ss, 4);
        tt += __shfl_xor(tt, 1); tt += __shfl_xor(tt, 2); tt += __shfl_xor(tt, 4);
        if (c == 0) { unsafeAtomicAdd(sv + n0 + n, ss); unsafeAtomicAdd(tv + n0 + n, tt); } }
    LDS_WAIT();
}
__device__ __forceinline__ void weight_items(const Params& P, LAS float* scr, int gw, int NGW, int lane, int part) {
    unsigned char* ws = P.ws;
    constexpr int I_AB = 16 * 64, I_GLU = 8 * 16, I_1M = 16 * 32, I_C = 16 * 128, I_UP = 16 * 128, I_DN = 64 * 32;
    constexpr int NREST = I_GLU + I_1M + I_C + I_1M + 2 * I_UP + 2 * I_DN;
    if (part == 0) { for (int it = gw; it < I_AB; it += NGW) transpose_item(P.in[2], 1024, 2048, (bf16_t*)(ws + OFF_WAB), scr, it, lane); return; }
    for (int it = gw; it < NREST; it += NGW) {
        int r = it;
        if (r < I_GLU) { transpose_item(P.in[11], 512, 512, (bf16_t*)(ws + OFF_WGLU), scr, r, lane); continue; } r -= I_GLU;
        if (r < I_1M) { transpose_item(P.in[13], 1024, 1024, (bf16_t*)(ws + OFF_WOAB), scr, r, lane); continue; } r -= I_1M;
        if (r < I_UP) { transpose_item_fold(P.in[20], 1024, 4096, (bf16_t*)(ws + OFF_WUP0), scr, r, lane, P.in[18], P.in[19], (float*)(ws + OFF_SV), (float*)(ws + OFF_TV)); continue; } r -= I_UP;
        if (r < I_DN) { transpose_item(P.in[22], 4096, 1024, (bf16_t*)(ws + OFF_WDN0), scr, r, lane); continue; } r -= I_DN;
        if (r < I_C) { transpose_item_fold(P.in[14], 1024, 4096, (bf16_t*)(ws + OFF_WC), scr, r, lane, P.in[24], P.in[25], (float*)(ws + OFF_SV) + 4096, (float*)(ws + OFF_TV) + 4096); continue; } r -= I_C;
        if (r < I_1M) { transpose_item(P.in[17], 1024, 1024, (bf16_t*)(ws + OFF_WOC), scr, r, lane); continue; } r -= I_1M;
        if (r < I_UP) { transpose_item_fold(P.in[20] + (size_t)1024 * 4096, 1024, 4096, (bf16_t*)(ws + OFF_WUP1), scr, r, lane, P.in[18] + 1024, P.in[19] + 1024, (float*)(ws + OFF_SV) + 8192, (float*)(ws + OFF_TV) + 8192); continue; } r -= I_UP;
        transpose_item(P.in[22] + (size_t)4096 * 1024, 4096, 1024, (bf16_t*)(ws + OFF_WDN1), scr, r, lane);
    }
}
__device__ __forceinline__ void prologue_phase(const Params& P, LAS unsigned char* lds, int blk, int G, int wave) {
    const int lane = lane_id_v(), tid = wave * 64 + lane;
    unsigned char* ws = P.ws;
    weight_items(P, (LAS float*)(lds + wave * 8448), blk * 8 + wave, G * 8, lane, 0);
    bf16_t* HB = (bf16_t*)(ws + OFF_HB);
    const size_t n8 = (size_t)R * 1024 / 8;
#pragma unroll 4
    for (size_t i = (size_t)blk * 512 + tid; i < n8; i += (size_t)G * 512) {
        const size_t e = i * 8;
        const float* src = e < (size_t)T * 1024 ? P.in[0] + e : P.in[1] + (e - (size_t)T * 1024);
        const f32x4 a = *(const f32x4*)src, b = *(const f32x4*)(src + 4);
        u32x4 w; w.x = pk2(a[0], a[1]); w.y = pk2(a[2], a[3]); w.z = pk2(b[0], b[1]); w.w = pk2(b[2], b[3]);
        *(u32x4*)(HB + e) = w;
    }
}

__device__ __forceinline__ void ln_phase(const float* Zin, float* Fout, bf16_t* Bout, const float* g, const float* bta, int nrows, int blk, int G, int wave) {
    const int lane = lane_id_v();
    for (int row = blk * 8 + wave; row < nrows; row += G * 8) {
        const f32x4* xr = (const f32x4*)(Zin + (size_t)row * 1024) + lane;
        f32x4 v[4]; float s = 0.f;
#pragma unroll
        for (int j = 0; j < 4; ++j) { v[j] = xr[64 * j]; s += (v[j][0] + v[j][1]) + (v[j][2] + v[j][3]); }
#pragma unroll
        for (int o = 1; o < 64; o <<= 1) s += __shfl_xor(s, o);
        const float mean = s * (1.f / 1024.f); float s2 = 0.f;
#pragma unroll
        for (int j = 0; j < 4; ++j) { v[j] = v[j] - mean; s2 += (v[j][0] * v[j][0] + v[j][1] * v[j][1]) + (v[j][2] * v[j][2] + v[j][3] * v[j][3]); }
#pragma unroll
        for (int o = 1; o < 64; o <<= 1) s2 += __shfl_xor(s2, o);
        const float rstd = 1.0f / sqrtf(s2 * (1.f / 1024.f) + 1e-5f);
#pragma unroll
        for (int j = 0; j < 4; ++j) {
            const int col = 4 * (lane + 64 * j);
            const f32x4 gg = *(const f32x4*)(g + col), bb = *(const f32x4*)(bta + col);
            const f32x4 o = v[j] * rstd * gg + bb;
            *(f32x4*)(Fout + (size_t)row * 1024 + col) = o;
            if (Bout) { u32x2 w; w.x = pk2(o[0], o[1]); w.y = pk2(o[2], o[3]); *(u32x2*)(Bout + (size_t)row * 1024 + col) = w; }
        }
    }
}

__device__ __forceinline__ void final_ln_phase(const bf16_t* Zb, const float* st, float* out, const float* g, const float* bta, int blk, int G, int wave) {
    const int lane = lane_id_v();
    for (int row0 = (blk * 8 + wave) * 4; row0 < T; row0 += G * 8 * 4) {
        u32x4 v[4][2];
#pragma unroll
        for (int rr = 0; rr < 4; ++rr)
#pragma unroll
            for (int j = 0; j < 2; ++j) v[rr][j] = *(const u32x4*)((const char*)Zb + ((unsigned)(row0 + rr) * 2048u + (unsigned)(8 * (lane + 64 * j)) * 2u));
#pragma unroll
        for (int rr = 0; rr < 4; ++rr) {
            const int row = row0 + rr;
            const RowCtx rc = ln_ctx(st, row);
#pragma unroll
            for (int j = 0; j < 2; ++j) {
                const int col = 8 * (lane + 64 * j);
                const f32x4 h0 = {bflo(v[rr][j].x), bfhi(v[rr][j].x), bflo(v[rr][j].y), bfhi(v[rr][j].y)}, h1 = {bflo(v[rr][j].z), bfhi(v[rr][j].z), bflo(v[rr][j].w), bfhi(v[rr][j].w)};
                float* op = out + (size_t)row * 1024 + col;
                *(f32x4*)op = (h0 - rc.mu) * rc.rstd * *(const f32x4*)(g + col) + *(const f32x4*)(bta + col);
                *(f32x4*)(op + 4) = (h1 - rc.mu) * rc.rstd * *(const f32x4*)(g + col + 4) + *(const f32x4*)(bta + col + 4);
            }
        }
    }
}

__device__ __forceinline__ void lam_coef(const float* lam_re, const float* lam_im, float dt, int idx, float& lbr, float& lbi, float& cr, float& ci) {
    const float lr = lam_re[idx], li = lam_im[idx];
    const float er = __expf(lr * dt);
    float ang = li * dt;
    const float kk = rintf(ang * 0.15915494309189535f);
    ang = fmaf(-kk, 6.2831854820251465f, ang); ang = fmaf(-kk, -1.7484555e-7f, ang);
    lbr = er * __cosf(ang); lbi = er * __sinf(ang);
    const float nr = lbr - 1.0f, ni = lbi, den = 1.0f / (lr * lr + li * li);
    cr = (nr * lr + ni * li) * den; ci = (ni * lr - nr * li) * den;
}
__device__ __forceinline__ void s5_phase(const Params& P, LAS unsigned char* lds, int blk, int G, int wave) {
    const int lane = lane_id_v(), l15 = lane & 15, quad = lane >> 4;
    LAS float* bu = (LAS float*)(lds + wave * 12800);
    LAS unsigned* sl = (LAS unsigned*)(lds + wave * 12800 + 8448);
    const bf16_t* PROJ = (const bf16_t*)(P.ws + OFF_BIG + BIG_PROJ);
    bf16_t* APRE = (bf16_t*)(P.ws + OFF_BIG + BIG_APRE);
    for (int vw = wave; blk + G * (vw >> 1) < 512; vw += 8) {
        const int item = blk + G * (vw >> 1), seg = vw & 1;
        const int b = item >> 5, g = item & 31;
        const int c_end = seg ? 129 : 65, c_out = seg ? 65 : 0;
        const float dt = __expf(P.in[5][g]);
        float lbr, lbi, cr_, ci_;
        lam_coef(P.in[3], P.in[4], dt, g * 64 + lane, lbr, lbi, cr_, ci_);
        bf16x8 bfrag[8];
#pragma unroll
        for (int tile = 0; tile < 8; ++tile) {
            const int comp = 16 * tile + l15, st = comp & 63, isim = comp >> 6;
            float a0, a1, cr, ci; lam_coef(P.in[3], P.in[4], dt, g * 64 + st, a0, a1, cr, ci);
            bf16x8 fr = {0, 0, 0, 0, 0, 0, 0, 0};
            if (quad < 2) {
                const float* bre = P.in[6] + (size_t)(g * 64 + st) * 16 + 8 * quad;
                const float* bim = P.in[7] + (size_t)(g * 64 + st) * 16 + 8 * quad;
#pragma unroll
                for (int j = 0; j < 8; ++j) { const float v = isim ? (cr * bim[j] + ci * bre[j]) : (cr * bre[j] - ci * bim[j]); fr[j] = (short)f2bf(v); }
            }
            bfrag[tile] = fr;
        }
        bf16x8 cfrag[4];
#pragma unroll
        for (int ks = 0; ks < 4; ++ks) {
#pragma unroll
            for (int j = 0; j < 8; ++j) {
                const int k = 32 * ks + 8 * quad + j, p = k >> 1;
                const float v = (k & 1) ? -P.in[9][(size_t)(g * 16 + l15) * 64 + p] : P.in[8][(size_t)(g * 16 + l15) * 64 + p];
                cfrag[ks][j] = (short)f2bf(v);
            }
        }
        const float dh = P.in[10][g * 16 + l15];
        float sr = 0.f, si = 0.f;
        const bf16x8 zero8 = {0, 0, 0, 0, 0, 0, 0, 0};
        bf16x8 ua_n = *(const bf16x8*)(PROJ + (size_t)(T + l15) * 2048 + g * 16 + 8 * (quad & 1));
        unsigned short ue_n[4];
#pragma unroll
        for (int r = 0; r < 4; ++r) ue_n[r] = PROJ[(size_t)(T + 4 * quad + r) * 2048 + g * 16 + l15];
        for (int chunk = 0; chunk < c_end; ++chunk) {
            const bool outp = chunk >= c_out;
            const int rowbase = chunk == 0 ? T : b * 2048 + (chunk - 1) * 16;
            const bf16x8 ua = quad < 2 ? ua_n : zero8;
            unsigned short ue[4];
#pragma unroll
            for (int r = 0; r < 4; ++r) ue[r] = ue_n[r];
            {
                const int cn = chunk + 1 < 129 ? chunk + 1 : 128;
                const int rbn = b * 2048 + (cn - 1) * 16;
                ua_n = *(const bf16x8*)(PROJ + (size_t)(rbn + l15) * 2048 + g * 16 + 8 * (quad & 1));
#pragma unroll
                for (int r = 0; r < 4; ++r) ue_n[r] = PROJ[(size_t)(rbn + 4 * quad + r) * 2048 + g * 16 + l15];
            }
#pragma unroll
            for (int tile = 0; tile < 8; ++tile) {
                f32x4 acc = {0.f, 0.f, 0.f, 0.f};
                acc = MFMA16(ua, bfrag[tile], acc);
#pragma unroll
                for (int r = 0; r < 4; ++r) bu[(4 * quad + r) * 132 + 16 * tile + l15] = acc[r];
            }
            LDS_WAIT();
            if (!outp) {
#pragma unroll
                for (int t = 0; t < 16; ++t) {
                    const float br = bu[t * 132 + lane], bi = bu[t * 132 + 64 + lane];
                    const float nsr = fmaf(lbr, sr, fmaf(-lbi, si, br)), nsi = fmaf(lbr, si, fmaf(lbi, sr, bi));
                    sr = nsr; si = nsi;
                }
                LDS_WAIT();
                continue;
            }
#pragma unroll
            for (int t = 0; t < 16; ++t) {
                const float br = bu[t * 132 + lane], bi = bu[t * 132 + 64 + lane];
                const float nsr = fmaf(lbr, sr, fmaf(-lbi, si, br)), nsi = fmaf(lbr, si, fmaf(lbi, sr, bi));
                sr = nsr; si = nsi;
                sl[t * 68 + lane] = pk2(sr, si);
            }
            LDS_WAIT();
            f32x4 y = {0.f, 0.f, 0.f, 0.f};
#pragma unroll
            for (int ks = 0; ks < 4; ++ks) {
                const bf16x8 sa = *(const LAS bf16x8*)((const LAS bf16_t*)sl + l15 * 136 + 32 * ks + 8 * quad);
                y = MFMA16(sa, cfrag[ks], y);
            }
            if (chunk > 0 || b == 0) {
#pragma unroll
                for (int r = 0; r < 4; ++r) {
                    const size_t row = (size_t)(rowbase + 4 * quad + r);
                    const float u = bf2f(ue[r]);
                    const float v = y[r] + dh * u;
                    const float a2 = 1.5957691216057308f * (v + 0.044715f * v * v * v);
                    APRE[row * 512 + g * 16 + l15] = f2bf(v * sigmoidf_(a2));
                }
            }
            LDS_WAIT();
        }
    }
}

template <bool MASKED>
__device__ __forceinline__ void attn_tile_sub(const LAS bf16_t* Kl, const LAS bf16_t* Vl, const bf16x8 (&qf)[4], int sub, int keybase  ,
                                              int iq, int l31, int h, bool pick0, f32x16& o0, f32x16& o1, float& Rrun) {
    bf16x8 ka[4];
#pragma unroll
    for (int s = 0; s < 4; ++s) ka[s] = *(const LAS bf16x8*)(Kl + (32 * sub + l31) * 72 + 16 * s + 8 * h);
    bf16x8 va[2][2];
#pragma unroll
    for (int s2 = 0; s2 < 2; ++s2)
#pragma unroll
        for (int mt = 0; mt < 2; ++mt) {
            const LAS bf16_t* vp = Vl + (32 * mt + l31) * 68 + 32 * sub + 16 * s2 + 4 * h;
            const s16x4 lo = *(const LAS s16x4*)vp, hi = *(const LAS s16x4*)(vp + 8);
            va[s2][mt] = __builtin_shufflevector(lo, hi, 0, 1, 2, 3, 4, 5, 6, 7);
        }
    __builtin_amdgcn_sched_barrier(0);
    f32x16 st;
#pragma unroll
    for (int i = 0; i < 16; ++i) st[i] = 0.f;
#pragma unroll
    for (int s = 0; s < 4; ++s) st = MFMA32(ka[s], qf[s], st);
    float kp[16], be[16];
#pragma unroll
    for (int i = 0; i < 16; ++i) {
        const float e = __builtin_amdgcn_exp2f(st[i]);
        float r = __builtin_amdgcn_rcpf(1.0f + e);
        if (MASKED) {
            const int kl = 32 * sub + (i & 3) + 8 * (i >> 2) + 4 * h;
            const bool vis = keybase >= 0 ? (keybase + kl < iq) : (kl < 16);
            r = vis ? r : 1.0f;
        }
        kp[i] = r; be[i] = 1.0f - r;
    }
    float ga[4], pa[4];
#pragma unroll
    for (int a = 0; a < 4; ++a) {
        ga[a] = (kp[4 * a] * kp[4 * a + 1]) * (kp[4 * a + 2] * kp[4 * a + 3]);
        const auto sw = __builtin_amdgcn_permlane32_swap(__float_as_uint(ga[a]), __float_as_uint(ga[a]), false, false);
        pa[a] = __uint_as_float(pick0 ? sw[0] : sw[1]);
    }
    float run = Rrun; float w[16];
#pragma unroll
    for (int a = 3; a >= 0; --a) {
        const float P3 = h ? run : run * pa[a];
        const float P2 = P3 * kp[4 * a + 3], P1 = P2 * kp[4 * a + 2], P0 = P1 * kp[4 * a + 1];
        w[4 * a + 3] = be[4 * a + 3] * P3; w[4 * a + 2] = be[4 * a + 2] * P2; w[4 * a + 1] = be[4 * a + 1] * P1; w[4 * a + 0] = be[4 * a + 0] * P0;
        run *= ga[a] * pa[a];
    }
    Rrun = run;
#pragma unroll
    for (int s2 = 0; s2 < 2; ++s2) {
        u32x4 pw; pw.x = pk2(w[8 * s2], w[8 * s2 + 1]); pw.y = pk2(w[8 * s2 + 2], w[8 * s2 + 3]); pw.z = pk2(w[8 * s2 + 4], w[8 * s2 + 5]); pw.w = pk2(w[8 * s2 + 6], w[8 * s2 + 7]);
        const bf16x8 pb = __builtin_bit_cast(bf16x8, pw);
        o0 = MFMA32(va[s2][0], pb, o0); o1 = MFMA32(va[s2][1], pb, o1);
    }
}
__device__ __forceinline__ void attn_phase(const Params& P, LAS unsigned char* lds, int blk, int G, int wave) {
    const int lane = lane_id_v(), tid = wave * 64 + lane, l31 = lane & 31, h = lane >> 5;
    const bf16_t* PROJ = (const bf16_t*)(P.ws + OFF_BIG + BIG_PROJ);
    bf16_t* CAT = (bf16_t*)(P.ws + OFF_BIG + BIG_CAT);
    if (blk == G - 1) {
        LAS float* wm = (LAS float*)(lds + 40960);
        if (tid < 128) {
            const int t = tid & 15, hd = tid >> 4;
            const bf16_t* qp = PROJ + (size_t)(T + t) * 2048 + 512 + hd * 64;
            float run = 1.f;
            for (int j = 15; j >= 0; --j) {
                float wv = 0.f;
                if (j < t) {
                    const bf16_t* kp = PROJ + (size_t)(T + j) * 2048 + 1024 + hd * 64;
                    float z = 0.f;
                    for (int d = 0; d < 64; ++d) z = fmaf(bf2f(qp[d]), bf2f(kp[d]), z);
                    const float r = __builtin_amdgcn_rcpf(1.0f + __builtin_amdgcn_exp2f(z));
                    wv = (1.0f - r) * run; run *= r;
                }
                wm[tid * 16 + j] = wv;
            }
        }
        __syncthreads();
        for (int idx = tid; idx < 16 * 512; idx += 512) {
            const int t = idx >> 9, c = idx & 511, hd = c >> 6;
            float o = 0.f;
            for (int j = 0; j < 16; ++j) o = fmaf(wm[(hd * 16 + t) * 16 + j], bf2f(PROJ[(size_t)(T + j) * 2048 + 1536 + c]), o);
            CAT[(size_t)(T + t) * 1024 + 512 + c] = f2bf(o);
        }
        __syncthreads();
    }
    bool pick0;
    { const auto hs = __builtin_amdgcn_permlane32_swap((unsigned)h, (unsigned)h, false, false); pick0 = hs[0] != (unsigned)h; }
    LAS bf16_t* Kl0 = (LAS bf16_t*)lds;
    LAS bf16_t* Vl0 = (LAS bf16_t*)(lds + 2 * 9216);
    const int lkey = tid >> 3, lpart = tid & 7;
    for (int j4 = 0; j4 < 4; ++j4) {
        const int item = blk + G * j4;
        if (item >= 1024) break;
        const int c = item % 256, jj = item / 256, bh = c >> 1, par = c & 1;
        const int qb = par == 0 ? (jj == 0 ? 7 : jj == 1 ? 0 : jj == 2 ? 4 : 3) : (jj == 0 ? 6 : jj == 1 ? 1 : jj == 2 ? 5 : 2);
        const int b = bh >> 3, hd = bh & 7;
        const int iq = 256 * qb + 32 * wave + l31;
        const size_t qrow = (size_t)b * 2048 + iq;
        bf16x8 qf[4];
#pragma unroll
        for (int s = 0; s < 4; ++s) qf[s] = *(const bf16x8*)(PROJ + qrow * 2048 + 512 + hd * 64 + 16 * s + 8 * h);
        f32x16 o0, o1;
#pragma unroll
        for (int i = 0; i < 16; ++i) { o0[i] = 0.f; o1[i] = 0.f; }
        float Rrun = 1.0f;
        const int nt = 4 * qb + 5;
        u32x4 kreg, vreg;
#define ATT_LOAD(it_) do { const int kt_ = 4 * qb + 3 - (it_); size_t row_; bool ok_ = true; \
            if (kt_ >= 0) row_ = (size_t)b * 2048 + 64 * kt_ + lkey; else { row_ = (size_t)T + lkey; ok_ = lkey < 16; } \
            if (ok_) { const bf16_t* p_ = PROJ + row_ * 2048 + 1024 + hd * 64 + lpart * 8; kreg = *(const u32x4*)p_; vreg = *(const u32x4*)(p_ + 512); } \
            else { kreg = (u32x4){0u, 0u, 0u, 0u}; vreg = kreg; } } while (0)
#define ATT_STORE(buf_) do { *(LAS u32x4*)(Kl0 + (buf_) * 4608 + lkey * 72 + lpart * 8) = kreg; \
            LAS bf16_t* vt_ = Vl0 + (buf_) * 4352 + (lpart * 8) * 68 + lkey; \
            vt_[0 * 68] = (bf16_t)(vreg.x & 0xffffu); vt_[1 * 68] = (bf16_t)(vreg.x >> 16); \
            vt_[2 * 68] = (bf16_t)(vreg.y & 0xffffu); vt_[3 * 68] = (bf16_t)(vreg.y >> 16); \
            vt_[4 * 68] = (bf16_t)(vreg.z & 0xffffu); vt_[5 * 68] = (bf16_t)(vreg.z >> 16); \
            vt_[6 * 68] = (bf16_t)(vreg.w & 0xffffu); vt_[7 * 68] = (bf16_t)(vreg.w >> 16); } while (0)
        ATT_LOAD(0); ATT_STORE(0);
        __syncthreads();
        int cur = 0;
        bool wdone = false;
        LAS unsigned* dflag = (LAS unsigned*)(lds + 36864);
        for (int it = 0; it < nt; ++it) {
            if (it + 1 < nt) ATT_LOAD(it + 1);
            const int kt = 4 * qb + 3 - it;
            const int keybase = kt >= 0 ? 64 * kt : -1;
            const int wq_end = 256 * qb + 32 * wave + 32;
            const LAS bf16_t* Kl = Kl0 + cur * 4608; const LAS bf16_t* Vl = Vl0 + cur * 4352;
            if (wdone) {}
            else if (kt < 0) { attn_tile_sub<true>(Kl, Vl, qf, 0, -1, iq, l31, h, pick0, o0, o1, Rrun); }
            else {
                const int wq_beg = wq_end - 32;
                if (keybase + 64 <= wq_beg) { attn_tile_sub<false>(Kl, Vl, qf, 1, keybase, iq, l31, h, pick0, o0, o1, Rrun); attn_tile_sub<false>(Kl, Vl, qf, 0, keybase, iq, l31, h, pick0, o0, o1, Rrun); }
                else {
                    if (keybase + 32 < wq_end) attn_tile_sub<true>(Kl, Vl, qf, 1, keybase, iq, l31, h, pick0, o0, o1, Rrun);
                    if (keybase < wq_end) attn_tile_sub<true>(Kl, Vl, qf, 0, keybase, iq, l31, h, pick0, o0, o1, Rrun);
                }
            }
            if (it + 1 < nt) ATT_STORE(cur ^ 1);
            wdone = __builtin_amdgcn_ballot_w64(Rrun >= 9.094947e-13f) == 0ull;
            if (lane == 0) dflag[(it & 1) * 8 + wave] = wdone ? 1u : 0u;
            __syncthreads();
            cur ^= 1;
            { const u32x4 f0 = *(const LAS u32x4*)(dflag + (it & 1) * 8), f1 = *(const LAS u32x4*)(dflag + (it & 1) * 8 + 4);
              if ((f0.x & f0.y & f0.z & f0.w & f1.x & f1.y & f1.z & f1.w) != 0u) break; }
        }
        bf16_t* op = CAT + qrow * 1024 + 512 + hd * 64;
#pragma unroll
        for (int a = 0; a < 4; ++a) {
            u32x2 w0; w0.x = pk2(o0[4 * a], o0[4 * a + 1]); w0.y = pk2(o0[4 * a + 2], o0[4 * a + 3]);
            u32x2 w1; w1.x = pk2(o1[4 * a], o1[4 * a + 1]); w1.y = pk2(o1[4 * a + 2], o1[4 * a + 3]);
            *(u32x2*)(op + 8 * a + 4 * h) = w0; *(u32x2*)(op + 32 + 8 * a + 4 * h) = w1;
        }
    }
}

__device__ __forceinline__ void hgrn_phase(const Params& P, LAS unsigned char* lds, int blk, int G, int wave) {
    const int lane = lane_id_v(), tid = wave * 64 + lane, l15 = lane & 15, quad = lane >> 4;
    LAS bf16_t* qd = (LAS bf16_t*)lds;
    LAS bf16_t* kd = qd + 64 * 136;
    LAS bf16_t* klT = kd + 64 * 136;
    LAS bf16_t* vT = klT + 128 * 72;
    LAS bf16_t* sc = vT + 128 * 72;
    LAS float* ebl = (LAS float*)(sc + 64 * 72);
    LAS float* segtot = ebl + 128;
    LAS float* red = segtot + 1024;
    const unsigned short* PC = (const unsigned short*)(P.ws + OFF_BIG);
    bf16_t* MIXC = (bf16_t*)P.out;
    const float* ng = P.in[16];
    for (int item = blk; item < 128; item += G) {
        const int b = item >> 3, hd = item & 7;
        f32x4 Sacc[8];
#pragma unroll
        for (int i = 0; i < 8; ++i) Sacc[i] = (f32x4){0.f, 0.f, 0.f, 0.f};
        const int dp = tid & 63, sg = tid >> 6;
        unsigned lfc[8], qc[8], vc[8];
#define HG_OFF0(cc_) ((unsigned)((cc_) > 0 ? b * 2048 + ((cc_) - 1) * 64 + 8 * sg : (sg >= 6 ? T + 8 * (sg - 6) : (int)((OFF_ZROW - OFF_BIG) / 8192))) * 8192u + (unsigned)(hd * 128 + 2 * dp) * 2u)
#define HG_LOAD(cc_, LF_, Q_, V_) do { const unsigned o0_ = HG_OFF0(cc_); _Pragma("unroll") for (int tt_ = 0; tt_ < 8; ++tt_) { const unsigned o_ = o0_ + (unsigned)tt_ * 8192u; \
            Q_[tt_] = *(const unsigned*)((const char*)PC + o_); LF_[tt_] = *(const unsigned*)((const char*)PC + o_ + 2048u); V_[tt_] = *(const unsigned*)((const char*)PC + o_ + 4096u); } } while (0)
        HG_LOAD(0, lfc, qc, vc);
        if (tid < 64) red[tid] = 0.f;
        for (int c = 0; c < 33; ++c) {
            unsigned lfn[8], qn[8], vn[8];
            { const int cn = c + 1 < 33 ? c + 1 : 32; HG_LOAD(cn, lfn, qn, vn); }
            {
                float cs0[8], cs1[8]; float run0 = 0.f, run1 = 0.f;
#pragma unroll
                for (int tt = 0; tt < 8; ++tt) {
                    const float l0 = 1.4426950408889634f * (float)__builtin_bit_cast(_Float16, (unsigned short)(lfc[tt] & 0xffffu));
                    const float l1 = 1.4426950408889634f * (float)__builtin_bit_cast(_Float16, (unsigned short)(lfc[tt] >> 16));
                    run0 += l0; run1 += l1; cs0[tt] = run0; cs1[tt] = run1;
                }
                segtot[sg * 128 + 2 * dp] = run0; segtot[sg * 128 + 2 * dp + 1] = run1;
                __syncthreads();
                if (tid < 64) red[((c + 1) & 1) * 64 + tid] = 0.f;
                float off0 = 0.f, off1 = 0.f, bl0 = 0.f, bl1 = 0.f;
#pragma unroll
                for (int s2 = 0; s2 < 8; ++s2) {
                    const float a0 = segtot[s2 * 128 + 2 * dp], a1 = segtot[s2 * 128 + 2 * dp + 1];
                    bl0 += a0; bl1 += a1; if (s2 < sg) { off0 += a0; off1 += a1; }
                }
                const float ebl0 = __builtin_amdgcn_exp2f(bl0), ebl1 = __builtin_amdgcn_exp2f(bl1);
                if (sg == 7) { ebl[2 * dp] = ebl0; ebl[2 * dp + 1] = ebl1; }
                float eip0 = __builtin_amdgcn_exp2f(-off0), eip1 = __builtin_amdgcn_exp2f(-off1);
                unsigned kl0[4], kl1[4], v0[4], v1[4];
#pragma unroll
                for (int tp = 0; tp < 4; ++tp) {
                    float klv0[2], klv1[2];
#pragma unroll
                    for (int e = 0; e < 2; ++e) {
                        const int tt = 2 * tp + e, t = 8 * sg + tt;
                        const float bt0 = off0 + cs0[tt], bt1 = off1 + cs1[tt];
                        const float q0 = bflo(qc[tt]), q1 = bfhi(qc[tt]);
                        const float eb0 = __builtin_amdgcn_exp2f(bt0), eb1 = __builtin_amdgcn_exp2f(bt1);
                        const float ei0 = __builtin_amdgcn_rcpf(eb0), ei1 = __builtin_amdgcn_rcpf(eb1);
                        const float k0 = 1.0f - eb0 * eip0, k1 = 1.0f - eb1 * eip1;
                        eip0 = ei0; eip1 = ei1;
                        const float kd0 = k0 * ei0, kd1 = k1 * ei1;
                        *(LAS unsigned*)(qd + t * 136 + 2 * dp) = pk2(q0 * eb0, q1 * eb1);
                        *(LAS unsigned*)(kd + t * 136 + 2 * dp) = pk2(kd0, kd1);
                        klv0[e] = kd0 * ebl0; klv1[e] = kd1 * ebl1;
                    }
                    kl0[tp] = pk2(klv0[0], klv0[1]); kl1[tp] = pk2(klv1[0], klv1[1]);
                    const unsigned va = vc[2 * tp], vb = vc[2 * tp + 1];
                    v0[tp] = (va & 0xffffu) | (vb << 16); v1[tp] = (va >> 16) | (vb & 0xffff0000u);
                }
                *(LAS u32x4*)(klT + (2 * dp) * 72 + 8 * sg) = (u32x4){kl0[0], kl0[1], kl0[2], kl0[3]};
                *(LAS u32x4*)(klT + (2 * dp + 1) * 72 + 8 * sg) = (u32x4){kl1[0], kl1[1], kl1[2], kl1[3]};
                *(LAS u32x4*)(vT + (2 * dp) * 72 + 8 * sg) = (u32x4){v0[0], v0[1], v0[2], v0[3]};
                *(LAS u32x4*)(vT + (2 * dp + 1) * 72 + 8 * sg) = (u32x4){v1[0], v1[1], v1[2], v1[3]};
            }
            __syncthreads();
            f32x4 oacc[4];
#pragma unroll
            for (int i = 0; i < 4; ++i) oacc[i] = (f32x4){0.f, 0.f, 0.f, 0.f};
#pragma unroll
            for (int kh = 0; kh < 2; ++kh) {
                s16x4 alo[2][4], ahi[2][4];
#pragma unroll
                for (int k2 = 0; k2 < 2; ++k2)
#pragma unroll
                    for (int tt = 0; tt < 4; ++tt) { const LAS bf16_t* ap = qd + (16 * tt + l15) * 136 + 32 * (2 * kh + k2) + 4 * quad; alo[k2][tt] = *(const LAS s16x4*)ap; ahi[k2][tt] = *(const LAS s16x4*)(ap + 16); }
                __builtin_amdgcn_sched_barrier(0);
#pragma unroll
                for (int k2 = 0; k2 < 2; ++k2) {
                    const int ks = 2 * kh + k2;
                    u32x4 sw; sw.x = pk2(Sacc[2 * ks][0], Sacc[2 * ks][1]); sw.y = pk2(Sacc[2 * ks][2], Sacc[2 * ks][3]);
                    sw.z = pk2(Sacc[2 * ks + 1][0], Sacc[2 * ks + 1][1]); sw.w = pk2(Sacc[2 * ks + 1][2], Sacc[2 * ks + 1][3]);
                    const bf16x8 sb = __builtin_bit_cast(bf16x8, sw);
#pragma unroll
                    for (int tt = 0; tt < 4; ++tt) oacc[tt] = MFMA16(__builtin_shufflevector(alo[k2][tt], ahi[k2][tt], 0, 1, 2, 3, 4, 5, 6, 7), sb, oacc[tt]);
                }
                __builtin_amdgcn_sched_barrier(0);
            }
#pragma unroll
            for (int e = 0; e < 2; ++e) {
                const int tile = 2 * wave + e, tt = tile >> 2, ss = tile & 3;
                bf16x8 fa[4], fb[4];
#pragma unroll
                for (int ks = 0; ks < 4; ++ks) { fa[ks] = *(const LAS bf16x8*)(qd + (16 * tt + l15) * 136 + 32 * ks + 8 * quad); fb[ks] = *(const LAS bf16x8*)(kd + (16 * ss + l15) * 136 + 32 * ks + 8 * quad); }
                __builtin_amdgcn_sched_barrier(0);
                f32x4 sa = {0.f, 0.f, 0.f, 0.f};
#pragma unroll
                for (int ks = 0; ks < 4; ++ks) sa = MFMA16(fa[ks], fb[ks], sa);
#pragma unroll
                for (int r = 0; r < 4; ++r) { const int tg = 16 * tt + 4 * quad + r, sg_ = 16 * ss + l15; sc[tg * 72 + sg_] = f2bf(sg_ <= tg ? sa[r] : 0.f); }
                __builtin_amdgcn_sched_barrier(0);
            }
            __syncthreads();
            unsigned short gr[16];
            {
                const int cg_ = c > 0 ? c : 1;
#pragma unroll
                for (int tt = 0; tt < 4; ++tt)
#pragma unroll
                    for (int r = 0; r < 4; ++r) gr[4 * tt + r] = *(const unsigned short*)((const char*)PC + ((unsigned)(b * 2048 + (cg_ - 1) * 64 + 16 * tt + 4 * quad + r) * 8192u + (unsigned)(3072 + hd * 128 + 16 * wave + l15) * 2u));
            }
            {
#pragma unroll
                for (int dt = 0; dt < 8; ++dt) Sacc[dt] *= *(const LAS f32x4*)(ebl + 16 * dt + 4 * quad);
                __builtin_amdgcn_sched_barrier(0);
#pragma unroll
                for (int ks = 0; ks < 2; ++ks) {
                    bf16x8 fsc[4], fkl[8];
                    const bf16x8 vb = *(const LAS bf16x8*)(vT + (16 * wave + l15) * 72 + 32 * ks + 8 * quad);
#pragma unroll
                    for (int tt = 0; tt < 4; ++tt) fsc[tt] = *(const LAS bf16x8*)(sc + (16 * tt + l15) * 72 + 32 * ks + 8 * quad);
#pragma unroll
                    for (int dt = 0; dt < 8; ++dt) fkl[dt] = *(const LAS bf16x8*)(klT + (16 * dt + l15) * 72 + 32 * ks + 8 * quad);
                    __builtin_amdgcn_sched_barrier(0);
#pragma unroll
                    for (int tt = 0; tt < 4; ++tt) oacc[tt] = MFMA16(fsc[tt], vb, oacc[tt]);
#pragma unroll
                    for (int dt = 0; dt < 8; ++dt) Sacc[dt] = MFMA16(fkl[dt], vb, Sacc[dt]);
                    __builtin_amdgcn_sched_barrier(0);
                }
            }
#pragma unroll
            for (int tt = 0; tt < 4; ++tt)
#pragma unroll
                for (int r = 0; r < 4; ++r) {
                    float sq = oacc[tt][r] * oacc[tt][r];
                    sq += __int_as_float(__builtin_amdgcn_update_dpp(0, __float_as_int(sq), 0xB1, 0xf, 0xf, false));
                    sq += __int_as_float(__builtin_amdgcn_update_dpp(0, __float_as_int(sq), 0x4E, 0xf, 0xf, false));
                    sq += __int_as_float(__builtin_amdgcn_update_dpp(0, __float_as_int(sq), 0x141, 0xf, 0xf, false));
                    sq += __int_as_float(__builtin_amdgcn_update_dpp(0, __float_as_int(sq), 0x140, 0xf, 0xf, false));
                    if (l15 == 0) __hip_atomic_fetch_add(red + (c & 1) * 64 + 16 * tt + 4 * quad + r, sq, __ATOMIC_RELAXED, __HIP_MEMORY_SCOPE_WORKGROUP);
                }
            __syncthreads();
            if (c > 0) {
                const int dvg = hd * 128 + 16 * wave + l15;
                const float gn = ng[dvg];
#pragma unroll
                for (int tt = 0; tt < 4; ++tt)
#pragma unroll
                    for (int r = 0; r < 4; ++r) {
                        const int t = 16 * tt + 4 * quad + r;
                        const float ssum = red[(c & 1) * 64 + t];
                        const float rs = __builtin_amdgcn_rsqf(ssum * (1.0f / 128.0f) + 1e-6f);
                        const unsigned moff = (unsigned)(b * 2048 + (c - 1) * 64 + t) * 2048u + (unsigned)dvg * 2u;
                        const float gv = bf2f(gr[4 * tt + r]);
                        *(bf16_t*)((char*)MIXC + moff) = f2bf(oacc[tt][r] * rs * gn * gv * __builtin_amdgcn_rcpf(1.0f + __builtin_amdgcn_exp2f(-1.4426950408889634f * gv)));
                    }
            }
#pragma unroll
            for (int i = 0; i < 8; ++i) { lfc[i] = lfn[i]; qc[i] = qn[i]; vc[i] = vn[i]; }
        }
        __syncthreads();
    }
}

constexpr size_t HG_QDX_OFF = 67108864;
constexpr size_t HG_KLX = 0, HG_SCX = 67108864, HG_EBX = HG_SCX + 33554432, HG_META = HG_EBX + 2097152;
__device__ __forceinline__ void hgrn_prep_phase(const Params& P, LAS unsigned char* lds, int blk, int G, int wave) {
    const int lane = lane_id_v(), tid = wave * 64 + lane, l15 = lane & 15, quad = lane >> 4;
    LAS bf16_t* qd = (LAS bf16_t*)lds;
    LAS bf16_t* kd = qd + 64 * 136;
    LAS bf16_t* sc = kd + 64 * 136;
    LAS float* segtot = (LAS float*)(sc + 64 * 72);
    const unsigned short* PC = (const unsigned short*)(P.ws + OFF_BIG);
    char* ZR = (char*)(P.ws + OFF_Z);
    char* QDX = (char*)P.out + HG_QDX_OFF;
    const int dp = tid & 63, sg = tid >> 6;
    constexpr int NIT = 4096 + 8;
#define H1_DEC(it_, b_, hd_, c_) const int b_ = (it_) < 4096 ? (it_) >> 8 : 0, hd_ = (it_) < 4096 ? ((it_) >> 5) & 7 : (it_) - 4096, c_ = (it_) < 4096 ? ((it_) & 31) + 1 : 0
#define H1_OFF0(b_, hd_, c_) ((unsigned)((c_) > 0 ? (b_) * 2048 + ((c_) - 1) * 64 + 8 * sg : T + (sg >= 6 ? 8 * (sg - 6) : 0)) * 8192u + (unsigned)((hd_) * 128 + 2 * dp) * 2u)
#define H1_LOAD(it_, LF_, Q_) do { H1_DEC(it_, b__, hd__, c__); const unsigned o0_ = H1_OFF0(b__, hd__, c__); _Pragma("unroll") for (int tt_ = 0; tt_ < 8; ++tt_) { const unsigned o_ = o0_ + (unsigned)tt_ * 8192u; \
            Q_[tt_] = *(const unsigned*)((const char*)PC + o_); LF_[tt_] = *(const unsigned*)((const char*)PC + o_ + 2048u); } } while (0)
    unsigned lfc[8], qc[8];
    if (blk < NIT) H1_LOAD(blk, lfc, qc);
    for (int it = blk; it < NIT; it += G) {
        H1_DEC(it, b, hd, c);
        (void)b;
        unsigned lfn[8], qn[8];
        { const int itn = it + G < NIT ? it + G : it; H1_LOAD(itn, lfn, qn); }
        char *gQD, *gKL, *gSC, *gEB;
        if (c > 0) { const unsigned ix = (unsigned)(it >> 5) * 32u + (unsigned)(it & 31); gQD = QDX + (size_t)ix * 16384; gKL = ZR + HG_KLX + (size_t)ix * 16384; gSC = ZR + HG_SCX + (size_t)ix * 8192; gEB = ZR + HG_EBX + (size_t)ix * 512; }
        else { char* mb = ZR + HG_META + (size_t)hd * 41472; gQD = mb; gKL = mb + 16384; gSC = mb + 32768; gEB = mb + 40960; }
        {
            float cs0[8], cs1[8]; float run0 = 0.f, run1 = 0.f;
#pragma unroll
            for (int tt = 0; tt < 8; ++tt) {
                const bool ok = c > 0 || (8 * sg + tt) >= 48;
                const float l0 = ok ? 1.4426950408889634f * (float)__builtin_bit_cast(_Float16, (unsigned short)(lfc[tt] & 0xffffu)) : 0.f;
                const float l1 = ok ? 1.4426950408889634f * (float)__builtin_bit_cast(_Float16, (unsigned short)(lfc[tt] >> 16)) : 0.f;
                run0 += l0; run1 += l1; cs0[tt] = run0; cs1[tt] = run1;
            }
            segtot[sg * 128 + 2 * dp] = run0; segtot[sg * 128 + 2 * dp + 1] = run1;
            __syncthreads();
            float off0 = 0.f, off1 = 0.f, bl0 = 0.f, bl1 = 0.f;
#pragma unroll
            for (int s2 = 0; s2 < 8; ++s2) {
                const float a0 = segtot[s2 * 128 + 2 * dp], a1 = segtot[s2 * 128 + 2 * dp + 1];
                bl0 += a0; bl1 += a1; if (s2 < sg) { off0 += a0; off1 += a1; }
            }
            const float ebl0 = __builtin_amdgcn_exp2f(bl0), ebl1 = __builtin_amdgcn_exp2f(bl1);
            if (sg == 7) { *(float*)(gEB + (2 * dp) * 4) = ebl0; *(float*)(gEB + (2 * dp + 1) * 4) = ebl1; }
            float eip0 = __builtin_amdgcn_exp2f(-off0), eip1 = __builtin_amdgcn_exp2f(-off1);
            unsigned kl0[4], kl1[4];
#pragma unroll
            for (int tp = 0; tp < 4; ++tp) {
                float klv0[2], klv1[2];
#pragma unroll
                for (int e = 0; e < 2; ++e) {
                    const int tt = 2 * tp + e, t = 8 * sg + tt;
                    const bool ok = c > 0 || t >= 48;
                    const float bt0 = off0 + cs0[tt], bt1 = off1 + cs1[tt];
                    const float q0 = ok ? bflo(qc[tt]) : 0.f, q1 = ok ? bfhi(qc[tt]) : 0.f;
                    const float eb0 = __builtin_amdgcn_exp2f(bt0), eb1 = __builtin_amdgcn_exp2f(bt1);
                    const float ei0 = __builtin_amdgcn_rcpf(eb0), ei1 = __builtin_amdgcn_rcpf(eb1);
                    const float k0 = 1.0f - eb0 * eip0, k1 = 1.0f - eb1 * eip1;
                    eip0 = ei0; eip1 = ei1;
                    const float kd0 = k0 * ei0, kd1 = k1 * ei1;
                    const unsigned qw = pk2(q0 * eb0, q1 * eb1);
                    *(LAS unsigned*)(qd + t * 136 + 2 * dp) = qw;
                    *(unsigned*)(gQD + (unsigned)(t * 128 + 2 * dp) * 2u) = qw;
                    *(LAS unsigned*)(kd + t * 136 + 2 * dp) = pk2(kd0, kd1);
                    klv0[e] = kd0 * ebl0; klv1[e] = kd1 * ebl1;
                }
                kl0[tp] = pk2(klv0[0], klv0[1]); kl1[tp] = pk2(klv1[0], klv1[1]);
            }
            *(u32x4*)(gKL + (unsigned)((2 * dp) * 64 + 8 * sg) * 2u) = (u32x4){kl0[0], kl0[1], kl0[2], kl0[3]};
            *(u32x4*)(gKL + (unsigned)((2 * dp + 1) * 64 + 8 * sg) * 2u) = (u32x4){kl1[0], kl1[1], kl1[2], kl1[3]};
        }
        __syncthreads();
#pragma unroll
        for (int e = 0; e < 2; ++e) {
            const int tile = 2 * wave + e, tt = tile >> 2, ss = tile & 3;
            bf16x8 fa[4], fb[4];
#pragma unroll
            for (int ks = 0; ks < 4; ++ks) { fa[ks] = *(const LAS bf16x8*)(qd + (16 * tt + l15) * 136 + 32 * ks + 8 * quad); fb[ks] = *(const LAS bf16x8*)(kd + (16 * ss + l15) * 136 + 32 * ks + 8 * quad); }
            __builtin_amdgcn_sched_barrier(0);
            f32x4 sa = {0.f, 0.f, 0.f, 0.f};
#pragma unroll
            for (int ks = 0; ks < 4; ++ks) sa = MFMA16(fa[ks], fb[ks], sa);
#pragma unroll
            for (int r = 0; r < 4; ++r) { const int tg = 16 * tt + 4 * quad + r, sg_ = 16 * ss + l15; sc[tg * 72 + sg_] = f2bf(sg_ <= tg ? sa[r] : 0.f); }
            __builtin_amdgcn_sched_barrier(0);
        }
        __syncthreads();
        { const int row = tid >> 3, seg = tid & 7; *(u32x4*)(gSC + (unsigned)(row * 64 + seg * 8) * 2u) = *(const LAS u32x4*)(sc + row * 72 + seg * 8); }
#pragma unroll
        for (int i = 0; i < 8; ++i) { lfc[i] = lfn[i]; qc[i] = qn[i]; }
    }
    __syncthreads();
}
__device__ __forceinline__ void hgrn_core_phase(const Params& P, LAS unsigned char* lds, int blk, int G, int wave) {
    const int lane = lane_id_v(), tid = wave * 64 + lane, l15 = lane & 15, quad = lane >> 4;
    LAS bf16_t* qd = (LAS bf16_t*)lds;
    LAS bf16_t* klT = qd + 64 * 136;
    LAS bf16_t* vT = klT + 128 * 72;
    LAS bf16_t* sc = vT + 128 * 72;
    LAS float* ebl = (LAS float*)(sc + 64 * 72);
    LAS float* red = ebl + 128;
    const unsigned short* PC = (const unsigned short*)(P.ws + OFF_BIG);
    const char* ZR = (const char*)(P.ws + OFF_Z);
    const char* QDX = (const char*)P.out + HG_QDX_OFF;
    bf16_t* MIXC = (bf16_t*)P.out;
    const float* ng = P.in[16];
    const int dp = tid & 63, sg = tid >> 6;
    for (int item = blk; item < 128; item += G) {
        const int b = item >> 3, hd = item & 7;
        f32x4 Sacc[8];
#pragma unroll
        for (int i = 0; i < 8; ++i) Sacc[i] = (f32x4){0.f, 0.f, 0.f, 0.f};
        u32x4 rq[2], rk[2], rs, re; unsigned rv[8];
#define H2_LOAD(cc_) do { const char *gQD_, *gKL_, *gSC_, *gEB_; \
            if ((cc_) > 0) { const unsigned ix_ = (unsigned)item * 32u + (unsigned)((cc_) - 1); gQD_ = QDX + (size_t)ix_ * 16384; gKL_ = ZR + HG_KLX + (size_t)ix_ * 16384; gSC_ = ZR + HG_SCX + (size_t)ix_ * 8192; gEB_ = ZR + HG_EBX + (size_t)ix_ * 512; } \
            else { const char* mb_ = ZR + HG_META + (size_t)hd * 41472; gQD_ = mb_; gKL_ = mb_ + 16384; gSC_ = mb_ + 32768; gEB_ = mb_ + 40960; } \
            rq[0] = *(const u32x4*)(gQD_ + tid * 16); rq[1] = *(const u32x4*)(gQD_ + 8192 + tid * 16); \
            rk[0] = *(const u32x4*)(gKL_ + tid * 16); rk[1] = *(const u32x4*)(gKL_ + 8192 + tid * 16); \
            rs = *(const u32x4*)(gSC_ + tid * 16); re = *(const u32x4*)(gEB_ + (tid & 31) * 16); \
            const unsigned o0_ = (unsigned)((cc_) > 0 ? b * 2048 + ((cc_) - 1) * 64 + 8 * sg : T + (sg >= 6 ? 8 * (sg - 6) : 0)) * 8192u + (unsigned)(2048 + hd * 128 + 2 * dp) * 2u; \
            _Pragma("unroll") for (int tt_ = 0; tt_ < 8; ++tt_) rv[tt_] = *(const unsigned*)((const char*)PC + o0_ + (unsigned)tt_ * 8192u); } while (0)
        H2_LOAD(0);
        for (int c = 0; c < 33; ++c) {
            {
#pragma unroll
                for (int j = 0; j < 2; ++j) { const int e = tid * 8 + j * 4096; *(LAS u32x4*)(qd + (e >> 7) * 136 + (e & 127)) = rq[j]; *(LAS u32x4*)(klT + (e >> 6) * 72 + (e & 63)) = rk[j]; }
                { const int e = tid * 8; *(LAS u32x4*)(sc + (e >> 6) * 72 + (e & 63)) = rs; }
                if (tid < 32) *(LAS u32x4*)(ebl + tid * 4) = re;
                unsigned v0[4], v1[4];
#pragma unroll
                for (int tp = 0; tp < 4; ++tp) {
                    const bool okA = c > 0 || (8 * sg + 2 * tp) >= 48, okB = c > 0 || (8 * sg + 2 * tp + 1) >= 48;
                    const unsigned va = okA ? rv[2 * tp] : 0u, vb = okB ? rv[2 * tp + 1] : 0u;
                    v0[tp] = (va & 0xffffu) | (vb << 16); v1[tp] = (va >> 16) | (vb & 0xffff0000u);
                }
                *(LAS u32x4*)(vT + (2 * dp) * 72 + 8 * sg) = (u32x4){v0[0], v0[1], v0[2], v0[3]};
                *(LAS u32x4*)(vT + (2 * dp + 1) * 72 + 8 * sg) = (u32x4){v1[0], v1[1], v1[2], v1[3]};
            }
            __syncthreads();
            { const int cn = c + 1 < 33 ? c + 1 : 32; H2_LOAD(cn); }
            unsigned short gr[16];
            {
                const int cg_ = c > 0 ? c : 1;
#pragma unroll
                for (int tt = 0; tt < 4; ++tt)
#pragma unroll
                    for (int r = 0; r < 4; ++r) gr[4 * tt + r] = *(const unsigned short*)((const char*)PC + ((unsigned)(b * 2048 + (cg_ - 1) * 64 + 16 * tt + 4 * quad + r) * 8192u + (unsigned)(3072 + hd * 128 + 16 * wave + l15) * 2u));
            }
            f32x4 oacc[4];
#pragma unroll
            for (int i = 0; i < 4; ++i) oacc[i] = (f32x4){0.f, 0.f, 0.f, 0.f};
#pragma unroll
            for (int kh = 0; kh < 2; ++kh) {
                s16x4 alo[2][4], ahi[2][4];
#pragma unroll
                for (int k2 = 0; k2 < 2; ++k2)
#pragma unroll
                    for (int tt = 0; tt < 4; ++tt) { const LAS bf16_t* ap = qd + (16 * tt + l15) * 136 + 32 * (2 * kh + k2) + 4 * quad; alo[k2][tt] = *(const LAS s16x4*)ap; ahi[k2][tt] = *(const LAS s16x4*)(ap + 16); }
                __builtin_amdgcn_sched_barrier(0);
#pragma unroll
                for (int k2 = 0; k2 < 2; ++k2) {
                    const int ks = 2 * kh + k2;
                    u32x4 sw; sw.x = pk2(Sacc[2 * ks][0], Sacc[2 * ks][1]); sw.y = pk2(Sacc[2 * ks][2], Sacc[2 * ks][3]);
                    sw.z = pk2(Sacc[2 * ks + 1][0], Sacc[2 * ks + 1][1]); sw.w = pk2(Sacc[2 * ks + 1][2], Sacc[2 * ks + 1][3]);
                    const bf16x8 sb = __builtin_bit_cast(bf16x8, sw);
#pragma unroll
                    for (int tt = 0; tt < 4; ++tt) oacc[tt] = MFMA16(__builtin_shufflevector(alo[k2][tt], ahi[k2][tt], 0, 1, 2, 3, 4, 5, 6, 7), sb, oacc[tt]);
                }
                __builtin_amdgcn_sched_barrier(0);
            }
            {
#pragma unroll
                for (int dt = 0; dt < 8; ++dt) Sacc[dt] *= *(const LAS f32x4*)(ebl + 16 * dt + 4 * quad);
                __builtin_amdgcn_sched_barrier(0);
#pragma unroll
                for (int ks = 0; ks < 2; ++ks) {
                    bf16x8 fsc[4], fkl[8];
                    const bf16x8 vb = *(const LAS bf16x8*)(vT + (16 * wave + l15) * 72 + 32 * ks + 8 * quad);
#pragma unroll
                    for (int tt = 0; tt < 4; ++tt) fsc[tt] = *(const LAS bf16x8*)(sc + (16 * tt + l15) * 72 + 32 * ks + 8 * quad);
#pragma unroll
                    for (int dt = 0; dt < 8; ++dt) fkl[dt] = *(const LAS bf16x8*)(klT + (16 * dt + l15) * 72 + 32 * ks + 8 * quad);
                    __builtin_amdgcn_sched_barrier(0);
#pragma unroll
                    for (int tt = 0; tt < 4; ++tt) oacc[tt] = MFMA16(fsc[tt], vb, oacc[tt]);
#pragma unroll
                    for (int dt = 0; dt < 8; ++dt) Sacc[dt] = MFMA16(fkl[dt], vb, Sacc[dt]);
                    __builtin_amdgcn_sched_barrier(0);
                }
            }
#pragma unroll
            for (int tt = 0; tt < 4; ++tt)
#pragma unroll
                for (int r = 0; r < 4; ++r) {
                    float sq = oacc[tt][r] * oacc[tt][r];
                    sq += __int_as_float(__builtin_amdgcn_update_dpp(0, __float_as_int(sq), 0xB1, 0xf, 0xf, false));
                    sq += __int_as_float(__builtin_amdgcn_update_dpp(0, __float_as_int(sq), 0x4E, 0xf, 0xf, false));
                    sq += __int_as_float(__builtin_amdgcn_update_dpp(0, __float_as_int(sq), 0x141, 0xf, 0xf, false));
                    sq += __int_as_float(__builtin_amdgcn_update_dpp(0, __float_as_int(sq), 0x140, 0xf, 0xf, false));
                    if (l15 == 0) red[(16 * tt + 4 * quad + r) * 8 + wave] = sq;
                }
            __syncthreads();
            if (c > 0) {
                const int dvg = hd * 128 + 16 * wave + l15;
                const float gn = ng[dvg];
#pragma unroll
                for (int tt = 0; tt < 4; ++tt)
#pragma unroll
                    for (int r = 0; r < 4; ++r) {
                        const int t = 16 * tt + 4 * quad + r;
                        const f32x4 r0 = *(const LAS f32x4*)(red + t * 8), r1 = *(const LAS f32x4*)(red + t * 8 + 4);
                        const float ssum = ((r0[0] + r0[1]) + (r0[2] + r0[3])) + ((r1[0] + r1[1]) + (r1[2] + r1[3]));
                        const float rs_ = __builtin_amdgcn_rsqf(ssum * (1.0f / 128.0f) + 1e-6f);
                        const unsigned moff = (unsigned)(b * 2048 + (c - 1) * 64 + t) * 2048u + (unsigned)dvg * 2u;
                        const float gv = bf2f(gr[4 * tt + r]);
                        *(bf16_t*)((char*)MIXC + moff) = f2bf(oacc[tt][r] * rs_ * gn * gv * __builtin_amdgcn_rcpf(1.0f + __builtin_amdgcn_exp2f(-1.4426950408889634f * gv)));
                    }
            }
        }
        __syncthreads();
    }
}

__global__ void __launch_bounds__(512, 2) fwd_megakernel(Params P) {
    extern __shared__ __attribute__((aligned(16))) unsigned char lds_raw[];
    LAS unsigned char* lds = (LAS unsigned char*)lds_raw;
    cg::grid_group grid = cg::this_grid();
    const int blk = blockIdx.x, G = gridDim.x, wave = __builtin_amdgcn_readfirstlane((int)(threadIdx.x >> 6));
    unsigned char* ws = P.ws;
    bf16_t* HB = (bf16_t*)(ws + OFF_HB);
    float* Z = (float*)(ws + OFF_Z);
    bf16_t* PROJ = (bf16_t*)(ws + OFF_BIG + BIG_PROJ);
    bf16_t* APRE = (bf16_t*)(ws + OFF_BIG + BIG_APRE);
    bf16_t* CAT = (bf16_t*)(ws + OFF_BIG + BIG_CAT);
    bf16_t* HID = (bf16_t*)(ws + OFF_BIG);
    unsigned short* PC = (unsigned short*)(ws + OFF_BIG);

    volatile LAS unsigned* xst = (volatile LAS unsigned*)(lds + 131072);
    if (wave == 0 && lane_id_v() < 4) xst[lane_id_v()] = 0u;
    __syncthreads();
    const XcdBarrier xb = xcd_barrier_post((unsigned*)(ws + OFF_BAR), xst, wave);
    prologue_phase(P, lds, blk, G, wave);
#if PROBE_DUP_PRO
    __syncthreads();
    prologue_phase(P, lds, blk, G, wave);
#endif
    if (G == 0x7fffffff) grid.sync();
    xcd_barrier(xb, wave);
    run_gemm(lds, HB, (const bf16_t*)(ws + OFF_WAB), 2048, 1024, EpInAB{PROJ}, true, blk, G, wave);
#if PROBE_GEMMS
    __syncthreads();
    run_gemm(lds, HB, (const bf16_t*)(ws + OFF_WAB), 2048, 1024, EpInAB{PROJ}, true, blk, G, wave);
#endif
    xcd_barrier(xb, wave);
    if (wave >= 4) weight_items(P, (LAS float*)(lds + 51200 + (wave - 4) * 8448), blk * 4 + (wave - 4), G * 4, lane_id_v(), 1);
    s5_phase(P, lds, blk, G, wave);
    __syncthreads();
#if PROBE_DUP_S5
    s5_phase(P, lds, blk, G, wave);
    __syncthreads();
#endif
    attn_phase(P, lds, blk, G, wave);
#if PROBE_DUP_ATTN
    __syncthreads();
    attn_phase(P, lds, blk, G, wave);
#endif
    xcd_barrier(xb, wave);
    run_gemm(lds, APRE, (const bf16_t*)(ws + OFF_WGLU), 512, 512, EpGlu{APRE, P.in[12], CAT}, true, blk, G, wave);
    xcd_barrier(xb, wave);
    float* ST = (float*)(ws + OFF_ST); const float* SV = (const float*)(ws + OFF_SV); const float* TV = (const float*)(ws + OFF_TV);
    float *ST1 = ST, *ST2 = ST + 2 * (size_t)R, *ST3 = ST + 4 * (size_t)R, *ST4 = ST + 6 * (size_t)R;
#if PROBE_DUP_OUTAB
    run_gemm(lds, CAT, (const bf16_t*)(ws + OFF_WOAB), 1024, 1024, EpRes<NB_OUTAB>{HB, nullptr, nullptr, nullptr, nullptr, ST + 8 * (size_t)R}, true, blk, G, wave);
    __syncthreads();
#endif
    run_gemm(lds, CAT, (const bf16_t*)(ws + OFF_WOAB), 1024, 1024, EpRes<NB_OUTAB>{HB, nullptr, nullptr, nullptr, nullptr, ST1}, true, blk, G, wave);
    xcd_barrier(xb, wave);
    run_gemm(lds, HB, (const bf16_t*)(ws + OFF_WUP0), 4096, 1024, EpUp{HID, P.in[21], ST1, SV, TV}, true, blk, G, wave);
#if PROBE_DUP_UP0
    __syncthreads();
    run_gemm(lds, HB, (const bf16_t*)(ws + OFF_WUP0), 4096, 1024, EpUp{HID, P.in[21], ST1, SV, TV}, true, blk, G, wave);
#endif
#if PROBE_SYNCS
    for (int i_ = 0; i_ < PROBE_SYNCS; ++i_) xcd_barrier(xb, wave);
#endif
    xcd_barrier(xb, wave);
#if PROBE_GEMMS
    run_gemm(lds, HID, (const bf16_t*)(ws + OFF_WDN0), 1024, 4096, EpInAB{(bf16_t*)P.out}, false, blk, G, wave);
    __syncthreads();
#endif
    run_gemm(lds, HID, (const bf16_t*)(ws + OFF_WDN0), 1024, 4096, EpRes<NB_DN0>{HB, P.in[23], ST1, P.in[18], P.in[19], ST2}, true, blk, G, wave);
    xcd_barrier(xb, wave);
    run_gemm(lds, HB, (const bf16_t*)(ws + OFF_WC), 4096, 1024, EpInC{PC, P.in[15], ST2, SV + 4096, TV + 4096}, true, blk, G, wave);
#if PROBE_DUP_INC
    __syncthreads();
    run_gemm(lds, HB, (const bf16_t*)(ws + OFF_WC), 4096, 1024, EpInC{PC, P.in[15], ST2, SV + 4096, TV + 4096}, true, blk, G, wave);
#endif
    xcd_barrier(xb, wave);
#if HGRN_TWO_PHASE
    hgrn_prep_phase(P, lds, blk, G, wave);
    xcd_barrier(xb, wave);
    hgrn_core_phase(P, lds, blk, G, wave);
#else
    hgrn_phase(P, lds, blk, G, wave);
#endif
    xcd_barrier(xb, wave);
    run_gemm(lds, (const bf16_t*)P.out  , (const bf16_t*)(ws + OFF_WOC), 1024, 1024, EpRes<NB_OUTC>{HB, nullptr, ST2, P.in[24], P.in[25], ST3}, false, blk, G, wave);
    xcd_barrier(xb, wave);
    run_gemm(lds, HB, (const bf16_t*)(ws + OFF_WUP1), 4096, 1024, EpUp{HID, P.in[21] + 4096, ST3, SV + 8192, TV + 8192}, false, blk, G, wave);
    xcd_barrier(xb, wave);
    run_gemm(lds, HID, (const bf16_t*)(ws + OFF_WDN1), 1024, 4096, EpRes<NB_DN1>{HB, P.in[23] + 1024, ST3, P.in[18] + 1024, P.in[19] + 1024, ST4}, false, blk, G, wave);
    xcd_barrier(xb, wave);
    final_ln_phase(HB, ST4, P.out, P.in[24] + 1024, P.in[25] + 1024, blk, G, wave);
}

extern "C" void kernel_launch(void* const* d_in, const int* in_sizes, int n_in, void* d_out, int out_size, void* d_ws, size_t ws_size, hipStream_t stream) {
    constexpr size_t kDynLds = 131072 + 256;
    static int grid_blocks = 0;
    if (!grid_blocks) {
        if (n_in != 26 || ws_size < ZERO_END) { fprintf(stderr, "kernel_launch: expected 26 inputs and >= %zu bytes of workspace (got %d, %zu)\n", (size_t)ZERO_END, n_in, ws_size); grid_blocks = -1; return; }
        int dev = 0, cus = 0, per_cu = 0;
        hipGetDevice(&dev);
        hipDeviceGetAttribute(&cus, hipDeviceAttributeMultiprocessorCount, dev);
        hipFuncSetAttribute((const void*)fwd_megakernel, hipFuncAttributeMaxDynamicSharedMemorySize, (int)kDynLds);
        hipOccupancyMaxActiveBlocksPerMultiprocessor(&per_cu, (const void*)fwd_megakernel, 512, kDynLds);
        if (per_cu < 1) { fprintf(stderr, "kernel_launch: occupancy query says %d blocks per CU\n", per_cu); per_cu = 1; }
        grid_blocks = cus * (per_cu > 1 ? 1 : per_cu);
        if (grid_blocks != 256) fprintf(stderr, "kernel_launch: note: grid is %d workgroups (tuned for 256)\n", grid_blocks);
    }
    if (grid_blocks < 1) return;
    Params p{};
    for (int i = 0; i < 26; ++i) p.in[i] = (const float*)d_in[i];
    p.out = (float*)d_out; p.ws = (unsigned char*)d_ws;
    hipMemsetAsync((char*)d_ws + OFF_ST, 0, ZERO_END - OFF_ST, stream);
    void* args[] = {&p};
    hipError_t e = hipLaunchCooperativeKernel((const void*)fwd_megakernel, dim3(grid_blocks), dim3(512), args, kDynLds, stream);
    if (e != hipSuccess) fprintf(stderr, "cooperative launch failed: %s (grid %d)\n", hipGetErrorString(e), grid_blocks);
}
```

```cpp
#define NB_OUTAB 4
#define NB_DN0 2
#define NB_OUTC 4
#define NB_DN1 2
#include <hip/hip_runtime.h>
#include <hip/hip_cooperative_groups.h>
#include <cstdio>
#include <cstdint>
namespace cg = cooperative_groups;
#ifndef PROBE_DUP_S5
#define PROBE_DUP_S5 0
#endif
#ifndef PROBE_DUP_ATTN
#define PROBE_DUP_ATTN 0
#endif
#ifndef PROBE_DUP_HGRN
#define PROBE_DUP_HGRN 0
#endif
#ifndef PROBE_DUP_INC
#define PROBE_DUP_INC 0
#endif
__device__ __forceinline__ int lane_id_v() { int l; asm volatile("v_mbcnt_lo_u32_b32 %0, -1, 0\n\tv_mbcnt_hi_u32_b32 %0, -1, %0" : "=v"(l)); return l; }
#ifndef PROBE_DUP_UP0
#define PROBE_DUP_UP0 0
#endif
#ifndef PROBE_SYNCS
#define PROBE_SYNCS 0
#endif
#ifndef NB_OUTAB
#define NB_OUTAB 4
#endif
#ifndef NB_DN0
#define NB_DN0 4
#endif
#ifndef NB_OUTC
#define NB_OUTC 4
#endif
#ifndef NB_DN1
#define NB_DN1 4
#endif
#ifndef PROBE_GEMMS
#define PROBE_GEMMS 0
#endif
#ifndef PROBE_DUP_PRO
#define PROBE_DUP_PRO 0
#endif
#ifndef PROBE_DUP_OUTAB
#define PROBE_DUP_OUTAB 0
#endif
#ifndef HGRN_TWO_PHASE
#define HGRN_TWO_PHASE 0
#endif
#define XB_TMO      128
#define XB_XCNT(j)  (256  + 64 * (j))
#define XB_XSUB(j)  (1280 + 64 * (j))
#define XB_XGEN(j)  (2304 + 64 * (j))
#define XB_TOP      3328
#define XB_TOPGEN   3392
#define XCD_BAR_WORDS 3456
#define XB_SPIN_CAP (1u << 18)

__device__ __forceinline__ unsigned xb_ld(unsigned* p)              { return __hip_atomic_load(p, __ATOMIC_RELAXED, __HIP_MEMORY_SCOPE_AGENT); }
__device__ __forceinline__ unsigned xb_add(unsigned* p, unsigned v) { return __hip_atomic_fetch_add(p, v, __ATOMIC_RELAXED, __HIP_MEMORY_SCOPE_AGENT); }
__device__ __forceinline__ unsigned xb_xcc_id() { return (unsigned)__builtin_amdgcn_s_getreg((3 << 11) | 20) & 0xFu; }
#define XB_SPIN(cond, bar) do { unsigned _sp = 0; while (cond) { __builtin_amdgcn_s_sleep(1); \
    if ((++_sp & 255u) == 0u) { if (xb_ld(&(bar)[XB_TMO])) break; if (_sp > XB_SPIN_CAP) { atomicAdd(&(bar)[XB_TMO], 1u); break; } } } } while (0)

struct XcdBarrier {
    unsigned* bar; unsigned x;
    volatile __attribute__((address_space(3))) unsigned* st;
};

__device__ __forceinline__ XcdBarrier xcd_barrier_post(unsigned* bar, volatile __attribute__((address_space(3))) unsigned* st, int wave_in) {
    XcdBarrier b; b.bar = bar; b.x = xb_xcc_id(); b.st = st;
    if (wave_in == 0 && lane_id_v() == 0) (void)xb_add(&bar[XB_XCNT(b.x)], 1u);
    return b;
}
__device__ __forceinline__ void xcd_barrier_complete(unsigned* bar, unsigned x, unsigned& nloc, unsigned& nx) {
    const unsigned G = gridDim.x * gridDim.y * gridDim.z;
    unsigned sum, cnt, mine, sp = 0u;
    for (;;) {
        sum = 0u; cnt = 0u; mine = 0u;
#pragma unroll
        for (unsigned j = 0; j < 16; ++j) { const unsigned c = xb_ld(&bar[XB_XCNT(j)]); sum += c; cnt += (c > 0u) ? 1u : 0u; mine = (j == x) ? c : mine; }
        if (sum == G) break;
        __builtin_amdgcn_s_sleep(1);
        if ((++sp & 255u) == 0u) { if (xb_ld(&bar[XB_TMO])) break; if (sp > XB_SPIN_CAP) { atomicAdd(&bar[XB_TMO], 1u); break; } }
    }
    nloc = mine > 0u ? mine : 1u; nx = cnt > 0u ? cnt : 1u;
}

__device__ __forceinline__ void xcd_barrier(const XcdBarrier& b, int wave_in) {
    asm volatile("s_waitcnt vmcnt(0)" ::: "memory");
    __syncthreads();
    if (wave_in == 0 && lane_id_v() == 0) {
        unsigned* bar = b.bar;
        __builtin_amdgcn_s_waitcnt(0);
        unsigned nloc = b.st[0], nx = b.st[1];
        if (nloc == 0u) { xcd_barrier_complete(bar, b.x, nloc, nx); b.st[0] = nloc; b.st[1] = nx; }
        const unsigned old = xb_add(&bar[XB_XSUB(b.x)], 1u);
        const unsigned gen = old / nloc;
        if (old + 1u == (gen + 1u) * nloc) {
            __builtin_amdgcn_fence(__ATOMIC_RELEASE, "agent");
            asm volatile("s_waitcnt vmcnt(0)" ::: "memory");
            const unsigned og = xb_add(&bar[XB_TOP], 1u);
            const unsigned tg = og / nx;
            if (og + 1u == (tg + 1u) * nx) xb_add(&bar[XB_TOPGEN], 1u);
            else XB_SPIN(xb_ld(&bar[XB_TOPGEN]) == tg, bar);
            __builtin_amdgcn_fence(__ATOMIC_ACQUIRE, "agent");
            xb_add(&bar[XB_XGEN(b.x)], 1u);
            asm volatile("s_waitcnt vmcnt(0)" ::: "memory");
        } else {
            XB_SPIN(xb_ld(&bar[XB_XGEN(b.x)]) == gen, bar);
            __builtin_amdgcn_fence(__ATOMIC_ACQUIRE, "agent");
            asm volatile("s_waitcnt vmcnt(0)" ::: "memory");
        }
    }
    __syncthreads();
}

namespace pg8 {
#define PG8_LAS __attribute__((address_space(3)))
typedef unsigned short bf16_t;
typedef short bf16x8 __attribute__((ext_vector_type(8)));
typedef float f32x4 __attribute__((ext_vector_type(4)));
typedef unsigned u32x4 __attribute__((ext_vector_type(4)));
constexpr int BM = 256, BK = 64, HALF = 128, HTB = HALF * BK * 2  , STAGE_BYTES = 8 * HTB, NXCD = 8, WGM = 8;

__host__ __device__ __forceinline__ int lds_byte(int r, int c) { const int st = (r >> 4) * 2 + (c >> 5), rr = r & 15, cc = c & 31, ob = rr * 64 + cc * 2; return st * 1024 + (ob ^ (((ob >> 9) & 1) << 5)); }
__host__ __device__ __forceinline__ void stage_rc(int b, int& R, int& C) { const int st = b / 1024, sb = b % 1024, swz = sb ^ (((sb >> 9) & 1) << 5); R = (st >> 1) * 16 + swz / 64; C = (st & 1) * 32 + (swz % 64) / 2; }
__host__ __device__ __forceinline__ int perm32(int rho) { const int n = rho >> 4, i = rho & 15; return 8 * (i >> 2) + 4 * n + (i & 3); }

struct Unit { int pm, pn; };
struct Gemm { const bf16_t* A; const bf16_t* Bt; int M, N, K; };

struct StaticOrder {
    int nM, nN, nwg, G, c;
    __host__ __device__ void init(int M, int N, int G_, int c_) { nM = M / BM; nN = N / BM; nwg = nM * nN; G = G_; c = c_; }
    __host__ __device__ bool next(int i, Unit& u) const {
        const long L = (long)i * G + c; if (L >= nwg) return false;
        int wgid = (int)L; { const int q = nwg / NXCD, r = nwg % NXCD, xcd = wgid % NXCD, off = wgid / NXCD; wgid = (xcd < r ? xcd * (q + 1) : r * (q + 1) + (xcd - r) * q) + off; }
        const int nig = WGM * nN, gid = wgid / nig, fm = gid * WGM, gsz = (nM - fm) < WGM ? (nM - fm) : WGM;
        u.pm = fm + ((wgid % nig) % gsz); u.pn = (wgid % nig) / gsz; return true;
    }
    __device__ __forceinline__ void a_ready(const Unit&) const {}
    __device__ __forceinline__ void done(const Unit&) const {}
};

__device__ __forceinline__ unsigned cvt_pk_bf16(float lo, float hi) { unsigned r; asm volatile("v_cvt_pk_bf16_f32 %0, %1, %2" : "=v"(r) : "v"(lo), "v"(hi)); return r; }
template <class Epi, class Sched, bool ALIGN_EPI = false, bool SP2 = false>
__device__ __forceinline__ void gemm_phase(PG8_LAS unsigned char* lds, const Gemm g, const Sched& S, const Epi& E, int wave_in) {
    const int lane = lane_id_v(), wid = __builtin_amdgcn_readfirstlane(wave_in), tid = wid * 64 + lane, wr = wid >> 2, wc = wid & 3, fr = lane & 15, fq = lane >> 4;
    const int K = g.K, nt = K / BK;
    unsigned voffA[2], voffB[2];
#pragma unroll
    for (int i = 0; i < 2; ++i) { int R, C; stage_rc(tid * 16 + i * 8192, R, C); const int Rb = Epi::PERM ? ((R & ~31) + perm32(R & 31)) : R;
        voffA[i] = (unsigned)(R * K + C) * 2u; voffB[i] = (unsigned)(Rb * K + C) * 2u; }
    const size_t kstep = (size_t)(BK * 2);
    const size_t hstep = (size_t)HALF * K * 2;
    const size_t tstep = 2 * hstep;
    const unsigned ldsw = (unsigned)wid * 1024u;
    const int aoff = lds_byte(wr * 64 + fr, fq * 8), boff = lds_byte(wc * 32 + fr, fq * 8);
#define PG8_SA(b, h) (((b) * 2 + (h)) * HTB)
#define PG8_SB(b, h) ((4 + (b) * 2 + (h)) * HTB)
#define PG8_STAGE(bufoff, gbase, voff) do { _Pragma("unroll") for (int _i = 0; _i < 2; ++_i) \
        __builtin_amdgcn_global_load_lds((const unsigned*)((const char*)(gbase) + (voff)[_i]), (PG8_LAS unsigned*)(lds + (bufoff) + ldsw + _i * 8192), 16, 0, 0); } while (0)
#define PG8_LDA(dst, b, h) do { _Pragma("unroll") for (int m = 0; m < 4; ++m) _Pragma("unroll") for (int k = 0; k < 2; ++k) dst[m][k] = *(const PG8_LAS bf16x8*)(lds + PG8_SA(b, h) + aoff + m * 2048 + k * 1024); } while (0)
#define PG8_LDB(dst, b, h) do { _Pragma("unroll") for (int n = 0; n < 2; ++n) _Pragma("unroll") for (int k = 0; k < 2; ++k) dst[n][k] = *(const PG8_LAS bf16x8*)(lds + PG8_SB(b, h) + boff + n * 2048 + k * 1024); } while (0)
#define PG8_MMA(ai, bj, At, Bt) do { __builtin_amdgcn_s_setprio(1); _Pragma("unroll") for (int m = 0; m < 4; ++m) _Pragma("unroll") for (int n = 0; n < 2; ++n) _Pragma("unroll") for (int k = 0; k < 2; ++k) \
        acc[ai][bj][m][n] = __builtin_amdgcn_mfma_f32_16x16x32_bf16(Bt[n][k], At[m][k], acc[ai][bj][m][n], 0, 0, 0); __builtin_amdgcn_s_setprio(0); } while (0)
#define PG8_WAIT_V(n) asm volatile("s_waitcnt vmcnt(" #n ")" ::: "memory")
#define PG8_WAIT_L(n) asm volatile("s_waitcnt lgkmcnt(" #n ")" ::: "memory")
#define PG8_BAR __builtin_amdgcn_s_barrier()
#define PG8_SCHED __builtin_amdgcn_sched_barrier(0)
    Unit cur, nxt; int ui = 0;
    if (!S.next(0, cur)) return;
    f32x4 acc[2][2][4][2];
#pragma unroll
    for (int a = 0; a < 2; ++a)
#pragma unroll
        for (int b = 0; b < 2; ++b)
#pragma unroll
            for (int m = 0; m < 4; ++m)
#pragma unroll
                for (int n = 0; n < 2; ++n) acc[a][b][m][n] = (f32x4){0.f, 0.f, 0.f, 0.f};
    bf16x8 At[4][2], B0[2][2], B1[2][2];
    const char* cA = (const char*)g.A + (size_t)cur.pm * tstep; const char* cB = (const char*)g.Bt + (size_t)cur.pn * tstep;
    S.a_ready(cur);
    if constexpr (SP2) {
        PG8_STAGE(PG8_SB(0, 0), cB, voffB); PG8_STAGE(PG8_SB(0, 1), cB + hstep, voffB); PG8_STAGE(PG8_SA(0, 0), cA, voffA); PG8_STAGE(PG8_SA(0, 1), cA + hstep, voffA);
        if (wr == 1) PG8_BAR;
        PG8_WAIT_V(2); PG8_BAR;
        PG8_STAGE(PG8_SB(1, 0), cB + kstep, voffB); PG8_STAGE(PG8_SA(1, 0), cA + kstep, voffA); PG8_STAGE(PG8_SB(1, 1), cB + hstep + kstep, voffB);
        PG8_WAIT_V(6); PG8_BAR;
    } else {
        PG8_STAGE(PG8_SB(0, 0), cB, voffB); PG8_STAGE(PG8_SA(0, 0), cA, voffA); PG8_STAGE(PG8_SB(0, 1), cB + hstep, voffB); PG8_STAGE(PG8_SA(0, 1), cA + hstep, voffA);
        if (wr == 1) PG8_BAR;
        PG8_WAIT_V(4); PG8_BAR;
        PG8_STAGE(PG8_SB(1, 0), cB + kstep, voffB); PG8_STAGE(PG8_SA(1, 0), cA + kstep, voffA); PG8_STAGE(PG8_SB(1, 1), cB + hstep + kstep, voffB);
        PG8_WAIT_V(6); PG8_BAR;
    }
    for (;;) {
        const bool has_next = S.next(ui + 1, nxt);
        const char* nA = has_next ? (const char*)g.A + (size_t)nxt.pm * tstep : cA; const char* nB = has_next ? (const char*)g.Bt + (size_t)nxt.pn * tstep : cB;
        for (int t = 0; t < nt; t += 2) {
            const bool last = (t == nt - 2);
            const char* a1 = cA + (size_t)(t + 1) * kstep;
            const char* a2 = last ? nA : cA + (size_t)(t + 2) * kstep; const char* b2 = last ? nB : cB + (size_t)(t + 2) * kstep;
            const char* a3 = a2 + kstep; const char* b3 = b2 + kstep;
            if (last && has_next) S.a_ready(nxt);
            if constexpr (SP2) {
            PG8_LDB(B0, 0, 0); PG8_LDB(B1, 0, 1); PG8_SCHED; PG8_LDA(At, 0, 0); PG8_STAGE(PG8_SA(1, 1), a1 + hstep, voffA);
            PG8_WAIT_V(8); PG8_WAIT_L(0); PG8_BAR; PG8_MMA(0, 0, At, B0); PG8_MMA(0, 1, At, B1); PG8_BAR; PG8_SCHED;
            PG8_LDA(At, 0, 1); PG8_STAGE(PG8_SB(0, 0), b2, voffB); PG8_STAGE(PG8_SB(0, 1), b2 + hstep, voffB); PG8_STAGE(PG8_SA(0, 0), a2, voffA);
            PG8_WAIT_V(8); PG8_WAIT_L(0); PG8_BAR; PG8_MMA(1, 0, At, B0); PG8_MMA(1, 1, At, B1); PG8_BAR; PG8_SCHED;
            PG8_LDB(B0, 1, 0); PG8_LDB(B1, 1, 1); PG8_SCHED; PG8_LDA(At, 1, 0); PG8_STAGE(PG8_SA(0, 1), a2 + hstep, voffA);
            PG8_WAIT_V(8); PG8_WAIT_L(0); PG8_BAR; PG8_MMA(0, 0, At, B0); PG8_MMA(0, 1, At, B1); PG8_BAR; PG8_SCHED;
            PG8_LDA(At, 1, 1); PG8_STAGE(PG8_SB(1, 0), b3, voffB); PG8_STAGE(PG8_SB(1, 1), b3 + hstep, voffB); PG8_STAGE(PG8_SA(1, 0), a3, voffA);
            PG8_WAIT_V(8); PG8_WAIT_L(0); PG8_BAR; PG8_MMA(1, 0, At, B0); PG8_MMA(1, 1, At, B1); PG8_BAR; PG8_SCHED;
            } else {
            PG8_LDB(B0, 0, 0); PG8_SCHED; PG8_LDA(At, 0, 0); PG8_STAGE(PG8_SA(1, 1), a1 + hstep, voffA);
            PG8_WAIT_L(8); PG8_BAR; PG8_WAIT_L(0); PG8_MMA(0, 0, At, B0); PG8_BAR; PG8_SCHED;
            PG8_LDB(B1, 0, 1); PG8_STAGE(PG8_SB(0, 0), b2, voffB);
            PG8_BAR; PG8_WAIT_L(0); PG8_MMA(0, 1, At, B1); PG8_BAR;
            PG8_LDA(At, 0, 1); PG8_STAGE(PG8_SA(0, 0), a2, voffA);
            PG8_BAR; PG8_WAIT_L(0); PG8_MMA(1, 0, At, B0); PG8_BAR; PG8_SCHED;
            PG8_STAGE(PG8_SB(0, 1), b2 + hstep, voffB);
            PG8_WAIT_V(6); PG8_BAR; PG8_MMA(1, 1, At, B1); PG8_BAR;
            PG8_LDB(B0, 1, 0); PG8_SCHED; PG8_LDA(At, 1, 0); PG8_STAGE(PG8_SA(0, 1), a2 + hstep, voffA);
            PG8_WAIT_L(8); PG8_BAR; PG8_WAIT_L(0); PG8_MMA(0, 0, At, B0); PG8_BAR; PG8_SCHED;
            PG8_LDB(B1, 1, 1); PG8_STAGE(PG8_SB(1, 0), b3, voffB);
            PG8_BAR; PG8_WAIT_L(0); PG8_MMA(0, 1, At, B1); PG8_BAR;
            PG8_LDA(At, 1, 1); PG8_STAGE(PG8_SA(1, 0), a3, voffA);
            PG8_BAR; PG8_WAIT_L(0); PG8_MMA(1, 0, At, B0); PG8_BAR; PG8_SCHED;
            PG8_STAGE(PG8_SB(1, 1), b3 + hstep, voffB);
            PG8_WAIT_V(6); PG8_BAR; PG8_MMA(1, 1, At, B1); PG8_BAR;
            }
        }
        if constexpr (ALIGN_EPI) { if (wr == 0) PG8_BAR; }
        if constexpr (!Epi::AFTER_DRAIN) { E(acc, cur, wr, wc, fr, fq); S.done(cur); }
        if (!has_next) break;
#pragma unroll
        for (int a = 0; a < 2; ++a)
#pragma unroll
            for (int b = 0; b < 2; ++b)
#pragma unroll
                for (int m = 0; m < 4; ++m)
#pragma unroll
                    for (int n = 0; n < 2; ++n) acc[a][b][m][n] = (f32x4){0.f, 0.f, 0.f, 0.f};
        cur = nxt; cA = nA; cB = nB; ++ui;
        if constexpr (ALIGN_EPI) { if (wr == 1) PG8_BAR; }
    }
    PG8_WAIT_V(0);
    if constexpr (!ALIGN_EPI) { if (wr == 0) PG8_BAR; }
    PG8_BAR;
    if constexpr (Epi::AFTER_DRAIN) { E.fused(acc, cur, wr, wc, fr, fq, lds, wid, lane); S.done(cur); }
#undef PG8_SA
#undef PG8_SB
#undef PG8_STAGE
#undef PG8_LDA
#undef PG8_LDB
#undef PG8_MMA
#undef PG8_WAIT_V
#undef PG8_WAIT_L
#undef PG8_BAR
#undef PG8_SCHED
}
}

#define LAS __attribute__((address_space(3)))
typedef unsigned short bf16_t;
typedef short bf16x8 __attribute__((ext_vector_type(8)));
typedef short s16x4 __attribute__((ext_vector_type(4)));
typedef float f32x4 __attribute__((ext_vector_type(4)));
typedef float f32x16 __attribute__((ext_vector_type(16)));
typedef unsigned u32x4 __attribute__((ext_vector_type(4)));
typedef unsigned u32x2 __attribute__((ext_vector_type(2)));

constexpr int T = 16 * 2048;
constexpr int NMETA = 16;
constexpr int R = T + NMETA;
constexpr int DM = 1024, DFF = 4096;
constexpr float ALPHA = 1.4142135623730951f;
constexpr float QSCALE = 0.125f * 1.4426950408889634f;

constexpr size_t SZ_WAB = (size_t)2048 * 1024 * 2, SZ_WGLU = (size_t)512 * 512 * 2, SZ_W1M = (size_t)1024 * 1024 * 2, SZ_W4M = (size_t)4096 * 1024 * 2;
constexpr size_t OFF_WAB = 0, OFF_WGLU = OFF_WAB + SZ_WAB, OFF_WOAB = OFF_WGLU + SZ_WGLU, OFF_WC = OFF_WOAB + SZ_W1M, OFF_WOC = OFF_WC + SZ_W4M,
                 OFF_WUP0 = OFF_WOC + SZ_W1M, OFF_WUP1 = OFF_WUP0 + SZ_W4M, OFF_WDN0 = OFF_WUP1 + SZ_W4M, OFF_WDN1 = OFF_WDN0 + SZ_W4M,
                 OFF_HB = OFF_WDN1 + SZ_W4M, OFF_Z = OFF_HB + (size_t)R * 1024 * 2, OFF_BIG = OFF_Z + (size_t)R * 1024 * 4, WS_END = OFF_BIG + (size_t)R * 4096 * 2;
constexpr size_t OFF_ST = (WS_END + 255) & ~(size_t)255;
constexpr size_t SZ_ST = (size_t)5 * R * 2 * 4;
constexpr size_t OFF_SV = OFF_ST + SZ_ST, OFF_TV = OFF_SV + (size_t)3 * 4096 * 4, OFF_BAR = OFF_TV + (size_t)3 * 4096 * 4, OFF_ZROW = OFF_BIG + ((OFF_BAR + (size_t)XCD_BAR_WORDS * 4 - OFF_BIG + 8191) / 8192) * 8192, ZERO_END = OFF_ZROW + (size_t)8 * 8192;
constexpr size_t BIG_PROJ = 0, BIG_APRE = (size_t)R * 2048 * 2, BIG_CAT = BIG_APRE + (size_t)R * 512 * 2;

struct Params { const float* in[26]; float* out; unsigned char* ws; };

__device__ __forceinline__ unsigned pk2(float lo, float hi) {
    typedef __bf16 bf2 __attribute__((ext_vector_type(2)));
    typedef float fl2 __attribute__((ext_vector_type(2)));
    fl2 v = {lo, hi}; bf2 r = __builtin_convertvector(v, bf2); return __builtin_bit_cast(unsigned, r);
}
__device__ __forceinline__ bf16_t f2bf(float x) { return (bf16_t)(pk2(x, 0.f) & 0xffffu); }
__device__ __forceinline__ float bf2f(bf16_t v) { return __uint_as_float((unsigned)v << 16); }
__device__ __forceinline__ float bflo(unsigned w) { return __uint_as_float(w << 16); }
__device__ __forceinline__ float bfhi(unsigned w) { return __uint_as_float(w & 0xffff0000u); }
__device__ __forceinline__ float sigmoidf_(float x) { return 1.0f / (1.0f + __expf(-x)); }
#define LDS_WAIT() asm volatile("s_waitcnt lgkmcnt(0)" ::: "memory")
#define MFMA16(a, b, c) __builtin_amdgcn_mfma_f32_16x16x32_bf16((a), (b), (c), 0, 0, 0)
#define MFMA32(a, b, c) __builtin_amdgcn_mfma_f32_32x32x16_bf16((a), (b), (c), 0, 0, 0)

struct RowCtx { float mu, rstd; };
__device__ __forceinline__ RowCtx ln_ctx(const float* st, int row) {
    const float sum = st[2 * (size_t)row], sq = st[2 * (size_t)row + 1];
    RowCtx rc; rc.mu = sum * (1.0f / 1024.0f); const float var = fmaxf(sq * (1.0f / 1024.0f) - rc.mu * rc.mu, 0.f); rc.rstd = 1.0f / sqrtf(var + 1e-5f); return rc;
}
struct NoCtx {};
struct EpInAB {
    static constexpr bool MAKES_STATS = false; static constexpr int BATCH = 8;
    typedef NoCtx ColCtx; typedef NoCtx Pre;
    bf16_t* O;
    __device__ __forceinline__ ColCtx col_ctx(int) const { return NoCtx{}; }
    template <bool META> __device__ __forceinline__ Pre pre(int, int) const { return NoCtx{}; }
    __device__ __forceinline__ RowCtx row_ctx(int) const { return RowCtx{0.f, 1.f}; }
    __device__ __forceinline__ float* st_ptr() const { return nullptr; }
    __device__ __forceinline__ void apply8(int row, int col, f32x4 a, f32x4 b, const RowCtx&, const ColCtx&, const Pre&, float&, float&) const {
        const float s = (col >= 512 && col < 1024) ? QSCALE : 1.0f;
        u32x4 w; w.x = pk2(a[0] * s, a[1] * s); w.y = pk2(a[2] * s, a[3] * s); w.z = pk2(b[0] * s, b[1] * s); w.w = pk2(b[2] * s, b[3] * s);
        *(u32x4*)(O + (size_t)row * 2048 + col) = w;
    }
};
struct EpGlu {
    static constexpr bool MAKES_STATS = false; static constexpr int BATCH = 4;
    struct ColCtx { f32x4 b0, b1; }; struct Pre { u32x4 ap; };
    const bf16_t* APRE; const float* bias; bf16_t* CAT;
    __device__ __forceinline__ ColCtx col_ctx(int col) const { return ColCtx{*(const f32x4*)(bias + col), *(const f32x4*)(bias + col + 4)}; }
    template <bool META> __device__ __forceinline__ Pre pre(int row, int col) const { return Pre{*(const u32x4*)((const char*)APRE + ((unsigned)row * 1024u + (unsigned)col * 2u))}; }
    __device__ __forceinline__ RowCtx row_ctx(int) const { return RowCtx{0.f, 1.f}; }
    __device__ __forceinline__ float* st_ptr() const { return nullptr; }
    __device__ __forceinline__ void apply8(int row, int col, f32x4 a, f32x4 b, const RowCtx&, const ColCtx& cc, const Pre& pr, float&, float&) const {
        const u32x4 ap = pr.ap;
        float v[8] = {a[0] + cc.b0[0], a[1] + cc.b0[1], a[2] + cc.b0[2], a[3] + cc.b0[3], b[0] + cc.b1[0], b[1] + cc.b1[1], b[2] + cc.b1[2], b[3] + cc.b1[3]};
        float y[8] = {bflo(ap.x), bfhi(ap.x), bflo(ap.y), bfhi(ap.y), bflo(ap.z), bfhi(ap.z), bflo(ap.w), bfhi(ap.w)};
#pragma unroll
        for (int i = 0; i < 8; ++i) y[i] = y[i] * sigmoidf_(v[i]);
        u32x4 w; w.x = pk2(y[0], y[1]); w.y = pk2(y[2], y[3]); w.z = pk2(y[4], y[5]); w.w = pk2(y[6], y[7]);
        *(u32x4*)(CAT + (size_t)row * 1024 + col) = w;
    }
};
template <int NB_> struct EpRes {
    static constexpr bool MAKES_STATS = true; static constexpr int BATCH = NB_;
    struct ColCtx { f32x4 ag0, ag1, ab0, ab1; }; struct Pre { u32x4 h; };
    bf16_t* HBp; const float* bias;
    const float* st_prev; const float* g; const float* bta; float* st_out;
    __device__ __forceinline__ ColCtx col_ctx(int col) const {
        ColCtx c; const f32x4 one = {1.f, 1.f, 1.f, 1.f}, zero = {0.f, 0.f, 0.f, 0.f};
        const f32x4 g0 = st_prev ? *(const f32x4*)(g + col) : one, g1 = st_prev ? *(const f32x4*)(g + col + 4) : one;
        const f32x4 t0 = st_prev ? *(const f32x4*)(bta + col) : zero, t1 = st_prev ? *(const f32x4*)(bta + col + 4) : zero;
        const f32x4 b0 = bias ? *(const f32x4*)(bias + col) : zero, b1 = bias ? *(const f32x4*)(bias + col + 4) : zero;
        c.ag0 = g0 * ALPHA; c.ag1 = g1 * ALPHA; c.ab0 = t0 * ALPHA + b0; c.ab1 = t1 * ALPHA + b1; return c;
    }
    template <bool META> __device__ __forceinline__ Pre pre(int row, int col) const { return Pre{*(const u32x4*)((const char*)HBp + ((unsigned)row * 2048u + (unsigned)col * 2u))}; }
    __device__ __forceinline__ RowCtx row_ctx(int row) const { return st_prev ? ln_ctx(st_prev, row) : RowCtx{0.f, 1.f}; }
    __device__ __forceinline__ float* st_ptr() const { return st_out; }
    __device__ __forceinline__ void apply8(int row, int col, f32x4 a, f32x4 b, const RowCtx& rc, const ColCtx& cc, const Pre& pr, float& s, float& q) const {
        const f32x4 h0 = {bflo(pr.h.x), bfhi(pr.h.x), bflo(pr.h.y), bfhi(pr.h.y)}, h1 = {bflo(pr.h.z), bfhi(pr.h.z), bflo(pr.h.w), bfhi(pr.h.w)};
        const f32x4 o0 = (h0 - rc.mu) * rc.rstd * cc.ag0 + cc.ab0 + a, o1 = (h1 - rc.mu) * rc.rstd * cc.ag1 + cc.ab1 + b;
        u32x4 w; w.x = pk2(o0[0], o0[1]); w.y = pk2(o0[2], o0[3]); w.z = pk2(o1[0], o1[1]); w.w = pk2(o1[2], o1[3]);
        *(u32x4*)((char*)HBp + ((unsigned)row * 2048u + (unsigned)col * 2u)) = w;
        s += ((o0[0] + o0[1]) + (o0[2] + o0[3])) + ((o1[0] + o1[1]) + (o1[2] + o1[3]));
        q += ((o0[0] * o0[0] + o0[1] * o0[1]) + (o0[2] * o0[2] + o0[3] * o0[3])) + ((o1[0] * o1[0] + o1[1] * o1[1]) + (o1[2] * o1[2] + o1[3] * o1[3]));
    }
};
struct EpUp {
    static constexpr bool MAKES_STATS = false; static constexpr int BATCH = 8;
    struct ColCtx { f32x4 s0, s1, t0, t1; }; typedef NoCtx Pre;
    bf16_t* H; const float* bias; const float* st_prev; const float* sv; const float* tv;
    __device__ __forceinline__ ColCtx col_ctx(int col) const {
        return ColCtx{*(const f32x4*)(sv + col), *(const f32x4*)(sv + col + 4), *(const f32x4*)(tv + col) + *(const f32x4*)(bias + col), *(const f32x4*)(tv + col + 4) + *(const f32x4*)(bias + col + 4)};
    }
    template <bool META> __device__ __forceinline__ Pre pre(int, int) const { return NoCtx{}; }
    __device__ __forceinline__ RowCtx row_ctx(int row) const { return ln_ctx(st_prev, row); }
    __device__ __forceinline__ float* st_ptr() const { return nullptr; }
    __device__ __forceinline__ void apply8(int row, int col, f32x4 a, f32x4 b, const RowCtx& rc, const ColCtx& cc, const Pre&, float&, float&) const {
        f32x4 v0 = (a - rc.mu * cc.s0) * rc.rstd + cc.t0, v1 = (b - rc.mu * cc.s1) * rc.rstd + cc.t1;
#pragma unroll
        for (int i = 0; i < 4; ++i) { v0[i] = fmaxf(v0[i], 0.f); v0[i] *= v0[i]; v1[i] = fmaxf(v1[i], 0.f); v1[i] *= v1[i]; }
        u32x4 w; w.x = pk2(v0[0], v0[1]); w.y = pk2(v0[2], v0[3]); w.z = pk2(v1[0], v1[1]); w.w = pk2(v1[2], v1[3]);
        *(u32x4*)(H + (size_t)row * 4096 + col) = w;
    }
};
struct EpInC {
    static constexpr bool MAKES_STATS = false; static constexpr int BATCH = 8;
    struct ColCtx { f32x4 s0, s1, t0, t1, lb0, lb1; }; typedef NoCtx Pre;
    unsigned short* PC; const float* gamma; const float* st_prev; const float* sv; const float* tv;
    __device__ __forceinline__ ColCtx col_ctx(int col) const {
        ColCtx c{*(const f32x4*)(sv + col), *(const f32x4*)(sv + col + 4), *(const f32x4*)(tv + col), *(const f32x4*)(tv + col + 4), {0.f, 0.f, 0.f, 0.f}, {0.f, 0.f, 0.f, 0.f}};
        if (col >= 1024 && col < 2048) {
            const f32x4 ga = *(const f32x4*)(gamma + col - 1024), gb = *(const f32x4*)(gamma + col - 1020), gc = *(const f32x4*)(gamma + col), gd = *(const f32x4*)(gamma + col + 4);
#pragma unroll
            for (int i = 0; i < 4; ++i) { c.lb0[i] = 1.0f / (1.0f + __expf(ga[i] - gc[i])); c.lb1[i] = 1.0f / (1.0f + __expf(gb[i] - gd[i])); }
        }
        return c;
    }
    template <bool META> __device__ __forceinline__ Pre pre(int, int) const { return NoCtx{}; }
    __device__ __forceinline__ RowCtx row_ctx(int row) const { return ln_ctx(st_prev, row); }
    __device__ __forceinline__ float* st_ptr() const { return nullptr; }
    __device__ __forceinline__ void apply8(int row, int col, f32x4 a, f32x4 b, const RowCtx& rc, const ColCtx& cc, const Pre&, float&, float&) const {
        a = (a - rc.mu * cc.s0) * rc.rstd + cc.t0;
        b = (b - rc.mu * cc.s1) * rc.rstd + cc.t1;
        u32x4 w;
        if (col >= 1024 && col < 2048) {
            float v[8] = {a[0], a[1], a[2], a[3], b[0], b[1], b[2], b[3]};
            float lb[8] = {cc.lb0[0], cc.lb0[1], cc.lb0[2], cc.lb0[3], cc.lb1[0], cc.lb1[1], cc.lb1[2], cc.lb1[3]};
            unsigned short h[8];
#pragma unroll
            for (int i = 0; i < 8; ++i) {
                const float f = lb[i] + (1.0f - lb[i]) * sigmoidf_(v[i]);
                const _Float16 hf = (_Float16)__logf(f);
                h[i] = __builtin_bit_cast(unsigned short, hf);
            }
            w.x = h[0] | ((unsigned)h[1] << 16); w.y = h[2] | ((unsigned)h[3] << 16); w.z = h[4] | ((unsigned)h[5] << 16); w.w = h[6] | ((unsigned)h[7] << 16);
        } else { w.x = pk2(a[0], a[1]); w.y = pk2(a[2], a[3]); w.z = pk2(b[0], b[1]); w.w = pk2(b[2], b[3]); }
        *(u32x4*)(PC + (size_t)row * 4096 + col) = w;
    }
};
template <class F> struct EpiAdapt {
    static constexpr bool PERM = true, AFTER_DRAIN = false; F f;
    __device__ __forceinline__ void operator()(const f32x4 (&acc)[2][2][4][2], const pg8::Unit& u, int wr, int wc, int, int) const {
        const int lane_ = lane_id_v(), fr = lane_ & 15, fq = lane_ >> 4;
        const int col0 = u.pn * 256 + wc * 32 + 8 * fq, row0 = u.pm * 256 + wr * 64 + fr;
        constexpr int NB = F::BATCH;
#pragma unroll
        for (int bt = 0; bt < 8 / NB; ++bt) {
            const typename F::ColCtx cc[2] = {f.col_ctx(col0), f.col_ctx(col0 + 128)};
            RowCtx rc[NB];
            typename F::Pre pr[NB][2];
#pragma unroll
            for (int i = 0; i < NB; ++i) { const int r8 = bt * NB + i, row = row0 + (r8 >> 2) * 128 + (r8 & 3) * 16;
                rc[i] = f.row_ctx(row); pr[i][0] = f.template pre<false>(row, col0); pr[i][1] = f.template pre<false>(row, col0 + 128); }
#pragma unroll
            for (int i = 0; i < NB; ++i) { const int r8 = bt * NB + i, ai = r8 >> 2, m = r8 & 3, row = row0 + ai * 128 + m * 16;
                float s = 0.f, q = 0.f;
                f.apply8(row, col0, acc[ai][0][m][0], acc[ai][0][m][1], rc[i], cc[0], pr[i][0], s, q);
                f.apply8(row, col0 + 128, acc[ai][1][m][0], acc[ai][1][m][1], rc[i], cc[1], pr[i][1], s, q);
                if (F::MAKES_STATS) {
                    s += __shfl_xor(s, 16); s += __shfl_xor(s, 32); q += __shfl_xor(q, 16); q += __shfl_xor(q, 32);
                    if (fq == 0) { float* st = (float*)((char*)f.st_ptr() + (unsigned)row * 8u); unsafeAtomicAdd(st, s); unsafeAtomicAdd(st + 1, q); }
                }
            }
            asm volatile("" ::: "memory");
        }
    }
};
template <class F> __device__ __forceinline__ void meta_gemm(const bf16_t* A16  , const bf16_t* Bt, int N, int K, const F& f, int blk, int G, int wave, int lane, LAS float* red  ) {
    const int l15 = lane & 15, quad = lane >> 4, kw = K >> 3;
    for (int item = blk; item < N / 32; item += G) {
        const int c0 = item * 32;
        const bf16_t* ap = A16 + (size_t)l15 * K + 8 * quad + wave * kw;
        const bf16_t* w0 = Bt + (size_t)(c0 + 8 * (l15 >> 2) + (l15 & 3)) * K + 8 * quad + wave * kw;
        const bf16_t* w1 = w0 + (size_t)4 * K;
        f32x4 acc0 = {0.f, 0.f, 0.f, 0.f}, acc1 = {0.f, 0.f, 0.f, 0.f};
#pragma unroll 4
        for (int k = 0; k < kw; k += 32) {
            const bf16x8 xa = *(const bf16x8*)(ap + k), b0 = *(const bf16x8*)(w0 + k), b1 = *(const bf16x8*)(w1 + k);
            acc0 = MFMA16(b0, xa, acc0); acc1 = MFMA16(b1, xa, acc1);
        }
        *(LAS f32x4*)(red + (wave * 64 + lane) * 8) = acc0; *(LAS f32x4*)(red + (wave * 64 + lane) * 8 + 4) = acc1;
        __syncthreads();
        if (wave == 0) {
#pragma unroll
            for (int w = 1; w < 8; ++w) { acc0 += *(const LAS f32x4*)(red + (w * 64 + lane) * 8); acc1 += *(const LAS f32x4*)(red + (w * 64 + lane) * 8 + 4); }
            const RowCtx rc = f.row_ctx(T + l15);
            const typename F::ColCtx cc = f.col_ctx(c0 + 8 * quad);
            const typename F::Pre pr = f.template pre<true>(T + l15, c0 + 8 * quad);
            float s = 0.f, q = 0.f;
            f.apply8(T + l15, c0 + 8 * quad, acc0, acc1, rc, cc, pr, s, q);
            if (F::MAKES_STATS) {
                s += __shfl_xor(s, 16); s += __shfl_xor(s, 32); q += __shfl_xor(q, 16); q += __shfl_xor(q, 32);
                if (quad == 0) { float* st = f.st_ptr() + 2 * (size_t)(T + l15); unsafeAtomicAdd(st, s); unsafeAtomicAdd(st + 1, q); }
            }
        }
        __syncthreads();
    }
}
template <class F> __device__ __forceinline__ void run_gemm(LAS unsigned char* lds, const bf16_t* A, const bf16_t* Bt, int N, int K, const F& f, bool with_meta, int blk, int G, int wave) {
    pg8::Gemm g{A, Bt, T, N, K}; pg8::StaticOrder S; S.init(T, N, G, blk);
    EpiAdapt<F> E{f};
    pg8::gemm_phase<EpiAdapt<F>, pg8::StaticOrder, true, true>((PG8_LAS unsigned char*)lds, g, S, E, wave);
    if (with_meta) meta_gemm<F>(A + (size_t)T * K, Bt, N, K, f, blk, G, wave, lane_id_v(), (LAS float*)lds);
}

__device__ __forceinline__ void transpose_item(const float* W, int K, int N, bf16_t* WT, LAS float* scr, int item, int lane) {
    const int nblk = N / 32, kb = item / nblk, nb = item % nblk, k0 = 64 * kb, n0 = 32 * nb;
    float wv_[32];
#pragma unroll
    for (int i = 0; i < 32; ++i) wv_[i] = W[(size_t)(k0 + 2 * i + (lane >> 5)) * N + n0 + (lane & 31)];
#pragma unroll
    for (int i = 0; i < 32; ++i) scr[(2 * i + (lane >> 5)) * 33 + (lane & 31)] = wv_[i];
    LDS_WAIT();
    const int c = lane & 7;
#pragma unroll
    for (int j = 0; j < 4; ++j) { const int n = (lane >> 3) + 8 * j; const LAS float* s = scr + (8 * c) * 33 + n;
        u32x4 o; o.x = pk2(s[0 * 33], s[1 * 33]); o.y = pk2(s[2 * 33], s[3 * 33]); o.z = pk2(s[4 * 33], s[5 * 33]); o.w = pk2(s[6 * 33], s[7 * 33]);
        *(u32x4*)(WT + (size_t)(n0 + n) * K + k0 + 8 * c) = o; }
    LDS_WAIT();
}
__device__ __forceinline__ void transpose_item_fold(const float* W, int K, int N, bf16_t* WT, LAS float* scr, int item, int lane, const float* g, const float* bta, float* sv, float* tv) {
    const int nblk = N / 32, kb = item / nblk, nb = item % nblk, k0 = 64 * kb, n0 = 32 * nb;
    float wv_[32];
#pragma unroll
    for (int i = 0; i < 32; ++i) wv_[i] = W[(size_t)(k0 + 2 * i + (lane >> 5)) * N + n0 + (lane & 31)];
#pragma unroll
    for (int i = 0; i < 32; ++i) scr[(2 * i + (lane >> 5)) * 33 + (lane & 31)] = wv_[i];
    LDS_WAIT();
    const int c = lane & 7;
    const f32x4 g0 = *(const f32x4*)(g + k0 + 8 * c), g1 = *(const f32x4*)(g + k0 + 8 * c + 4), b0 = *(const f32x4*)(bta + k0 + 8 * c), b1 = *(const f32x4*)(bta + k0 + 8 * c + 4);
#pragma unroll
    for (int j = 0; j < 4; ++j) { const int n = (lane >> 3) + 8 * j; const LAS float* s = scr + (8 * c) * 33 + n;
        const float w0 = s[0 * 33], w1 = s[1 * 33], w2 = s[2 * 33], w3 = s[3 * 33], w4 = s[4 * 33], w5 = s[5 * 33], w6 = s[6 * 33], w7 = s[7 * 33];
        u32x4 o; o.x = pk2(g0[0] * w0, g0[1] * w1); o.y = pk2(g0[2] * w2, g0[3] * w3); o.z = pk2(g1[0] * w4, g1[1] * w5); o.w = pk2(g1[2] * w6, g1[3] * w7);
        *(u32x4*)(WT + (size_t)(n0 + n) * K + k0 + 8 * c) = o;
        float ss = ((bflo(o.x) + bfhi(o.x)) + (bflo(o.y) + bfhi(o.y))) + ((bflo(o.z) + bfhi(o.z)) + (bflo(o.w) + bfhi(o.w)));
        float tt = ((b0[0] * w0 + b0[1] * w1) + (b0[2] * w2 + b0[3] * w3)) + ((b1[0] * w4 + b1[1] * w5) + (b1[2] * w6 + b1[3] * w7));
        ss += __shfl_xor(ss, 1); ss += __shfl_xor(ss, 2); ss += __shfl_xor(ss, 4);
        tt += __shfl_xor(tt, 1); tt += __shfl_xor(tt, 2); tt += __shfl_xor(tt, 4);
        if (c == 0) { unsafeAtomicAdd(sv + n0 + n, ss); unsafeAtomicAdd(tv + n0 + n, tt); } }
    LDS_WAIT();
}
__device__ __forceinline__ void weight_items(const Params& P, LAS float* scr, int gw, int NGW, int lane, int part) {
    unsigned char* ws = P.ws;
    constexpr int I_AB = 16 * 64, I_GLU = 8 * 16, I_1M = 16 * 32, I_C = 16 * 128, I_UP = 16 * 128, I_DN = 64 * 32;
    constexpr int NREST = I_GLU + I_1M + I_C + I_1M + 2 * I_UP + 2 * I_DN;
    if (part == 0) { for (int it = gw; it < I_AB; it += NGW) transpose_item(P.in[2], 1024, 2048, (bf16_t*)(ws + OFF_WAB), scr, it, lane); return; }
    for (int it = gw; it < NREST; it += NGW) {
        int r = it;
        if (r < I_GLU) { transpose_item(P.in[11], 512, 512, (bf16_t*)(ws + OFF_WGLU), scr, r, lane); continue; } r -= I_GLU;
        if (r < I_1M) { transpose_item(P.in[13], 1024, 1024, (bf16_t*)(ws + OFF_WOAB), scr, r, lane); continue; } r -= I_1M;
        if (r < I_UP) { transpose_item_fold(P.in[20], 1024, 4096, (bf16_t*)(ws + OFF_WUP0), scr, r, lane, P.in[18], P.in[19], (float*)(ws + OFF_SV), (float*)(ws + OFF_TV)); continue; } r -= I_UP;
        if (r < I_DN) { transpose_item(P.in[22], 4096, 1024, (bf16_t*)(ws + OFF_WDN0), scr, r, lane); continue; } r -= I_DN;
        if (r < I_C) { transpose_item_fold(P.in[14], 1024, 4096, (bf16_t*)(ws + OFF_WC), scr, r, lane, P.in[24], P.in[25], (float*)(ws + OFF_SV) + 4096, (float*)(ws + OFF_TV) + 4096); continue; } r -= I_C;
        if (r < I_1M) { transpose_item(P.in[17], 1024, 1024, (bf16_t*)(ws + OFF_WOC), scr, r, lane); continue; } r -= I_1M;
        if (r < I_UP) { transpose_item_fold(P.in[20] + (size_t)1024 * 4096, 1024, 4096, (bf16_t*)(ws + OFF_WUP1), scr, r, lane, P.in[18] + 1024, P.in[19] + 1024, (float*)(ws + OFF_SV) + 8192, (float*)(ws + OFF_TV) + 8192); continue; } r -= I_UP;
        transpose_item(P.in[22] + (size_t)4096 * 1024, 4096, 1024, (bf16_t*)(ws + OFF_WDN1), scr, r, lane);
    }
}
__device__ __forceinline__ void prologue_phase(const Params& P, LAS unsigned char* lds, int blk, int G, int wave) {
    const int lane = lane_id_v(), tid = wave * 64 + lane;
    unsigned char* ws = P.ws;
    weight_items(P, (LAS float*)(lds + wave * 8448), blk * 8 + wave, G * 8, lane, 0);
    bf16_t* HB = (bf16_t*)(ws + OFF_HB);
    const size_t n8 = (size_t)R * 1024 / 8;
#pragma unroll 4
    for (size_t i = (size_t)blk * 512 + tid; i < n8; i += (size_t)G * 512) {
        const size_t e = i * 8;
        const float* src = e < (size_t)T * 1024 ? P.in[0] + e : P.in[1] + (e - (size_t)T * 1024);
        const f32x4 a = *(const f32x4*)src, b = *(const f32x4*)(src + 4);
        u32x4 w; w.x = pk2(a[0], a[1]); w.y = pk2(a[2], a[3]); w.z = pk2(b[0], b[1]); w.w = pk2(b[2], b[3]);
        *(u32x4*)(HB + e) = w;
    }
}

__device__ __forceinline__ void ln_phase(const float* Zin, float* Fout, bf16_t* Bout, const float* g, const float* bta, int nrows, int blk, int G, int wave) {
    const int lane = lane_id_v();
    for (int row = blk * 8 + wave; row < nrows; row += G * 8) {
        const f32x4* xr = (const f32x4*)(Zin + (size_t)row * 1024) + lane;
        f32x4 v[4]; float s = 0.f;
#pragma unroll
        for (int j = 0; j < 4; ++j) { v[j] = xr[64 * j]; s += (v[j][0] + v[j][1]) + (v[j][2] + v[j][3]); }
#pragma unroll
        for (int o = 1; o < 64; o <<= 1) s += __shfl_xor(s, o);
        const float mean = s * (1.f / 1024.f); float s2 = 0.f;
#pragma unroll
        for (int j = 0; j < 4; ++j) { v[j] = v[j] - mean; s2 += (v[j][0] * v[j][0] + v[j][1] * v[j][1]) + (v[j][2] * v[j][2] + v[j][3] * v[j][3]); }
#pragma unroll
        for (int o = 1; o < 64; o <<= 1) s2 += __shfl_xor(s2, o);
        const float rstd = 1.0f / sqrtf(s2 * (1.f / 1024.f) + 1e-5f);
#pragma unroll
        for (int j = 0; j < 4; ++j) {
            const int col = 4 * (lane + 64 * j);
            const f32x4 gg = *(const f32x4*)(g + col), bb = *(const f32x4*)(bta + col);
            const f32x4 o = v[j] * rstd * gg + bb;
            *(f32x4*)(Fout + (size_t)row * 1024 + col) = o;
            if (Bout) { u32x2 w; w.x = pk2(o[0], o[1]); w.y = pk2(o[2], o[3]); *(u32x2*)(Bout + (size_t)row * 1024 + col) = w; }
        }
    }
}

__device__ __forceinline__ void final_ln_phase(const bf16_t* Zb, const float* st, float* out, const float* g, const float* bta, int blk, int G, int wave) {
    const int lane = lane_id_v();
    for (int row0 = (blk * 8 + wave) * 4; row0 < T; row0 += G * 8 * 4) {
        u32x4 v[4][2];
#pragma unroll
        for (int rr = 0; rr < 4; ++rr)
#pragma unroll
            for (int j = 0; j < 2; ++j) v[rr][j] = *(const u32x4*)((const char*)Zb + ((unsigned)(row0 + rr) * 2048u + (unsigned)(8 * (lane + 64 * j)) * 2u));
#pragma unroll
        for (int rr = 0; rr < 4; ++rr) {
            const int row = row0 + rr;
            const RowCtx rc = ln_ctx(st, row);
#pragma unroll
            for (int j = 0; j < 2; ++j) {
                const int col = 8 * (lane + 64 * j);
                const f32x4 h0 = {bflo(v[rr][j].x), bfhi(v[rr][j].x), bflo(v[rr][j].y), bfhi(v[rr][j].y)}, h1 = {bflo(v[rr][j].z), bfhi(v[rr][j].z), bflo(v[rr][j].w), bfhi(v[rr][j].w)};
                float* op = out + (size_t)row * 1024 + col;
                *(f32x4*)op = (h0 - rc.mu) * rc.rstd * *(const f32x4*)(g + col) + *(const f32x4*)(bta + col);
                *(f32x4*)(op + 4) = (h1 - rc.mu) * rc.rstd * *(const f32x4*)(g + col + 4) + *(const f32x4*)(bta + col + 4);
            }
        }
    }
}

__device__ __forceinline__ void lam_coef(const float* lam_re, const float* lam_im, float dt, int idx, float& lbr, float& lbi, float& cr, float& ci) {
    const float lr = lam_re[idx], li = lam_im[idx];
    const float er = __expf(lr * dt);
    float ang = li * dt;
    const float kk = rintf(ang * 0.15915494309189535f);
    ang = fmaf(-kk, 6.2831854820251465f, ang); ang = fmaf(-kk, -1.7484555e-7f, ang);
    lbr = er * __cosf(ang); lbi = er * __sinf(ang);
    const float nr = lbr - 1.0f, ni = lbi, den = 1.0f / (lr * lr + li * li);
    cr = (nr * lr + ni * li) * den; ci = (ni * lr - nr * li) * den;
}
__device__ __forceinline__ void s5_phase(const Params& P, LAS unsigned char* lds, int blk, int G, int wave) {
    const int lane = lane_id_v(), l15 = lane & 15, quad = lane >> 4;
    LAS float* bu = (LAS float*)(lds + wave * 12800);
    LAS unsigned* sl = (LAS unsigned*)(lds + wave * 12800 + 8448);
    const bf16_t* PROJ = (const bf16_t*)(P.ws + OFF_BIG + BIG_PROJ);
    bf16_t* APRE = (bf16_t*)(P.ws + OFF_BIG + BIG_APRE);
    for (int vw = wave; blk + G * (vw >> 1) < 512; vw += 8) {
        const int item = blk + G * (vw >> 1), seg = vw & 1;
        const int b = item >> 5, g = item & 31;
        const int c_end = seg ? 129 : 65, c_out = seg ? 65 : 0;
        const float dt = __expf(P.in[5][g]);
        float lbr, lbi, cr_, ci_;
        lam_coef(P.in[3], P.in[4], dt, g * 64 + lane, lbr, lbi, cr_, ci_);
        bf16x8 bfrag[8];
#pragma unroll
        for (int tile = 0; tile < 8; ++tile) {
            const int comp = 16 * tile + l15, st = comp & 63, isim = comp >> 6;
            float a0, a1, cr, ci; lam_coef(P.in[3], P.in[4], dt, g * 64 + st, a0, a1, cr, ci);
            bf16x8 fr = {0, 0, 0, 0, 0, 0, 0, 0};
            if (quad < 2) {
                const float* bre = P.in[6] + (size_t)(g * 64 + st) * 16 + 8 * quad;
                const float* bim = P.in[7] + (size_t)(g * 64 + st) * 16 + 8 * quad;
#pragma unroll
                for (int j = 0; j < 8; ++j) { const float v = isim ? (cr * bim[j] + ci * bre[j]) : (cr * bre[j] - ci * bim[j]); fr[j] = (short)f2bf(v); }
            }
            bfrag[tile] = fr;
        }
        bf16x8 cfrag[4];
#pragma unroll
        for (int ks = 0; ks < 4; ++ks) {
#pragma unroll
            for (int j = 0; j < 8; ++j) {
                const int k = 32 * ks + 8 * quad + j, p = k >> 1;
                const float v = (k & 1) ? -P.in[9][(size_t)(g * 16 + l15) * 64 + p] : P.in[8][(size_t)(g * 16 + l15) * 64 + p];
                cfrag[ks][j] = (short)f2bf(v);
            }
        }
        const float dh = P.in[10][g * 16 + l15];
        float sr = 0.f, si = 0.f;
        const bf16x8 zero8 = {0, 0, 0, 0, 0, 0, 0, 0};
        bf16x8 ua_n = *(const bf16x8*)(PROJ + (size_t)(T + l15) * 2048 + g * 16 + 8 * (quad & 1));
        unsigned short ue_n[4];
#pragma unroll
        for (int r = 0; r < 4; ++r) ue_n[r] = PROJ[(size_t)(T + 4 * quad + r) * 2048 + g * 16 + l15];
        for (int chunk = 0; chunk < c_end; ++chunk) {
            const bool outp = chunk >= c_out;
            const int rowbase = chunk == 0 ? T : b * 2048 + (chunk - 1) * 16;
            const bf16x8 ua = quad < 2 ? ua_n : zero8;
            unsigned short ue[4];
#pragma unroll
            for (int r = 0; r < 4; ++r) ue[r] = ue_n[r];
            {
                const int cn = chunk + 1 < 129 ? chunk + 1 : 128;
                const int rbn = b * 2048 + (cn - 1) * 16;
                ua_n = *(const bf16x8*)(PROJ + (size_t)(rbn + l15) * 2048 + g * 16 + 8 * (quad & 1));
#pragma unroll
                for (int r = 0; r < 4; ++r) ue_n[r] = PROJ[(size_t)(rbn + 4 * quad + r) * 2048 + g * 16 + l15];
            }
#pragma unroll
            for (int tile = 0; tile < 8; ++tile) {
                f32x4 acc = {0.f, 0.f, 0.f, 0.f};
                acc = MFMA16(ua, bfrag[tile], acc);
#pragma unroll
                for (int r = 0; r < 4; ++r) bu[(4 * quad + r) * 132 + 16 * tile + l15] = acc[r];
            }
            LDS_WAIT();
            if (!outp) {
#pragma unroll
                for (int t = 0; t < 16; ++t) {
                    const float br = bu[t * 132 + lane], bi = bu[t * 132 + 64 + lane];
                    const float nsr = fmaf(lbr, sr, fmaf(-lbi, si, br)), nsi = fmaf(lbr, si, fmaf(lbi, sr, bi));
                    sr = nsr; si = nsi;
                }
                LDS_WAIT();
                continue;
            }
#pragma unroll
            for (int t = 0; t < 16; ++t) {
                const float br = bu[t * 132 + lane], bi = bu[t * 132 + 64 + lane];
                const float nsr = fmaf(lbr, sr, fmaf(-lbi, si, br)), nsi = fmaf(lbr, si, fmaf(lbi, sr, bi));
                sr = nsr; si = nsi;
                sl[t * 68 + lane] = pk2(sr, si);
            }
            LDS_WAIT();
            f32x4 y = {0.f, 0.f, 0.f, 0.f};
#pragma unroll
            for (int ks = 0; ks < 4; ++ks) {
                const bf16x8 sa = *(const LAS bf16x8*)((const LAS bf16_t*)sl + l15 * 136 + 32 * ks + 8 * quad);
                y = MFMA16(sa, cfrag[ks], y);
            }
            if (chunk > 0 || b == 0) {
#pragma unroll
                for (int r = 0; r < 4; ++r) {
                    const size_t row = (size_t)(rowbase + 4 * quad + r);
                    const float u = bf2f(ue[r]);
                    const float v = y[r] + dh * u;
                    const float a2 = 1.5957691216057308f * (v + 0.044715f * v * v * v);
                    APRE[row * 512 + g * 16 + l15] = f2bf(v * sigmoidf_(a2));
                }
            }
            LDS_WAIT();
        }
    }
}

template <bool MASKED>
__device__ __forceinline__ void attn_tile_sub(const LAS bf16_t* Kl, const LAS bf16_t* Vl, const bf16x8 (&qf)[4], int sub, int keybase  ,
                                              int iq, int l31, int h, bool pick0, f32x16& o0, f32x16& o1, float& Rrun) {
    bf16x8 ka[4];
#pragma unroll
    for (int s = 0; s < 4; ++s) ka[s] = *(const LAS bf16x8*)(Kl + (32 * sub + l31) * 72 + 16 * s + 8 * h);
    bf16x8 va[2][2];
#pragma unroll
    for (int s2 = 0; s2 < 2; ++s2)
#pragma unroll
        for (int mt = 0; mt < 2; ++mt) {
            const LAS bf16_t* vp = Vl + (32 * mt + l31) * 68 + 32 * sub + 16 * s2 + 4 * h;
            const s16x4 lo = *(const LAS s16x4*)vp, hi = *(const LAS s16x4*)(vp + 8);
            va[s2][mt] = __builtin_shufflevector(lo, hi, 0, 1, 2, 3, 4, 5, 6, 7);
        }
    __builtin_amdgcn_sched_barrier(0);
    f32x16 st;
#pragma unroll
    for (int i = 0; i < 16; ++i) st[i] = 0.f;
#pragma unroll
    for (int s = 0; s < 4; ++s) st = MFMA32(ka[s], qf[s], st);
    float kp[16], be[16];
#pragma unroll
    for (int i = 0; i < 16; ++i) {
        const float e = __builtin_amdgcn_exp2f(st[i]);
        float r = __builtin_amdgcn_rcpf(1.0f + e);
        if (MASKED) {
            const int kl = 32 * sub + (i & 3) + 8 * (i >> 2) + 4 * h;
            const bool vis = keybase >= 0 ? (keybase + kl < iq) : (kl < 16);
            r = vis ? r : 1.0f;
        }
        kp[i] = r; be[i] = 1.0f - r;
    }
    float ga[4], pa[4];
#pragma unroll
    for (int a = 0; a < 4; ++a) {
        ga[a] = (kp[4 * a] * kp[4 * a + 1]) * (kp[4 * a + 2] * kp[4 * a + 3]);
        const auto sw = __builtin_amdgcn_permlane32_swap(__float_as_uint(ga[a]), __float_as_uint(ga[a]), false, false);
        pa[a] = __uint_as_float(pick0 ? sw[0] : sw[1]);
    }
    float run = Rrun; float w[16];
#pragma unroll
    for (int a = 3; a >= 0; --a) {
        const float P3 = h ? run : run * pa[a];
        const float P2 = P3 * kp[4 * a + 3], P1 = P2 * kp[4 * a + 2], P0 = P1 * kp[4 * a + 1];
        w[4 * a + 3] = be[4 * a + 3] * P3; w[4 * a + 2] = be[4 * a + 2] * P2; w[4 * a + 1] = be[4 * a + 1] * P1; w[4 * a + 0] = be[4 * a + 0] * P0;
        run *= ga[a] * pa[a];
    }
    Rrun = run;
#pragma unroll
    for (int s2 = 0; s2 < 2; ++s2) {
        u32x4 pw; pw.x = pk2(w[8 * s2], w[8 * s2 + 1]); pw.y = pk2(w[8 * s2 + 2], w[8 * s2 + 3]); pw.z = pk2(w[8 * s2 + 4], w[8 * s2 + 5]); pw.w = pk2(w[8 * s2 + 6], w[8 * s2 + 7]);
        const bf16x8 pb = __builtin_bit_cast(bf16x8, pw);
        o0 = MFMA32(va[s2][0], pb, o0); o1 = MFMA32(va[s2][1], pb, o1);
    }
}
__device__ __forceinline__ void attn_phase(const Params& P, LAS unsigned char* lds, int blk, int G, int wave) {
    const int lane = lane_id_v(), tid = wave * 64 + lane, l31 = lane & 31, h = lane >> 5;
    const bf16_t* PROJ = (const bf16_t*)(P.ws + OFF_BIG + BIG_PROJ);
    bf16_t* CAT = (bf16_t*)(P.ws + OFF_BIG + BIG_CAT);
    if (blk == G - 1) {
        LAS float* wm = (LAS float*)(lds + 40960);
        if (tid < 128) {
            const int t = tid & 15, hd = tid >> 4;
            const bf16_t* qp = PROJ + (size_t)(T + t) * 2048 + 512 + hd * 64;
            float run = 1.f;
            for (int j = 15; j >= 0; --j) {
                float wv = 0.f;
                if (j < t) {
                    const bf16_t* kp = PROJ + (size_t)(T + j) * 2048 + 1024 + hd * 64;
                    float z = 0.f;
                    for (int d = 0; d < 64; ++d) z = fmaf(bf2f(qp[d]), bf2f(kp[d]), z);
                    const float r = __builtin_amdgcn_rcpf(1.0f + __builtin_amdgcn_exp2f(z));
                    wv = (1.0f - r) * run; run *= r;
                }
                wm[tid * 16 + j] = wv;
            }
        }
        __syncthreads();
        for (int idx = tid; idx < 16 * 512; idx += 512) {
            const int t = idx >> 9, c = idx & 511, hd = c >> 6;
            float o = 0.f;
            for (int j = 0; j < 16; ++j) o = fmaf(wm[(hd * 16 + t) * 16 + j], bf2f(PROJ[(size_t)(T + j) * 2048 + 1536 + c]), o);
            CAT[(size_t)(T + t) * 1024 + 512 + c] = f2bf(o);
        }
        __syncthreads();
    }
    bool pick0;
    { const auto hs = __builtin_amdgcn_permlane32_swap((unsigned)h, (unsigned)h, false, false); pick0 = hs[0] != (unsigned)h; }
    LAS bf16_t* Kl0 = (LAS bf16_t*)lds;
    LAS bf16_t* Vl0 = (LAS bf16_t*)(lds + 2 * 9216);
    const int lkey = tid >> 3, lpart = tid & 7;
    for (int j4 = 0; j4 < 4; ++j4) {
        const int item = blk + G * j4;
        if (item >= 1024) break;
        const int c = item % 256, jj = item / 256, bh = c >> 1, par = c & 1;
        const int qb = par == 0 ? (jj == 0 ? 7 : jj == 1 ? 0 : jj == 2 ? 4 : 3) : (jj == 0 ? 6 : jj == 1 ? 1 : jj == 2 ? 5 : 2);
        const int b = bh >> 3, hd = bh & 7;
        const int iq = 256 * qb + 32 * wave + l31;
        const size_t qrow = (size_t)b * 2048 + iq;
        bf16x8 qf[4];
#pragma unroll
        for (int s = 0; s < 4; ++s) qf[s] = *(const bf16x8*)(PROJ + qrow * 2048 + 512 + hd * 64 + 16 * s + 8 * h);
        f32x16 o0, o1;
#pragma unroll
        for (int i = 0; i < 16; ++i) { o0[i] = 0.f; o1[i] = 0.f; }
        float Rrun = 1.0f;
        const int nt = 4 * qb + 5;
        u32x4 kreg, vreg;
#define ATT_LOAD(it_) do { const int kt_ = 4 * qb + 3 - (it_); size_t row_; bool ok_ = true; \
            if (kt_ >= 0) row_ = (size_t)b * 2048 + 64 * kt_ + lkey; else { row_ = (size_t)T + lkey; ok_ = lkey < 16; } \
            if (ok_) { const bf16_t* p_ = PROJ + row_ * 2048 + 1024 + hd * 64 + lpart * 8; kreg = *(const u32x4*)p_; vreg = *(const u32x4*)(p_ + 512); } \
            else { kreg = (u32x4){0u, 0u, 0u, 0u}; vreg = kreg; } } while (0)
#define ATT_STORE(buf_) do { *(LAS u32x4*)(Kl0 + (buf_) * 4608 + lkey * 72 + lpart * 8) = kreg; \
            LAS bf16_t* vt_ = Vl0 + (buf_) * 4352 + (lpart * 8) * 68 + lkey; \
            vt_[0 * 68] = (bf16_t)(vreg.x & 0xffffu); vt_[1 * 68] = (bf16_t)(vreg.x >> 16); \
            vt_[2 * 68] = (bf16_t)(vreg.y & 0xffffu); vt_[3 * 68] = (bf16_t)(vreg.y >> 16); \
            vt_[4 * 68] = (bf16_t)(vreg.z & 0xffffu); vt_[5 * 68] = (bf16_t)(vreg.z >> 16); \
            vt_[6 * 68] = (bf16_t)(vreg.w & 0xffffu); vt_[7 * 68] = (bf16_t)(vreg.w >> 16); } while (0)
        ATT_LOAD(0); ATT_STORE(0);
        __syncthreads();
        int cur = 0;
        bool wdone = false;
        LAS unsigned* dflag = (LAS unsigned*)(lds + 36864);
        for (int it = 0; it < nt; ++it) {
            if (it + 1 < nt) ATT_LOAD(it + 1);
            const int kt = 4 * qb + 3 - it;
            const int keybase = kt >= 0 ? 64 * kt : -1;
            const int wq_end = 256 * qb + 32 * wave + 32;
            const LAS bf16_t* Kl = Kl0 + cur * 4608; const LAS bf16_t* Vl = Vl0 + cur * 4352;
            if (wdone) {}
            else if (kt < 0) { attn_tile_sub<true>(Kl, Vl, qf, 0, -1, iq, l31, h, pick0, o0, o1, Rrun); }
            else {
                const int wq_beg = wq_end - 32;
                if (keybase + 64 <= wq_beg) { attn_tile_sub<false>(Kl, Vl, qf, 1, keybase, iq, l31, h, pick0, o0, o1, Rrun); attn_tile_sub<false>(Kl, Vl, qf, 0, keybase, iq, l31, h, pick0, o0, o1, Rrun); }
                else {
                    if (keybase + 32 < wq_end) attn_tile_sub<true>(Kl, Vl, qf, 1, keybase, iq, l31, h, pick0, o0, o1, Rrun);
                    if (keybase < wq_end) attn_tile_sub<true>(Kl, Vl, qf, 0, keybase, iq, l31, h, pick0, o0, o1, Rrun);
                }
            }
            if (it + 1 < nt) ATT_STORE(cur ^ 1);
            wdone = __builtin_amdgcn_ballot_w64(Rrun >= 9.094947e-13f) == 0ull;
            if (lane == 0) dflag[(it & 1) * 8 + wave] = wdone ? 1u : 0u;
            __syncthreads();
            cur ^= 1;
            { const u32x4 f0 = *(const LAS u32x4*)(dflag + (it & 1) * 8), f1 = *(const LAS u32x4*)(dflag + (it & 1) * 8 + 4);
              if ((f0.x & f0.y & f0.z & f0.w & f1.x & f1.y & f1.z & f1.w) != 0u) break; }
        }
        bf16_t* op = CAT + qrow * 1024 + 512 + hd * 64;
#pragma unroll
        for (int a = 0; a < 4; ++a) {
            u32x2 w0; w0.x = pk2(o0[4 * a], o0[4 * a + 1]); w0.y = pk2(o0[4 * a + 2], o0[4 * a + 3]);
            u32x2 w1; w1.x = pk2(o1[4 * a], o1[4 * a + 1]); w1.y = pk2(o1[4 * a + 2], o1[4 * a + 3]);
            *(u32x2*)(op + 8 * a + 4 * h) = w0; *(u32x2*)(op + 32 + 8 * a + 4 * h) = w1;
        }
    }
}

__device__ __forceinline__ void meta_attn(const Params& P, LAS unsigned char* lds, int blk, int G, int wave) {
    const int hd = G - 1 - blk;
    if (hd < 0 || hd >= 8) return;
    const int lane = lane_id_v(), tid = wave * 64 + lane;
    const bf16_t* PROJ = (const bf16_t*)(P.ws + OFF_BIG + BIG_PROJ);
    bf16_t* CAT = (bf16_t*)(P.ws + OFF_BIG + BIG_CAT);
    LAS float* zz = (LAS float*)(lds + 40960);
    if (tid < 256) {
        const int t = tid >> 4, j = tid & 15;
        const u32x4* qp = (const u32x4*)(PROJ + (size_t)(T + t) * 2048 + 512 + hd * 64);
        const u32x4* kp = (const u32x4*)(PROJ + (size_t)(T + j) * 2048 + 1024 + hd * 64);
        float z = 0.f;
#pragma unroll
        for (int c = 0; c < 8; ++c) { const u32x4 a = qp[c], k = kp[c];
            z += bflo(a.x) * bflo(k.x) + bfhi(a.x) * bfhi(k.x) + bflo(a.y) * bflo(k.y) + bfhi(a.y) * bfhi(k.y) + bflo(a.z) * bflo(k.z) + bfhi(a.z) * bfhi(k.z) + bflo(a.w) * bflo(k.w) + bfhi(a.w) * bfhi(k.w); }
        zz[t * 16 + j] = z;
    }
    __syncthreads();
    if (tid < 16) {
        const int t = tid; float run = 1.f;
        for (int j = 15; j >= 0; --j) {
            float wv = 0.f;
            if (j < t) { const float r = __builtin_amdgcn_rcpf(1.0f + __builtin_amdgcn_exp2f(zz[t * 16 + j])); wv = (1.0f - r) * run; run *= r; }
            zz[t * 16 + j] = wv;
        }
    }
    __syncthreads();
    for (int idx = tid; idx < 16 * 64; idx += 512) {
        const int t = idx >> 6, d = idx & 63;
        float o = 0.f;
#pragma unroll
        for (int j = 0; j < 16; ++j) o = fmaf(zz[t * 16 + j], bf2f(PROJ[(size_t)(T + j) * 2048 + 1536 + hd * 64 + d]), o);
        CAT[(size_t)(T + t) * 1024 + 512 + hd * 64 + d] = f2bf(o);
    }
    __syncthreads();
}
template <bool MASKED>
__device__ __forceinline__ void attn_sub_reg(const bf16x8 (&ka)[4], const LAS bf16_t* Vl  , const bf16x8 (&qf)[4], int keybase  ,
                                             int iq, int l31, int h, bool pick0, f32x16& o0, f32x16& o1, float& Rrun) {
    bf16x8 va[2][2];
#pragma unroll
    for (int s2 = 0; s2 < 2; ++s2)
#pragma unroll
        for (int mt = 0; mt < 2; ++mt) {
            const LAS bf16_t* vp = Vl + (32 * mt + l31) * 36 + 16 * s2 + 4 * h;
            const s16x4 lo = *(const LAS s16x4*)vp, hi = *(const LAS s16x4*)(vp + 8);
            va[s2][mt] = __builtin_shufflevector(lo, hi, 0, 1, 2, 3, 4, 5, 6, 7);
        }
    f32x16 st;
#pragma unroll
    for (int i = 0; i < 16; ++i) st[i] = 0.f;
#pragma unroll
    for (int s = 0; s < 4; ++s) st = MFMA32(ka[s], qf[s], st);
    float kp[16], be[16];
#pragma unroll
    for (int i = 0; i < 16; ++i) {
        const float e = __builtin_amdgcn_exp2f(st[i]);
        float r = __builtin_amdgcn_rcpf(1.0f + e);
        if (MASKED) {
            const int kl = (i & 3) + 8 * (i >> 2) + 4 * h;
            const bool vis = keybase >= 0 ? (keybase + kl < iq) : (kl < 16);
            r = vis ? r : 1.0f;
        }
        kp[i] = r; be[i] = 1.0f - r;
    }
    float ga[4], pa[4];
#pragma unroll
    for (int a = 0; a < 4; ++a) {
        ga[a] = (kp[4 * a] * kp[4 * a + 1]) * (kp[4 * a + 2] * kp[4 * a + 3]);
        const auto sw = __builtin_amdgcn_permlane32_swap(__float_as_uint(ga[a]), __float_as_uint(ga[a]), false, false);
        pa[a] = __uint_as_float(pick0 ? sw[0] : sw[1]);
    }
    float run = Rrun; float w[16];
#pragma unroll
    for (int a = 3; a >= 0; --a) {
        const float P3 = h ? run : run * pa[a];
        const float P2 = P3 * kp[4 * a + 3], P1 = P2 * kp[4 * a + 2], P0 = P1 * kp[4 * a + 1];
        w[4 * a + 3] = be[4 * a + 3] * P3; w[4 * a + 2] = be[4 * a + 2] * P2; w[4 * a + 1] = be[4 * a + 1] * P1; w[4 * a + 0] = be[4 * a + 0] * P0;
        run *= ga[a] * pa[a];
    }
    Rrun = run;
#pragma unroll
    for (int s2 = 0; s2 < 2; ++s2) {
        u32x4 pw; pw.x = pk2(w[8 * s2], w[8 * s2 + 1]); pw.y = pk2(w[8 * s2 + 2], w[8 * s2 + 3]); pw.z = pk2(w[8 * s2 + 4], w[8 * s2 + 5]); pw.w = pk2(w[8 * s2 + 6], w[8 * s2 + 7]);
        const bf16x8 pb = __builtin_bit_cast(bf16x8, pw);
        o0 = MFMA32(va[s2][0], pb, o0); o1 = MFMA32(va[s2][1], pb, o1);
    }
}
__device__ __forceinline__ void attn_phase2(const Params& P, LAS unsigned char* lds, int blk, int G, int wave) {
    const int lane = lane_id_v(), tid = wave * 64 + lane, l31 = lane & 31, h = lane >> 5;
    const bf16_t* PROJ = (const bf16_t*)(P.ws + OFF_BIG + BIG_PROJ);
    bf16_t* CAT = (bf16_t*)(P.ws + OFF_BIG + BIG_CAT);
    meta_attn(P, lds, blk, G, wave);
    bool pick0;
    { const auto hs = __builtin_amdgcn_permlane32_swap((unsigned)h, (unsigned)h, false, false); pick0 = hs[0] != (unsigned)h; }
    LAS bf16_t* Vl = (LAS bf16_t*)(lds + wave * 4608);
    const int kp_ = lane & 15, dg = lane >> 4;
    for (int u = blk * 8 + wave; u < 8192; u += G * 8) {
        const int q32 = 63 - (u >> 7), bh = u & 127, b = bh >> 3, hd = bh & 7;
        const int iq = 32 * q32 + l31;
        const size_t qrow = (size_t)b * 2048 + iq;
        bf16x8 qf[4];
#pragma unroll
        for (int s = 0; s < 4; ++s) qf[s] = *(const bf16x8*)(PROJ + qrow * 2048 + 512 + hd * 64 + 16 * s + 8 * h);
        f32x16 o0, o1;
#pragma unroll
        for (int i = 0; i < 16; ++i) { o0[i] = 0.f; o1[i] = 0.f; }
        float Rrun = 1.0f;
        bf16x8 kn[4]; u32x4 vn[2][2];
#define A2_LOAD(st_) do { const size_t krow_ = (st_) >= 0 ? (size_t)b * 2048 + 32 * (st_) + l31 : (size_t)T + (l31 & 15); \
            const bf16_t* kp2_ = PROJ + krow_ * 2048 + 1024 + hd * 64 + 8 * h; \
            _Pragma("unroll") for (int s_ = 0; s_ < 4; ++s_) kn[s_] = *(const bf16x8*)(kp2_ + 16 * s_); \
            _Pragma("unroll") for (int e_ = 0; e_ < 2; ++e_) { const size_t vrow_ = (st_) >= 0 ? (size_t)b * 2048 + 32 * (st_) + 2 * kp_ + e_ : (size_t)T + ((2 * kp_ + e_) & 15); \
                const bf16_t* vp2_ = PROJ + vrow_ * 2048 + 1536 + hd * 64 + 16 * dg; vn[e_][0] = *(const u32x4*)vp2_; vn[e_][1] = *(const u32x4*)(vp2_ + 8); } } while (0)
        A2_LOAD(q32);
        for (int st = q32; st >= -1; --st) {
            bf16x8 ka[4]; u32x4 vc[2][2];
#pragma unroll
            for (int s = 0; s < 4; ++s) ka[s] = kn[s];
#pragma unroll
            for (int e = 0; e < 2; ++e) { vc[e][0] = vn[e][0]; vc[e][1] = vn[e][1]; }
            if (st > -1) A2_LOAD(st - 1);
#pragma unroll
            for (int half = 0; half < 2; ++half) {
                const unsigned a0[4] = {vc[0][half].x, vc[0][half].y, vc[0][half].z, vc[0][half].w}, a1[4] = {vc[1][half].x, vc[1][half].y, vc[1][half].z, vc[1][half].w};
#pragma unroll
                for (int i = 0; i < 4; ++i) {
                    const int d = 16 * dg + 8 * half + 2 * i;
                    *(LAS unsigned*)(Vl + d * 36 + 2 * kp_) = (a0[i] & 0xffffu) | (a1[i] << 16);
                    *(LAS unsigned*)(Vl + (d + 1) * 36 + 2 * kp_) = (a0[i] >> 16) | (a1[i] & 0xffff0000u);
                }
            }
            LDS_WAIT();
            if (st == q32 || st < 0) attn_sub_reg<true>(ka, Vl, qf, st >= 0 ? 32 * st : -1, iq, l31, h, pick0, o0, o1, Rrun);
            else attn_sub_reg<false>(ka, Vl, qf, 32 * st, iq, l31, h, pick0, o0, o1, Rrun);
            if (__builtin_amdgcn_ballot_w64(Rrun >= 9.094947e-13f) == 0ull) break;
        }
        bf16_t* op = CAT + qrow * 1024 + 512 + hd * 64;
#pragma unroll
        for (int a = 0; a < 4; ++a) {
            u32x2 w0; w0.x = pk2(o0[4 * a], o0[4 * a + 1]); w0.y = pk2(o0[4 * a + 2], o0[4 * a + 3]);
            u32x2 w1; w1.x = pk2(o1[4 * a], o1[4 * a + 1]); w1.y = pk2(o1[4 * a + 2], o1[4 * a + 3]);
            *(u32x2*)(op + 8 * a + 4 * h) = w0; *(u32x2*)(op + 32 + 8 * a + 4 * h) = w1;
        }
    }
    __syncthreads();
}

__device__ __forceinline__ void hgrn_phase(const Params& P, LAS unsigned char* lds, int blk, int G, int wave) {
    const int lane = lane_id_v(), tid = wave * 64 + lane, l15 = lane & 15, quad = lane >> 4;
    LAS bf16_t* qd = (LAS bf16_t*)lds;
    LAS bf16_t* kd = qd + 64 * 136;
    LAS bf16_t* klT = kd + 64 * 136;
    LAS bf16_t* vT = klT + 128 * 72;
    LAS bf16_t* sc = vT + 128 * 72;
    LAS float* ebl = (LAS float*)(sc + 64 * 72);
    LAS float* segtot = ebl + 128;
    LAS float* red = segtot + 1024;
    const unsigned short* PC = (const unsigned short*)(P.ws + OFF_BIG);
    bf16_t* MIXC = (bf16_t*)P.out;
    const float* ng = P.in[16];
    for (int item = blk; item < 128; item += G) {
        const int b = item >> 3, hd = item & 7;
        f32x4 Sacc[8];
#pragma unroll
        for (int i = 0; i < 8; ++i) Sacc[i] = (f32x4){0.f, 0.f, 0.f, 0.f};
        const int dp = tid & 63, sg = tid >> 6;
        unsigned lfc[8], qc[8], vc[8];
#define HG_OFF0(cc_) ((unsigned)((cc_) > 0 ? b * 2048 + ((cc_) - 1) * 64 + 8 * sg : (sg >= 6 ? T + 8 * (sg - 6) : (int)((OFF_ZROW - OFF_BIG) / 8192))) * 8192u + (unsigned)(hd * 128 + 2 * dp) * 2u)
#define HG_LOAD(cc_, LF_, Q_, V_) do { const unsigned o0_ = HG_OFF0(cc_); _Pragma("unroll") for (int tt_ = 0; tt_ < 8; ++tt_) { const unsigned o_ = o0_ + (unsigned)tt_ * 8192u; \
            Q_[tt_] = *(const unsigned*)((const char*)PC + o_); LF_[tt_] = *(const unsigned*)((const char*)PC + o_ + 2048u); V_[tt_] = *(const unsigned*)((const char*)PC + o_ + 4096u); } } while (0)
        HG_LOAD(0, lfc, qc, vc);
        if (tid < 64) red[tid] = 0.f;
        for (int c = 0; c < 33; ++c) {
            unsigned lfn[8], qn[8], vn[8];
            { const int cn = c + 1 < 33 ? c + 1 : 32; HG_LOAD(cn, lfn, qn, vn); }
            {
                float cs0[8], cs1[8]; float run0 = 0.f, run1 = 0.f;
#pragma unroll
                for (int tt = 0; tt < 8; ++tt) {
                    const float l0 = 1.4426950408889634f * (float)__builtin_bit_cast(_Float16, (unsigned short)(lfc[tt] & 0xffffu));
                    const float l1 = 1.4426950408889634f * (float)__builtin_bit_cast(_Float16, (unsigned short)(lfc[tt] >> 16));
                    run0 += l0; run1 += l1; cs0[tt] = run0; cs1[tt] = run1;
                }
                segtot[sg * 128 + 2 * dp] = run0; segtot[sg * 128 + 2 * dp + 1] = run1;
                __syncthreads();
                if (tid < 64) red[((c + 1) & 1) * 64 + tid] = 0.f;
                float off0 = 0.f, off1 = 0.f, bl0 = 0.f, bl1 = 0.f;
#pragma unroll
                for (int s2 = 0; s2 < 8; ++s2) {
                    const float a0 = segtot[s2 * 128 + 2 * dp], a1 = segtot[s2 * 128 + 2 * dp + 1];
                    bl0 += a0; bl1 += a1; if (s2 < sg) { off0 += a0; off1 += a1; }
                }
                const float ebl0 = __builtin_amdgcn_exp2f(bl0), ebl1 = __builtin_amdgcn_exp2f(bl1);
                if (sg == 7) { ebl[2 * dp] = ebl0; ebl[2 * dp + 1] = ebl1; }
                float eip0 = __builtin_amdgcn_exp2f(-off0), eip1 = __builtin_amdgcn_exp2f(-off1);
                unsigned kl0[4], kl1[4], v0[4], v1[4];
#pragma unroll
                for (int tp = 0; tp < 4; ++tp) {
                    float klv0[2], klv1[2];
#pragma unroll
                    for (int e = 0; e < 2; ++e) {
                        const int tt = 2 * tp + e, t = 8 * sg + tt;
                        const float bt0 = off0 + cs0[tt], bt1 = off1 + cs1[tt];
                        const float q0 = bflo(qc[tt]), q1 = bfhi(qc[tt]);
                        const float eb0 = __builtin_amdgcn_exp2f(bt0), eb1 = __builtin_amdgcn_exp2f(bt1);
                        const float ei0 = __builtin_amdgcn_rcpf(eb0), ei1 = __builtin_amdgcn_rcpf(eb1);
                        const float k0 = 1.0f - eb0 * eip0, k1 = 1.0f - eb1 * eip1;
                        eip0 = ei0; eip1 = ei1;
                        const float kd0 = k0 * ei0, kd1 = k1 * ei1;
                        *(LAS unsigned*)(qd + t * 136 + 2 * dp) = pk2(q0 * eb0, q1 * eb1);
                        *(LAS unsigned*)(kd + t * 136 + 2 * dp) = pk2(kd0, kd1);
                        klv0[e] = kd0 * ebl0; klv1[e] = kd1 * ebl1;
                    }
                    kl0[tp] = pk2(klv0[0], klv0[1]); kl1[tp] = pk2(klv1[0], klv1[1]);
                    const unsigned va = vc[2 * tp], vb = vc[2 * tp + 1];
                    v0[tp] = (va & 0xffffu) | (vb << 16); v1[tp] = (va >> 16) | (vb & 0xffff0000u);
                }
                *(LAS u32x4*)(klT + (2 * dp) * 72 + 8 * sg) = (u32x4){kl0[0], kl0[1], kl0[2], kl0[3]};
                *(LAS u32x4*)(klT + (2 * dp + 1) * 72 + 8 * sg) = (u32x4){kl1[0], kl1[1], kl1[2], kl1[3]};
                *(LAS u32x4*)(vT + (2 * dp) * 72 + 8 * sg) = (u32x4){v0[0], v0[1], v0[2], v0[3]};
                *(LAS u32x4*)(vT + (2 * dp + 1) * 72 + 8 * sg) = (u32x4){v1[0], v1[1], v1[2], v1[3]};
            }
            __syncthreads();
            f32x4 oacc[4];
#pragma unroll
            for (int i = 0; i < 4; ++i) oacc[i] = (f32x4){0.f, 0.f, 0.f, 0.f};
#pragma unroll
            for (int kh = 0; kh < 2; ++kh) {
                s16x4 alo[2][4], ahi[2][4];
#pragma unroll
                for (int k2 = 0; k2 < 2; ++k2)
#pragma unroll
                    for (int tt = 0; tt < 4; ++tt) { const LAS bf16_t* ap = qd + (16 * tt + l15) * 136 + 32 * (2 * kh + k2) + 4 * quad; alo[k2][tt] = *(const LAS s16x4*)ap; ahi[k2][tt] = *(const LAS s16x4*)(ap + 16); }
                __builtin_amdgcn_sched_barrier(0);
#pragma unroll
                for (int k2 = 0; k2 < 2; ++k2) {
                    const int ks = 2 * kh + k2;
                    u32x4 sw; sw.x = pk2(Sacc[2 * ks][0], Sacc[2 * ks][1]); sw.y = pk2(Sacc[2 * ks][2], Sacc[2 * ks][3]);
                    sw.z = pk2(Sacc[2 * ks + 1][0], Sacc[2 * ks + 1][1]); sw.w = pk2(Sacc[2 * ks + 1][2], Sacc[2 * ks + 1][3]);
                    const bf16x8 sb = __builtin_bit_cast(bf16x8, sw);
#pragma unroll
                    for (int tt = 0; tt < 4; ++tt) oacc[tt] = MFMA16(__builtin_shufflevector(alo[k2][tt], ahi[k2][tt], 0, 1, 2, 3, 4, 5, 6, 7), sb, oacc[tt]);
                }
                __builtin_amdgcn_sched_barrier(0);
            }
#pragma unroll
            for (int e = 0; e < 2; ++e) {
                const int tile = 2 * wave + e, tt = tile >> 2, ss = tile & 3;
                bf16x8 fa[4], fb[4];
#pragma unroll
                for (int ks = 0; ks < 4; ++ks) { fa[ks] = *(const LAS bf16x8*)(qd + (16 * tt + l15) * 136 + 32 * ks + 8 * quad); fb[ks] = *(const LAS bf16x8*)(kd + (16 * ss + l15) * 136 + 32 * ks + 8 * quad); }
                __builtin_amdgcn_sched_barrier(0);
                f32x4 sa = {0.f, 0.f, 0.f, 0.f};
#pragma unroll
                for (int ks = 0; ks < 4; ++ks) sa = MFMA16(fa[ks], fb[ks], sa);
#pragma unroll
                for (int r = 0; r < 4; ++r) { const int tg = 16 * tt + 4 * quad + r, sg_ = 16 * ss + l15; sc[tg * 72 + sg_] = f2bf(sg_ <= tg ? sa[r] : 0.f); }
                __builtin_amdgcn_sched_barrier(0);
            }
            __syncthreads();
            unsigned short gr[16];
            {
                const int cg_ = c > 0 ? c : 1;
#pragma unroll
                for (int tt = 0; tt < 4; ++tt)
#pragma unroll
                    for (int r = 0; r < 4; ++r) gr[4 * tt + r] = *(const unsigned short*)((const char*)PC + ((unsigned)(b * 2048 + (cg_ - 1) * 64 + 16 * tt + 4 * quad + r) * 8192u + (unsigned)(3072 + hd * 128 + 16 * wave + l15) * 2u));
            }
            {
#pragma unroll
                for (int dt = 0; dt < 8; ++dt) Sacc[dt] *= *(const LAS f32x4*)(ebl + 16 * dt + 4 * quad);
                __builtin_amdgcn_sched_barrier(0);
#pragma unroll
                for (int ks = 0; ks < 2; ++ks) {
                    bf16x8 fsc[4], fkl[8];
                    const bf16x8 vb = *(const LAS bf16x8*)(vT + (16 * wave + l15) * 72 + 32 * ks + 8 * quad);
#pragma unroll
                    for (int tt = 0; tt < 4; ++tt) fsc[tt] = *(const LAS bf16x8*)(sc + (16 * tt + l15) * 72 + 32 * ks + 8 * quad);
#pragma unroll
                    for (int dt = 0; dt < 8; ++dt) fkl[dt] = *(const LAS bf16x8*)(klT + (16 * dt + l15) * 72 + 32 * ks + 8 * quad);
                    __builtin_amdgcn_sched_barrier(0);
#pragma unroll
                    for (int tt = 0; tt < 4; ++tt) oacc[tt] = MFMA16(fsc[tt], vb, oacc[tt]);
#pragma unroll
                    for (int dt = 0; dt < 8; ++dt) Sacc[dt] = MFMA16(fkl[dt], vb, Sacc[dt]);
                    __builtin_amdgcn_sched_barrier(0);
                }
            }
#pragma unroll
            for (int tt = 0; tt < 4; ++tt)
#pragma unroll
                for (int r = 0; r < 4; ++r) {
                    float sq = oacc[tt][r] * oacc[tt][r];
                    sq += __int_as_float(__builtin_amdgcn_update_dpp(0, __float_as_int(sq), 0xB1, 0xf, 0xf, false));
                    sq += __int_as_float(__builtin_amdgcn_update_dpp(0, __float_as_int(sq), 0x4E, 0xf, 0xf, false));
                    sq += __int_as_float(__builtin_amdgcn_update_dpp(0, __float_as_int(sq), 0x141, 0xf, 0xf, false));
                    sq += __int_as_float(__builtin_amdgcn_update_dpp(0, __float_as_int(sq), 0x140, 0xf, 0xf, false));
                    if (l15 == 0) __hip_atomic_fetch_add(red + (c & 1) * 64 + 16 * tt + 4 * quad + r, sq, __ATOMIC_RELAXED, __HIP_MEMORY_SCOPE_WORKGROUP);
                }
            __syncthreads();
            if (c > 0) {
                const int dvg = hd * 128 + 16 * wave + l15;
                const float gn = ng[dvg];
#pragma unroll
                for (int tt = 0; tt < 4; ++tt)
#pragma unroll
                    for (int r = 0; r < 4; ++r) {
                        const int t = 16 * tt + 4 * quad + r;
                        const float ssum = red[(c & 1) * 64 + t];
                        const float rs = __builtin_amdgcn_rsqf(ssum * (1.0f / 128.0f) + 1e-6f);
                        const unsigned moff = (unsigned)(b * 2048 + (c - 1) * 64 + t) * 2048u + (unsigned)dvg * 2u;
                        const float gv = bf2f(gr[4 * tt + r]);
                        *(bf16_t*)((char*)MIXC + moff) = f2bf(oacc[tt][r] * rs * gn * gv * __builtin_amdgcn_rcpf(1.0f + __builtin_amdgcn_exp2f(-1.4426950408889634f * gv)));
                    }
            }
#pragma unroll
            for (int i = 0; i < 8; ++i) { lfc[i] = lfn[i]; qc[i] = qn[i]; vc[i] = vn[i]; }
        }
        __syncthreads();
    }
}

constexpr size_t HG_QDX_OFF = 67108864;
constexpr size_t HG_KLX = 0, HG_SCX = 67108864, HG_EBX = HG_SCX + 33554432, HG_META = HG_EBX + 2097152;
__device__ __forceinline__ void hgrn_prep_phase(const Params& P, LAS unsigned char* lds, int blk, int G, int wave) {
    const int lane = lane_id_v(), tid = wave * 64 + lane, l15 = lane & 15, quad = lane >> 4;
    LAS bf16_t* qd = (LAS bf16_t*)lds;
    LAS bf16_t* kd = qd + 64 * 136;
    LAS bf16_t* sc = kd + 64 * 136;
    LAS float* segtot = (LAS float*)(sc + 64 * 72);
    const unsigned short* PC = (const unsigned short*)(P.ws + OFF_BIG);
    char* ZR = (char*)(P.ws + OFF_Z);
    char* QDX = (char*)P.out + HG_QDX_OFF;
    const int dp = tid & 63, sg = tid >> 6;
    constexpr int NIT = 4096 + 8;
#define H1_DEC(it_, b_, hd_, c_) const int b_ = (it_) < 4096 ? (it_) >> 8 : 0, hd_ = (it_) < 4096 ? ((it_) >> 5) & 7 : (it_) - 4096, c_ = (it_) < 4096 ? ((it_) & 31) + 1 : 0
#define H1_OFF0(b_, hd_, c_) ((unsigned)((c_) > 0 ? (b_) * 2048 + ((c_) - 1) * 64 + 8 * sg : T + (sg >= 6 ? 8 * (sg - 6) : 0)) * 8192u + (unsigned)((hd_) * 128 + 2 * dp) * 2u)
#define H1_LOAD(it_, LF_, Q_) do { H1_DEC(it_, b__, hd__, c__); const unsigned o0_ = H1_OFF0(b__, hd__, c__); _Pragma("unroll") for (int tt_ = 0; tt_ < 8; ++tt_) { const unsigned o_ = o0_ + (unsigned)tt_ * 8192u; \
            Q_[tt_] = *(const unsigned*)((const char*)PC + o_); LF_[tt_] = *(const unsigned*)((const char*)PC + o_ + 2048u); } } while (0)
    unsigned lfc[8], qc[8];
    if (blk < NIT) H1_LOAD(blk, lfc, qc);
    for (int it = blk; it < NIT; it += G) {
        H1_DEC(it, b, hd, c);
        (void)b;
        unsigned lfn[8], qn[8];
        { const int itn = it + G < NIT ? it + G : it; H1_LOAD(itn, lfn, qn); }
        char *gQD, *gKL, *gSC, *gEB;
        if (c > 0) { const unsigned ix = (unsigned)(it >> 5) * 32u + (unsigned)(it & 31); gQD = QDX + (size_t)ix * 16384; gKL = ZR + HG_KLX + (size_t)ix * 16384; gSC = ZR + HG_SCX + (size_t)ix * 8192; gEB = ZR + HG_EBX + (size_t)ix * 512; }
        else { char* mb = ZR + HG_META + (size_t)hd * 41472; gQD = mb; gKL = mb + 16384; gSC = mb + 32768; gEB = mb + 40960; }
        {
            float cs0[8], cs1[8]; float run0 = 0.f, run1 = 0.f;
#pragma unroll
            for (int tt = 0; tt < 8; ++tt) {
                const bool ok = c > 0 || (8 * sg + tt) >= 48;
                const float l0 = ok ? 1.4426950408889634f * (float)__builtin_bit_cast(_Float16, (unsigned short)(lfc[tt] & 0xffffu)) : 0.f;
                const float l1 = ok ? 1.4426950408889634f * (float)__builtin_bit_cast(_Float16, (unsigned short)(lfc[tt] >> 16)) : 0.f;
                run0 += l0; run1 += l1; cs0[tt] = run0; cs1[tt] = run1;
            }
            segtot[sg * 128 + 2 * dp] = run0; segtot[sg * 128 + 2 * dp + 1] = run1;
            __syncthreads();
            float off0 = 0.f, off1 = 0.f, bl0 = 0.f, bl1 = 0.f;
#pragma unroll
            for (int s2 = 0; s2 < 8; ++s2) {
                const float a0 = segtot[s2 * 128 + 2 * dp], a1 = segtot[s2 * 128 + 2 * dp + 1];
                bl0 += a0; bl1 += a1; if (s2 < sg) { off0 += a0; off1 += a1; }
            }
            const float ebl0 = __builtin_amdgcn_exp2f(bl0), ebl1 = __builtin_amdgcn_exp2f(bl1);
            if (sg == 7) { *(float*)(gEB + (2 * dp) * 4) = ebl0; *(float*)(gEB + (2 * dp + 1) * 4) = ebl1; }
            float eip0 = __builtin_amdgcn_exp2f(-off0), eip1 = __builtin_amdgcn_exp2f(-off1);
            unsigned kl0[4], kl1[4];
#pragma unroll
            for (int tp = 0; tp < 4; ++tp) {
                float klv0[2], klv1[2];
#pragma unroll
                for (int e = 0; e < 2; ++e) {
                    const int tt = 2 * tp + e, t = 8 * sg + tt;
                    const bool ok = c > 0 || t >= 48;
                    const float bt0 = off0 + cs0[tt], bt1 = off1 + cs1[tt];
                    const float q0 = ok ? bflo(qc[tt]) : 0.f, q1 = ok ? bfhi(qc[tt]) : 0.f;
                    const float eb0 = __builtin_amdgcn_exp2f(bt0), eb1 = __builtin_amdgcn_exp2f(bt1);
                    const float ei0 = __builtin_amdgcn_rcpf(eb0), ei1 = __builtin_amdgcn_rcpf(eb1);
                    const float k0 = 1.0f - eb0 * eip0, k1 = 1.0f - eb1 * eip1;
                    eip0 = ei0; eip1 = ei1;
                    const float kd0 = k0 * ei0, kd1 = k1 * ei1;
                    const unsigned qw = pk2(q0 * eb0, q1 * eb1);
                    *(LAS unsigned*)(qd + t * 136 + 2 * dp) = qw;
                    *(unsigned*)(gQD + (unsigned)(t * 128 + 2 * dp) * 2u) = qw;
                    *(LAS unsigned*)(kd + t * 136 + 2 * dp) = pk2(kd0, kd1);
                    klv0[e] = kd0 * ebl0; klv1[e] = kd1 * ebl1;
                }
                kl0[tp] = pk2(klv0[0], klv0[1]); kl1[tp] = pk2(klv1[0], klv1[1]);
            }
            *(u32x4*)(gKL + (unsigned)((2 * dp) * 64 + 8 * sg) * 2u) = (u32x4){kl0[0], kl0[1], kl0[2], kl0[3]};
            *(u32x4*)(gKL + (unsigned)((2 * dp + 1) * 64 + 8 * sg) * 2u) = (u32x4){kl1[0], kl1[1], kl1[2], kl1[3]};
        }
        __syncthreads();
#pragma unroll
        for (int e = 0; e < 2; ++e) {
            const int tile = 2 * wave + e, tt = tile >> 2, ss = tile & 3;
            bf16x8 fa[4], fb[4];
#pragma unroll
            for (int ks = 0; ks < 4; ++ks) { fa[ks] = *(const LAS bf16x8*)(qd + (16 * tt + l15) * 136 + 32 * ks + 8 * quad); fb[ks] = *(const LAS bf16x8*)(kd + (16 * ss + l15) * 136 + 32 * ks + 8 * quad); }
            __builtin_amdgcn_sched_barrier(0);
            f32x4 sa = {0.f, 0.f, 0.f, 0.f};
#pragma unroll
            for (int ks = 0; ks < 4; ++ks) sa = MFMA16(fa[ks], fb[ks], sa);
#pragma unroll
            for (int r = 0; r < 4; ++r) { const int tg = 16 * tt + 4 * quad + r, sg_ = 16 * ss + l15; sc[tg * 72 + sg_] = f2bf(sg_ <= tg ? sa[r] : 0.f); }
            __builtin_amdgcn_sched_barrier(0);
        }
        __syncthreads();
        { const int row = tid >> 3, seg = tid & 7; *(u32x4*)(gSC + (unsigned)(row * 64 + seg * 8) * 2u) = *(const LAS u32x4*)(sc + row * 72 + seg * 8); }
#pragma unroll
        for (int i = 0; i < 8; ++i) { lfc[i] = lfn[i]; qc[i] = qn[i]; }
    }
    __syncthreads();
}
__device__ __forceinline__ void hgrn_core_phase(const Params& P, LAS unsigned char* lds, int blk, int G, int wave) {
    const int lane = lane_id_v(), tid = wave * 64 + lane, l15 = lane & 15, quad = lane >> 4;
    LAS bf16_t* qd = (LAS bf16_t*)lds;
    LAS bf16_t* klT = qd + 64 * 136;
    LAS bf16_t* vT = klT + 128 * 72;
    LAS bf16_t* sc = vT + 128 * 72;
    LAS float* ebl = (LAS float*)(sc + 64 * 72);
    LAS float* red = ebl + 128;
    const unsigned short* PC = (const unsigned short*)(P.ws + OFF_BIG);
    const char* ZR = (const char*)(P.ws + OFF_Z);
    const char* QDX = (const char*)P.out + HG_QDX_OFF;
    bf16_t* MIXC = (bf16_t*)P.out;
    const float* ng = P.in[16];
    const int dp = tid & 63, sg = tid >> 6;
    for (int item = blk; item < 128; item += G) {
        const int b = item >> 3, hd = item & 7;
        f32x4 Sacc[8];
#pragma unroll
        for (int i = 0; i < 8; ++i) Sacc[i] = (f32x4){0.f, 0.f, 0.f, 0.f};
        u32x4 rq[2], rk[2], rs, re; unsigned rv[8];
#define H2_LOAD(cc_) do { const char *gQD_, *gKL_, *gSC_, *gEB_; \
            if ((cc_) > 0) { const unsigned ix_ = (unsigned)item * 32u + (unsigned)((cc_) - 1); gQD_ = QDX + (size_t)ix_ * 16384; gKL_ = ZR + HG_KLX + (size_t)ix_ * 16384; gSC_ = ZR + HG_SCX + (size_t)ix_ * 8192; gEB_ = ZR + HG_EBX + (size_t)ix_ * 512; } \
            else { const char* mb_ = ZR + HG_META + (size_t)hd * 41472; gQD_ = mb_; gKL_ = mb_ + 16384; gSC_ = mb_ + 32768; gEB_ = mb_ + 40960; } \
            rq[0] = *(const u32x4*)(gQD_ + tid * 16); rq[1] = *(const u32x4*)(gQD_ + 8192 + tid * 16); \
            rk[0] = *(const u32x4*)(gKL_ + tid * 16); rk[1] = *(const u32x4*)(gKL_ + 8192 + tid * 16); \
            rs = *(const u32x4*)(gSC_ + tid * 16); re = *(const u32x4*)(gEB_ + (tid & 31) * 16); \
            const unsigned o0_ = (unsigned)((cc_) > 0 ? b * 2048 + ((cc_) - 1) * 64 + 8 * sg : T + (sg >= 6 ? 8 * (sg - 6) : 0)) * 8192u + (unsigned)(2048 + hd * 128 + 2 * dp) * 2u; \
            _Pragma("unroll") for (int tt_ = 0; tt_ < 8; ++tt_) rv[tt_] = *(const unsigned*)((const char*)PC + o0_ + (unsigned)tt_ * 8192u); } while (0)
        H2_LOAD(0);
        for (int c = 0; c < 33; ++c) {
            {
#pragma unroll
                for (int j = 0; j < 2; ++j) { const int e = tid * 8 + j * 4096; *(LAS u32x4*)(qd + (e >> 7) * 136 + (e & 127)) = rq[j]; *(LAS u32x4*)(klT + (e >> 6) * 72 + (e & 63)) = rk[j]; }
                { const int e = tid * 8; *(LAS u32x4*)(sc + (e >> 6) * 72 + (e & 63)) = rs; }
                if (tid < 32) *(LAS u32x4*)(ebl + tid * 4) = re;
                unsigned v0[4], v1[4];
#pragma unroll
                for (int tp = 0; tp < 4; ++tp) {
                    const bool okA = c > 0 || (8 * sg + 2 * tp) >= 48, okB = c > 0 || (8 * sg + 2 * tp + 1) >= 48;
                    const unsigned va = okA ? rv[2 * tp] : 0u, vb = okB ? rv[2 * tp + 1] : 0u;
                    v0[tp] = (va & 0xffffu) | (vb << 16); v1[tp] = (va >> 16) | (vb & 0xffff0000u);
                }
                *(LAS u32x4*)(vT + (2 * dp) * 72 + 8 * sg) = (u32x4){v0[0], v0[1], v0[2], v0[3]};
                *(LAS u32x4*)(vT + (2 * dp + 1) * 72 + 8 * sg) = (u32x4){v1[0], v1[1], v1[2], v1[3]};
            }
            __syncthreads();
            { const int cn = c + 1 < 33 ? c + 1 : 32; H2_LOAD(cn); }
            unsigned short gr[16];
            {
                const int cg_ = c > 0 ? c : 1;
#pragma unroll
                for (int tt = 0; tt < 4; ++tt)
#pragma unroll
                    for (int r = 0; r < 4; ++r) gr[4 * tt + r] = *(const unsigned short*)((const char*)PC + ((unsigned)(b * 2048 + (cg_ - 1) * 64 + 16 * tt + 4 * quad + r) * 8192u + (unsigned)(3072 + hd * 128 + 16 * wave + l15) * 2u));
            }
            f32x4 oacc[4];
#pragma unroll
            for (int i = 0; i < 4; ++i) oacc[i] = (f32x4){0.f, 0.f, 0.f, 0.f};
#pragma unroll
            for (int kh = 0; kh < 2; ++kh) {
                s16x4 alo[2][4], ahi[2][4];
#pragma unroll
                for (int k2 = 0; k2 < 2; ++k2)
#pragma unroll
                    for (int tt = 0; tt < 4; ++tt) { const LAS bf16_t* ap = qd + (16 * tt + l15) * 136 + 32 * (2 * kh + k2) + 4 * quad; alo[k2][tt] = *(const LAS s16x4*)ap; ahi[k2][tt] = *(const LAS s16x4*)(ap + 16); }
                __builtin_amdgcn_sched_barrier(0);
#pragma unroll
                for (int k2 = 0; k2 < 2; ++k2) {
                    const int ks = 2 * kh + k2;
                    u32x4 sw; sw.x = pk2(Sacc[2 * ks][0], Sacc[2 * ks][1]); sw.y = pk2(Sacc[2 * ks][2], Sacc[2 * ks][3]);
                    sw.z = pk2(Sacc[2 * ks + 1][0], Sacc[2 * ks + 1][1]); sw.w = pk2(Sacc[2 * ks + 1][2], Sacc[2 * ks + 1][3]);
                    const bf16x8 sb = __builtin_bit_cast(bf16x8, sw);
#pragma unroll
                    for (int tt = 0; tt < 4; ++tt) oacc[tt] = MFMA16(__builtin_shufflevector(alo[k2][tt], ahi[k2][tt], 0, 1, 2, 3, 4, 5, 6, 7), sb, oacc[tt]);
                }
                __builtin_amdgcn_sched_barrier(0);
            }
            {
#pragma unroll
                for (int dt = 0; dt < 8; ++dt) Sacc[dt] *= *(const LAS f32x4*)(ebl + 16 * dt + 4 * quad);
                __builtin_amdgcn_sched_barrier(0);
#pragma unroll
                for (int ks = 0; ks < 2; ++ks) {
                    bf16x8 fsc[4], fkl[8];
                    const bf16x8 vb = *(const LAS bf16x8*)(vT + (16 * wave + l15) * 72 + 32 * ks + 8 * quad);
#pragma unroll
                    for (int tt = 0; tt < 4; ++tt) fsc[tt] = *(const LAS bf16x8*)(sc + (16 * tt + l15) * 72 + 32 * ks + 8 * quad);
#pragma unroll
                    for (int dt = 0; dt < 8; ++dt) fkl[dt] = *(const LAS bf16x8*)(klT + (16 * dt + l15) * 72 + 32 * ks + 8 * quad);
                    __builtin_amdgcn_sched_barrier(0);
#pragma unroll
                    for (int tt = 0; tt < 4; ++tt) oacc[tt] = MFMA16(fsc[tt], vb, oacc[tt]);
#pragma unroll
                    for (int dt = 0; dt < 8; ++dt) Sacc[dt] = MFMA16(fkl[dt], vb, Sacc[dt]);
                    __builtin_amdgcn_sched_barrier(0);
                }
            }
#pragma unroll
            for (int tt = 0; tt < 4; ++tt)
#pragma unroll
                for (int r = 0; r < 4; ++r) {
                    float sq = oacc[tt][r] * oacc[tt][r];
                    sq += __int_as_float(__builtin_amdgcn_update_dpp(0, __float_as_int(sq), 0xB1, 0xf, 0xf, false));
                    sq += __int_as_float(__builtin_amdgcn_update_dpp(0, __float_as_int(sq), 0x4E, 0xf, 0xf, false));
                    sq += __int_as_float(__builtin_amdgcn_update_dpp(0, __float_as_int(sq), 0x141, 0xf, 0xf, false));
                    sq += __int_as_float(__builtin_amdgcn_update_dpp(0, __float_as_int(sq), 0x140, 0xf, 0xf, false));
                    if (l15 == 0) red[(16 * tt + 4 * quad + r) * 8 + wave] = sq;
                }
            __syncthreads();
            if (c > 0) {
                const int dvg = hd * 128 + 16 * wave + l15;
                const float gn = ng[dvg];
#pragma unroll
                for (int tt = 0; tt < 4; ++tt)
#pragma unroll
                    for (int r = 0; r < 4; ++r) {
                        const int t = 16 * tt + 4 * quad + r;
                        const f32x4 r0 = *(const LAS f32x4*)(red + t * 8), r1 = *(const LAS f32x4*)(red + t * 8 + 4);
                        const float ssum = ((r0[0] + r0[1]) + (r0[2] + r0[3])) + ((r1[0] + r1[1]) + (r1[2] + r1[3]));
                        const float rs_ = __builtin_amdgcn_rsqf(ssum * (1.0f / 128.0f) + 1e-6f);
                        const unsigned moff = (unsigned)(b * 2048 + (c - 1) * 64 + t) * 2048u + (unsigned)dvg * 2u;
                        const float gv = bf2f(gr[4 * tt + r]);
                        *(bf16_t*)((char*)MIXC + moff) = f2bf(oacc[tt][r] * rs_ * gn * gv * __builtin_amdgcn_rcpf(1.0f + __builtin_amdgcn_exp2f(-1.4426950408889634f * gv)));
                    }
            }
        }
        __syncthreads();
    }
}

__global__ void __launch_bounds__(512, 2) fwd_megakernel(Params P) {
    extern __shared__ __attribute__((aligned(16))) unsigned char lds_raw[];
    LAS unsigned char* lds = (LAS unsigned char*)lds_raw;
    cg::grid_group grid = cg::this_grid();
    const int blk = blockIdx.x, G = gridDim.x, wave = __builtin_amdgcn_readfirstlane((int)(threadIdx.x >> 6));
    unsigned char* ws = P.ws;
    bf16_t* HB = (bf16_t*)(ws + OFF_HB);
    float* Z = (float*)(ws + OFF_Z);
    bf16_t* PROJ = (bf16_t*)(ws + OFF_BIG + BIG_PROJ);
    bf16_t* APRE = (bf16_t*)(ws + OFF_BIG + BIG_APRE);
    bf16_t* CAT = (bf16_t*)(ws + OFF_BIG + BIG_CAT);
    bf16_t* HID = (bf16_t*)(ws + OFF_BIG);
    unsigned short* PC = (unsigned short*)(ws + OFF_BIG);

    volatile LAS unsigned* xst = (volatile LAS unsigned*)(lds + 131072);
    if (wave == 0 && lane_id_v() < 4) xst[lane_id_v()] = 0u;
    __syncthreads();
    const XcdBarrier xb = xcd_barrier_post((unsigned*)(ws + OFF_BAR), xst, wave);
    prologue_phase(P, lds, blk, G, wave);
#if PROBE_DUP_PRO
    __syncthreads();
    prologue_phase(P, lds, blk, G, wave);
#endif
    if (G == 0x7fffffff) grid.sync();
    xcd_barrier(xb, wave);
    run_gemm(lds, HB, (const bf16_t*)(ws + OFF_WAB), 2048, 1024, EpInAB{PROJ}, true, blk, G, wave);
#if PROBE_GEMMS
    __syncthreads();
    run_gemm(lds, HB, (const bf16_t*)(ws + OFF_WAB), 2048, 1024, EpInAB{PROJ}, true, blk, G, wave);
#endif
    xcd_barrier(xb, wave);
    if (wave >= 4) weight_items(P, (LAS float*)(lds + 51200 + (wave - 4) * 8448), blk * 4 + (wave - 4), G * 4, lane_id_v(), 1);
    s5_phase(P, lds, blk, G, wave);
    __syncthreads();
#if PROBE_DUP_S5
    s5_phase(P, lds, blk, G, wave);
    __syncthreads();
#endif
    attn_phase2(P, lds, blk, G, wave);
#if PROBE_DUP_ATTN
    attn_phase2(P, lds, blk, G, wave);
#endif
    xcd_barrier(xb, wave);
    run_gemm(lds, APRE, (const bf16_t*)(ws + OFF_WGLU), 512, 512, EpGlu{APRE, P.in[12], CAT}, true, blk, G, wave);
    xcd_barrier(xb, wave);
    float* ST = (float*)(ws + OFF_ST); const float* SV = (const float*)(ws + OFF_SV); const float* TV = (const float*)(ws + OFF_TV);
    float *ST1 = ST, *ST2 = ST + 2 * (size_t)R, *ST3 = ST + 4 * (size_t)R, *ST4 = ST + 6 * (size_t)R;
#if PROBE_DUP_OUTAB
    run_gemm(lds, CAT, (const bf16_t*)(ws + OFF_WOAB), 1024, 1024, EpRes<NB_OUTAB>{HB, nullptr, nullptr, nullptr, nullptr, ST + 8 * (size_t)R}, true, blk, G, wave);
    __syncthreads();
#endif
    run_gemm(lds, CAT, (const bf16_t*)(ws + OFF_WOAB), 1024, 1024, EpRes<NB_OUTAB>{HB, nullptr, nullptr, nullptr, nullptr, ST1}, true, blk, G, wave);
    xcd_barrier(xb, wave);
    run_gemm(lds, HB, (const bf16_t*)(ws + OFF_WUP0), 4096, 1024, EpUp{HID, P.in[21], ST1, SV, TV}, true, blk, G, wave);
#if PROBE_DUP_UP0
    __syncthreads();
    run_gemm(lds, HB, (const bf16_t*)(ws + OFF_WUP0), 4096, 1024, EpUp{HID, P.in[21], ST1, SV, TV}, true, blk, G, wave);
#endif
#if PROBE_SYNCS
    for (int i_ = 0; i_ < PROBE_SYNCS; ++i_) xcd_barrier(xb, wave);
#endif
    xcd_barrier(xb, wave);
#if PROBE_GEMMS
    run_gemm(lds, HID, (const bf16_t*)(ws + OFF_WDN0), 1024, 4096, EpInAB{(bf16_t*)P.out}, false, blk, G, wave);
    __syncthreads();
#endif
    run_gemm(lds, HID, (const bf16_t*)(ws + OFF_WDN0), 1024, 4096, EpRes<NB_DN0>{HB, P.in[23], ST1, P.in[18], P.in[19], ST2}, true, blk, G, wave);
    xcd_barrier(xb, wave);
    run_gemm(lds, HB, (const bf16_t*)(ws + OFF_WC), 4096, 1024, EpInC{PC, P.in[15], ST2, SV + 4096, TV + 4096}, true, blk, G, wave);
#if PROBE_DUP_INC
    __syncthreads();
    run_gemm(lds, HB, (const bf16_t*)(ws + OFF_WC), 4096, 1024, EpInC{PC, P.in[15], ST2, SV + 4096, TV + 4096}, true, blk, G, wave);
#endif
    xcd_barrier(xb, wave);
#if HGRN_TWO_PHASE
    hgrn_prep_phase(P, lds, blk, G, wave);
    xcd_barrier(xb, wave);
    hgrn_core_phase(P, lds, blk, G, wave);
#else
    hgrn_phase(P, lds, blk, G, wave);
#endif
    xcd_barrier(xb, wave);
    run_gemm(lds, (const bf16_t*)P.out  , (const bf16_t*)(ws + OFF_WOC), 1024, 1024, EpRes<NB_OUTC>{HB, nullptr, ST2, P.in[24], P.in[25], ST3}, false, blk, G, wave);
    xcd_barrier(xb, wave);
    run_gemm(lds, HB, (const bf16_t*)(ws + OFF_WUP1), 4096, 1024, EpUp{HID, P.in[21] + 4096, ST3, SV + 8192, TV + 8192}, false, blk, G, wave);
    xcd_barrier(xb, wave);
    run_gemm(lds, HID, (const bf16_t*)(ws + OFF_WDN1), 1024, 4096, EpRes<NB_DN1>{HB, P.in[23] + 1024, ST3, P.in[18] + 1024, P.in[19] + 1024, ST4}, false, blk, G, wave);
    xcd_barrier(xb, wave);
    final_ln_phase(HB, ST4, P.out, P.in[24] + 1024, P.in[25] + 1024, blk, G, wave);
}

extern "C" void kernel_launch(void* const* d_in, const int* in_sizes, int n_in, void* d_out, int out_size, void* d_ws, size_t ws_size, hipStream_t stream) {
    constexpr size_t kDynLds = 131072 + 256;
    static int grid_blocks = 0;
    if (!grid_blocks) {
        if (n_in != 26 || ws_size < ZERO_END) { fprintf(stderr, "kernel_launch: expected 26 inputs and >= %zu bytes of workspace (got %d, %zu)\n", (size_t)ZERO_END, n_in, ws_size); grid_blocks = -1; return; }
        int dev = 0, cus = 0, per_cu = 0;
        hipGetDevice(&dev);
        hipDeviceGetAttribute(&cus, hipDeviceAttributeMultiprocessorCount, dev);
        hipFuncSetAttribute((const void*)fwd_megakernel, hipFuncAttributeMaxDynamicSharedMemorySize, (int)kDynLds);
        hipOccupancyMaxActiveBlocksPerMultiprocessor(&per_cu, (const void*)fwd_megakernel, 512, kDynLds);
        if (per_cu < 1) { fprintf(stderr, "kernel_launch: occupancy query says %d blocks per CU\n", per_cu); per_cu = 1; }
        grid_blocks = cus * (per_cu > 1 ? 1 : per_cu);
        if (grid_blocks != 256) fprintf(stderr, "kernel_launch: note: grid is %d workgroups (tuned for 256)\n", grid_blocks);
    }
    if (grid_blocks < 1) return;
    Params p{};
    for (int i = 0; i < 26; ++i) p.in[i] = (const float*)d_in[i];
    p.out = (float*)d_out; p.ws = (unsigned char*)d_ws;
    hipMemsetAsync((char*)d_ws + OFF_ST, 0, ZERO_END - OFF_ST, stream);
    void* args[] = {&p};
    hipError_t e = hipLaunchCooperativeKernel((const void*)fwd_megakernel, dim3(grid_blocks), dim3(512), args, kDynLds, stream);
    if (e != hipSuccess) fprintf(stderr, "cooperative launch failed: %s (grid %d)\n", hipGetErrorString(e), grid_blocks);
}
```

```cpp
#include <hip/hip_runtime.h>
#include <hip/hip_cooperative_groups.h>
#include <cstdio>
#include <cstdint>
namespace cg = cooperative_groups;
#ifndef PROBE_DUP_S5
#define PROBE_DUP_S5 0
#endif
#ifndef PROBE_DUP_ATTN
#define PROBE_DUP_ATTN 0
#endif
#ifndef PROBE_DUP_HGRN
#define PROBE_DUP_HGRN 0
#endif
#ifndef PROBE_DUP_INC
#define PROBE_DUP_INC 0
#endif
__device__ __forceinline__ int lane_id_v() { int l; asm volatile("v_mbcnt_lo_u32_b32 %0, -1, 0\n\tv_mbcnt_hi_u32_b32 %0, -1, %0" : "=v"(l)); return l; }
#ifndef PROBE_DUP_UP0
#define PROBE_DUP_UP0 0
#endif
#ifndef PROBE_SYNCS
#define PROBE_SYNCS 0
#endif
#ifndef NB_OUTAB
#define NB_OUTAB 4
#endif
#ifndef NB_DN0
#define NB_DN0 2
#endif
#ifndef NB_OUTC
#define NB_OUTC 4
#endif
#ifndef NB_DN1
#define NB_DN1 2
#endif
#ifndef PROBE_GEMMS
#define PROBE_GEMMS 0
#endif
#ifndef PROBE_DUP_PRO
#define PROBE_DUP_PRO 0
#endif
#ifndef PROBE_DUP_OUTAB
#define PROBE_DUP_OUTAB 0
#endif
#ifndef HGRN_TWO_PHASE
#define HGRN_TWO_PHASE 0
#endif
#ifndef STAGGER_TICKS
#define STAGGER_TICKS 0
#endif
#define XB_TMO      128
#define XB_XCNT(j)  (256  + 64 * (j))
#define XB_XSUB(j)  (1280 + 64 * (j))
#define XB_XGEN(j)  (2304 + 64 * (j))
#define XB_TOP      3328
#define XB_TOPGEN   3392
#define XCD_BAR_WORDS 3456
#define XB_SPIN_CAP (1u << 18)

__device__ __forceinline__ unsigned xb_ld(unsigned* p)              { return __hip_atomic_load(p, __ATOMIC_RELAXED, __HIP_MEMORY_SCOPE_AGENT); }
__device__ __forceinline__ unsigned xb_add(unsigned* p, unsigned v) { return __hip_atomic_fetch_add(p, v, __ATOMIC_RELAXED, __HIP_MEMORY_SCOPE_AGENT); }
__device__ __forceinline__ unsigned xb_xcc_id() { return (unsigned)__builtin_amdgcn_s_getreg((3 << 11) | 20) & 0xFu; }
#define XB_SPIN(cond, bar) do { unsigned _sp = 0; while (cond) { __builtin_amdgcn_s_sleep(1); \
    if ((++_sp & 255u) == 0u) { if (xb_ld(&(bar)[XB_TMO])) break; if (_sp > XB_SPIN_CAP) { atomicAdd(&(bar)[XB_TMO], 1u); break; } } } } while (0)

struct XcdBarrier {
    unsigned* bar; unsigned x;
    volatile __attribute__((address_space(3))) unsigned* st;
};

__device__ __forceinline__ XcdBarrier xcd_barrier_post(unsigned* bar, volatile __attribute__((address_space(3))) unsigned* st, int wave_in) {
    XcdBarrier b; b.bar = bar; b.x = xb_xcc_id(); b.st = st;
    if (wave_in == 0 && lane_id_v() == 0) (void)xb_add(&bar[XB_XCNT(b.x)], 1u);
    return b;
}
__device__ __forceinline__ void xcd_barrier_complete(unsigned* bar, unsigned x, unsigned& nloc, unsigned& nx) {
    const unsigned G = gridDim.x * gridDim.y * gridDim.z;
    unsigned sum, cnt, mine, sp = 0u;
    for (;;) {
        sum = 0u; cnt = 0u; mine = 0u;
#pragma unroll
        for (unsigned j = 0; j < 16; ++j) { const unsigned c = xb_ld(&bar[XB_XCNT(j)]); sum += c; cnt += (c > 0u) ? 1u : 0u; mine = (j == x) ? c : mine; }
        if (sum == G) break;
        __builtin_amdgcn_s_sleep(1);
        if ((++sp & 255u) == 0u) { if (xb_ld(&bar[XB_TMO])) break; if (sp > XB_SPIN_CAP) { atomicAdd(&bar[XB_TMO], 1u); break; } }
    }
    nloc = mine > 0u ? mine : 1u; nx = cnt > 0u ? cnt : 1u;
}

__device__ __forceinline__ void xcd_barrier(const XcdBarrier& b, int wave_in) {
    asm volatile("s_waitcnt vmcnt(0)" ::: "memory");
    __syncthreads();
    if (wave_in == 0 && lane_id_v() == 0) {
        unsigned* bar = b.bar;
        __builtin_amdgcn_s_waitcnt(0);
        unsigned nloc = b.st[0], nx = b.st[1];
        if (nloc == 0u) { xcd_barrier_complete(bar, b.x, nloc, nx); b.st[0] = nloc; b.st[1] = nx; }
        const unsigned old = xb_add(&bar[XB_XSUB(b.x)], 1u);
        const unsigned gen = old / nloc;
        if (old + 1u == (gen + 1u) * nloc) {
            __builtin_amdgcn_fence(__ATOMIC_RELEASE, "agent");
            asm volatile("s_waitcnt vmcnt(0)" ::: "memory");
            const unsigned og = xb_add(&bar[XB_TOP], 1u);
            const unsigned tg = og / nx;
            if (og + 1u == (tg + 1u) * nx) xb_add(&bar[XB_TOPGEN], 1u);
            else XB_SPIN(xb_ld(&bar[XB_TOPGEN]) == tg, bar);
            __builtin_amdgcn_fence(__ATOMIC_ACQUIRE, "agent");
            xb_add(&bar[XB_XGEN(b.x)], 1u);
            asm volatile("s_waitcnt vmcnt(0)" ::: "memory");
        } else {
            XB_SPIN(xb_ld(&bar[XB_XGEN(b.x)]) == gen, bar);
            __builtin_amdgcn_fence(__ATOMIC_ACQUIRE, "agent");
            asm volatile("s_waitcnt vmcnt(0)" ::: "memory");
        }
    }
    __syncthreads();
}

namespace pg8 {
#define PG8_LAS __attribute__((address_space(3)))
typedef unsigned short bf16_t;
typedef short bf16x8 __attribute__((ext_vector_type(8)));
typedef float f32x4 __attribute__((ext_vector_type(4)));
typedef unsigned u32x4 __attribute__((ext_vector_type(4)));
constexpr int BM = 256, BK = 64, HALF = 128, HTB = HALF * BK * 2  , STAGE_BYTES = 8 * HTB, NXCD = 8, WGM = 8;

__host__ __device__ __forceinline__ int lds_byte(int r, int c) { const int st = (r >> 4) * 2 + (c >> 5), rr = r & 15, cc = c & 31, ob = rr * 64 + cc * 2; return st * 1024 + (ob ^ (((ob >> 9) & 1) << 5)); }
__host__ __device__ __forceinline__ void stage_rc(int b, int& R, int& C) { const int st = b / 1024, sb = b % 1024, swz = sb ^ (((sb >> 9) & 1) << 5); R = (st >> 1) * 16 + swz / 64; C = (st & 1) * 32 + (swz % 64) / 2; }
__host__ __device__ __forceinline__ int perm32(int rho) { const int n = rho >> 4, i = rho & 15; return 8 * (i >> 2) + 4 * n + (i & 3); }

struct Unit { int pm, pn; };
struct Gemm { const bf16_t* A; const bf16_t* Bt; int M, N, K; };

struct StaticOrder {
    int nM, nN, nwg, G, c;
    __host__ __device__ void init(int M, int N, int G_, int c_) { nM = M / BM; nN = N / BM; nwg = nM * nN; G = G_; c = c_; }
    __host__ __device__ bool next(int i, Unit& u) const {
        const long L = (long)i * G + c; if (L >= nwg) return false;
        int wgid = (int)L; { const int q = nwg / NXCD, r = nwg % NXCD, xcd = wgid % NXCD, off = wgid / NXCD; wgid = (xcd < r ? xcd * (q + 1) : r * (q + 1) + (xcd - r) * q) + off; }
        const int nig = WGM * nN, gid = wgid / nig, fm = gid * WGM, gsz = (nM - fm) < WGM ? (nM - fm) : WGM;
        u.pm = fm + ((wgid % nig) % gsz); u.pn = (wgid % nig) / gsz; return true;
    }
    __device__ __forceinline__ void a_ready(const Unit&) const {}
    __device__ __forceinline__ void done(const Unit&) const {}
};

__device__ __forceinline__ unsigned cvt_pk_bf16(float lo, float hi) { unsigned r; asm volatile("v_cvt_pk_bf16_f32 %0, %1, %2" : "=v"(r) : "v"(lo), "v"(hi)); return r; }
template <class Epi, class Sched, bool ALIGN_EPI = false, bool SP2 = false>
__device__ __forceinline__ void gemm_phase(PG8_LAS unsigned char* lds, const Gemm g, const Sched& S, const Epi& E, int wave_in) {
    const int lane = lane_id_v(), wid = __builtin_amdgcn_readfirstlane(wave_in), tid = wid * 64 + lane, wr = wid >> 2, wc = wid & 3, fr = lane & 15, fq = lane >> 4;
    const int K = g.K, nt = K / BK;
    unsigned voffA[2], voffB[2];
#pragma unroll
    for (int i = 0; i < 2; ++i) { int R, C; stage_rc(tid * 16 + i * 8192, R, C); const int Rb = Epi::PERM ? ((R & ~31) + perm32(R & 31)) : R;
        voffA[i] = (unsigned)(R * K + C) * 2u; voffB[i] = (unsigned)(Rb * K + C) * 2u; }
    const size_t kstep = (size_t)(BK * 2);
    const size_t hstep = (size_t)HALF * K * 2;
    const size_t tstep = 2 * hstep;
    const unsigned ldsw = (unsigned)wid * 1024u;
    const int aoff = lds_byte(wr * 64 + fr, fq * 8), boff = lds_byte(wc * 32 + fr, fq * 8);
#define PG8_SA(b, h) (((b) * 2 + (h)) * HTB)
#define PG8_SB(b, h) ((4 + (b) * 2 + (h)) * HTB)
#define PG8_STAGE(bufoff, gbase, voff) do { _Pragma("unroll") for (int _i = 0; _i < 2; ++_i) \
        __builtin_amdgcn_global_load_lds((const unsigned*)((const char*)(gbase) + (voff)[_i]), (PG8_LAS unsigned*)(lds + (bufoff) + ldsw + _i * 8192), 16, 0, 0); } while (0)
#define PG8_LDA(dst, b, h) do { _Pragma("unroll") for (int m = 0; m < 4; ++m) _Pragma("unroll") for (int k = 0; k < 2; ++k) dst[m][k] = *(const PG8_LAS bf16x8*)(lds + PG8_SA(b, h) + aoff + m * 2048 + k * 1024); } while (0)
#define PG8_LDB(dst, b, h) do { _Pragma("unroll") for (int n = 0; n < 2; ++n) _Pragma("unroll") for (int k = 0; k < 2; ++k) dst[n][k] = *(const PG8_LAS bf16x8*)(lds + PG8_SB(b, h) + boff + n * 2048 + k * 1024); } while (0)
#define PG8_MMA(ai, bj, At, Bt) do { __builtin_amdgcn_s_setprio(1); _Pragma("unroll") for (int m = 0; m < 4; ++m) _Pragma("unroll") for (int n = 0; n < 2; ++n) _Pragma("unroll") for (int k = 0; k < 2; ++k) \
        acc[ai][bj][m][n] = __builtin_amdgcn_mfma_f32_16x16x32_bf16(Bt[n][k], At[m][k], acc[ai][bj][m][n], 0, 0, 0); __builtin_amdgcn_s_setprio(0); } while (0)
#define PG8_WAIT_V(n) asm volatile("s_waitcnt vmcnt(" #n ")" ::: "memory")
#define PG8_WAIT_L(n) asm volatile("s_waitcnt lgkmcnt(" #n ")" ::: "memory")
#define PG8_BAR __builtin_amdgcn_s_barrier()
#define PG8_SCHED __builtin_amdgcn_sched_barrier(0)
    Unit cur, nxt; int ui = 0;
    if (!S.next(0, cur)) return;
    f32x4 acc[2][2][4][2];
#pragma unroll
    for (int a = 0; a < 2; ++a)
#pragma unroll
        for (int b = 0; b < 2; ++b)
#pragma unroll
            for (int m = 0; m < 4; ++m)
#pragma unroll
                for (int n = 0; n < 2; ++n) acc[a][b][m][n] = (f32x4){0.f, 0.f, 0.f, 0.f};
    bf16x8 At[4][2], B0[2][2], B1[2][2];
    const char* cA = (const char*)g.A + (size_t)cur.pm * tstep; const char* cB = (const char*)g.Bt + (size_t)cur.pn * tstep;
    S.a_ready(cur);
    if constexpr (SP2) {
        PG8_STAGE(PG8_SB(0, 0), cB, voffB); PG8_STAGE(PG8_SB(0, 1), cB + hstep, voffB); PG8_STAGE(PG8_SA(0, 0), cA, voffA); PG8_STAGE(PG8_SA(0, 1), cA + hstep, voffA);
        if (wr == 1) PG8_BAR;
        PG8_WAIT_V(2); PG8_BAR;
        PG8_STAGE(PG8_SB(1, 0), cB + kstep, voffB); PG8_STAGE(PG8_SA(1, 0), cA + kstep, voffA); PG8_STAGE(PG8_SB(1, 1), cB + hstep + kstep, voffB);
        PG8_WAIT_V(6); PG8_BAR;
    } else {
        PG8_STAGE(PG8_SB(0, 0), cB, voffB); PG8_STAGE(PG8_SA(0, 0), cA, voffA); PG8_STAGE(PG8_SB(0, 1), cB + hstep, voffB); PG8_STAGE(PG8_SA(0, 1), cA + hstep, voffA);
        if (wr == 1) PG8_BAR;
        PG8_WAIT_V(4); PG8_BAR;
        PG8_STAGE(PG8_SB(1, 0), cB + kstep, voffB); PG8_STAGE(PG8_SA(1, 0), cA + kstep, voffA); PG8_STAGE(PG8_SB(1, 1), cB + hstep + kstep, voffB);
        PG8_WAIT_V(6); PG8_BAR;
    }
    for (;;) {
        const bool has_next = S.next(ui + 1, nxt);
        const char* nA = has_next ? (const char*)g.A + (size_t)nxt.pm * tstep : cA; const char* nB = has_next ? (const char*)g.Bt + (size_t)nxt.pn * tstep : cB;
        for (int t = 0; t < nt; t += 2) {
            const bool last = (t == nt - 2);
            const char* a1 = cA + (size_t)(t + 1) * kstep;
            const char* a2 = last ? nA : cA + (size_t)(t + 2) * kstep; const char* b2 = last ? nB : cB + (size_t)(t + 2) * kstep;
            const char* a3 = a2 + kstep; const char* b3 = b2 + kstep;
            if (last && has_next) S.a_ready(nxt);
            if constexpr (SP2) {
            PG8_LDB(B0, 0, 0); PG8_LDB(B1, 0, 1); PG8_SCHED; PG8_LDA(At, 0, 0); PG8_STAGE(PG8_SA(1, 1), a1 + hstep, voffA);
            PG8_WAIT_V(8); PG8_WAIT_L(0); PG8_BAR; PG8_MMA(0, 0, At, B0); PG8_MMA(0, 1, At, B1); PG8_BAR; PG8_SCHED;
            PG8_LDA(At, 0, 1); PG8_STAGE(PG8_SB(0, 0), b2, voffB); PG8_STAGE(PG8_SB(0, 1), b2 + hstep, voffB); PG8_STAGE(PG8_SA(0, 0), a2, voffA);
            PG8_WAIT_V(8); PG8_WAIT_L(0); PG8_BAR; PG8_MMA(1, 0, At, B0); PG8_MMA(1, 1, At, B1); PG8_BAR; PG8_SCHED;
            PG8_LDB(B0, 1, 0); PG8_LDB(B1, 1, 1); PG8_SCHED; PG8_LDA(At, 1, 0); PG8_STAGE(PG8_SA(0, 1), a2 + hstep, voffA);
            PG8_WAIT_V(8); PG8_WAIT_L(0); PG8_BAR; PG8_MMA(0, 0, At, B0); PG8_MMA(0, 1, At, B1); PG8_BAR; PG8_SCHED;
            PG8_LDA(At, 1, 1); PG8_STAGE(PG8_SB(1, 0), b3, voffB); PG8_STAGE(PG8_SB(1, 1), b3 + hstep, voffB); PG8_STAGE(PG8_SA(1, 0), a3, voffA);
            PG8_WAIT_V(8); PG8_WAIT_L(0); PG8_BAR; PG8_MMA(1, 0, At, B0); PG8_MMA(1, 1, At, B1); PG8_BAR; PG8_SCHED;
            } else {
            PG8_LDB(B0, 0, 0); PG8_SCHED; PG8_LDA(At, 0, 0); PG8_STAGE(PG8_SA(1, 1), a1 + hstep, voffA);
            PG8_WAIT_L(8); PG8_BAR; PG8_WAIT_L(0); PG8_MMA(0, 0, At, B0); PG8_BAR; PG8_SCHED;
            PG8_LDB(B1, 0, 1); PG8_STAGE(PG8_SB(0, 0), b2, voffB);
            PG8_BAR; PG8_WAIT_L(0); PG8_MMA(0, 1, At, B1); PG8_BAR;
            PG8_LDA(At, 0, 1); PG8_STAGE(PG8_SA(0, 0), a2, voffA);
            PG8_BAR; PG8_WAIT_L(0); PG8_MMA(1, 0, At, B0); PG8_BAR; PG8_SCHED;
            PG8_STAGE(PG8_SB(0, 1), b2 + hstep, voffB);
            PG8_WAIT_V(6); PG8_BAR; PG8_MMA(1, 1, At, B1); PG8_BAR;
            PG8_LDB(B0, 1, 0); PG8_SCHED; PG8_LDA(At, 1, 0); PG8_STAGE(PG8_SA(0, 1), a2 + hstep, voffA);
            PG8_WAIT_L(8); PG8_BAR; PG8_WAIT_L(0); PG8_MMA(0, 0, At, B0); PG8_BAR; PG8_SCHED;
            PG8_LDB(B1, 1, 1); PG8_STAGE(PG8_SB(1, 0), b3, voffB);
            PG8_BAR; PG8_WAIT_L(0); PG8_MMA(0, 1, At, B1); PG8_BAR;
            PG8_LDA(At, 1, 1); PG8_STAGE(PG8_SA(1, 0), a3, voffA);
            PG8_BAR; PG8_WAIT_L(0); PG8_MMA(1, 0, At, B0); PG8_BAR; PG8_SCHED;
            PG8_STAGE(PG8_SB(1, 1), b3 + hstep, voffB);
            PG8_WAIT_V(6); PG8_BAR; PG8_MMA(1, 1, At, B1); PG8_BAR;
            }
        }
        if constexpr (ALIGN_EPI) { if (wr == 0) PG8_BAR; }
        if constexpr (!Epi::AFTER_DRAIN) { E(acc, cur, wr, wc, fr, fq); S.done(cur); }
        if (!has_next) break;
#pragma unroll
        for (int a = 0; a < 2; ++a)
#pragma unroll
            for (int b = 0; b < 2; ++b)
#pragma unroll
                for (int m = 0; m < 4; ++m)
#pragma unroll
                    for (int n = 0; n < 2; ++n) acc[a][b][m][n] = (f32x4){0.f, 0.f, 0.f, 0.f};
        cur = nxt; cA = nA; cB = nB; ++ui;
        if constexpr (ALIGN_EPI) { if (wr == 1) PG8_BAR; }
    }
    PG8_WAIT_V(0);
    if constexpr (!ALIGN_EPI) { if (wr == 0) PG8_BAR; }
    PG8_BAR;
    if constexpr (Epi::AFTER_DRAIN) { E.fused(acc, cur, wr, wc, fr, fq, lds, wid, lane); S.done(cur); }
#undef PG8_SA
#undef PG8_SB
#undef PG8_STAGE
#undef PG8_LDA
#undef PG8_LDB
#undef PG8_MMA
#undef PG8_WAIT_V
#undef PG8_WAIT_L
#undef PG8_BAR
#undef PG8_SCHED
}
}

#define LAS __attribute__((address_space(3)))
typedef unsigned short bf16_t;
typedef short bf16x8 __attribute__((ext_vector_type(8)));
typedef short s16x4 __attribute__((ext_vector_type(4)));
typedef float f32x4 __attribute__((ext_vector_type(4)));
typedef float f32x16 __attribute__((ext_vector_type(16)));
typedef unsigned u32x4 __attribute__((ext_vector_type(4)));
typedef unsigned u32x2 __attribute__((ext_vector_type(2)));

constexpr int T = 16 * 2048;
constexpr int NMETA = 16;
constexpr int R = T + NMETA;
constexpr int DM = 1024, DFF = 4096;
constexpr float ALPHA = 1.4142135623730951f;
constexpr float QSCALE = 0.125f * 1.4426950408889634f;

constexpr size_t SZ_WAB = (size_t)2048 * 1024 * 2, SZ_WGLU = (size_t)512 * 512 * 2, SZ_W1M = (size_t)1024 * 1024 * 2, SZ_W4M = (size_t)4096 * 1024 * 2;
constexpr size_t OFF_WAB = 0, OFF_WGLU = OFF_WAB + SZ_WAB, OFF_WOAB = OFF_WGLU + SZ_WGLU, OFF_WC = OFF_WOAB + SZ_W1M, OFF_WOC = OFF_WC + SZ_W4M,
                 OFF_WUP0 = OFF_WOC + SZ_W1M, OFF_WUP1 = OFF_WUP0 + SZ_W4M, OFF_WDN0 = OFF_WUP1 + SZ_W4M, OFF_WDN1 = OFF_WDN0 + SZ_W4M,
                 OFF_HB = OFF_WDN1 + SZ_W4M, OFF_Z = OFF_HB + (size_t)R * 1024 * 2, OFF_BIG = OFF_Z + (size_t)R * 1024 * 4, WS_END = OFF_BIG + (size_t)R * 4096 * 2;
constexpr size_t OFF_ST = (WS_END + 255) & ~(size_t)255;
constexpr size_t SZ_ST = (size_t)5 * R * 2 * 4;
constexpr size_t OFF_SV = OFF_ST + SZ_ST, OFF_TV = OFF_SV + (size_t)3 * 4096 * 4, OFF_BAR = OFF_TV + (size_t)3 * 4096 * 4, OFF_ZROW = OFF_BIG + ((OFF_BAR + (size_t)XCD_BAR_WORDS * 4 - OFF_BIG + 8191) / 8192) * 8192, ZERO_END = OFF_ZROW + (size_t)8 * 8192;
constexpr size_t BIG_PROJ = 0, BIG_APRE = (size_t)R * 2048 * 2, BIG_CAT = BIG_APRE + (size_t)R * 512 * 2;

struct Params { const float* in[26]; float* out; unsigned char* ws; };

__device__ __forceinline__ unsigned pk2(float lo, float hi) {
    typedef __bf16 bf2 __attribute__((ext_vector_type(2)));
    typedef float fl2 __attribute__((ext_vector_type(2)));
    fl2 v = {lo, hi}; bf2 r = __builtin_convertvector(v, bf2); return __builtin_bit_cast(unsigned, r);
}
__device__ __forceinline__ bf16_t f2bf(float x) { return (bf16_t)(pk2(x, 0.f) & 0xffffu); }
__device__ __forceinline__ float bf2f(bf16_t v) { return __uint_as_float((unsigned)v << 16); }
__device__ __forceinline__ float bflo(unsigned w) { return __uint_as_float(w << 16); }
__device__ __forceinline__ float bfhi(unsigned w) { return __uint_as_float(w & 0xffff0000u); }
__device__ __forceinline__ float sigmoidf_(float x) { return 1.0f / (1.0f + __expf(-x)); }
#define LDS_WAIT() asm volatile("s_waitcnt lgkmcnt(0)" ::: "memory")
#define MFMA16(a, b, c) __builtin_amdgcn_mfma_f32_16x16x32_bf16((a), (b), (c), 0, 0, 0)
#define MFMA32(a, b, c) __builtin_amdgcn_mfma_f32_32x32x16_bf16((a), (b), (c), 0, 0, 0)

struct RowCtx { float mu, rstd; };
__device__ __forceinline__ RowCtx ln_ctx(const float* st, int row) {
    const float sum = st[2 * (size_t)row], sq = st[2 * (size_t)row + 1];
    RowCtx rc; rc.mu = sum * (1.0f / 1024.0f); const float var = fmaxf(sq * (1.0f / 1024.0f) - rc.mu * rc.mu, 0.f); rc.rstd = 1.0f / sqrtf(var + 1e-5f); return rc;
}
struct NoCtx {};
struct EpInAB {
    static constexpr bool MAKES_STATS = false; static constexpr int BATCH = 8;
    typedef NoCtx ColCtx; typedef NoCtx Pre;
    bf16_t* O;
    __device__ __forceinline__ ColCtx col_ctx(int) const { return NoCtx{}; }
    template <bool META> __device__ __forceinline__ Pre pre(int, int) const { return NoCtx{}; }
    __device__ __forceinline__ RowCtx row_ctx(int) const { return RowCtx{0.f, 1.f}; }
    __device__ __forceinline__ float* st_ptr() const { return nullptr; }
    __device__ __forceinline__ void apply8(int row, int col, f32x4 a, f32x4 b, const RowCtx&, const ColCtx&, const Pre&, float&, float&) const {
        const float s = (col >= 512 && col < 1024) ? QSCALE : 1.0f;
        u32x4 w; w.x = pk2(a[0] * s, a[1] * s); w.y = pk2(a[2] * s, a[3] * s); w.z = pk2(b[0] * s, b[1] * s); w.w = pk2(b[2] * s, b[3] * s);
        *(u32x4*)(O + (size_t)row * 2048 + col) = w;
    }
};
struct EpGlu {
    static constexpr bool MAKES_STATS = false; static constexpr int BATCH = 4;
    struct ColCtx { f32x4 b0, b1; }; struct Pre { u32x4 ap; };
    const bf16_t* APRE; const float* bias; bf16_t* CAT;
    __device__ __forceinline__ ColCtx col_ctx(int col) const { return ColCtx{*(const f32x4*)(bias + col), *(const f32x4*)(bias + col + 4)}; }
    template <bool META> __device__ __forceinline__ Pre pre(int row, int col) const { return Pre{*(const u32x4*)((const char*)APRE + ((unsigned)row * 1024u + (unsigned)col * 2u))}; }
    __device__ __forceinline__ RowCtx row_ctx(int) const { return RowCtx{0.f, 1.f}; }
    __device__ __forceinline__ float* st_ptr() const { return nullptr; }
    __device__ __forceinline__ void apply8(int row, int col, f32x4 a, f32x4 b, const RowCtx&, const ColCtx& cc, const Pre& pr, float&, float&) const {
        const u32x4 ap = pr.ap;
        float v[8] = {a[0] + cc.b0[0], a[1] + cc.b0[1], a[2] + cc.b0[2], a[3] + cc.b0[3], b[0] + cc.b1[0], b[1] + cc.b1[1], b[2] + cc.b1[2], b[3] + cc.b1[3]};
        float y[8] = {bflo(ap.x), bfhi(ap.x), bflo(ap.y), bfhi(ap.y), bflo(ap.z), bfhi(ap.z), bflo(ap.w), bfhi(ap.w)};
#pragma unroll
        for (int i = 0; i < 8; ++i) y[i] = y[i] * sigmoidf_(v[i]);
        u32x4 w; w.x = pk2(y[0], y[1]); w.y = pk2(y[2], y[3]); w.z = pk2(y[4], y[5]); w.w = pk2(y[6], y[7]);
        *(u32x4*)(CAT + (size_t)row * 1024 + col) = w;
    }
};
template <int NB_> struct EpRes {
    static constexpr bool MAKES_STATS = true; static constexpr int BATCH = NB_;
    struct ColCtx { f32x4 ag0, ag1, ab0, ab1; }; struct Pre { u32x4 h; };
    bf16_t* HBp; const float* bias;
    const float* st_prev; const float* g; const float* bta; float* st_out;
    __device__ __forceinline__ ColCtx col_ctx(int col) const {
        ColCtx c; const f32x4 one = {1.f, 1.f, 1.f, 1.f}, zero = {0.f, 0.f, 0.f, 0.f};
        const f32x4 g0 = st_prev ? *(const f32x4*)(g + col) : one, g1 = st_prev ? *(const f32x4*)(g + col + 4) : one;
        const f32x4 t0 = st_prev ? *(const f32x4*)(bta + col) : zero, t1 = st_prev ? *(const f32x4*)(bta + col + 4) : zero;
        const f32x4 b0 = bias ? *(const f32x4*)(bias + col) : zero, b1 = bias ? *(const f32x4*)(bias + col + 4) : zero;
        c.ag0 = g0 * ALPHA; c.ag1 = g1 * ALPHA; c.ab0 = t0 * ALPHA + b0; c.ab1 = t1 * ALPHA + b1; return c;
    }
    template <bool META> __device__ __forceinline__ Pre pre(int row, int col) const { return Pre{*(const u32x4*)((const char*)HBp + ((unsigned)row * 2048u + (unsigned)col * 2u))}; }
    __device__ __forceinline__ RowCtx row_ctx(int row) const { return st_prev ? ln_ctx(st_prev, row) : RowCtx{0.f, 1.f}; }
    __device__ __forceinline__ float* st_ptr() const { return st_out; }
    __device__ __forceinline__ void apply8(int row, int col, f32x4 a, f32x4 b, const RowCtx& rc, const ColCtx& cc, const Pre& pr, float& s, float& q) const {
        const f32x4 h0 = {bflo(pr.h.x), bfhi(pr.h.x), bflo(pr.h.y), bfhi(pr.h.y)}, h1 = {bflo(pr.h.z), bfhi(pr.h.z), bflo(pr.h.w), bfhi(pr.h.w)};
        const f32x4 o0 = (h0 - rc.mu) * rc.rstd * cc.ag0 + cc.ab0 + a, o1 = (h1 - rc.mu) * rc.rstd * cc.ag1 + cc.ab1 + b;
        u32x4 w; w.x = pk2(o0[0], o0[1]); w.y = pk2(o0[2], o0[3]); w.z = pk2(o1[0], o1[1]); w.w = pk2(o1[2], o1[3]);
        *(u32x4*)((char*)HBp + ((unsigned)row * 2048u + (unsigned)col * 2u)) = w;
        s += ((o0[0] + o0[1]) + (o0[2] + o0[3])) + ((o1[0] + o1[1]) + (o1[2] + o1[3]));
        q += ((o0[0] * o0[0] + o0[1] * o0[1]) + (o0[2] * o0[2] + o0[3] * o0[3])) + ((o1[0] * o1[0] + o1[1] * o1[1]) + (o1[2] * o1[2] + o1[3] * o1[3]));
    }
};
struct EpUp {
    static constexpr bool MAKES_STATS = false; static constexpr int BATCH = 8;
    struct ColCtx { f32x4 s0, s1, t0, t1; }; typedef NoCtx Pre;
    bf16_t* H; const float* bias; const float* st_prev; const float* sv; const float* tv;
    __device__ __forceinline__ ColCtx col_ctx(int col) const {
        return ColCtx{*(const f32x4*)(sv + col), *(const f32x4*)(sv + col + 4), *(const f32x4*)(tv + col) + *(const f32x4*)(bias + col), *(const f32x4*)(tv + col + 4) + *(const f32x4*)(bias + col + 4)};
    }
    template <bool META> __device__ __forceinline__ Pre pre(int, int) const { return NoCtx{}; }
    __device__ __forceinline__ RowCtx row_ctx(int row) const { return ln_ctx(st_prev, row); }
    __device__ __forceinline__ float* st_ptr() const { return nullptr; }
    __device__ __forceinline__ void apply8(int row, int col, f32x4 a, f32x4 b, const RowCtx& rc, const ColCtx& cc, const Pre&, float&, float&) const {
        f32x4 v0 = (a - rc.mu * cc.s0) * rc.rstd + cc.t0, v1 = (b - rc.mu * cc.s1) * rc.rstd + cc.t1;
#pragma unroll
        for (int i = 0; i < 4; ++i) { v0[i] = fmaxf(v0[i], 0.f); v0[i] *= v0[i]; v1[i] = fmaxf(v1[i], 0.f); v1[i] *= v1[i]; }
        u32x4 w; w.x = pk2(v0[0], v0[1]); w.y = pk2(v0[2], v0[3]); w.z = pk2(v1[0], v1[1]); w.w = pk2(v1[2], v1[3]);
        *(u32x4*)(H + (size_t)row * 4096 + col) = w;
    }
};
struct EpInC {
    static constexpr bool MAKES_STATS = false; static constexpr int BATCH = 8;
    struct ColCtx { f32x4 s0, s1, t0, t1, lb0, lb1; }; typedef NoCtx Pre;
    unsigned short* PC; const float* gamma; const float* st_prev; const float* sv; const float* tv;
    __device__ __forceinline__ ColCtx col_ctx(int col) const {
        ColCtx c{*(const f32x4*)(sv + col), *(const f32x4*)(sv + col + 4), *(const f32x4*)(tv + col), *(const f32x4*)(tv + col + 4), {0.f, 0.f, 0.f, 0.f}, {0.f, 0.f, 0.f, 0.f}};
        if (col >= 1024 && col < 2048) {
            const f32x4 ga = *(const f32x4*)(gamma + col - 1024), gb = *(const f32x4*)(gamma + col - 1020), gc = *(const f32x4*)(gamma + col), gd = *(const f32x4*)(gamma + col + 4);
#pragma unroll
            for (int i = 0; i < 4; ++i) { c.lb0[i] = 1.0f / (1.0f + __expf(ga[i] - gc[i])); c.lb1[i] = 1.0f / (1.0f + __expf(gb[i] - gd[i])); }
        }
        return c;
    }
    template <bool META> __device__ __forceinline__ Pre pre(int, int) const { return NoCtx{}; }
    __device__ __forceinline__ RowCtx row_ctx(int row) const { return ln_ctx(st_prev, row); }
    __device__ __forceinline__ float* st_ptr() const { return nullptr; }
    __device__ __forceinline__ void apply8(int row, int col, f32x4 a, f32x4 b, const RowCtx& rc, const ColCtx& cc, const Pre&, float&, float&) const {
        a = (a - rc.mu * cc.s0) * rc.rstd + cc.t0;
        b = (b - rc.mu * cc.s1) * rc.rstd + cc.t1;
        u32x4 w;
        if (col >= 1024 && col < 2048) {
            float v[8] = {a[0], a[1], a[2], a[3], b[0], b[1], b[2], b[3]};
            float lb[8] = {cc.lb0[0], cc.lb0[1], cc.lb0[2], cc.lb0[3], cc.lb1[0], cc.lb1[1], cc.lb1[2], cc.lb1[3]};
            unsigned short h[8];
#pragma unroll
            for (int i = 0; i < 8; ++i) {
                const float f = lb[i] + (1.0f - lb[i]) * sigmoidf_(v[i]);
                const _Float16 hf = (_Float16)__logf(f);
                h[i] = __builtin_bit_cast(unsigned short, hf);
            }
            w.x = h[0] | ((unsigned)h[1] << 16); w.y = h[2] | ((unsigned)h[3] << 16); w.z = h[4] | ((unsigned)h[5] << 16); w.w = h[6] | ((unsigned)h[7] << 16);
        } else { w.x = pk2(a[0], a[1]); w.y = pk2(a[2], a[3]); w.z = pk2(b[0], b[1]); w.w = pk2(b[2], b[3]); }
        *(u32x4*)(PC + (size_t)row * 4096 + col) = w;
    }
};
template <class F> struct EpiAdapt {
    static constexpr bool PERM = true, AFTER_DRAIN = false; F f;
    __device__ __forceinline__ void operator()(const f32x4 (&acc)[2][2][4][2], const pg8::Unit& u, int wr, int wc, int, int) const {
        const int lane_ = lane_id_v(), fr = lane_ & 15, fq = lane_ >> 4;
        const int col0 = u.pn * 256 + wc * 32 + 8 * fq, row0 = u.pm * 256 + wr * 64 + fr;
        constexpr int NB = F::BATCH;
#pragma unroll
        for (int bt = 0; bt < 8 / NB; ++bt) {
            const typename F::ColCtx cc[2] = {f.col_ctx(col0), f.col_ctx(col0 + 128)};
            RowCtx rc[NB];
            typename F::Pre pr[NB][2];
#pragma unroll
            for (int i = 0; i < NB; ++i) { const int r8 = bt * NB + i, row = row0 + (r8 >> 2) * 128 + (r8 & 3) * 16;
                rc[i] = f.row_ctx(row); pr[i][0] = f.template pre<false>(row, col0); pr[i][1] = f.template pre<false>(row, col0 + 128); }
#pragma unroll
            for (int i = 0; i < NB; ++i) { const int r8 = bt * NB + i, ai = r8 >> 2, m = r8 & 3, row = row0 + ai * 128 + m * 16;
                float s = 0.f, q = 0.f;
                f.apply8(row, col0, acc[ai][0][m][0], acc[ai][0][m][1], rc[i], cc[0], pr[i][0], s, q);
                f.apply8(row, col0 + 128, acc[ai][1][m][0], acc[ai][1][m][1], rc[i], cc[1], pr[i][1], s, q);
                if (F::MAKES_STATS) {
                    s += __shfl_xor(s, 16); s += __shfl_xor(s, 32); q += __shfl_xor(q, 16); q += __shfl_xor(q, 32);
                    if (fq == 0) { float* st = (float*)((char*)f.st_ptr() + (unsigned)row * 8u); unsafeAtomicAdd(st, s); unsafeAtomicAdd(st + 1, q); }
                }
            }
            asm volatile("" ::: "memory");
        }
    }
};
template <class F> __device__ __forceinline__ void meta_gemm(const bf16_t* A16  , const bf16_t* Bt, int N, int K, const F& f, int blk, int G, int wave, int lane, LAS float* red  ) {
    const int l15 = lane & 15, quad = lane >> 4, kw = K >> 3;
    for (int item = blk; item < N / 32; item += G) {
        const int c0 = item * 32;
        const bf16_t* ap = A16 + (size_t)l15 * K + 8 * quad + wave * kw;
        const bf16_t* w0 = Bt + (size_t)(c0 + 8 * (l15 >> 2) + (l15 & 3)) * K + 8 * quad + wave * kw;
        const bf16_t* w1 = w0 + (size_t)4 * K;
        f32x4 acc0 = {0.f, 0.f, 0.f, 0.f}, acc1 = {0.f, 0.f, 0.f, 0.f};
#pragma unroll 4
        for (int k = 0; k < kw; k += 32) {
            const bf16x8 xa = *(const bf16x8*)(ap + k), b0 = *(const bf16x8*)(w0 + k), b1 = *(const bf16x8*)(w1 + k);
            acc0 = MFMA16(b0, xa, acc0); acc1 = MFMA16(b1, xa, acc1);
        }
        *(LAS f32x4*)(red + (wave * 64 + lane) * 8) = acc0; *(LAS f32x4*)(red + (wave * 64 + lane) * 8 + 4) = acc1;
        __syncthreads();
        if (wave == 0) {
#pragma unroll
            for (int w = 1; w < 8; ++w) { acc0 += *(const LAS f32x4*)(red + (w * 64 + lane) * 8); acc1 += *(const LAS f32x4*)(red + (w * 64 + lane) * 8 + 4); }
            const RowCtx rc = f.row_ctx(T + l15);
            const typename F::ColCtx cc = f.col_ctx(c0 + 8 * quad);
            const typename F::Pre pr = f.template pre<true>(T + l15, c0 + 8 * quad);
            float s = 0.f, q = 0.f;
            f.apply8(T + l15, c0 + 8 * quad, acc0, acc1, rc, cc, pr, s, q);
            if (F::MAKES_STATS) {
                s += __shfl_xor(s, 16); s += __shfl_xor(s, 32); q += __shfl_xor(q, 16); q += __shfl_xor(q, 32);
                if (quad == 0) { float* st = f.st_ptr() + 2 * (size_t)(T + l15); unsafeAtomicAdd(st, s); unsafeAtomicAdd(st + 1, q); }
            }
        }
        __syncthreads();
    }
}
template <class F> __device__ __forceinline__ void run_gemm(LAS unsigned char* lds, const bf16_t* A, const bf16_t* Bt, int N, int K, const F& f, bool with_meta, int blk, int G, int wave) {
    pg8::Gemm g{A, Bt, T, N, K}; pg8::StaticOrder S; S.init(T, N, G, blk);
    EpiAdapt<F> E{f};
    pg8::gemm_phase<EpiAdapt<F>, pg8::StaticOrder, true, true>((PG8_LAS unsigned char*)lds, g, S, E, wave);
    if (with_meta) meta_gemm<F>(A + (size_t)T * K, Bt, N, K, f, blk, G, wave, lane_id_v(), (LAS float*)lds);
}

__device__ __forceinline__ void transpose_item(const float* W, int K, int N, bf16_t* WT, LAS float* scr, int item, int lane) {
    const int nblk = N / 32, kb = item / nblk, nb = item % nblk, k0 = 64 * kb, n0 = 32 * nb;
    float wv_[32];
#pragma unroll
    for (int i = 0; i < 32; ++i) wv_[i] = W[(size_t)(k0 + 2 * i + (lane >> 5)) * N + n0 + (lane & 31)];
#pragma unroll
    for (int i = 0; i < 32; ++i) scr[(2 * i + (lane >> 5)) * 33 + (lane & 31)] = wv_[i];
    LDS_WAIT();
    const int c = lane & 7;
#pragma unroll
    for (int j = 0; j < 4; ++j) { const int n = (lane >> 3) + 8 * j; const LAS float* s = scr + (8 * c) * 33 + n;
        u32x4 o; o.x = pk2(s[0 * 33], s[1 * 33]); o.y = pk2(s[2 * 33], s[3 * 33]); o.z = pk2(s[4 * 33], s[5 * 33]); o.w = pk2(s[6 * 33], s[7 * 33]);
        *(u32x4*)(WT + (size_t)(n0 + n) * K + k0 + 8 * c) = o; }
    LDS_WAIT();
}
__device__ __forceinline__ void transpose_item_fold(const float* W, int K, int N, bf16_t* WT, LAS float* scr, int item, int lane, const float* g, const float* bta, float* sv, float* tv) {
    const int nblk = N / 32, kb = item / nblk, nb = item % nblk, k0 = 64 * kb, n0 = 32 * nb;
    float wv_[32];
#pragma unroll
    for (int i = 0; i < 32; ++i) wv_[i] = W[(size_t)(k0 + 2 * i + (lane >> 5)) * N + n0 + (lane & 31)];
#pragma unroll
    for (int i = 0; i < 32; ++i) scr[(2 * i + (lane >> 5)) * 33 + (lane & 31)] = wv_[i];
    LDS_WAIT();
    const int c = lane & 7;
    const f32x4 g0 = *(const f32x4*)(g + k0 + 8 * c), g1 = *(const f32x4*)(g + k0 + 8 * c + 4), b0 = *(const f32x4*)(bta + k0 + 8 * c), b1 = *(const f32x4*)(bta + k0 + 8 * c + 4);
#pragma unroll
    for (int j = 0; j < 4; ++j) { const int n = (lane >> 3) + 8 * j; const LAS float* s = scr + (8 * c) * 33 + n;
        const float w0 = s[0 * 33], w1 = s[1 * 33], w2 = s[2 * 33], w3 = s[3 * 33], w4 = s[4 * 33], w5 = s[5 * 33], w6 = s[6 * 33], w7 = s[7 * 33];
        u32x4 o; o.x = pk2(g0[0] * w0, g0[1] * w1); o.y = pk2(g0[2] * w2, g0[3] * w3); o.z = pk2(g1[0] * w4, g1[1] * w5); o.w = pk2(g1[2] * w6, g1[3] * w7);
        *(u32x4*)(WT + (size_t)(n0 + n) * K + k0 + 8 * c) = o;
        float ss = ((bflo(o.x) + bfhi(o.x)) + (bflo(o.y) + bfhi(o.y))) + ((bflo(o.z) + bfhi(o.z)) + (bflo(o.w) + bfhi(o.w)));
        float tt = ((b0[0] * w0 + b0[1] * w1) + (b0[2] * w2 + b0[3] * w3)) + ((b1[0] * w4 + b1[1] * w5) + (b1[2] * w6 + b1[3] * w7));
        ss += __shfl_xor(ss, 1); ss += __shfl_xor(ss, 2); ss += __shfl_xor(ss, 4);
        tt += __shfl_xor(tt, 1); tt += __shfl_xor(tt, 2); tt += __shfl_xor(tt, 4);
        if (c == 0) { unsafeAtomicAdd(sv + n0 + n, ss); unsafeAtomicAdd(tv + n0 + n, tt); } }
    LDS_WAIT();
}
__device__ __forceinline__ void weight_items(const Params& P, LAS float* scr, int gw, int NGW, int lane, int part) {
    unsigned char* ws = P.ws;
    constexpr int I_AB = 16 * 64, I_GLU = 8 * 16, I_1M = 16 * 32, I_C = 16 * 128, I_UP = 16 * 128, I_DN = 64 * 32;
    constexpr int NREST = I_GLU + I_1M + I_C + I_1M + 2 * I_UP + 2 * I_DN;
    if (part == 0) { for (int it = gw; it < I_AB; it += NGW) transpose_item(P.in[2], 1024, 2048, (bf16_t*)(ws + OFF_WAB), scr, it, lane); return; }
    for (int it = gw; it < NREST; it += NGW) {
        int r = it;
        if (r < I_GLU) { transpose_item(P.in[11], 512, 512, (bf16_t*)(ws + OFF_WGLU), scr, r, lane); continue; } r -= I_GLU;
        if (r < I_1M) { transpose_item(P.in[13], 1024, 1024, (bf16_t*)(ws + OFF_WOAB), scr, r, lane); continue; } r -= I_1M;
        if (r < I_UP) { transpose_item_fold(P.in[20], 1024, 4096, (bf16_t*)(ws + OFF_WUP0), scr, r, lane, P.in[18], P.in[19], (float*)(ws + OFF_SV), (float*)(ws + OFF_TV)); continue; } r -= I_UP;
        if (r < I_DN) { transpose_item(P.in[22], 4096, 1024, (bf16_t*)(ws + OFF_WDN0), scr, r, lane); continue; } r -= I_DN;
        if (r < I_C) { transpose_item_fold(P.in[14], 1024, 4096, (bf16_t*)(ws + OFF_WC), scr, r, lane, P.in[24], P.in[25], (float*)(ws + OFF_SV) + 4096, (float*)(ws + OFF_TV) + 4096); continue; } r -= I_C;
        if (r < I_1M) { transpose_item(P.in[17], 1024, 1024, (bf16_t*)(ws + OFF_WOC), scr, r, lane); continue; } r -= I_1M;
        if (r < I_UP) { transpose_item_fold(P.in[20] + (size_t)1024 * 4096, 1024, 4096, (bf16_t*)(ws + OFF_WUP1), scr, r, lane, P.in[18] + 1024, P.in[19] + 1024, (float*)(ws + OFF_SV) + 8192, (float*)(ws + OFF_TV) + 8192); continue; } r -= I_UP;
        transpose_item(P.in[22] + (size_t)4096 * 1024, 4096, 1024, (bf16_t*)(ws + OFF_WDN1), scr, r, lane);
    }
}
__device__ __forceinline__ void prologue_phase(const Params& P, LAS unsigned char* lds, int blk, int G, int wave) {
    const int lane = lane_id_v(), tid = wave * 64 + lane;
    unsigned char* ws = P.ws;
    weight_items(P, (LAS float*)(lds + wave * 8448), blk * 8 + wave, G * 8, lane, 0);
    bf16_t* HB = (bf16_t*)(ws + OFF_HB);
    const size_t n8 = (size_t)R * 1024 / 8;
#pragma unroll 4
    for (size_t i = (size_t)blk * 512 + tid; i < n8; i += (size_t)G * 512) {
        const size_t e = i * 8;
        const float* src = e < (size_t)T * 1024 ? P.in[0] + e : P.in[1] + (e - (size_t)T * 1024);
        const f32x4 a = *(const f32x4*)src, b = *(const f32x4*)(src + 4);
        u32x4 w; w.x = pk2(a[0], a[1]); w.y = pk2(a[2], a[3]); w.z = pk2(b[0], b[1]); w.w = pk2(b[2], b[3]);
        *(u32x4*)(HB + e) = w;
    }
}

__device__ __forceinline__ void ln_phase(const float* Zin, float* Fout, bf16_t* Bout, const float* g, const float* bta, int nrows, int blk, int G, int wave) {
    const int lane = lane_id_v();
    for (int row = blk * 8 + wave; row < nrows; row += G * 8) {
        const f32x4* xr = (const f32x4*)(Zin + (size_t)row * 1024) + lane;
        f32x4 v[4]; float s = 0.f;
#pragma unroll
        for (int j = 0; j < 4; ++j) { v[j] = xr[64 * j]; s += (v[j][0] + v[j][1]) + (v[j][2] + v[j][3]); }
#pragma unroll
        for (int o = 1; o < 64; o <<= 1) s += __shfl_xor(s, o);
        const float mean = s * (1.f / 1024.f); float s2 = 0.f;
#pragma unroll
        for (int j = 0; j < 4; ++j) { v[j] = v[j] - mean; s2 += (v[j][0] * v[j][0] + v[j][1] * v[j][1]) + (v[j][2] * v[j][2] + v[j][3] * v[j][3]); }
#pragma unroll
        for (int o = 1; o < 64; o <<= 1) s2 += __shfl_xor(s2, o);
        const float rstd = 1.0f / sqrtf(s2 * (1.f / 1024.f) + 1e-5f);
#pragma unroll
        for (int j = 0; j < 4; ++j) {
            const int col = 4 * (lane + 64 * j);
            const f32x4 gg = *(const f32x4*)(g + col), bb = *(const f32x4*)(bta + col);
            const f32x4 o = v[j] * rstd * gg + bb;
            *(f32x4*)(Fout + (size_t)row * 1024 + col) = o;
            if (Bout) { u32x2 w; w.x = pk2(o[0], o[1]); w.y = pk2(o[2], o[3]); *(u32x2*)(Bout + (size_t)row * 1024 + col) = w; }
        }
    }
}

__device__ __forceinline__ void final_ln_phase(const bf16_t* Zb, const float* st, float* out, const float* g, const float* bta, int blk, int G, int wave) {
    const int lane = lane_id_v();
    for (int row0 = (blk * 8 + wave) * 4; row0 < T; row0 += G * 8 * 4) {
        u32x4 v[4][2];
#pragma unroll
        for (int rr = 0; rr < 4; ++rr)
#pragma unroll
            for (int j = 0; j < 2; ++j) v[rr][j] = *(const u32x4*)((const char*)Zb + ((unsigned)(row0 + rr) * 2048u + (unsigned)(8 * (lane + 64 * j)) * 2u));
#pragma unroll
        for (int rr = 0; rr < 4; ++rr) {
            const int row = row0 + rr;
            const RowCtx rc = ln_ctx(st, row);
#pragma unroll
            for (int j = 0; j < 2; ++j) {
                const int col = 8 * (lane + 64 * j);
                const f32x4 h0 = {bflo(v[rr][j].x), bfhi(v[rr][j].x), bflo(v[rr][j].y), bfhi(v[rr][j].y)}, h1 = {bflo(v[rr][j].z), bfhi(v[rr][j].z), bflo(v[rr][j].w), bfhi(v[rr][j].w)};
                float* op = out + (size_t)row * 1024 + col;
                *(f32x4*)op = (h0 - rc.mu) * rc.rstd * *(const f32x4*)(g + col) + *(const f32x4*)(bta + col);
                *(f32x4*)(op + 4) = (h1 - rc.mu) * rc.rstd * *(const f32x4*)(g + col + 4) + *(const f32x4*)(bta + col + 4);
            }
        }
    }
}

__device__ __forceinline__ void lam_coef(const float* lam_re, const float* lam_im, float dt, int idx, float& lbr, float& lbi, float& cr, float& ci) {
    const float lr = lam_re[idx], li = lam_im[idx];
    const float er = __expf(lr * dt);
    float ang = li * dt;
    const float kk = rintf(ang * 0.15915494309189535f);
    ang = fmaf(-kk, 6.2831854820251465f, ang); ang = fmaf(-kk, -1.7484555e-7f, ang);
    lbr = er * __cosf(ang); lbi = er * __sinf(ang);
    const float nr = lbr - 1.0f, ni = lbi, den = 1.0f / (lr * lr + li * li);
    cr = (nr * lr + ni * li) * den; ci = (ni * lr - nr * li) * den;
}
__device__ __forceinline__ void s5_phase(const Params& P, LAS unsigned char* lds, int blk, int G, int wave) {
    const int lane = lane_id_v(), l15 = lane & 15, quad = lane >> 4;
    LAS float* bu = (LAS float*)(lds + wave * 12800);
    LAS unsigned* sl = (LAS unsigned*)(lds + wave * 12800 + 8448);
    const bf16_t* PROJ = (const bf16_t*)(P.ws + OFF_BIG + BIG_PROJ);
    bf16_t* APRE = (bf16_t*)(P.ws + OFF_BIG + BIG_APRE);
    for (int vw = wave; blk + G * (vw >> 1) < 512; vw += 8) {
        const int item = blk + G * (vw >> 1), seg = vw & 1;
        const int b = item >> 5, g = item & 31;
        const int c_end = seg ? 129 : 65, c_out = seg ? 65 : 0;
        const float dt = __expf(P.in[5][g]);
        float lbr, lbi, cr_, ci_;
        lam_coef(P.in[3], P.in[4], dt, g * 64 + lane, lbr, lbi, cr_, ci_);
        bf16x8 bfrag[8];
#pragma unroll
        for (int tile = 0; tile < 8; ++tile) {
            const int comp = 16 * tile + l15, st = comp & 63, isim = comp >> 6;
            float a0, a1, cr, ci; lam_coef(P.in[3], P.in[4], dt, g * 64 + st, a0, a1, cr, ci);
            bf16x8 fr = {0, 0, 0, 0, 0, 0, 0, 0};
            if (quad < 2) {
                const float* bre = P.in[6] + (size_t)(g * 64 + st) * 16 + 8 * quad;
                const float* bim = P.in[7] + (size_t)(g * 64 + st) * 16 + 8 * quad;
#pragma unroll
                for (int j = 0; j < 8; ++j) { const float v = isim ? (cr * bim[j] + ci * bre[j]) : (cr * bre[j] - ci * bim[j]); fr[j] = (short)f2bf(v); }
            }
            bfrag[tile] = fr;
        }
        bf16x8 cfrag[4];
#pragma unroll
        for (int ks = 0; ks < 4; ++ks) {
#pragma unroll
            for (int j = 0; j < 8; ++j) {
                const int k = 32 * ks + 8 * quad + j, p = k >> 1;
                const float v = (k & 1) ? -P.in[9][(size_t)(g * 16 + l15) * 64 + p] : P.in[8][(size_t)(g * 16 + l15) * 64 + p];
                cfrag[ks][j] = (short)f2bf(v);
            }
        }
        const float dh = P.in[10][g * 16 + l15];
        float sr = 0.f, si = 0.f;
        const bf16x8 zero8 = {0, 0, 0, 0, 0, 0, 0, 0};
        bf16x8 ua_n = *(const bf16x8*)(PROJ + (size_t)(T + l15) * 2048 + g * 16 + 8 * (quad & 1));
        unsigned short ue_n[4];
#pragma unroll
        for (int r = 0; r < 4; ++r) ue_n[r] = PROJ[(size_t)(T + 4 * quad + r) * 2048 + g * 16 + l15];
        for (int chunk = 0; chunk < c_end; ++chunk) {
            const bool outp = chunk >= c_out;
            const int rowbase = chunk == 0 ? T : b * 2048 + (chunk - 1) * 16;
            const bf16x8 ua = quad < 2 ? ua_n : zero8;
            unsigned short ue[4];
#pragma unroll
            for (int r = 0; r < 4; ++r) ue[r] = ue_n[r];
            {
                const int cn = chunk + 1 < 129 ? chunk + 1 : 128;
                const int rbn = b * 2048 + (cn - 1) * 16;
                ua_n = *(const bf16x8*)(PROJ + (size_t)(rbn + l15) * 2048 + g * 16 + 8 * (quad & 1));
#pragma unroll
                for (int r = 0; r < 4; ++r) ue_n[r] = PROJ[(size_t)(rbn + 4 * quad + r) * 2048 + g * 16 + l15];
            }
#pragma unroll
            for (int tile = 0; tile < 8; ++tile) {
                f32x4 acc = {0.f, 0.f, 0.f, 0.f};
                acc = MFMA16(ua, bfrag[tile], acc);
#pragma unroll
                for (int r = 0; r < 4; ++r) bu[(4 * quad + r) * 132 + 16 * tile + l15] = acc[r];
            }
            LDS_WAIT();
            if (!outp) {
#pragma unroll
                for (int t = 0; t < 16; ++t) {
                    const float br = bu[t * 132 + lane], bi = bu[t * 132 + 64 + lane];
                    const float nsr = fmaf(lbr, sr, fmaf(-lbi, si, br)), nsi = fmaf(lbr, si, fmaf(lbi, sr, bi));
                    sr = nsr; si = nsi;
                }
                LDS_WAIT();
                continue;
            }
#pragma unroll
            for (int t = 0; t < 16; ++t) {
                const float br = bu[t * 132 + lane], bi = bu[t * 132 + 64 + lane];
                const float nsr = fmaf(lbr, sr, fmaf(-lbi, si, br)), nsi = fmaf(lbr, si, fmaf(lbi, sr, bi));
                sr = nsr; si = nsi;
                sl[t * 68 + lane] = pk2(sr, si);
            }
            LDS_WAIT();
            f32x4 y = {0.f, 0.f, 0.f, 0.f};
#pragma unroll
            for (int ks = 0; ks < 4; ++ks) {
                const bf16x8 sa = *(const LAS bf16x8*)((const LAS bf16_t*)sl + l15 * 136 + 32 * ks + 8 * quad);
                y = MFMA16(sa, cfrag[ks], y);
            }
            if (chunk > 0 || b == 0) {
#pragma unroll
                for (int r = 0; r < 4; ++r) {
                    const size_t row = (size_t)(rowbase + 4 * quad + r);
                    const float u = bf2f(ue[r]);
                    const float v = y[r] + dh * u;
                    const float a2 = 1.5957691216057308f * (v + 0.044715f * v * v * v);
                    APRE[row * 512 + g * 16 + l15] = f2bf(v * sigmoidf_(a2));
                }
            }
            LDS_WAIT();
        }
    }
}

template <bool MASKED>
__device__ __forceinline__ void attn_tile_sub(const LAS bf16_t* Kl, const LAS bf16_t* Vl, const bf16x8 (&qf)[4], int sub, int keybase  ,
                                              int iq, int l31, int h, bool pick0, f32x16& o0, f32x16& o1, float& Rrun) {
    bf16x8 ka[4];
#pragma unroll
    for (int s = 0; s < 4; ++s) ka[s] = *(const LAS bf16x8*)(Kl + (32 * sub + l31) * 72 + 16 * s + 8 * h);
    bf16x8 va[2][2];
#pragma unroll
    for (int s2 = 0; s2 < 2; ++s2)
#pragma unroll
        for (int mt = 0; mt < 2; ++mt) {
            const LAS bf16_t* vp = Vl + (32 * mt + l31) * 68 + 32 * sub + 16 * s2 + 4 * h;
            const s16x4 lo = *(const LAS s16x4*)vp, hi = *(const LAS s16x4*)(vp + 8);
            va[s2][mt] = __builtin_shufflevector(lo, hi, 0, 1, 2, 3, 4, 5, 6, 7);
        }
    __builtin_amdgcn_sched_barrier(0);
    f32x16 st;
#pragma unroll
    for (int i = 0; i < 16; ++i) st[i] = 0.f;
#pragma unroll
    for (int s = 0; s < 4; ++s) st = MFMA32(ka[s], qf[s], st);
    float kp[16], be[16];
#pragma unroll
    for (int i = 0; i < 16; ++i) {
        const float e = __builtin_amdgcn_exp2f(st[i]);
        float r = __builtin_amdgcn_rcpf(1.0f + e);
        if (MASKED) {
            const int kl = 32 * sub + (i & 3) + 8 * (i >> 2) + 4 * h;
            const bool vis = keybase >= 0 ? (keybase + kl < iq) : (kl < 16);
            r = vis ? r : 1.0f;
        }
        kp[i] = r; be[i] = 1.0f - r;
    }
    float ga[4], pa[4];
#pragma unroll
    for (int a = 0; a < 4; ++a) {
        ga[a] = (kp[4 * a] * kp[4 * a + 1]) * (kp[4 * a + 2] * kp[4 * a + 3]);
        const auto sw = __builtin_amdgcn_permlane32_swap(__float_as_uint(ga[a]), __float_as_uint(ga[a]), false, false);
        pa[a] = __uint_as_float(pick0 ? sw[0] : sw[1]);
    }
    float run = Rrun; float w[16];
#pragma unroll
    for (int a = 3; a >= 0; --a) {
        const float P3 = h ? run : run * pa[a];
        const float P2 = P3 * kp[4 * a + 3], P1 = P2 * kp[4 * a + 2], P0 = P1 * kp[4 * a + 1];
        w[4 * a + 3] = be[4 * a + 3] * P3; w[4 * a + 2] = be[4 * a + 2] * P2; w[4 * a + 1] = be[4 * a + 1] * P1; w[4 * a + 0] = be[4 * a + 0] * P0;
        run *= ga[a] * pa[a];
    }
    Rrun = run;
#pragma unroll
    for (int s2 = 0; s2 < 2; ++s2) {
        u32x4 pw; pw.x = pk2(w[8 * s2], w[8 * s2 + 1]); pw.y = pk2(w[8 * s2 + 2], w[8 * s2 + 3]); pw.z = pk2(w[8 * s2 + 4], w[8 * s2 + 5]); pw.w = pk2(w[8 * s2 + 6], w[8 * s2 + 7]);
        const bf16x8 pb = __builtin_bit_cast(bf16x8, pw);
        o0 = MFMA32(va[s2][0], pb, o0); o1 = MFMA32(va[s2][1], pb, o1);
    }
}
__device__ __forceinline__ void attn_phase(const Params& P, LAS unsigned char* lds, int blk, int G, int wave) {
    const int lane = lane_id_v(), tid = wave * 64 + lane, l31 = lane & 31, h = lane >> 5;
    const bf16_t* PROJ = (const bf16_t*)(P.ws + OFF_BIG + BIG_PROJ);
    bf16_t* CAT = (bf16_t*)(P.ws + OFF_BIG + BIG_CAT);
    if (blk == G - 1) {
        LAS float* wm = (LAS float*)(lds + 40960);
        if (tid < 128) {
            const int t = tid & 15, hd = tid >> 4;
            const bf16_t* qp = PROJ + (size_t)(T + t) * 2048 + 512 + hd * 64;
            float run = 1.f;
            for (int j = 15; j >= 0; --j) {
                float wv = 0.f;
                if (j < t) {
                    const bf16_t* kp = PROJ + (size_t)(T + j) * 2048 + 1024 + hd * 64;
                    float z = 0.f;
                    for (int d = 0; d < 64; ++d) z = fmaf(bf2f(qp[d]), bf2f(kp[d]), z);
                    const float r = __builtin_amdgcn_rcpf(1.0f + __builtin_amdgcn_exp2f(z));
                    wv = (1.0f - r) * run; run *= r;
                }
                wm[tid * 16 + j] = wv;
            }
        }
        __syncthreads();
        for (int idx = tid; idx < 16 * 512; idx += 512) {
            const int t = idx >> 9, c = idx & 511, hd = c >> 6;
            float o = 0.f;
            for (int j = 0; j < 16; ++j) o = fmaf(wm[(hd * 16 + t) * 16 + j], bf2f(PROJ[(size_t)(T + j) * 2048 + 1536 + c]), o);
            CAT[(size_t)(T + t) * 1024 + 512 + c] = f2bf(o);
        }
        __syncthreads();
    }
    bool pick0;
    { const auto hs = __builtin_amdgcn_permlane32_swap((unsigned)h, (unsigned)h, false, false); pick0 = hs[0] != (unsigned)h; }
    LAS bf16_t* Kl0 = (LAS bf16_t*)lds;
    LAS bf16_t* Vl0 = (LAS bf16_t*)(lds + 2 * 9216);
    const int lkey = tid >> 3, lpart = tid & 7;
    for (int j4 = 0; j4 < 4; ++j4) {
        const int item = blk + G * j4;
        if (item >= 1024) break;
        const int c = item % 256, jj = item / 256, bh = c >> 1, par = c & 1;
        const int qb = par == 0 ? (jj == 0 ? 7 : jj == 1 ? 0 : jj == 2 ? 4 : 3) : (jj == 0 ? 6 : jj == 1 ? 1 : jj == 2 ? 5 : 2);
        const int b = bh >> 3, hd = bh & 7;
        const int iq = 256 * qb + 32 * wave + l31;
        const size_t qrow = (size_t)b * 2048 + iq;
        bf16x8 qf[4];
#pragma unroll
        for (int s = 0; s < 4; ++s) qf[s] = *(const bf16x8*)(PROJ + qrow * 2048 + 512 + hd * 64 + 16 * s + 8 * h);
        f32x16 o0, o1;
#pragma unroll
        for (int i = 0; i < 16; ++i) { o0[i] = 0.f; o1[i] = 0.f; }
        float Rrun = 1.0f;
        const int nt = 4 * qb + 5;
        u32x4 kreg, vreg;
#define ATT_LOAD(it_) do { const int kt_ = 4 * qb + 3 - (it_); size_t row_; bool ok_ = true; \
            if (kt_ >= 0) row_ = (size_t)b * 2048 + 64 * kt_ + lkey; else { row_ = (size_t)T + lkey; ok_ = lkey < 16; } \
            if (ok_) { const bf16_t* p_ = PROJ + row_ * 2048 + 1024 + hd * 64 + lpart * 8; kreg = *(const u32x4*)p_; vreg = *(const u32x4*)(p_ + 512); } \
            else { kreg = (u32x4){0u, 0u, 0u, 0u}; vreg = kreg; } } while (0)
#define ATT_STORE(buf_) do { *(LAS u32x4*)(Kl0 + (buf_) * 4608 + lkey * 72 + lpart * 8) = kreg; \
            LAS bf16_t* vt_ = Vl0 + (buf_) * 4352 + (lpart * 8) * 68 + lkey; \
            vt_[0 * 68] = (bf16_t)(vreg.x & 0xffffu); vt_[1 * 68] = (bf16_t)(vreg.x >> 16); \
            vt_[2 * 68] = (bf16_t)(vreg.y & 0xffffu); vt_[3 * 68] = (bf16_t)(vreg.y >> 16); \
            vt_[4 * 68] = (bf16_t)(vreg.z & 0xffffu); vt_[5 * 68] = (bf16_t)(vreg.z >> 16); \
            vt_[6 * 68] = (bf16_t)(vreg.w & 0xffffu); vt_[7 * 68] = (bf16_t)(vreg.w >> 16); } while (0)
        ATT_LOAD(0); ATT_STORE(0);
        __syncthreads();
        int cur = 0;
        bool wdone = false;
        LAS unsigned* dflag = (LAS unsigned*)(lds + 36864);
        for (int it = 0; it < nt; ++it) {
            if (it + 1 < nt) ATT_LOAD(it + 1);
            const int kt = 4 * qb + 3 - it;
            const int keybase = kt >= 0 ? 64 * kt : -1;
            const int wq_end = 256 * qb + 32 * wave + 32;
            const LAS bf16_t* Kl = Kl0 + cur * 4608; const LAS bf16_t* Vl = Vl0 + cur * 4352;
            if (wdone) {}
            else if (kt < 0) { attn_tile_sub<true>(Kl, Vl, qf, 0, -1, iq, l31, h, pick0, o0, o1, Rrun); }
            else {
                const int wq_beg = wq_end - 32;
                if (keybase + 64 <= wq_beg) { attn_tile_sub<false>(Kl, Vl, qf, 1, keybase, iq, l31, h, pick0, o0, o1, Rrun); attn_tile_sub<false>(Kl, Vl, qf, 0, keybase, iq, l31, h, pick0, o0, o1, Rrun); }
                else {
                    if (keybase + 32 < wq_end) attn_tile_sub<true>(Kl, Vl, qf, 1, keybase, iq, l31, h, pick0, o0, o1, Rrun);
                    if (keybase < wq_end) attn_tile_sub<true>(Kl, Vl, qf, 0, keybase, iq, l31, h, pick0, o0, o1, Rrun);
                }
            }
            if (it + 1 < nt) ATT_STORE(cur ^ 1);
            wdone = __builtin_amdgcn_ballot_w64(Rrun >= 9.094947e-13f) == 0ull;
            if (lane == 0) dflag[(it & 1) * 8 + wave] = wdone ? 1u : 0u;
            __syncthreads();
            cur ^= 1;
            { const u32x4 f0 = *(const LAS u32x4*)(dflag + (it & 1) * 8), f1 = *(const LAS u32x4*)(dflag + (it & 1) * 8 + 4);
              if ((f0.x & f0.y & f0.z & f0.w & f1.x & f1.y & f1.z & f1.w) != 0u) break; }
        }
        bf16_t* op = CAT + qrow * 1024 + 512 + hd * 64;
#pragma unroll
        for (int a = 0; a < 4; ++a) {
            u32x2 w0; w0.x = pk2(o0[4 * a], o0[4 * a + 1]); w0.y = pk2(o0[4 * a + 2], o0[4 * a + 3]);
            u32x2 w1; w1.x = pk2(o1[4 * a], o1[4 * a + 1]); w1.y = pk2(o1[4 * a + 2], o1[4 * a + 3]);
            *(u32x2*)(op + 8 * a + 4 * h) = w0; *(u32x2*)(op + 32 + 8 * a + 4 * h) = w1;
        }
    }
}

__device__ __forceinline__ void meta_attn(const Params& P, LAS unsigned char* lds, int blk, int G, int wave) {
    const int hd = G - 1 - blk;
    if (hd < 0 || hd >= 8) return;
    const int lane = lane_id_v(), tid = wave * 64 + lane;
    const bf16_t* PROJ = (const bf16_t*)(P.ws + OFF_BIG + BIG_PROJ);
    bf16_t* CAT = (bf16_t*)(P.ws + OFF_BIG + BIG_CAT);
    LAS float* zz = (LAS float*)(lds + 40960);
    if (tid < 256) {
        const int t = tid >> 4, j = tid & 15;
        const u32x4* qp = (const u32x4*)(PROJ + (size_t)(T + t) * 2048 + 512 + hd * 64);
        const u32x4* kp = (const u32x4*)(PROJ + (size_t)(T + j) * 2048 + 1024 + hd * 64);
        float z = 0.f;
#pragma unroll
        for (int c = 0; c < 8; ++c) { const u32x4 a = qp[c], k = kp[c];
            z += bflo(a.x) * bflo(k.x) + bfhi(a.x) * bfhi(k.x) + bflo(a.y) * bflo(k.y) + bfhi(a.y) * bfhi(k.y) + bflo(a.z) * bflo(k.z) + bfhi(a.z) * bfhi(k.z) + bflo(a.w) * bflo(k.w) + bfhi(a.w) * bfhi(k.w); }
        zz[t * 16 + j] = z;
    }
    __syncthreads();
    if (tid < 16) {
        const int t = tid; float run = 1.f;
        for (int j = 15; j >= 0; --j) {
            float wv = 0.f;
            if (j < t) { const float r = __builtin_amdgcn_rcpf(1.0f + __builtin_amdgcn_exp2f(zz[t * 16 + j])); wv = (1.0f - r) * run; run *= r; }
            zz[t * 16 + j] = wv;
        }
    }
    __syncthreads();
    for (int idx = tid; idx < 16 * 64; idx += 512) {
        const int t = idx >> 6, d = idx & 63;
        float o = 0.f;
#pragma unroll
        for (int j = 0; j < 16; ++j) o = fmaf(zz[t * 16 + j], bf2f(PROJ[(size_t)(T + j) * 2048 + 1536 + hd * 64 + d]), o);
        CAT[(size_t)(T + t) * 1024 + 512 + hd * 64 + d] = f2bf(o);
    }
    __syncthreads();
}
template <bool MASKED>
__device__ __forceinline__ void attn_sub_reg(const bf16x8 (&ka)[4], const LAS bf16_t* Vl  , const bf16x8 (&qf)[4], int keybase  ,
                                             int iq, int l31, int h, bool pick0, f32x16& o0, f32x16& o1, float& Rrun) {
    bf16x8 va[2][2];
#pragma unroll
    for (int s2 = 0; s2 < 2; ++s2)
#pragma unroll
        for (int mt = 0; mt < 2; ++mt) {
            const LAS bf16_t* vp = Vl + (32 * mt + l31) * 36 + 16 * s2 + 4 * h;
            const s16x4 lo = *(const LAS s16x4*)vp, hi = *(const LAS s16x4*)(vp + 8);
            va[s2][mt] = __builtin_shufflevector(lo, hi, 0, 1, 2, 3, 4, 5, 6, 7);
        }
    f32x16 st;
#pragma unroll
    for (int i = 0; i < 16; ++i) st[i] = 0.f;
#pragma unroll
    for (int s = 0; s < 4; ++s) st = MFMA32(ka[s], qf[s], st);
    float kp[16], be[16];
#pragma unroll
    for (int i = 0; i < 16; ++i) {
        const float e = __builtin_amdgcn_exp2f(st[i]);
        float r = __builtin_amdgcn_rcpf(1.0f + e);
        if (MASKED) {
            const int kl = (i & 3) + 8 * (i >> 2) + 4 * h;
            const bool vis = keybase >= 0 ? (keybase + kl < iq) : (kl < 16);
            r = vis ? r : 1.0f;
        }
        kp[i] = r; be[i] = 1.0f - r;
    }
    float ga[4], pa[4];
#pragma unroll
    for (int a = 0; a < 4; ++a) {
        ga[a] = (kp[4 * a] * kp[4 * a + 1]) * (kp[4 * a + 2] * kp[4 * a + 3]);
        const auto sw = __builtin_amdgcn_permlane32_swap(__float_as_uint(ga[a]), __float_as_uint(ga[a]), false, false);
        pa[a] = __uint_as_float(pick0 ? sw[0] : sw[1]);
    }
    float run = Rrun; float w[16];
#pragma unroll
    for (int a = 3; a >= 0; --a) {
        const float P3 = h ? run : run * pa[a];
        const float P2 = P3 * kp[4 * a + 3], P1 = P2 * kp[4 * a + 2], P0 = P1 * kp[4 * a + 1];
        w[4 * a + 3] = be[4 * a + 3] * P3; w[4 * a + 2] = be[4 * a + 2] * P2; w[4 * a + 1] = be[4 * a + 1] * P1; w[4 * a + 0] = be[4 * a + 0] * P0;
        run *= ga[a] * pa[a];
    }
    Rrun = run;
#pragma unroll
    for (int s2 = 0; s2 < 2; ++s2) {
        u32x4 pw; pw.x = pk2(w[8 * s2], w[8 * s2 + 1]); pw.y = pk2(w[8 * s2 + 2], w[8 * s2 + 3]); pw.z = pk2(w[8 * s2 + 4], w[8 * s2 + 5]); pw.w = pk2(w[8 * s2 + 6], w[8 * s2 + 7]);
        const bf16x8 pb = __builtin_bit_cast(bf16x8, pw);
        o0 = MFMA32(va[s2][0], pb, o0); o1 = MFMA32(va[s2][1], pb, o1);
    }
}
__device__ __forceinline__ void attn_phase2(const Params& P, LAS unsigned char* lds, int blk, int G, int wave) {
    const int lane = lane_id_v(), tid = wave * 64 + lane, l31 = lane & 31, h = lane >> 5;
    const bf16_t* PROJ = (const bf16_t*)(P.ws + OFF_BIG + BIG_PROJ);
    bf16_t* CAT = (bf16_t*)(P.ws + OFF_BIG + BIG_CAT);
    meta_attn(P, lds, blk, G, wave);
    bool pick0;
    { const auto hs = __builtin_amdgcn_permlane32_swap((unsigned)h, (unsigned)h, false, false); pick0 = hs[0] != (unsigned)h; }
    LAS bf16_t* Vl = (LAS bf16_t*)(lds + wave * 4608);
    const int kp_ = lane & 15, dg = lane >> 4;
    for (int u = blk * 8 + wave; u < 8192; u += G * 8) {
        const int q32 = 63 - (u >> 7), bh = u & 127, b = bh >> 3, hd = bh & 7;
        const int iq = 32 * q32 + l31;
        const size_t qrow = (size_t)b * 2048 + iq;
        bf16x8 qf[4];
#pragma unroll
        for (int s = 0; s < 4; ++s) qf[s] = *(const bf16x8*)(PROJ + qrow * 2048 + 512 + hd * 64 + 16 * s + 8 * h);
        f32x16 o0, o1;
#pragma unroll
        for (int i = 0; i < 16; ++i) { o0[i] = 0.f; o1[i] = 0.f; }
        float Rrun = 1.0f;
        bf16x8 kn[4]; u32x4 vn[2][2];
#define A2_LOAD(st_) do { const size_t krow_ = (st_) >= 0 ? (size_t)b * 2048 + 32 * (st_) + l31 : (size_t)T + (l31 & 15); \
            const bf16_t* kp2_ = PROJ + krow_ * 2048 + 1024 + hd * 64 + 8 * h; \
            _Pragma("unroll") for (int s_ = 0; s_ < 4; ++s_) kn[s_] = *(const bf16x8*)(kp2_ + 16 * s_); \
            _Pragma("unroll") for (int e_ = 0; e_ < 2; ++e_) { const size_t vrow_ = (st_) >= 0 ? (size_t)b * 2048 + 32 * (st_) + 2 * kp_ + e_ : (size_t)T + ((2 * kp_ + e_) & 15); \
                const bf16_t* vp2_ = PROJ + vrow_ * 2048 + 1536 + hd * 64 + 16 * dg; vn[e_][0] = *(const u32x4*)vp2_; vn[e_][1] = *(const u32x4*)(vp2_ + 8); } } while (0)
        A2_LOAD(q32);
        for (int st = q32; st >= -1; --st) {
            bf16x8 ka[4]; u32x4 vc[2][2];
#pragma unroll
            for (int s = 0; s < 4; ++s) ka[s] = kn[s];
#pragma unroll
            for (int e = 0; e < 2; ++e) { vc[e][0] = vn[e][0]; vc[e][1] = vn[e][1]; }
            if (st > -1) A2_LOAD(st - 1);
#pragma unroll
            for (int half = 0; half < 2; ++half) {
                const unsigned a0[4] = {vc[0][half].x, vc[0][half].y, vc[0][half].z, vc[0][half].w}, a1[4] = {vc[1][half].x, vc[1][half].y, vc[1][half].z, vc[1][half].w};
#pragma unroll
                for (int i = 0; i < 4; ++i) {
                    const int d = 16 * dg + 8 * half + 2 * i;
                    *(LAS unsigned*)(Vl + d * 36 + 2 * kp_) = (a0[i] & 0xffffu) | (a1[i] << 16);
                    *(LAS unsigned*)(Vl + (d + 1) * 36 + 2 * kp_) = (a0[i] >> 16) | (a1[i] & 0xffff0000u);
                }
            }
            LDS_WAIT();
            if (st == q32 || st < 0) attn_sub_reg<true>(ka, Vl, qf, st >= 0 ? 32 * st : -1, iq, l31, h, pick0, o0, o1, Rrun);
            else attn_sub_reg<false>(ka, Vl, qf, 32 * st, iq, l31, h, pick0, o0, o1, Rrun);
            if (__builtin_amdgcn_ballot_w64(Rrun >= 9.094947e-13f) == 0ull) break;
        }
        bf16_t* op = CAT + qrow * 1024 + 512 + hd * 64;
#pragma unroll
        for (int a = 0; a < 4; ++a) {
            u32x2 w0; w0.x = pk2(o0[4 * a], o0[4 * a + 1]); w0.y = pk2(o0[4 * a + 2], o0[4 * a + 3]);
            u32x2 w1; w1.x = pk2(o1[4 * a], o1[4 * a + 1]); w1.y = pk2(o1[4 * a + 2], o1[4 * a + 3]);
            *(u32x2*)(op + 8 * a + 4 * h) = w0; *(u32x2*)(op + 32 + 8 * a + 4 * h) = w1;
        }
    }
    __syncthreads();
}

__device__ __forceinline__ void hgrn_phase(const Params& P, LAS unsigned char* lds, int blk, int G, int wave) {
    const int lane = lane_id_v(), tid = wave * 64 + lane, l15 = lane & 15, quad = lane >> 4;
    LAS bf16_t* qd = (LAS bf16_t*)lds;
    LAS bf16_t* kd = qd + 64 * 136;
    LAS bf16_t* klT = kd + 64 * 136;
    LAS bf16_t* vT = klT + 128 * 72;
    LAS bf16_t* sc = vT + 128 * 72;
    LAS float* ebl = (LAS float*)(sc + 64 * 72);
    LAS float* segtot = ebl + 128;
    LAS float* red = segtot + 1024;
    const unsigned short* PC = (const unsigned short*)(P.ws + OFF_BIG);
    bf16_t* MIXC = (bf16_t*)P.out;
    const float* ng = P.in[16];
    for (int item = blk; item < 128; item += G) {
        const int b = item >> 3, hd = item & 7;
        f32x4 Sacc[8];
#pragma unroll
        for (int i = 0; i < 8; ++i) Sacc[i] = (f32x4){0.f, 0.f, 0.f, 0.f};
        const int dp = tid & 63, sg = tid >> 6;
        unsigned lfc[8], qc[8], vc[8];
#define HG_OFF0(cc_) ((unsigned)((cc_) > 0 ? b * 2048 + ((cc_) - 1) * 64 + 8 * sg : (sg >= 6 ? T + 8 * (sg - 6) : (int)((OFF_ZROW - OFF_BIG) / 8192))) * 8192u + (unsigned)(hd * 128 + 2 * dp) * 2u)
#define HG_LOAD(cc_, LF_, Q_, V_) do { const unsigned o0_ = HG_OFF0(cc_); _Pragma("unroll") for (int tt_ = 0; tt_ < 8; ++tt_) { const unsigned o_ = o0_ + (unsigned)tt_ * 8192u; \
            Q_[tt_] = *(const unsigned*)((const char*)PC + o_); LF_[tt_] = *(const unsigned*)((const char*)PC + o_ + 2048u); V_[tt_] = *(const unsigned*)((const char*)PC + o_ + 4096u); } } while (0)
        HG_LOAD(0, lfc, qc, vc);
        if (tid < 64) red[tid] = 0.f;
        for (int c = 0; c < 33; ++c) {
            unsigned lfn[8], qn[8], vn[8];
            { const int cn = c + 1 < 33 ? c + 1 : 32; HG_LOAD(cn, lfn, qn, vn); }
            {
                float cs0[8], cs1[8]; float run0 = 0.f, run1 = 0.f;
#pragma unroll
                for (int tt = 0; tt < 8; ++tt) {
                    const float l0 = 1.4426950408889634f * (float)__builtin_bit_cast(_Float16, (unsigned short)(lfc[tt] & 0xffffu));
                    const float l1 = 1.4426950408889634f * (float)__builtin_bit_cast(_Float16, (unsigned short)(lfc[tt] >> 16));
                    run0 += l0; run1 += l1; cs0[tt] = run0; cs1[tt] = run1;
                }
                segtot[sg * 128 + 2 * dp] = run0; segtot[sg * 128 + 2 * dp + 1] = run1;
                __syncthreads();
                if (tid < 64) red[((c + 1) & 1) * 64 + tid] = 0.f;
                float off0 = 0.f, off1 = 0.f, bl0 = 0.f, bl1 = 0.f;
#pragma unroll
                for (int s2 = 0; s2 < 8; ++s2) {
                    const float a0 = segtot[s2 * 128 + 2 * dp], a1 = segtot[s2 * 128 + 2 * dp + 1];
                    bl0 += a0; bl1 += a1; if (s2 < sg) { off0 += a0; off1 += a1; }
                }
                const float ebl0 = __builtin_amdgcn_exp2f(bl0), ebl1 = __builtin_amdgcn_exp2f(bl1);
                if (sg == 7) { ebl[2 * dp] = ebl0; ebl[2 * dp + 1] = ebl1; }
                float eip0 = __builtin_amdgcn_exp2f(-off0), eip1 = __builtin_amdgcn_exp2f(-off1);
                unsigned kl0[4], kl1[4], v0[4], v1[4];
#pragma unroll
                for (int tp = 0; tp < 4; ++tp) {
                    float klv0[2], klv1[2];
#pragma unroll
                    for (int e = 0; e < 2; ++e) {
                        const int tt = 2 * tp + e, t = 8 * sg + tt;
                        const float bt0 = off0 + cs0[tt], bt1 = off1 + cs1[tt];
                        const float q0 = bflo(qc[tt]), q1 = bfhi(qc[tt]);
                        const float eb0 = __builtin_amdgcn_exp2f(bt0), eb1 = __builtin_amdgcn_exp2f(bt1);
                        const float ei0 = __builtin_amdgcn_rcpf(eb0), ei1 = __builtin_amdgcn_rcpf(eb1);
                        const float k0 = 1.0f - eb0 * eip0, k1 = 1.0f - eb1 * eip1;
                        eip0 = ei0; eip1 = ei1;
                        const float kd0 = k0 * ei0, kd1 = k1 * ei1;
                        *(LAS unsigned*)(qd + t * 136 + 2 * dp) = pk2(q0 * eb0, q1 * eb1);
                        *(LAS unsigned*)(kd + t * 136 + 2 * dp) = pk2(kd0, kd1);
                        klv0[e] = kd0 * ebl0; klv1[e] = kd1 * ebl1;
                    }
                    kl0[tp] = pk2(klv0[0], klv0[1]); kl1[tp] = pk2(klv1[0], klv1[1]);
                    const unsigned va = vc[2 * tp], vb = vc[2 * tp + 1];
                    v0[tp] = (va & 0xffffu) | (vb << 16); v1[tp] = (va >> 16) | (vb & 0xffff0000u);
                }
                *(LAS u32x4*)(klT + (2 * dp) * 72 + 8 * sg) = (u32x4){kl0[0], kl0[1], kl0[2], kl0[3]};
                *(LAS u32x4*)(klT + (2 * dp + 1) * 72 + 8 * sg) = (u32x4){kl1[0], kl1[1], kl1[2], kl1[3]};
                *(LAS u32x4*)(vT + (2 * dp) * 72 + 8 * sg) = (u32x4){v0[0], v0[1], v0[2], v0[3]};
                *(LAS u32x4*)(vT + (2 * dp + 1) * 72 + 8 * sg) = (u32x4){v1[0], v1[1], v1[2], v1[3]};
            }
            __syncthreads();
            f32x4 oacc[4];
#pragma unroll
            for (int i = 0; i < 4; ++i) oacc[i] = (f32x4){0.f, 0.f, 0.f, 0.f};
#pragma unroll
            for (int kh = 0; kh < 2; ++kh) {
                s16x4 alo[2][4], ahi[2][4];
#pragma unroll
                for (int k2 = 0; k2 < 2; ++k2)
#pragma unroll
                    for (int tt = 0; tt < 4; ++tt) { const LAS bf16_t* ap = qd + (16 * tt + l15) * 136 + 32 * (2 * kh + k2) + 4 * quad; alo[k2][tt] = *(const LAS s16x4*)ap; ahi[k2][tt] = *(const LAS s16x4*)(ap + 16); }
                __builtin_amdgcn_sched_barrier(0);
#pragma unroll
                for (int k2 = 0; k2 < 2; ++k2) {
                    const int ks = 2 * kh + k2;
                    u32x4 sw; sw.x = pk2(Sacc[2 * ks][0], Sacc[2 * ks][1]); sw.y = pk2(Sacc[2 * ks][2], Sacc[2 * ks][3]);
                    sw.z = pk2(Sacc[2 * ks + 1][0], Sacc[2 * ks + 1][1]); sw.w = pk2(Sacc[2 * ks + 1][2], Sacc[2 * ks + 1][3]);
                    const bf16x8 sb = __builtin_bit_cast(bf16x8, sw);
#pragma unroll
                    for (int tt = 0; tt < 4; ++tt) oacc[tt] = MFMA16(__builtin_shufflevector(alo[k2][tt], ahi[k2][tt], 0, 1, 2, 3, 4, 5, 6, 7), sb, oacc[tt]);
                }
                __builtin_amdgcn_sched_barrier(0);
            }
#pragma unroll
            for (int e = 0; e < 2; ++e) {
                const int tile = 2 * wave + e, tt = tile >> 2, ss = tile & 3;
                bf16x8 fa[4], fb[4];
#pragma unroll
                for (int ks = 0; ks < 4; ++ks) { fa[ks] = *(const LAS bf16x8*)(qd + (16 * tt + l15) * 136 + 32 * ks + 8 * quad); fb[ks] = *(const LAS bf16x8*)(kd + (16 * ss + l15) * 136 + 32 * ks + 8 * quad); }
                __builtin_amdgcn_sched_barrier(0);
                f32x4 sa = {0.f, 0.f, 0.f, 0.f};
#pragma unroll
                for (int ks = 0; ks < 4; ++ks) sa = MFMA16(fa[ks], fb[ks], sa);
#pragma unroll
                for (int r = 0; r < 4; ++r) { const int tg = 16 * tt + 4 * quad + r, sg_ = 16 * ss + l15; sc[tg * 72 + sg_] = f2bf(sg_ <= tg ? sa[r] : 0.f); }
                __builtin_amdgcn_sched_barrier(0);
            }
            __syncthreads();
            unsigned short gr[16];
            {
                const int cg_ = c > 0 ? c : 1;
#pragma unroll
                for (int tt = 0; tt < 4; ++tt)
#pragma unroll
                    for (int r = 0; r < 4; ++r) gr[4 * tt + r] = *(const unsigned short*)((const char*)PC + ((unsigned)(b * 2048 + (cg_ - 1) * 64 + 16 * tt + 4 * quad + r) * 8192u + (unsigned)(3072 + hd * 128 + 16 * wave + l15) * 2u));
            }
            {
#pragma unroll
                for (int dt = 0; dt < 8; ++dt) Sacc[dt] *= *(const LAS f32x4*)(ebl + 16 * dt + 4 * quad);
                __builtin_amdgcn_sched_barrier(0);
#pragma unroll
                for (int ks = 0; ks < 2; ++ks) {
                    bf16x8 fsc[4], fkl[8];
                    const bf16x8 vb = *(const LAS bf16x8*)(vT + (16 * wave + l15) * 72 + 32 * ks + 8 * quad);
#pragma unroll
                    for (int tt = 0; tt < 4; ++tt) fsc[tt] = *(const LAS bf16x8*)(sc + (16 * tt + l15) * 72 + 32 * ks + 8 * quad);
#pragma unroll
                    for (int dt = 0; dt < 8; ++dt) fkl[dt] = *(const LAS bf16x8*)(klT + (16 * dt + l15) * 72 + 32 * ks + 8 * quad);
                    __builtin_amdgcn_sched_barrier(0);
#pragma unroll
                    for (int tt = 0; tt < 4; ++tt) oacc[tt] = MFMA16(fsc[tt], vb, oacc[tt]);
#pragma unroll
                    for (int dt = 0; dt < 8; ++dt) Sacc[dt] = MFMA16(fkl[dt], vb, Sacc[dt]);
                    __builtin_amdgcn_sched_barrier(0);
                }
            }
#pragma unroll
            for (int tt = 0; tt < 4; ++tt)
#pragma unroll
                for (int r = 0; r < 4; ++r) {
                    float sq = oacc[tt][r] * oacc[tt][r];
                    sq += __int_as_float(__builtin_amdgcn_update_dpp(0, __float_as_int(sq), 0xB1, 0xf, 0xf, false));
                    sq += __int_as_float(__builtin_amdgcn_update_dpp(0, __float_as_int(sq), 0x4E, 0xf, 0xf, false));
                    sq += __int_as_float(__builtin_amdgcn_update_dpp(0, __float_as_int(sq), 0x141, 0xf, 0xf, false));
                    sq += __int_as_float(__builtin_amdgcn_update_dpp(0, __float_as_int(sq), 0x140, 0xf, 0xf, false));
                    if (l15 == 0) __hip_atomic_fetch_add(red + (c & 1) * 64 + 16 * tt + 4 * quad + r, sq, __ATOMIC_RELAXED, __HIP_MEMORY_SCOPE_WORKGROUP);
                }
            __syncthreads();
            if (c > 0) {
                const int dvg = hd * 128 + 16 * wave + l15;
                const float gn = ng[dvg];
#pragma unroll
                for (int tt = 0; tt < 4; ++tt)
#pragma unroll
                    for (int r = 0; r < 4; ++r) {
                        const int t = 16 * tt + 4 * quad + r;
                        const float ssum = red[(c & 1) * 64 + t];
                        const float rs = __builtin_amdgcn_rsqf(ssum * (1.0f / 128.0f) + 1e-6f);
                        const unsigned moff = (unsigned)(b * 2048 + (c - 1) * 64 + t) * 2048u + (unsigned)dvg * 2u;
                        const float gv = bf2f(gr[4 * tt + r]);
                        *(bf16_t*)((char*)MIXC + moff) = f2bf(oacc[tt][r] * rs * gn * gv * __builtin_amdgcn_rcpf(1.0f + __builtin_amdgcn_exp2f(-1.4426950408889634f * gv)));
                    }
            }
#pragma unroll
            for (int i = 0; i < 8; ++i) { lfc[i] = lfn[i]; qc[i] = qn[i]; vc[i] = vn[i]; }
        }
        __syncthreads();
    }
}

constexpr size_t HG_QDX_OFF = 67108864;
constexpr size_t HG_KLX = 0, HG_SCX = 67108864, HG_EBX = HG_SCX + 33554432, HG_META = HG_EBX + 2097152;
__device__ __forceinline__ void hgrn_prep_phase(const Params& P, LAS unsigned char* lds, int blk, int G, int wave) {
    const int lane = lane_id_v(), tid = wave * 64 + lane, l15 = lane & 15, quad = lane >> 4;
    LAS bf16_t* qd = (LAS bf16_t*)lds;
    LAS bf16_t* kd = qd + 64 * 136;
    LAS bf16_t* sc = kd + 64 * 136;
    LAS float* segtot = (LAS float*)(sc + 64 * 72);
    const unsigned short* PC = (const unsigned short*)(P.ws + OFF_BIG);
    char* ZR = (char*)(P.ws + OFF_Z);
    char* QDX = (char*)P.out + HG_QDX_OFF;
    const int dp = tid & 63, sg = tid >> 6;
    constexpr int NIT = 4096 + 8;
#define H1_DEC(it_, b_, hd_, c_) const int b_ = (it_) < 4096 ? (it_) >> 8 : 0, hd_ = (it_) < 4096 ? ((it_) >> 5) & 7 : (it_) - 4096, c_ = (it_) < 4096 ? ((it_) & 31) + 1 : 0
#define H1_OFF0(b_, hd_, c_) ((unsigned)((c_) > 0 ? (b_) * 2048 + ((c_) - 1) * 64 + 8 * sg : T + (sg >= 6 ? 8 * (sg - 6) : 0)) * 8192u + (unsigned)((hd_) * 128 + 2 * dp) * 2u)
#define H1_LOAD(it_, LF_, Q_) do { H1_DEC(it_, b__, hd__, c__); const unsigned o0_ = H1_OFF0(b__, hd__, c__); _Pragma("unroll") for (int tt_ = 0; tt_ < 8; ++tt_) { const unsigned o_ = o0_ + (unsigned)tt_ * 8192u; \
            Q_[tt_] = *(const unsigned*)((const char*)PC + o_); LF_[tt_] = *(const unsigned*)((const char*)PC + o_ + 2048u); } } while (0)
    unsigned lfc[8], qc[8];
    if (blk < NIT) H1_LOAD(blk, lfc, qc);
    for (int it = blk; it < NIT; it += G) {
        H1_DEC(it, b, hd, c);
        (void)b;
        unsigned lfn[8], qn[8];
        { const int itn = it + G < NIT ? it + G : it; H1_LOAD(itn, lfn, qn); }
        char *gQD, *gKL, *gSC, *gEB;
        if (c > 0) { const unsigned ix = (unsigned)(it >> 5) * 32u + (unsigned)(it & 31); gQD = QDX + (size_t)ix * 16384; gKL = ZR + HG_KLX + (size_t)ix * 16384; gSC = ZR + HG_SCX + (size_t)ix * 8192; gEB = ZR + HG_EBX + (size_t)ix * 512; }
        else { char* mb = ZR + HG_META + (size_t)hd * 41472; gQD = mb; gKL = mb + 16384; gSC = mb + 32768; gEB = mb + 40960; }
        {
            float cs0[8], cs1[8]; float run0 = 0.f, run1 = 0.f;
#pragma unroll
            for (int tt = 0; tt < 8; ++tt) {
                const bool ok = c > 0 || (8 * sg + tt) >= 48;
                const float l0 = ok ? 1.4426950408889634f * (float)__builtin_bit_cast(_Float16, (unsigned short)(lfc[tt] & 0xffffu)) : 0.f;
                const float l1 = ok ? 1.4426950408889634f * (float)__builtin_bit_cast(_Float16, (unsigned short)(lfc[tt] >> 16)) : 0.f;
                run0 += l0; run1 += l1; cs0[tt] = run0; cs1[tt] = run1;
            }
            segtot[sg * 128 + 2 * dp] = run0; segtot[sg * 128 + 2 * dp + 1] = run1;
            __syncthreads();
            float off0 = 0.f, off1 = 0.f, bl0 = 0.f, bl1 = 0.f;
#pragma unroll
            for (int s2 = 0; s2 < 8; ++s2) {
                const float a0 = segtot[s2 * 128 + 2 * dp], a1 = segtot[s2 * 128 + 2 * dp + 1];
                bl0 += a0; bl1 += a1; if (s2 < sg) { off0 += a0; off1 += a1; }
            }
            const float ebl0 = __builtin_amdgcn_exp2f(bl0), ebl1 = __builtin_amdgcn_exp2f(bl1);
            if (sg == 7) { *(float*)(gEB + (2 * dp) * 4) = ebl0; *(float*)(gEB + (2 * dp + 1) * 4) = ebl1; }
            float eip0 = __builtin_amdgcn_exp2f(-off0), eip1 = __builtin_amdgcn_exp2f(-off1);
            unsigned kl0[4], kl1[4];
#pragma unroll
            for (int tp = 0; tp < 4; ++tp) {
                float klv0[2], klv1[2];
#pragma unroll
                for (int e = 0; e < 2; ++e) {
                    const int tt = 2 * tp + e, t = 8 * sg + tt;
                    const bool ok = c > 0 || t >= 48;
                    const float bt0 = off0 + cs0[tt], bt1 = off1 + cs1[tt];
                    const float q0 = ok ? bflo(qc[tt]) : 0.f, q1 = ok ? bfhi(qc[tt]) : 0.f;
                    const float eb0 = __builtin_amdgcn_exp2f(bt0), eb1 = __builtin_amdgcn_exp2f(bt1);
                    const float ei0 = __builtin_amdgcn_rcpf(eb0), ei1 = __builtin_amdgcn_rcpf(eb1);
                    const float k0 = 1.0f - eb0 * eip0, k1 = 1.0f - eb1 * eip1;
                    eip0 = ei0; eip1 = ei1;
                    const float kd0 = k0 * ei0, kd1 = k1 * ei1;
                    const unsigned qw = pk2(q0 * eb0, q1 * eb1);
                    *(LAS unsigned*)(qd + t * 136 + 2 * dp) = qw;
                    *(unsigned*)(gQD + (unsigned)(t * 128 + 2 * dp) * 2u) = qw;
                    *(LAS unsigned*)(kd + t * 136 + 2 * dp) = pk2(kd0, kd1);
                    klv0[e] = kd0 * ebl0; klv1[e] = kd1 * ebl1;
                }
                kl0[tp] = pk2(klv0[0], klv0[1]); kl1[tp] = pk2(klv1[0], klv1[1]);
            }
            *(u32x4*)(gKL + (unsigned)((2 * dp) * 64 + 8 * sg) * 2u) = (u32x4){kl0[0], kl0[1], kl0[2], kl0[3]};
            *(u32x4*)(gKL + (unsigned)((2 * dp + 1) * 64 + 8 * sg) * 2u) = (u32x4){kl1[0], kl1[1], kl1[2], kl1[3]};
        }
        __syncthreads();
#pragma unroll
        for (int e = 0; e < 2; ++e) {
            const int tile = 2 * wave + e, tt = tile >> 2, ss = tile & 3;
            bf16x8 fa[4], fb[4];
#pragma unroll
            for (int ks = 0; ks < 4; ++ks) { fa[ks] = *(const LAS bf16x8*)(qd + (16 * tt + l15) * 136 + 32 * ks + 8 * quad); fb[ks] = *(const LAS bf16x8*)(kd + (16 * ss + l15) * 136 + 32 * ks + 8 * quad); }
            __builtin_amdgcn_sched_barrier(0);
            f32x4 sa = {0.f, 0.f, 0.f, 0.f};
#pragma unroll
            for (int ks = 0; ks < 4; ++ks) sa = MFMA16(fa[ks], fb[ks], sa);
#pragma unroll
            for (int r = 0; r < 4; ++r) { const int tg = 16 * tt + 4 * quad + r, sg_ = 16 * ss + l15; sc[tg * 72 + sg_] = f2bf(sg_ <= tg ? sa[r] : 0.f); }
            __builtin_amdgcn_sched_barrier(0);
        }
        __syncthreads();
        { const int row = tid >> 3, seg = tid & 7; *(u32x4*)(gSC + (unsigned)(row * 64 + seg * 8) * 2u) = *(const LAS u32x4*)(sc + row * 72 + seg * 8); }
#pragma unroll
        for (int i = 0; i < 8; ++i) { lfc[i] = lfn[i]; qc[i] = qn[i]; }
    }
    __syncthreads();
}
__device__ __forceinline__ void hgrn_core_phase(const Params& P, LAS unsigned char* lds, int blk, int G, int wave) {
    const int lane = lane_id_v(), tid = wave * 64 + lane, l15 = lane & 15, quad = lane >> 4;
    LAS bf16_t* qd = (LAS bf16_t*)lds;
    LAS bf16_t* klT = qd + 64 * 136;
    LAS bf16_t* vT = klT + 128 * 72;
    LAS bf16_t* sc = vT + 128 * 72;
    LAS float* ebl = (LAS float*)(sc + 64 * 72);
    LAS float* red = ebl + 128;
    const unsigned short* PC = (const unsigned short*)(P.ws + OFF_BIG);
    const char* ZR = (const char*)(P.ws + OFF_Z);
    const char* QDX = (const char*)P.out + HG_QDX_OFF;
    bf16_t* MIXC = (bf16_t*)P.out;
    const float* ng = P.in[16];
    const int dp = tid & 63, sg = tid >> 6;
    for (int item = blk; item < 128; item += G) {
        const int b = item >> 3, hd = item & 7;
        f32x4 Sacc[8];
#pragma unroll
        for (int i = 0; i < 8; ++i) Sacc[i] = (f32x4){0.f, 0.f, 0.f, 0.f};
        u32x4 rq[2], rk[2], rs, re; unsigned rv[8];
#define H2_LOAD(cc_) do { const char *gQD_, *gKL_, *gSC_, *gEB_; \
            if ((cc_) > 0) { const unsigned ix_ = (unsigned)item * 32u + (unsigned)((cc_) - 1); gQD_ = QDX + (size_t)ix_ * 16384; gKL_ = ZR + HG_KLX + (size_t)ix_ * 16384; gSC_ = ZR + HG_SCX + (size_t)ix_ * 8192; gEB_ = ZR + HG_EBX + (size_t)ix_ * 512; } \
            else { const char* mb_ = ZR + HG_META + (size_t)hd * 41472; gQD_ = mb_; gKL_ = mb_ + 16384; gSC_ = mb_ + 32768; gEB_ = mb_ + 40960; } \
            rq[0] = *(const u32x4*)(gQD_ + tid * 16); rq[1] = *(const u32x4*)(gQD_ + 8192 + tid * 16); \
            rk[0] = *(const u32x4*)(gKL_ + tid * 16); rk[1] = *(const u32x4*)(gKL_ + 8192 + tid * 16); \
            rs = *(const u32x4*)(gSC_ + tid * 16); re = *(const u32x4*)(gEB_ + (tid & 31) * 16); \
            const unsigned o0_ = (unsigned)((cc_) > 0 ? b * 2048 + ((cc_) - 1) * 64 + 8 * sg : T + (sg >= 6 ? 8 * (sg - 6) : 0)) * 8192u + (unsigned)(2048 + hd * 128 + 2 * dp) * 2u; \
            _Pragma("unroll") for (int tt_ = 0; tt_ < 8; ++tt_) rv[tt_] = *(const unsigned*)((const char*)PC + o0_ + (unsigned)tt_ * 8192u); } while (0)
        H2_LOAD(0);
        for (int c = 0; c < 33; ++c) {
            {
#pragma unroll
                for (int j = 0; j < 2; ++j) { const int e = tid * 8 + j * 4096; *(LAS u32x4*)(qd + (e >> 7) * 136 + (e & 127)) = rq[j]; *(LAS u32x4*)(klT + (e >> 6) * 72 + (e & 63)) = rk[j]; }
                { const int e = tid * 8; *(LAS u32x4*)(sc + (e >> 6) * 72 + (e & 63)) = rs; }
                if (tid < 32) *(LAS u32x4*)(ebl + tid * 4) = re;
                unsigned v0[4], v1[4];
#pragma unroll
                for (int tp = 0; tp < 4; ++tp) {
                    const bool okA = c > 0 || (8 * sg + 2 * tp) >= 48, okB = c > 0 || (8 * sg + 2 * tp + 1) >= 48;
                    const unsigned va = okA ? rv[2 * tp] : 0u, vb = okB ? rv[2 * tp + 1] : 0u;
                    v0[tp] = (va & 0xffffu) | (vb << 16); v1[tp] = (va >> 16) | (vb & 0xffff0000u);
                }
                *(LAS u32x4*)(vT + (2 * dp) * 72 + 8 * sg) = (u32x4){v0[0], v0[1], v0[2], v0[3]};
                *(LAS u32x4*)(vT + (2 * dp + 1) * 72 + 8 * sg) = (u32x4){v1[0], v1[1], v1[2], v1[3]};
            }
            __syncthreads();
            { const int cn = c + 1 < 33 ? c + 1 : 32; H2_LOAD(cn); }
            unsigned short gr[16];
            {
                const int cg_ = c > 0 ? c : 1;
#pragma unroll
                for (int tt = 0; tt < 4; ++tt)
#pragma unroll
                    for (int r = 0; r < 4; ++r) gr[4 * tt + r] = *(const unsigned short*)((const char*)PC + ((unsigned)(b * 2048 + (cg_ - 1) * 64 + 16 * tt + 4 * quad + r) * 8192u + (unsigned)(3072 + hd * 128 + 16 * wave + l15) * 2u));
            }
            f32x4 oacc[4];
#pragma unroll
            for (int i = 0; i < 4; ++i) oacc[i] = (f32x4){0.f, 0.f, 0.f, 0.f};
#pragma unroll
            for (int kh = 0; kh < 2; ++kh) {
                s16x4 alo[2][4], ahi[2][4];
#pragma unroll
                for (int k2 = 0; k2 < 2; ++k2)
#pragma unroll
                    for (int tt = 0; tt < 4; ++tt) { const LAS bf16_t* ap = qd + (16 * tt + l15) * 136 + 32 * (2 * kh + k2) + 4 * quad; alo[k2][tt] = *(const LAS s16x4*)ap; ahi[k2][tt] = *(const LAS s16x4*)(ap + 16); }
                __builtin_amdgcn_sched_barrier(0);
#pragma unroll
                for (int k2 = 0; k2 < 2; ++k2) {
                    const int ks = 2 * kh + k2;
                    u32x4 sw; sw.x = pk2(Sacc[2 * ks][0], Sacc[2 * ks][1]); sw.y = pk2(Sacc[2 * ks][2], Sacc[2 * ks][3]);
                    sw.z = pk2(Sacc[2 * ks + 1][0], Sacc[2 * ks + 1][1]); sw.w = pk2(Sacc[2 * ks + 1][2], Sacc[2 * ks + 1][3]);
                    const bf16x8 sb = __builtin_bit_cast(bf16x8, sw);
#pragma unroll
                    for (int tt = 0; tt < 4; ++tt) oacc[tt] = MFMA16(__builtin_shufflevector(alo[k2][tt], ahi[k2][tt], 0, 1, 2, 3, 4, 5, 6, 7), sb, oacc[tt]);
                }
                __builtin_amdgcn_sched_barrier(0);
            }
            {
#pragma unroll
                for (int dt = 0; dt < 8; ++dt) Sacc[dt] *= *(const LAS f32x4*)(ebl + 16 * dt + 4 * quad);
                __builtin_amdgcn_sched_barrier(0);
#pragma unroll
                for (int ks = 0; ks < 2; ++ks) {
                    bf16x8 fsc[4], fkl[8];
                    const bf16x8 vb = *(const LAS bf16x8*)(vT + (16 * wave + l15) * 72 + 32 * ks + 8 * quad);
#pragma unroll
                    for (int tt = 0; tt < 4; ++tt) fsc[tt] = *(const LAS bf16x8*)(sc + (16 * tt + l15) * 72 + 32 * ks + 8 * quad);
#pragma unroll
                    for (int dt = 0; dt < 8; ++dt) fkl[dt] = *(const LAS bf16x8*)(klT + (16 * dt + l15) * 72 + 32 * ks + 8 * quad);
                    __builtin_amdgcn_sched_barrier(0);
#pragma unroll
                    for (int tt = 0; tt < 4; ++tt) oacc[tt] = MFMA16(fsc[tt], vb, oacc[tt]);
#pragma unroll
                    for (int dt = 0; dt < 8; ++dt) Sacc[dt] = MFMA16(fkl[dt], vb, Sacc[dt]);
                    __builtin_amdgcn_sched_barrier(0);
                }
            }
#pragma unroll
            for (int tt = 0; tt < 4; ++tt)
#pragma unroll
                for (int r = 0; r < 4; ++r) {
                    float sq = oacc[tt][r] * oacc[tt][r];
                    sq += __int_as_float(__builtin_amdgcn_update_dpp(0, __float_as_int(sq), 0xB1, 0xf, 0xf, false));
                    sq += __int_as_float(__builtin_amdgcn_update_dpp(0, __float_as_int(sq), 0x4E, 0xf, 0xf, false));
                    sq += __int_as_float(__builtin_amdgcn_update_dpp(0, __float_as_int(sq), 0x141, 0xf, 0xf, false));
                    sq += __int_as_float(__builtin_amdgcn_update_dpp(0, __float_as_int(sq), 0x140, 0xf, 0xf, false));
                    if (l15 == 0) red[(16 * tt + 4 * quad + r) * 8 + wave] = sq;
                }
            __syncthreads();
            if (c > 0) {
                const int dvg = hd * 128 + 16 * wave + l15;
                const float gn = ng[dvg];
#pragma unroll
                for (int tt = 0; tt < 4; ++tt)
#pragma unroll
                    for (int r = 0; r < 4; ++r) {
                        const int t = 16 * tt + 4 * quad + r;
                        const f32x4 r0 = *(const LAS f32x4*)(red + t * 8), r1 = *(const LAS f32x4*)(red + t * 8 + 4);
                        const float ssum = ((r0[0] + r0[1]) + (r0[2] + r0[3])) + ((r1[0] + r1[1]) + (r1[2] + r1[3]));
                        const float rs_ = __builtin_amdgcn_rsqf(ssum * (1.0f / 128.0f) + 1e-6f);
                        const unsigned moff = (unsigned)(b * 2048 + (c - 1) * 64 + t) * 2048u + (unsigned)dvg * 2u;
                        const float gv = bf2f(gr[4 * tt + r]);
                        *(bf16_t*)((char*)MIXC + moff) = f2bf(oacc[tt][r] * rs_ * gn * gv * __builtin_amdgcn_rcpf(1.0f + __builtin_amdgcn_exp2f(-1.4426950408889634f * gv)));
                    }
            }
        }
        __syncthreads();
    }
}

__global__ void __launch_bounds__(512, 2) fwd_megakernel(Params P) {
    extern __shared__ __attribute__((aligned(16))) unsigned char lds_raw[];
    LAS unsigned char* lds = (LAS unsigned char*)lds_raw;
    cg::grid_group grid = cg::this_grid();
    const int blk = blockIdx.x, G = gridDim.x, wave = __builtin_amdgcn_readfirstlane((int)(threadIdx.x >> 6));
    unsigned char* ws = P.ws;
    bf16_t* HB = (bf16_t*)(ws + OFF_HB);
    float* Z = (float*)(ws + OFF_Z);
    bf16_t* PROJ = (bf16_t*)(ws + OFF_BIG + BIG_PROJ);
    bf16_t* APRE = (bf16_t*)(ws + OFF_BIG + BIG_APRE);
    bf16_t* CAT = (bf16_t*)(ws + OFF_BIG + BIG_CAT);
    bf16_t* HID = (bf16_t*)(ws + OFF_BIG);
    unsigned short* PC = (unsigned short*)(ws + OFF_BIG);

    volatile LAS unsigned* xst = (volatile LAS unsigned*)(lds + 131072);
    if (wave == 0 && lane_id_v() < 4) xst[lane_id_v()] = 0u;
    __syncthreads();
    const XcdBarrier xb = xcd_barrier_post((unsigned*)(ws + OFF_BAR), xst, wave);
    prologue_phase(P, lds, blk, G, wave);
#if PROBE_DUP_PRO
    __syncthreads();
    prologue_phase(P, lds, blk, G, wave);
#endif
    if (G == 0x7fffffff) grid.sync();
    xcd_barrier(xb, wave);
    run_gemm(lds, HB, (const bf16_t*)(ws + OFF_WAB), 2048, 1024, EpInAB{PROJ}, true, blk, G, wave);
#if PROBE_GEMMS
    __syncthreads();
    run_gemm(lds, HB, (const bf16_t*)(ws + OFF_WAB), 2048, 1024, EpInAB{PROJ}, true, blk, G, wave);
#endif
    xcd_barrier(xb, wave);
    if (wave >= 4) weight_items(P, (LAS float*)(lds + 51200 + (wave - 4) * 8448), blk * 4 + (wave - 4), G * 4, lane_id_v(), 1);
    s5_phase(P, lds, blk, G, wave);
    __syncthreads();
#if PROBE_DUP_S5
    s5_phase(P, lds, blk, G, wave);
    __syncthreads();
#endif
    attn_phase2(P, lds, blk, G, wave);
#if PROBE_DUP_ATTN
    attn_phase2(P, lds, blk, G, wave);
#endif
    xcd_barrier(xb, wave);
    run_gemm(lds, APRE, (const bf16_t*)(ws + OFF_WGLU), 512, 512, EpGlu{APRE, P.in[12], CAT}, true, blk, G, wave);
    xcd_barrier(xb, wave);
    float* ST = (float*)(ws + OFF_ST); const float* SV = (const float*)(ws + OFF_SV); const float* TV = (const float*)(ws + OFF_TV);
    float *ST1 = ST, *ST2 = ST + 2 * (size_t)R, *ST3 = ST + 4 * (size_t)R, *ST4 = ST + 6 * (size_t)R;
#if PROBE_DUP_OUTAB
    run_gemm(lds, CAT, (const bf16_t*)(ws + OFF_WOAB), 1024, 1024, EpRes<NB_OUTAB>{HB, nullptr, nullptr, nullptr, nullptr, ST + 8 * (size_t)R}, true, blk, G, wave);
    __syncthreads();
#endif
    run_gemm(lds, CAT, (const bf16_t*)(ws + OFF_WOAB), 1024, 1024, EpRes<NB_OUTAB>{HB, nullptr, nullptr, nullptr, nullptr, ST1}, true, blk, G, wave);
    xcd_barrier(xb, wave);
    run_gemm(lds, HB, (const bf16_t*)(ws + OFF_WUP0), 4096, 1024, EpUp{HID, P.in[21], ST1, SV, TV}, true, blk, G, wave);
#if PROBE_DUP_UP0
    __syncthreads();
    run_gemm(lds, HB, (const bf16_t*)(ws + OFF_WUP0), 4096, 1024, EpUp{HID, P.in[21], ST1, SV, TV}, true, blk, G, wave);
#endif
#if PROBE_SYNCS
    for (int i_ = 0; i_ < PROBE_SYNCS; ++i_) xcd_barrier(xb, wave);
#endif
    xcd_barrier(xb, wave);
#if PROBE_GEMMS
    run_gemm(lds, HID, (const bf16_t*)(ws + OFF_WDN0), 1024, 4096, EpInAB{(bf16_t*)P.out}, false, blk, G, wave);
    __syncthreads();
#endif
    run_gemm(lds, HID, (const bf16_t*)(ws + OFF_WDN0), 1024, 4096, EpRes<NB_DN0>{HB, P.in[23], ST1, P.in[18], P.in[19], ST2}, true, blk, G, wave);
    xcd_barrier(xb, wave);
    run_gemm(lds, HB, (const bf16_t*)(ws + OFF_WC), 4096, 1024, EpInC{PC, P.in[15], ST2, SV + 4096, TV + 4096}, true, blk, G, wave);
#if PROBE_DUP_INC
    __syncthreads();
    run_gemm(lds, HB, (const bf16_t*)(ws + OFF_WC), 4096, 1024, EpInC{PC, P.in[15], ST2, SV + 4096, TV + 4096}, true, blk, G, wave);
#endif
    xcd_barrier(xb, wave);
#if HGRN_TWO_PHASE
    hgrn_prep_phase(P, lds, blk, G, wave);
    xcd_barrier(xb, wave);
    hgrn_core_phase(P, lds, blk, G, wave);
#else
    hgrn_phase(P, lds, blk, G, wave);
#endif
    xcd_barrier(xb, wave);
    run_gemm(lds, (const bf16_t*)P.out  , (const bf16_t*)(ws + OFF_WOC), 1024, 1024, EpRes<NB_OUTC>{HB, nullptr, ST2, P.in[24], P.in[25], ST3}, false, blk, G, wave);
    xcd_barrier(xb, wave);
    run_gemm(lds, HB, (const bf16_t*)(ws + OFF_WUP1), 4096, 1024, EpUp{HID, P.in[21] + 4096, ST3, SV + 8192, TV + 8192}, false, blk, G, wave);
    xcd_barrier(xb, wave);
    run_gemm(lds, HID, (const bf16_t*)(ws + OFF_WDN1), 1024, 4096, EpRes<NB_DN1>{HB, P.in[23] + 1024, ST3, P.in[18] + 1024, P.in[19] + 1024, ST4}, false, blk, G, wave);
    xcd_barrier(xb, wave);
    final_ln_phase(HB, ST4, P.out, P.in[24] + 1024, P.in[25] + 1024, blk, G, wave);
}

extern "C" void kernel_launch(void* const* d_in, const int* in_sizes, int n_in, void* d_out, int out_size, void* d_ws, size_t ws_size, hipStream_t stream) {
    constexpr size_t kDynLds = 131072 + 256;
    static int grid_blocks = 0;
    if (!grid_blocks) {
        if (n_in != 26 || ws_size < ZERO_END) { fprintf(stderr, "kernel_launch: expected 26 inputs and >= %zu bytes of workspace (got %d, %zu)\n", (size_t)ZERO_END, n_in, ws_size); grid_blocks = -1; return; }
        int dev = 0, cus = 0, per_cu = 0;
        hipGetDevice(&dev);
        hipDeviceGetAttribute(&cus, hipDeviceAttributeMultiprocessorCount, dev);
        hipFuncSetAttribute((const void*)fwd_megakernel, hipFuncAttributeMaxDynamicSharedMemorySize, (int)kDynLds);
        hipOccupancyMaxActiveBlocksPerMultiprocessor(&per_cu, (const void*)fwd_megakernel, 512, kDynLds);
        if (per_cu < 1) { fprintf(stderr, "kernel_launch: occupancy query says %d blocks per CU\n", per_cu); per_cu = 1; }
        grid_blocks = cus * (per_cu > 1 ? 1 : per_cu);
        if (grid_blocks != 256) fprintf(stderr, "kernel_launch: note: grid is %d workgroups (tuned for 256)\n", grid_blocks);
    }
    if (grid_blocks < 1) return;
    Params p{};
    for (int i = 0; i < 26; ++i) p.in[i] = (const float*)d_in[i];
    p.out = (float*)d_out; p.ws = (unsigned char*)d_ws;
    hipMemsetAsync((char*)d_ws + OFF_ST, 0, ZERO_END - OFF_ST, stream);
    void* args[] = {&p};
    hipError_t e = hipLaunchCooperativeKernel((const void*)fwd_megakernel, dim3(grid_blocks), dim3(512), args, kDynLds, stream);
    if (e != hipSuccess) fprintf(stderr, "cooperative launch failed: %s (grid %d)\n", hipGetErrorString(e), grid_blocks);
}
```
